# Optimizing an MI355X kernel written in HIP

```python
import jax, jax.numpy as jnp
from jax import lax
import numpy as np


D_MODEL = 1024
BATCH = 4
SEQ = 8192
DEPTH = 4

CTX_LEN = 256
GRID_W = 64
N_EVEN = (DEPTH + 1) // 2
N_ODD = DEPTH // 2
EPS = 1e-6

HG_HEADS = 4
HG_DK = 128
HG_DV = 128
HG_W = HG_HEADS * HG_DV
ML_HEADS = 4
ML_DQK = 64
ML_DV = 128
ML_W = ML_HEADS * ML_DV
ML_FGATE_BIAS = 3.0
REC_CHUNK = 64
ROPE_BASE = 10000.0
REC_COLS = (HG_HEADS * HG_DK, HG_HEADS * HG_DK, HG_HEADS * HG_DK, HG_W, HG_W,
            ML_HEADS * ML_DQK, ML_HEADS * ML_DQK, ML_W, ML_W,
            ML_HEADS, ML_HEADS, ML_HEADS, ML_HEADS)
REC_P = sum(REC_COLS)

NA_HEADS = 16
NA_DH = 64
NA_W = NA_HEADS * NA_DH
NA_KR = 8
NA_KC = 16

N_EXPERTS = 32
TOP_K = 4
D_FF = 1024
SWIGLU_LIMIT = 7.0
SWIGLU_ALPHA = 1.702

kernel_name = 'hybrid_hgrn2_mlstm_natten_moe_dit'

F32 = jnp.float32


def rmsnorm(x, g):
    xf = x.astype(F32)
    y = xf * lax.rsqrt(jnp.mean(xf * xf, axis=-1, keepdims=True) + EPS)
    return (y * g.astype(F32)).astype(x.dtype)


def split_cols(p, sizes):
    idx = np.cumsum(np.array(sizes))[:-1].tolist()
    return jnp.split(p, idx, axis=-1)


def to_heads(a, n_heads):
    b, t, _ = a.shape
    return a.reshape(b, t, n_heads, -1).transpose(0, 2, 1, 3)


def from_heads(a):
    b, h, t, d = a.shape
    return a.transpose(0, 2, 1, 3).reshape(b, t, h * d)


def head_norm(o, g):
    return rmsnorm(o, g.reshape(o.shape[1], 1, o.shape[3]))


def axial_rope(x, n_tok):
    d = x.shape[-1]
    half, quarter = d // 2, d // 4
    pos = jnp.arange(n_tok)
    row = (pos // GRID_W).astype(F32)
    col = (pos % GRID_W).astype(F32)
    inv = ROPE_BASE ** (-jnp.arange(quarter, dtype=F32) / quarter)

    def rot(xa, p):
        ang = p[:, None] * inv[None, :]
        cs, sn = jnp.cos(ang), jnp.sin(ang)
        xa = xa.astype(F32)
        x1, x2 = xa[..., :quarter], xa[..., quarter:]
        return jnp.concatenate([x1 * cs - x2 * sn, x2 * cs + x1 * sn], axis=-1)

    out = jnp.concatenate([rot(x[..., :half], row), rot(x[..., half:], col)], axis=-1)
    return out.astype(x.dtype)


def _chunks(a, L):
    b, h, t = a.shape[:3]
    return jnp.moveaxis(a.reshape((b, h, t // L, L) + a.shape[3:]), 2, 0)


def _unchunk(a):
    n, b, h, L = a.shape[:4]
    return jnp.moveaxis(a, 0, 2).reshape((b, h, n * L) + a.shape[4:])


def gla_chunk_scan(inputs, S0):
    q, k, loga, v = inputs
    L = REC_CHUNK
    causal = jnp.tril(jnp.ones((L, L), bool))

    def step(S, blk):
        qb, kb, ab, vb = blk
        b = jnp.cumsum(ab, axis=2)
        diff = b[:, :, :, None, :] - b[:, :, None, :, :]
        decay = jnp.exp(jnp.where(causal[:, :, None], diff, -jnp.inf))
        att = jnp.sum(qb[:, :, :, None, :] * kb[:, :, None, :, :] * decay, axis=-1)
        o = (jnp.einsum('bhts,bhsv->bhtv', att, vb)
             + jnp.einsum('bhtd,bhdv->bhtv', qb * jnp.exp(b), S))
        b_end = b[:, :, -1:, :]
        S = (jnp.exp(b_end[:, :, 0, :, None]) * S
             + jnp.einsum('bhsd,bhsv->bhdv', kb * jnp.exp(b_end - b), vb))
        return S, o

    S, o = lax.scan(step, S0, tuple(_chunks(a, L) for a in (q, k, loga, v)))
    return _unchunk(o), S


def mlstm_chunk_scan(inputs, state0):
    q, k, v, ig, lf = inputs
    L = REC_CHUNK
    causal = jnp.tril(jnp.ones((L, L), bool))

    def step(state, blk):
        C, n, m = state
        qb, kb, vb, ib, fb = blk
        b = jnp.cumsum(fb, axis=-1)
        logw = jnp.where(causal, b[..., :, None] - b[..., None, :] + ib[..., None, :], -jnp.inf)
        log_inter = b + m[..., None]
        m_t = jnp.maximum(log_inter, jnp.max(logw, axis=-1))
        w = jnp.exp(logw - m_t[..., None])
        w_inter = jnp.exp(log_inter - m_t)
        att = jnp.einsum('bhtd,bhsd->bhts', qb, kb) * w
        num = (jnp.einsum('bhts,bhsv->bhtv', att, vb)
               + w_inter[..., None] * jnp.einsum('bhtd,bhdv->bhtv', qb, C))
        den = jnp.sum(att, axis=-1) + w_inter * jnp.einsum('bhtd,bhd->bht', qb, n)
        h = num / jnp.maximum(jnp.abs(den), jnp.exp(-m_t))[..., None]
        b_end = b[..., -1]
        log_k = b_end[..., None] - b + ib
        m_new = jnp.maximum(b_end + m, jnp.max(log_k, axis=-1))
        wk = jnp.exp(log_k - m_new[..., None])
        wc = jnp.exp(b_end + m - m_new)
        C = wc[..., None, None] * C + jnp.einsum('bhs,bhsd,bhsv->bhdv', wk, kb, vb)
        n = wc[..., None] * n + jnp.einsum('bhs,bhsd->bhd', wk, kb)
        return (C, n, m_new), h

    state, h = lax.scan(step, state0, tuple(_chunks(a, L) for a in (q, k, v, ig, lf)))
    return _unchunk(h), state


def bidir_scan(scan_fn, ctx_f, ctx_b, lat_f, lat_b, state0):
    rev = lambda xs: tuple(jnp.flip(a, axis=2) for a in xs)
    oc_f, sc_f = scan_fn(ctx_f, state0)
    o_f, _ = scan_fn(lat_f, sc_f)
    oc_b, sc_b = scan_fn(rev(ctx_b), state0)
    o_b, _ = scan_fn(rev(lat_b), sc_b)
    return o_f + jnp.flip(o_b, axis=2), oc_f + jnp.flip(oc_b, axis=2)


def hgrn_gates(f_pre, lb):
    log_f = jnp.logaddexp(jnp.log(lb), jnp.log1p(-lb) + jax.nn.log_sigmoid(f_pre))
    key = (1.0 - lb) * jax.nn.sigmoid(-f_pre)
    return key, log_f


def rec_streams(p, n_tok, lb, rotate):
    (hq, hf_f, hf_b, hi, hg, mq, mk, mv, mo, mi_f, mf_f, mi_b, mf_b) = split_cols(p.astype(F32), REC_COLS)
    q = to_heads(jax.nn.silu(hq), HG_HEADS) * HG_DK ** -0.5
    k_f, la_f = hgrn_gates(to_heads(hf_f, HG_HEADS), lb)
    k_b, la_b = hgrn_gates(to_heads(hf_b, HG_HEADS), lb)
    v = to_heads(hi, HG_HEADS)
    mq = to_heads(mq, ML_HEADS)
    mk = to_heads(mk, ML_HEADS) * ML_DQK ** -0.5
    if rotate:
        mq = axial_rope(mq, n_tok)
        mk = axial_rope(mk, n_tok)
    mv = to_heads(mv, ML_HEADS)
    gt = lambda a: a.transpose(0, 2, 1)
    ml_f = (mq, mk, mv, gt(mi_f), jax.nn.log_sigmoid(gt(mf_f)))
    ml_b = (mq, mk, mv, gt(mi_b), jax.nn.log_sigmoid(gt(mf_b)))
    return (q, k_f, la_f, v), (q, k_b, la_b, v), ml_f, ml_b, hg, mo


def rec_mixer(h, hc, w_in, b_in, w_out, lb, hg_g, ml_g):
    bsz = h.shape[0]
    lat = rec_streams(h @ w_in + b_in, h.shape[1], lb, True)
    ctx = rec_streams(hc @ w_in + b_in, hc.shape[1], lb, False)
    s0 = jnp.zeros((bsz, HG_HEADS, HG_DK, HG_DV), F32)
    o_hg, oc_hg = bidir_scan(gla_chunk_scan, ctx[0], ctx[1], lat[0], lat[1], s0)
    m0 = (jnp.zeros((bsz, ML_HEADS, ML_DQK, ML_DV), F32),
          jnp.zeros((bsz, ML_HEADS, ML_DQK), F32),
          jnp.zeros((bsz, ML_HEADS), F32))
    o_ml, oc_ml = bidir_scan(mlstm_chunk_scan, ctx[2], ctx[3], lat[2], lat[3], m0)

    def merge(a_hg, a_ml, g_hg, g_ml):
        ya = from_heads(head_norm(a_hg, hg_g)) * jax.nn.silu(g_hg)
        yb = from_heads(head_norm(a_ml, ml_g)) * jax.nn.sigmoid(g_ml)
        return jnp.concatenate([ya, yb], axis=-1).astype(h.dtype) @ w_out

    return merge(o_hg, o_ml, lat[4], lat[5]), merge(oc_hg, oc_ml, ctx[4], ctx[5])


def neighbourhood_attention(q, k, v, kc, vc, rpb):
    bsz, nh, t, dh = q.shape
    rows = t // GRID_W
    kr = min(NA_KR, rows)
    scale = dh ** -0.5
    grid = lambda a: a.reshape(bsz, nh, rows, GRID_W, dh)
    qg, kg, vg = grid(q), grid(k), grid(v)
    cpos = jnp.arange(GRID_W)
    cstart = jnp.clip(cpos - NA_KC // 2, 0, GRID_W - NA_KC)
    col_ok = (cpos[None, :] >= cstart[:, None]) & (cpos[None, :] < cstart[:, None] + NA_KC)
    rel_c = jnp.clip(cpos[None, :] - cpos[:, None], -(NA_KC - 1), NA_KC - 1) + NA_KC - 1
    bias_c = rpb[:, :, rel_c].astype(F32)
    n_loc = kr * GRID_W

    def row_block(r):
        rs = jnp.clip(r - kr // 2, 0, rows - kr)
        kb = lax.dynamic_slice_in_dim(kg, rs, kr, axis=2)
        vb = lax.dynamic_slice_in_dim(vg, rs, kr, axis=2)
        qb = lax.dynamic_index_in_dim(qg, r, axis=2, keepdims=False)
        s_loc = jnp.einsum('bhqd,bhrkd->bhqrk', qb, kb).astype(F32) * scale
        rel_r = rs + jnp.arange(kr) - r + NA_KR - 1
        bias = bias_c[:, rel_r].transpose(0, 2, 1, 3)
        s_loc = jnp.where(col_ok[:, None, :], s_loc + bias[None], -jnp.inf)
        s_loc = s_loc.reshape(bsz, nh, GRID_W, n_loc)
        s_ctx = jnp.einsum('bhqd,bhcd->bhqc', qb, kc).astype(F32) * scale
        p = jax.nn.softmax(jnp.concatenate([s_loc, s_ctx], axis=-1), axis=-1).astype(v.dtype)
        return (jnp.einsum('bhqk,bhkd->bhqd', p[..., :n_loc], vb.reshape(bsz, nh, n_loc, dh))
                + jnp.einsum('bhqc,bhcd->bhqd', p[..., n_loc:], vc))

    out = lax.map(row_block, jnp.arange(rows))
    return out.transpose(1, 2, 0, 3, 4).reshape(bsz, nh, t, dh)


def dense_attention(q, k, v):
    s = jnp.einsum('bhqd,bhkd->bhqk', q, k).astype(F32) * q.shape[-1] ** -0.5
    p = jax.nn.softmax(s, axis=-1).astype(v.dtype)
    return jnp.einsum('bhqk,bhkd->bhqd', p, v)


def na_mixer(h, hc, w_qkv, w_out, q_g, k_g, rpb, with_ctx_out):
    def project(a):
        q, k, v = jnp.split(a @ w_qkv, 3, axis=-1)
        return to_heads(q, NA_HEADS), rmsnorm(to_heads(k, NA_HEADS), k_g), to_heads(v, NA_HEADS)

    q, k, v = project(h)
    qc, kc, vc = project(hc)
    y = from_heads(neighbourhood_attention(rmsnorm(q, q_g), k, v, kc, vc, rpb)) @ w_out
    if not with_ctx_out:
        return y, None
    yc = from_heads(dense_attention(rmsnorm(qc, q_g), kc, vc)) @ w_out
    return y, yc


def moe(h, w_r, b_r, w_gu, b_gu, w_d, b_d):
    logits = (h @ w_r + b_r).astype(F32)
    top_v, top_i = lax.top_k(logits, TOP_K)
    top_w = jax.nn.softmax(top_v, axis=-1)
    comb = jnp.sum(jax.nn.one_hot(top_i, N_EXPERTS, dtype=F32) * top_w[..., None], axis=1)

    def expert(acc, prm):
        wgu, bgu, wd, bd, wt = prm
        gu = h @ wgu + bgu
        gate = jnp.minimum(gu[:, :D_FF], SWIGLU_LIMIT)
        up = jnp.clip(gu[:, D_FF:], -SWIGLU_LIMIT, SWIGLU_LIMIT)
        act = gate * jax.nn.sigmoid(SWIGLU_ALPHA * gate) * (up + 1)
        return acc + wt[:, None].astype(h.dtype) * (act @ wd + bd), None

    out, _ = lax.scan(expert, jnp.zeros_like(h), (w_gu, b_gu, w_d, b_d, comb.T))
    return out


def setup_inputs(seed: int = 0) -> dict:
    key = jax.random.key(seed)
    ks = jax.random.split(key, 32)
    nrm = lambda k, shape, s: jax.random.normal(k, shape, F32) * s
    D = D_MODEL
    rec_b_in = nrm(ks[9], (N_EVEN, REC_P), 0.02)
    f_fwd = sum(REC_COLS[:10])
    f_bwd = sum(REC_COLS[:12])
    rec_b_in = rec_b_in.at[:, f_fwd:f_fwd + ML_HEADS].add(ML_FGATE_BIAS)
    rec_b_in = rec_b_in.at[:, f_bwd:f_bwd + ML_HEADS].add(ML_FGATE_BIAS)
    return {
        'x': nrm(ks[0], (BATCH, SEQ, D), 1.0),
        'c': nrm(ks[1], (BATCH, D), 1.0),
        'ctx': nrm(ks[2], (BATCH, CTX_LEN, D), 1.0),
        'c_ctx': nrm(ks[3], (D,), 1.0),
        'ada_w': nrm(ks[4], (DEPTH, D, 6 * D), 0.3 * D ** -0.5),
        'ada_b': nrm(ks[5], (DEPTH, 6 * D), 0.02),
        'norm_mix_g': 1.0 + nrm(ks[6], (DEPTH, D), 0.02),
        'norm_ffn_g': 1.0 + nrm(ks[7], (DEPTH, D), 0.02),
        'rec_w_in': nrm(ks[8], (N_EVEN, D, REC_P), D ** -0.5),
        'rec_b_in': rec_b_in,
        'rec_w_out': nrm(ks[10], (N_EVEN, HG_W + ML_W, D), (HG_W + ML_W) ** -0.5),
        'hgrn_lb': nrm(ks[11], (DEPTH, HG_HEADS * HG_DK), 0.5),
        'hgrn_out_g': 1.0 + nrm(ks[12], (N_EVEN, HG_W), 0.02),
        'mlstm_out_g': 1.0 + nrm(ks[13], (N_EVEN, ML_W), 0.02),
        'na_w_qkv': nrm(ks[14], (N_ODD, D, 3 * NA_W), D ** -0.5),
        'na_w_out': nrm(ks[15], (N_ODD, NA_W, D), NA_W ** -0.5),
        'na_q_g': 1.0 + nrm(ks[16], (N_ODD, NA_DH), 0.02),
        'na_k_g': 1.0 + nrm(ks[17], (N_ODD, NA_DH), 0.02),
        'na_rpb': nrm(ks[18], (N_ODD, NA_HEADS, 2 * NA_KR - 1, 2 * NA_KC - 1), 0.1),
        'moe_w_router': nrm(ks[19], (DEPTH, D, N_EXPERTS), D ** -0.5),
        'moe_b_router': nrm(ks[20], (DEPTH, N_EXPERTS), 0.01),
        'moe_w_gu': nrm(ks[21], (DEPTH, N_EXPERTS, D, 2 * D_FF), D ** -0.5),
        'moe_b_gu': nrm(ks[22], (DEPTH, N_EXPERTS, 2 * D_FF), 0.02),
        'moe_w_down': nrm(ks[23], (DEPTH, N_EXPERTS, D_FF, D), D_FF ** -0.5),
        'moe_b_down': nrm(ks[24], (DEPTH, N_EXPERTS, D), 0.02),
    }


def reference(x, c, ctx, c_ctx, ada_w, ada_b, norm_mix_g, norm_ffn_g, rec_w_in, rec_b_in, rec_w_out,
              hgrn_lb, hgrn_out_g, mlstm_out_g, na_w_qkv, na_w_out, na_q_g, na_k_g, na_rpb,
              moe_w_router, moe_b_router, moe_w_gu, moe_b_gu, moe_w_down, moe_b_down):
    bsz, t_lat, d = x.shape
    t_ctx = ctx.shape[1]
    s_c = jax.nn.silu(c)
    s_cc = jax.nn.silu(c_ctx)
    lb_w = jax.nn.softmax(hgrn_lb.astype(F32), axis=0)
    lb_all = jnp.maximum(jnp.cumsum(lb_w, axis=0) - lb_w[0], 0.0)
    xc = ctx
    for l in range(DEPTH):
        last = l == DEPTH - 1
        j = l // 2
        mod = s_c @ ada_w[l] + ada_b[l]
        modc = s_cc @ ada_w[l] + ada_b[l]
        sh1, sc1, g1, sh2, sc2, g2 = jnp.split(mod[:, None, :], 6, axis=-1)
        csh1, csc1, cg1, csh2, csc2, cg2 = jnp.split(modc, 6, axis=-1)
        h = rmsnorm(x, norm_mix_g[l]) * (1 + sc1) + sh1
        hc = rmsnorm(xc, norm_mix_g[l]) * (1 + csc1) + csh1
        if l % 2 == 0:
            lb = lb_all[l].reshape(HG_HEADS, 1, HG_DK)
            y, yc = rec_mixer(h, hc, rec_w_in[j], rec_b_in[j], rec_w_out[j], lb, hgrn_out_g[j], mlstm_out_g[j])
        else:
            y, yc = na_mixer(h, hc, na_w_qkv[j], na_w_out[j], na_q_g[j], na_k_g[j], na_rpb[j], not last)
        x = x + g1 * y
        h2 = rmsnorm(x, norm_ffn_g[l]) * (1 + sc2) + sh2
        if last:
            f = moe(h2.reshape(-1, d), moe_w_router[l], moe_b_router[l], moe_w_gu[l], moe_b_gu[l],
                    moe_w_down[l], moe_b_down[l]).reshape(bsz, t_lat, d)
            x = x + g2 * f
        else:
            xc = xc + cg1 * yc
            h2c = rmsnorm(xc, norm_ffn_g[l]) * (1 + csc2) + csh2
            tok = jnp.concatenate([h2, h2c], axis=1).reshape(-1, d)
            f = moe(tok, moe_w_router[l], moe_b_router[l], moe_w_gu[l], moe_b_gu[l],
                    moe_w_down[l], moe_b_down[l]).reshape(bsz, t_lat + t_ctx, d)
            x = x + g2 * f[:, :t_lat]
            xc = xc + cg2 * f[:, t_lat:]
    return x
```

```cpp
#include <hip/hip_runtime.h>
#include <stdint.h>
#include <stdio.h>

#ifndef MK_ONE_LAUNCH
#define MK_ONE_LAUNCH 1
#endif
#ifndef REP_PRO
#define REP_PRO 1
#endif
#ifndef REP_SCAN1
#define REP_SCAN1 1
#endif
#ifndef REP_SCAN2
#define REP_SCAN2 1
#endif
#ifndef REP_SCAN3
#define REP_SCAN3 1
#endif
#ifndef REP_ATT
#define REP_ATT 1
#endif
#ifndef REP_MOE
#define REP_MOE 1
#endif
#ifndef REP_GIN
#define REP_GIN 1
#endif
#define LAS __attribute__((address_space(3)))
#define GAS __attribute__((address_space(1)))
typedef unsigned short bf16_t;
typedef short bf16x8 __attribute__((ext_vector_type(8)));
typedef float f32x4 __attribute__((ext_vector_type(4)));
typedef float f32x2 __attribute__((ext_vector_type(2)));
typedef unsigned u32x4 __attribute__((ext_vector_type(4)));
typedef unsigned u32x2 __attribute__((ext_vector_type(2)));

constexpr int D = 1024, NB = 4, TL = 8192, TC = 256;
constexpr int RL = NB * TL;
constexpr int RC = NB * TC;
constexpr int NR = RL + RC;
constexpr int NREC = 4352;
constexpr int NE = 32, DFF = 1024;
constexpr int CAP = NR;
constexpr int SLOT_ROWS = 143360;
constexpr float EPS = 1e-6f;
constexpr int NPHASE = 42;

constexpr size_t MiB = 1u << 20;
constexpr size_t WS_CTL = 0, CTL_BYTES = 1 * MiB;
constexpr size_t WS_MOD = 1 * MiB;
constexpr size_t WS_LB = WS_MOD + 512 * 1024;
constexpr size_t WS_ROPE = WS_LB + 8 * 1024;
constexpr size_t WS_WIN = 2 * MiB;
constexpr size_t WS_WROUT = 19 * MiB;
constexpr size_t WS_WQKV = 23 * MiB;
constexpr size_t WS_WNOUT = 35 * MiB;
constexpr size_t WS_WGU = 40 * MiB;
constexpr size_t WS_WD = 552 * MiB;
constexpr size_t WS_X = 808 * MiB;
constexpr size_t WS_H = 940 * MiB;
constexpr size_t WS_MERGED = 1006 * MiB;
constexpr size_t WS_STREAM = 1072 * MiB;
constexpr size_t SZ_B512 = (size_t)NR * 512 * 2;
constexpr size_t SZ_F512 = (size_t)NR * 512 * 4;
constexpr size_t WS_Q = WS_STREAM, WS_KF = WS_Q + SZ_B512, WS_KB = WS_KF + SZ_B512, WS_V = WS_KB + SZ_B512, WS_HG = WS_V + SZ_B512;
constexpr size_t WS_MV = WS_HG + SZ_B512, WS_MO = WS_MV + SZ_B512, WS_MQ = WS_MO + SZ_B512, WS_MK = WS_MQ + SZ_B512 / 2;
constexpr size_t WS_LAF = WS_MK + SZ_B512 / 2, WS_LAB = WS_LAF + SZ_F512, WS_GATES = WS_LAB + SZ_F512;
constexpr size_t WS_OHF = WS_GATES + 3 * MiB, WS_OHB = WS_OHF + SZ_F512, WS_OMF = WS_OHB + SZ_F512, WS_OMB = WS_OMF + SZ_F512;
constexpr size_t WS_STREAM_END = WS_OMB + SZ_F512;
constexpr size_t WS_Y = WS_STREAM;
constexpr size_t WS_QKV = WS_STREAM;
constexpr int TT = TL + TC;
constexpr size_t WS_VTG = WS_STREAM + 200 * MiB;
constexpr size_t WS_SSK = WS_STREAM + 272 * MiB;
constexpr size_t WS_TOKE = 1744 * MiB, WS_TOKP = WS_TOKE + 1 * MiB, WS_TOKW = WS_TOKP + 1 * MiB, WS_LIST = WS_TOKW + 1 * MiB;
constexpr size_t WS_ACT = 1752 * MiB;
constexpr size_t WS_YS = 2032 * MiB;
constexpr size_t WS_END = 2312 * MiB;
static_assert(WS_STREAM_END <= WS_TOKE && WS_QKV + (size_t)NR * 3072 * 2 <= WS_TOKE, "stream region");
static_assert(WS_LIST + (size_t)NE * CAP * 4 <= WS_ACT && WS_ACT + (size_t)SLOT_ROWS * 1024 * 2 <= WS_YS && WS_YS + (size_t)SLOT_ROWS * 1024 * 2 <= WS_END, "moe region");
static_assert(WS_WIN + (size_t)2 * NREC * 1024 * 2 <= WS_WROUT && WS_WGU + (size_t)128 * 2048 * 1024 * 2 <= WS_WD && WS_WD + (size_t)128 * 1024 * 1024 * 2 <= WS_X, "weights");
constexpr int CW_BAR = 4096;
constexpr int CW_CNT = 16384;

constexpr int RING_BYTES = 131072;
constexpr int MISC_OFF = RING_BYTES;
constexpr int LDS_BYTES = 147456;

__device__ __forceinline__ float bf2f(unsigned b) { return __uint_as_float(b << 16); }
typedef _Float16 f16x4 __attribute__((ext_vector_type(4)));
__device__ __forceinline__ f32x4 h4_to_f4(u32x2 q) { return __builtin_convertvector(__builtin_bit_cast(f16x4, q), f32x4); }
__device__ __forceinline__ u32x2 f4_to_h4(f32x4 v) { f32x4 c; c[0] = __builtin_amdgcn_fmed3f(v[0], -65504.f, 65504.f); c[1] = __builtin_amdgcn_fmed3f(v[1], -65504.f, 65504.f); c[2] = __builtin_amdgcn_fmed3f(v[2], -65504.f, 65504.f); c[3] = __builtin_amdgcn_fmed3f(v[3], -65504.f, 65504.f);
    return __builtin_bit_cast(u32x2, __builtin_convertvector(c, f16x4)); }
__device__ __forceinline__ f32x4 ld_bf4(const bf16_t* p) { const u32x2 q = *(const u32x2*)p; return (f32x4){bf2f(q.x & 0xffffu), bf2f(q.x >> 16), bf2f(q.y & 0xffffu), bf2f(q.y >> 16)}; }
__device__ __forceinline__ unsigned f2bf(float f) { unsigned u = __float_as_uint(f); return (u + 0x7fffu + ((u >> 16) & 1u)) >> 16; }
__device__ __forceinline__ unsigned pk2(float lo, float hi) { unsigned r; asm("v_cvt_pk_bf16_f32 %0, %1, %2" : "=v"(r) : "v"(lo), "v"(hi)); return r; }
__device__ __forceinline__ float shx(float v, int o, int lane) { return __int_as_float(__builtin_amdgcn_ds_bpermute((lane ^ o) << 2, __float_as_int(v))); }
__device__ __forceinline__ int shxi(int v, int o, int lane) { return __builtin_amdgcn_ds_bpermute((lane ^ o) << 2, v); }
__device__ __forceinline__ float wave_sum(float v, int) {
    v += __int_as_float(__builtin_amdgcn_update_dpp(0, __float_as_int(v), 0xB1, 0xF, 0xF, true));
    v += __int_as_float(__builtin_amdgcn_update_dpp(0, __float_as_int(v), 0x4E, 0xF, 0xF, true));
    v += __int_as_float(__builtin_amdgcn_update_dpp(0, __float_as_int(v), 0x141, 0xF, 0xF, true));
    v += __int_as_float(__builtin_amdgcn_update_dpp(0, __float_as_int(v), 0x140, 0xF, 0xF, true));
    const float r0 = __int_as_float(__builtin_amdgcn_readlane(__float_as_int(v), 0)), r1 = __int_as_float(__builtin_amdgcn_readlane(__float_as_int(v), 16));
    const float r2 = __int_as_float(__builtin_amdgcn_readlane(__float_as_int(v), 32)), r3 = __int_as_float(__builtin_amdgcn_readlane(__float_as_int(v), 48));
    return (r0 + r1) + (r2 + r3);
}
__device__ __forceinline__ float wave_max(float v, int lane) {
#pragma unroll
    for (int o = 1; o < 64; o <<= 1) v = fmaxf(v, shx(v, o, lane));
    return v;
}
__device__ __forceinline__ int lane_id_volatile() { int l; asm volatile("v_mbcnt_lo_u32_b32 %0, -1, 0\n\tv_mbcnt_hi_u32_b32 %0, -1, %0" : "=v"(l)); return l; }
__device__ __forceinline__ float sigmoidf_(float x) { return __builtin_amdgcn_rcpf(1.0f + __builtin_amdgcn_exp2f(x * -1.4426950408889634f)); }
__device__ __forceinline__ float siluf_(float x) { return x * sigmoidf_(x); }
__device__ __forceinline__ float logsigmoidf_(float x) { return fminf(x, 0.f) - 0.6931471805599453f * __builtin_amdgcn_logf(1.0f + __builtin_amdgcn_exp2f(fabsf(x) * -1.4426950408889634f)); }
__device__ __forceinline__ int row_bidx(int r) { return r < RL ? (r >> 13) : 4; }

#define XB_TMO      128
#define XB_XCNT(j)  (256  + 64 * (j))
#define XB_XSUB(j)  (1280 + 64 * (j))
#define XB_XGEN(j)  (2304 + 64 * (j))
#define XB_TOP      3328
#define XB_TOPGEN   3392
#define XCD_BAR_WORDS 3456
#define XB_SPIN_CAP (1u << 18)
__device__ __forceinline__ unsigned xb_ld(unsigned* p)              { return __hip_atomic_load((GAS unsigned*)p, __ATOMIC_RELAXED, __HIP_MEMORY_SCOPE_AGENT); }
__device__ __forceinline__ unsigned xb_add(unsigned* p, unsigned v) { return __hip_atomic_fetch_add((GAS unsigned*)p, v, __ATOMIC_RELAXED, __HIP_MEMORY_SCOPE_AGENT); }
__device__ __forceinline__ unsigned xb_xcc_id() { return (unsigned)__builtin_amdgcn_s_getreg((3 << 11) | 20) & 0xFu; }
#define XB_SPIN(cond, bar) do { unsigned _sp = 0; while (cond) { __builtin_amdgcn_s_sleep(1); \
    if ((++_sp & 255u) == 0u) { if (xb_ld(&(bar)[XB_TMO])) break; if (_sp > XB_SPIN_CAP) { (void)xb_add(&(bar)[XB_TMO], 1u); break; } } } } while (0)
struct XcdBarrier { unsigned* bar; unsigned x; volatile LAS unsigned* st; };
__device__ __forceinline__ XcdBarrier xcd_barrier_post(unsigned* bar, volatile LAS unsigned* st) {
    XcdBarrier b; b.bar = bar; b.x = xb_xcc_id(); b.st = st;
    if (threadIdx.x == 0) (void)xb_add(&bar[XB_XCNT(b.x)], 1u);
    return b;
}
__device__ __forceinline__ void xcd_barrier_complete(unsigned* bar, unsigned x, unsigned& nloc, unsigned& nx) {
    const unsigned G = gridDim.x * gridDim.y * gridDim.z;
    unsigned sum, cnt, mine, sp = 0u;
    for (;;) {
        sum = 0u; cnt = 0u; mine = 0u;
#pragma unroll
        for (unsigned j = 0; j < 16; ++j) { const unsigned c = xb_ld(&bar[XB_XCNT(j)]); sum += c; cnt += (c > 0u) ? 1u : 0u; mine = (j == x) ? c : mine; }
        if (sum == G) break;
        __builtin_amdgcn_s_sleep(1);
        if ((++sp & 255u) == 0u) { if (xb_ld(&bar[XB_TMO])) break; if (sp > XB_SPIN_CAP) { (void)xb_add(&bar[XB_TMO], 1u); break; } }
    }
    nloc = mine > 0u ? mine : 1u; nx = cnt > 0u ? cnt : 1u;
}
__device__ __noinline__ void xcd_barrier(const XcdBarrier b) {
    asm volatile("s_waitcnt vmcnt(0)" ::: "memory");
    __syncthreads();
    if (threadIdx.x == 0) {
        unsigned* bar = b.bar;
        __builtin_amdgcn_s_waitcnt(0);
        unsigned nloc = b.st[0], nx = b.st[1];
        if (nloc == 0u) { xcd_barrier_complete(bar, b.x, nloc, nx); b.st[0] = nloc; b.st[1] = nx; }
        const unsigned old = xb_add(&bar[XB_XSUB(b.x)], 1u);
        const unsigned gen = old / nloc;
        if (old + 1u == (gen + 1u) * nloc) {
            __builtin_amdgcn_fence(__ATOMIC_RELEASE, "agent");
            asm volatile("s_waitcnt vmcnt(0)" ::: "memory");
            const unsigned og = xb_add(&bar[XB_TOP], 1u);
            const unsigned tg = og / nx;
            if (og + 1u == (tg + 1u) * nx) xb_add(&bar[XB_TOPGEN], 1u);
            else XB_SPIN(xb_ld(&bar[XB_TOPGEN]) == tg, bar);
            __builtin_amdgcn_fence(__ATOMIC_ACQUIRE, "agent");
            xb_add(&bar[XB_XGEN(b.x)], 1u);
            asm volatile("s_waitcnt vmcnt(0)" ::: "memory");
        } else {
            XB_SPIN(xb_ld(&bar[XB_XGEN(b.x)]) == gen, bar);
            __builtin_amdgcn_fence(__ATOMIC_ACQUIRE, "agent");
            asm volatile("s_waitcnt vmcnt(0)" ::: "memory");
        }
    }
    __syncthreads();
}

namespace pg8 {
constexpr int BM = 256, BK = 64, HALF = 128, HTB = HALF * BK * 2, STAGE_BYTES = 8 * HTB, NXCD = 8, WGM = 8;
__host__ __device__ __forceinline__ int lds_byte(int r, int c) { const int st = (r >> 4) * 2 + (c >> 5), rr = r & 15, cc = c & 31, ob = rr * 64 + cc * 2; return st * 1024 + (ob ^ (((ob >> 9) & 1) << 5)); }
__host__ __device__ __forceinline__ void stage_rc(int b, int& R, int& C) { const int st = b / 1024, sb = b % 1024, swz = sb ^ (((sb >> 9) & 1) << 5); R = (st >> 1) * 16 + swz / 64; C = (st & 1) * 32 + (swz % 64) / 2; }
__host__ __device__ __forceinline__ int perm32(int rho) { const int n = rho >> 4, i = rho & 15; return 8 * (i >> 2) + 4 * n + (i & 3); }
struct Unit { int pm, pn, e, mt; };
struct StaticOrder {
    int nM, nN, nwg, G, c;
    __device__ void init(int M, int N, int G_, int c_) { nM = M / BM; nN = N / BM; nwg = nM * nN; G = G_; c = c_; }
    __device__ bool next(int i, Unit& u) const {
        const long L = (long)i * G + c; if (L >= nwg) return false;
        int wgid = (int)L; { const int q = nwg / NXCD, r = nwg % NXCD, xcd = wgid % NXCD, off = wgid / NXCD; wgid = (xcd < r ? xcd * (q + 1) : r * (q + 1) + (xcd - r) * q) + off; }
        const int nig = WGM * nN, gid = wgid / nig, fm = gid * WGM, gsz = (nM - fm) < WGM ? (nM - fm) : WGM;
        u.pm = fm + ((wgid % nig) % gsz); u.pn = (wgid % nig) / gsz; u.e = 0; u.mt = 0; return true;
    }
};
struct MoeOrder {
    const LAS int* tb; int T, lg, G, c;
    __device__ bool next(int i, Unit& u) const {
        int tile, pn; const int npn = 1 << lg;
        if (G == 256) { const int x = c & 7, j = c >> 3, tpx = 32 >> lg; tile = (i * 8 + x) * tpx + (j >> lg); pn = j & (npn - 1); }
        else { const long L = (long)i * G + c; tile = (int)(L >> lg); pn = (int)(L & (npn - 1)); }
        if (tile >= T) return false;
        int ln_; asm volatile("v_mbcnt_lo_u32_b32 %0, -1, 0\n\tv_mbcnt_hi_u32_b32 %0, -1, %0" : "=v"(ln_));
        const int e = (int)__builtin_popcountll(__ballot(ln_ < 31 && tb[(ln_ < 31 ? ln_ : 31) + 1] <= tile));
        u.e = e; u.mt = tile - tb[e]; u.pm = tile; u.pn = pn; return true;
    }
};
struct RowIdentity { static constexpr bool GATHER = false; __device__ __forceinline__ int row(const Unit& u, int r) const { return r; } };
struct RowGather { static constexpr bool GATHER = true; const int* list; const LAS int* cnt; __device__ __forceinline__ int row(const Unit& u, int r) const { const int p = u.mt * BM + r; return p < cnt[u.e] ? list[(size_t)u.e * CAP + p] : 0; } };

__device__ __forceinline__ unsigned cvt_pk_bf16(float lo, float hi) { unsigned r; asm volatile("v_cvt_pk_bf16_f32 %0, %1, %2" : "=v"(r) : "v"(lo), "v"(hi)); return r; }

template <class Epi, class Sched, class AOff>
__device__ __forceinline__ void gemm_phase(LAS unsigned char* lds, const bf16_t* A, const bf16_t* Bt, const int K, const size_t estride  , const Sched& S, const Epi& E, const AOff& AO, const int tid) {
    const int wid = __builtin_amdgcn_readfirstlane(tid >> 6), lane = tid & 63, wr = wid >> 2, wc = wid & 3, fr = lane & 15, fq = lane >> 4;
    const int nt = K / BK;
    int Rr[2], Cc[2]; unsigned voffB[2];
#pragma unroll
    for (int i = 0; i < 2; ++i) { int R, C; stage_rc(tid * 16 + i * 8192, R, C); const int Rb = Epi::PERM ? ((R & ~31) + perm32(R & 31)) : R;
        Rr[i] = R; Cc[i] = C; voffB[i] = (unsigned)(Rb * K + C) * 2u; }
    const size_t kstep = (size_t)(BK * 2);
    const size_t hstep = (size_t)HALF * K * 2;
    const size_t tstep = 2 * hstep;
    const unsigned ldsw = (unsigned)wid * 1024u;
    const int aoff = lds_byte(wr * 64 + fr, fq * 8), boff = lds_byte(wc * 32 + fr, fq * 8);
#define PG8_SA(b, h) (((b) * 2 + (h)) * HTB)
#define PG8_SB(b, h) ((4 + (b) * 2 + (h)) * HTB)
#define PG8_STAGE(bufoff, gbase, voff) do { _Pragma("unroll") for (int _i = 0; _i < 2; ++_i) \
        __builtin_amdgcn_global_load_lds((const unsigned*)((const char*)(gbase) + (voff)[_i]), (LAS unsigned*)(lds + (bufoff) + ldsw + _i * 8192), 16, 0, 0); } while (0)
#define PG8_STAGE2(bufoff, gbase, v0, v1) do { \
        __builtin_amdgcn_global_load_lds((const unsigned*)((const char*)(gbase) + (v0)), (LAS unsigned*)(lds + (bufoff) + ldsw), 16, 0, 0); \
        __builtin_amdgcn_global_load_lds((const unsigned*)((const char*)(gbase) + (v1)), (LAS unsigned*)(lds + (bufoff) + ldsw + 8192), 16, 0, 0); } while (0)
#define PG8_LDA(dst, b, h) do { _Pragma("unroll") for (int m = 0; m < 4; ++m) _Pragma("unroll") for (int k = 0; k < 2; ++k) dst[m][k] = *(const LAS bf16x8*)(lds + PG8_SA(b, h) + aoff + m * 2048 + k * 1024); } while (0)
#define PG8_LDB(dst, b, h) do { _Pragma("unroll") for (int n = 0; n < 2; ++n) _Pragma("unroll") for (int k = 0; k < 2; ++k) dst[n][k] = *(const LAS bf16x8*)(lds + PG8_SB(b, h) + boff + n * 2048 + k * 1024); } while (0)
#define PG8_MMA(ai, bj, At, Bt_) do { __builtin_amdgcn_s_setprio(1); _Pragma("unroll") for (int m = 0; m < 4; ++m) _Pragma("unroll") for (int n = 0; n < 2; ++n) _Pragma("unroll") for (int k = 0; k < 2; ++k) \
        acc[ai][bj][m][n] = __builtin_amdgcn_mfma_f32_16x16x32_bf16(Bt_[n][k], At[m][k], acc[ai][bj][m][n], 0, 0, 0); __builtin_amdgcn_s_setprio(0); } while (0)
#define PG8_WAIT_V(n) asm volatile("s_waitcnt vmcnt(" #n ")" ::: "memory")
#define PG8_WAIT_L(n) asm volatile("s_waitcnt lgkmcnt(" #n ")" ::: "memory")
#define PG8_BAR __builtin_amdgcn_s_barrier()
#define PG8_SCHED __builtin_amdgcn_sched_barrier(0)
#define PG8_AOFFS(dst, u) do { _Pragma("unroll") for (int _h = 0; _h < 2; ++_h) _Pragma("unroll") for (int _i = 0; _i < 2; ++_i) \
        dst[_h][_i] = ((unsigned)AO.row(u, _h * HALF + Rr[_i]) * (unsigned)K + (unsigned)Cc[_i]) * 2u; } while (0)
    Unit cur, nxt; int ui = 0;
    if (!S.next(0, cur)) return;
    f32x4 acc[2][2][4][2];
#pragma unroll
    for (int a = 0; a < 2; ++a)
#pragma unroll
        for (int b = 0; b < 2; ++b)
#pragma unroll
            for (int m = 0; m < 4; ++m)
#pragma unroll
                for (int n = 0; n < 2; ++n) acc[a][b][m][n] = (f32x4){0.f, 0.f, 0.f, 0.f};
    bf16x8 At[4][2], B0[2][2], B1[2][2];
    unsigned vc[2][2], vn[2][2];
    PG8_AOFFS(vc, cur);
    const char* Ab = (const char*)A;
    const char* aC = AOff::GATHER ? Ab : Ab + (size_t)cur.pm * tstep;
    const char* cB = (const char*)Bt + (size_t)cur.e * estride + (size_t)cur.pn * tstep;
    PG8_STAGE(PG8_SB(0, 0), cB, voffB); PG8_STAGE2(PG8_SA(0, 0), aC, vc[0][0], vc[0][1]); PG8_STAGE(PG8_SB(0, 1), cB + hstep, voffB); PG8_STAGE2(PG8_SA(0, 1), aC, vc[1][0], vc[1][1]);
    if (wr == 1) PG8_BAR;
    PG8_WAIT_V(4); PG8_BAR;
    PG8_STAGE(PG8_SB(1, 0), cB + kstep, voffB); PG8_STAGE2(PG8_SA(1, 0), aC + kstep, vc[0][0], vc[0][1]); PG8_STAGE(PG8_SB(1, 1), cB + hstep + kstep, voffB);
    PG8_WAIT_V(6); PG8_BAR;
    for (;;) {
        const bool has_next = S.next(ui + 1, nxt);
        if (AOff::GATHER && has_next) { PG8_AOFFS(vn, nxt); }
        else {
#pragma unroll
            for (int _h = 0; _h < 2; ++_h)
#pragma unroll
                for (int _i = 0; _i < 2; ++_i) vn[_h][_i] = vc[_h][_i];
        }
        const char* nB = has_next ? (const char*)Bt + (size_t)nxt.e * estride + (size_t)nxt.pn * tstep : cB;
        const char* aN = (AOff::GATHER || !has_next) ? aC : Ab + (size_t)nxt.pm * tstep;
        for (int t = 0; t < nt; t += 2) {
            const bool last = (t == nt - 2);
            const char* a1 = aC + (size_t)(t + 1) * kstep;
            const char* a2 = last ? aN : aC + (size_t)(t + 2) * kstep; const char* b2 = last ? nB : cB + (size_t)(t + 2) * kstep;
            const char* a3 = a2 + kstep; const char* b3 = b2 + kstep;
            const unsigned x00 = last ? vn[0][0] : vc[0][0], x01 = last ? vn[0][1] : vc[0][1], x10 = last ? vn[1][0] : vc[1][0], x11 = last ? vn[1][1] : vc[1][1];
            PG8_LDB(B0, 0, 0); PG8_SCHED; PG8_LDA(At, 0, 0); PG8_STAGE2(PG8_SA(1, 1), a1, vc[1][0], vc[1][1]);
            PG8_WAIT_L(8); PG8_BAR; PG8_WAIT_L(0); PG8_MMA(0, 0, At, B0); PG8_BAR; PG8_SCHED;
            PG8_LDB(B1, 0, 1); PG8_STAGE(PG8_SB(0, 0), b2, voffB);
            PG8_BAR; PG8_WAIT_L(0); PG8_MMA(0, 1, At, B1); PG8_BAR;
            PG8_LDA(At, 0, 1); PG8_STAGE2(PG8_SA(0, 0), a2, x00, x01);
            PG8_BAR; PG8_WAIT_L(0); PG8_MMA(1, 0, At, B0); PG8_BAR; PG8_SCHED;
            PG8_STAGE(PG8_SB(0, 1), b2 + hstep, voffB);
            PG8_WAIT_V(6); PG8_BAR; PG8_MMA(1, 1, At, B1); PG8_BAR;
            PG8_LDB(B0, 1, 0); PG8_SCHED; PG8_LDA(At, 1, 0); PG8_STAGE2(PG8_SA(0, 1), a2, x10, x11);
            PG8_WAIT_L(8); PG8_BAR; PG8_WAIT_L(0); PG8_MMA(0, 0, At, B0); PG8_BAR; PG8_SCHED;
            PG8_LDB(B1, 1, 1); PG8_STAGE(PG8_SB(1, 0), b3, voffB);
            PG8_BAR; PG8_WAIT_L(0); PG8_MMA(0, 1, At, B1); PG8_BAR;
            PG8_LDA(At, 1, 1); PG8_STAGE2(PG8_SA(1, 0), a3, x00, x01);
            PG8_BAR; PG8_WAIT_L(0); PG8_MMA(1, 0, At, B0); PG8_BAR; PG8_SCHED;
            PG8_STAGE(PG8_SB(1, 1), b3 + hstep, voffB);
            PG8_WAIT_V(6); PG8_BAR; PG8_MMA(1, 1, At, B1); PG8_BAR;
        }
        E(acc, cur, wr, wc, fr, fq);
        if (!has_next) break;
#pragma unroll
        for (int a = 0; a < 2; ++a)
#pragma unroll
            for (int b = 0; b < 2; ++b)
#pragma unroll
                for (int m = 0; m < 4; ++m)
#pragma unroll
                    for (int n = 0; n < 2; ++n) acc[a][b][m][n] = (f32x4){0.f, 0.f, 0.f, 0.f};
        cur = nxt; cB = nB; aC = aN; ++ui;
#pragma unroll
        for (int _h = 0; _h < 2; ++_h)
#pragma unroll
            for (int _i = 0; _i < 2; ++_i) vc[_h][_i] = vn[_h][_i];
    }
    PG8_WAIT_V(0);
    if (wr == 0) PG8_BAR;
    PG8_BAR;
#undef PG8_SA
#undef PG8_SB
#undef PG8_STAGE
#undef PG8_STAGE2
#undef PG8_LDA
#undef PG8_LDB
#undef PG8_MMA
#undef PG8_WAIT_V
#undef PG8_WAIT_L
#undef PG8_BAR
#undef PG8_SCHED
#undef PG8_AOFFS
}
}

struct Args { const float* in[25]; float* out; unsigned char* ws; int ph_lo, ph_hi; };
struct Frame {
    LAS unsigned char* lds; int tid, lane, wave, G, bid;
    float* out; unsigned char* ws; unsigned* ctl;
};
__device__ __forceinline__ const float* inp_ptr(const Frame& F, int k) {
    const LAS unsigned* t = (const LAS unsigned*)(F.lds + MISC_OFF + 256) + 2 * k;
    const unsigned lo = __builtin_amdgcn_readfirstlane(t[0]), hi = __builtin_amdgcn_readfirstlane(t[1]);
    return (const float*)(const GAS float*)(((unsigned long long)hi << 32) | lo);
}
#define INP(k) inp_ptr(F, (k))
__device__ __forceinline__ Frame fresh(const Frame& F) {
    Frame P = F;
    int z = 0;
    asm volatile("" : "+s"(z), "+s"(P.G), "+s"(P.bid), "+s"(P.wave));
    P.lane = lane_id_volatile() & 63; P.tid = (P.wave << 6) | P.lane;
    P.ws = F.ws + z; P.out = F.out + z;
    P.wave &= 7; P.ctl = (unsigned*)(P.ws + WS_CTL);
    return P;
}
__device__ __forceinline__ int fresh_i(int v) { asm volatile("" : "+s"(v)); return v; }
#define WSP(T, off) ((T*)(F.ws + (off)))

template <class T> __device__ __forceinline__ T* opaque(T* p) { int z = 0; asm volatile("" : "+s"(z)); return p + z; }
__device__ __forceinline__ u32x4 pack8(const f32x4 a, const f32x4 b) { u32x4 w; w.x = pk2(a[0], a[1]); w.y = pk2(a[2], a[3]); w.z = pk2(b[0], b[1]); w.w = pk2(b[2], b[3]); return w; }
__device__ __forceinline__ f32x4 sigm4(const f32x4 a) { const f32x4 z = a * -1.4426950408889634f; f32x4 e, r;
#pragma unroll
    for (int j = 0; j < 4; ++j) e[j] = __builtin_amdgcn_exp2f(z[j]);
    const f32x4 d = e + 1.0f;
#pragma unroll
    for (int j = 0; j < 4; ++j) r[j] = __builtin_amdgcn_rcpf(d[j]);
    return r; }
__device__ __forceinline__ f32x4 silu4(const f32x4 a) { return a * sigm4(a); }
__device__ __forceinline__ f32x4 lsig4(const f32x4 a) { return (f32x4){logsigmoidf_(a[0]), logsigmoidf_(a[1]), logsigmoidf_(a[2]), logsigmoidf_(a[3])}; }
__device__ __forceinline__ void fgate4(const f32x4 x, const f32x4 lbv, f32x4& kk, f32x4& la) {
    const f32x4 z = x * -1.4426950408889634f; f32x4 e, sg, lg;
#pragma unroll
    for (int j = 0; j < 4; ++j) e[j] = __builtin_amdgcn_exp2f(fminf(z[j], 125.0f));
    const f32x4 d = e + 1.0f;
#pragma unroll
    for (int j = 0; j < 4; ++j) sg[j] = __builtin_amdgcn_rcpf(d[j]);
    const f32x4 om = 1.0f - lbv;
    const f32x4 f = lbv + om * sg;
    kk = om * (1.0f - sg);
#pragma unroll
    for (int j = 0; j < 4; ++j) lg[j] = __builtin_amdgcn_logf(f[j]);
    la = lg * 0.6931471805599453f;
}
template <int KIND>
__device__ __forceinline__ void rec_group(unsigned char* ws, const float* bias, const float* lb, f32x4 v0, f32x4 v1, int row, int gc, int sc, int ct, int wc, int fq, int fr, bool latent) {
    const bool gate_lane = (KIND != 9) || (ct < 16);
    const int gcs = gate_lane ? gc : 0;
    v0 += *(const f32x4*)((const char*)bias + (unsigned)(gcs * 4)); v1 += *(const f32x4*)((const char*)bias + (unsigned)(gcs * 4 + 16));
    if (KIND == 0) {
        *(u32x4*)(ws + WS_Q + (unsigned)(row * 1024 + sc * 2)) = pack8(silu4(v0) * 0.08838834764831845f, silu4(v1) * 0.08838834764831845f);
    } else if (KIND == 1 || KIND == 2) {
        f32x4 k0, k1, l0, l1;
        fgate4(v0, *(const f32x4*)((const char*)lb + (unsigned)(sc * 4)), k0, l0); fgate4(v1, *(const f32x4*)((const char*)lb + (unsigned)(sc * 4 + 16)), k1, l1);
        *(u32x4*)(ws + (KIND == 1 ? WS_KF : WS_KB) + (unsigned)(row * 1024 + sc * 2)) = pack8(k0, k1);
        float* lp = (float*)(ws + (KIND == 1 ? WS_LAF : WS_LAB) + (unsigned)(row * 2048 + sc * 4));
        *(f32x4*)lp = l0; *(f32x4*)(lp + 4) = l1;
    } else if (KIND == 3 || KIND == 4 || KIND == 7 || KIND == 8) {
        if (KIND == 4) { v0 = silu4(v0); v1 = silu4(v1); }
        if (KIND == 8) { v0 = sigm4(v0); v1 = sigm4(v1); }
        const size_t off = KIND == 3 ? WS_V : KIND == 4 ? WS_HG : KIND == 7 ? WS_MV : WS_MO;
        *(u32x4*)(ws + off + (unsigned)(row * 1024 + sc * 2)) = pack8(v0, v1);
    } else if (KIND == 5 || KIND == 6) {
        if (KIND == 6) { v0 *= 0.125f; v1 *= 0.125f; }
        f32x4 p0, p1;
#pragma unroll
        for (int j = 0; j < 4; ++j) { p0[j] = shx(v0[j], 32, fq * 16 + fr); p1[j] = shx(v1[j], 32, fq * 16 + fr); }
        if (latent) {
            const int t = row & 8191; const int pos = (wc & 1) ? (t & 63) : (t >> 6);
            const f32x4* rp = (const f32x4*)((const f32x2*)(ws + WS_ROPE) + pos * 16 + 8 * (fq & 1));
            const f32x4 c01 = rp[0], c23 = rp[1], c45 = rp[2], c67 = rp[3];
            const f32x4 cs0 = (f32x4){c01[0], c01[2], c23[0], c23[2]}, sn0 = (f32x4){c01[1], c01[3], c23[1], c23[3]};
            const f32x4 cs1 = (f32x4){c45[0], c45[2], c67[0], c67[2]}, sn1 = (f32x4){c45[1], c45[3], c67[1], c67[3]};
            const float sg = (fq >= 2) ? 1.0f : -1.0f;
            v0 = v0 * cs0 + sg * (p0 * sn0); v1 = v1 * cs1 + sg * (p1 * sn1);
        }
        *(u32x4*)(ws + (KIND == 5 ? WS_MQ : WS_MK) + (unsigned)(row * 512 + sc * 2)) = pack8(v0, v1);
    } else {
        if (gate_lane) { float* gp = (float*)(ws + WS_GATES + (unsigned)(row * 64 + ct * 4)); *(f32x4*)gp = v0; *(f32x4*)(gp + 4) = lsig4(v1); }
    }
}
struct EpiRec {
    static constexpr bool PERM = true;
    unsigned char* ws; const float* bias; const float* lb; int layer;
    template <int KIND>
    __device__ __forceinline__ void run(const f32x4 (&acc)[2][2][4][2], const pg8::Unit& u, int wr, int wc, int fr, int fq, int cbase  ) const {
        const int row0 = u.pm * 256 + wr * 64 + fr;
        const bool latent = u.pm < 128;
#define REC_G(ai, m) { const int row = row0 + (ai) * 128 + (m) * 16; \
        { const int ct = wc * 32 + 8 * fq; rec_group<KIND>(ws, bias, lb, acc[ai][0][m][0], acc[ai][0][m][1], row, u.pn * 256 + ct, cbase + ct, ct, wc, fq, fr, latent); } \
        if (KIND != 9) { const int ct = 128 + wc * 32 + 8 * fq; rec_group<KIND>(ws, bias, lb, acc[ai][1][m][0], acc[ai][1][m][1], row, u.pn * 256 + ct, cbase + ct, ct, wc, fq, fr, latent); } if ((m) == 3) asm volatile("" ::: "memory"); }
        REC_G(0, 0) REC_G(0, 1) REC_G(0, 2) REC_G(0, 3) REC_G(1, 0) REC_G(1, 1) REC_G(1, 2) REC_G(1, 3)
#undef REC_G
    }
    __device__ __forceinline__ void operator()(const f32x4 (&acc)[2][2][4][2], const pg8::Unit& u, int wr, int wc, int fr, int fq) const {
        const int pn = u.pn;
        EpiRec o{opaque(ws), opaque(bias), opaque(lb), layer};
        asm volatile("" : "+v"(fr), "+v"(fq));
        o.dispatch(acc, u, wr, wc, fr, fq, pn);
    }
    __device__ __forceinline__ void dispatch(const f32x4 (&acc)[2][2][4][2], const pg8::Unit& u, int wr, int wc, int fr, int fq, int pn) const {
        if (pn < 2) run<0>(acc, u, wr, wc, fr, fq, pn * 256);
        else if (pn < 4) run<1>(acc, u, wr, wc, fr, fq, (pn - 2) * 256);
        else if (pn < 6) run<2>(acc, u, wr, wc, fr, fq, (pn - 4) * 256);
        else if (pn < 8) run<3>(acc, u, wr, wc, fr, fq, (pn - 6) * 256);
        else if (pn < 10) run<4>(acc, u, wr, wc, fr, fq, (pn - 8) * 256);
        else if (pn == 10) run<5>(acc, u, wr, wc, fr, fq, 0);
        else if (pn == 11) run<6>(acc, u, wr, wc, fr, fq, 0);
        else if (pn < 14) run<7>(acc, u, wr, wc, fr, fq, (pn - 12) * 256);
        else if (pn < 16) run<8>(acc, u, wr, wc, fr, fq, (pn - 14) * 256);
        else run<9>(acc, u, wr, wc, fr, fq, 0);
    }
};
struct EpiQKV {
    static constexpr bool PERM = true;
    unsigned char* ws;
    __device__ __forceinline__ void operator()(const f32x4 (&acc)[2][2][4][2], const pg8::Unit& u, int wr, int wc, int fr, int fq) const {
        const int row0 = u.pm * 256 + wr * 64 + fr;
        unsigned char* w_ = opaque(ws);
        asm volatile("" : "+v"(fr), "+v"(fq));
        if (u.pn < 8) {
            const int col0 = u.pn * 256 + wc * 32 + 8 * fq;
#pragma unroll
            for (int ai = 0; ai < 2; ++ai)
#pragma unroll
                for (int m = 0; m < 4; ++m) { const int row = row0 + ai * 128 + m * 16; const unsigned ob = (unsigned)(row * 3072 + col0) * 2u;
#pragma unroll
                    for (int bj = 0; bj < 2; ++bj) { const f32x4 v0 = acc[ai][bj][m][0], v1 = acc[ai][bj][m][1];
                        *(u32x4*)(w_ + WS_QKV + (ob + bj * 256u)) = pack8(v0, v1);
                        if (u.pn >= 4) {
                            float ss = (v0[0] * v0[0] + v0[1] * v0[1]) + (v0[2] * v0[2] + v0[3] * v0[3]) + (v1[0] * v1[0] + v1[1] * v1[1]) + (v1[2] * v1[2] + v1[3] * v1[3]);
                            const int lane = fq * 16 + fr; ss += shx(ss, 16, lane); ss += shx(ss, 32, lane);
                            if (fq == 0) atomicAdd((float*)(w_ + WS_SSK) + row * 16 + (((u.pn - 4) * 256 + bj * 128 + wc * 32) >> 6), ss); } } }
        } else {
            const int b = u.pm < 128 ? (u.pm >> 5) : (u.pm - 128); const int tt0 = u.pm < 128 ? ((u.pm & 31) * 256) : TL;
#pragma unroll
            for (int ai = 0; ai < 2; ++ai)
#pragma unroll
                for (int m = 0; m < 4; ++m) { const int tt = tt0 + wr * 64 + fr + ai * 128 + m * 16;
#pragma unroll
                    for (int bj = 0; bj < 2; ++bj) { const int c = (u.pn - 8) * 256 + bj * 128 + wc * 32 + 8 * fq;
                        const unsigned base = (unsigned)(((b * 16 + (c >> 6)) * 64 + (c & 63)) * TT + tt) * 2u;
                        const u32x4 pk = pack8(acc[ai][bj][m][0], acc[ai][bj][m][1]); const unsigned pw[4] = {pk.x, pk.y, pk.z, pk.w};
#pragma unroll
                        for (int q = 0; q < 8; ++q) *(bf16_t*)(w_ + WS_VTG + (base + (unsigned)q * (TT * 2u))) = (bf16_t)((q & 1) ? (pw[q >> 1] >> 16) : (pw[q >> 1] & 0xffffu)); } }
        }
    }
};
struct EpiResid {
    static constexpr bool PERM = true;
    bf16_t* Y; const float* modl;
    __device__ __forceinline__ void operator()(const f32x4 (&acc)[2][2][4][2], const pg8::Unit& u, int wr, int wc, int fr, int fq) const {
        const int row0 = u.pm * 256 + wr * 64 + fr, col0 = u.pn * 256 + wc * 32 + 8 * fq;
        const int bidx = u.pm < 128 ? (u.pm >> 5) : 4;
        bf16_t* Y = opaque(this->Y);
        const float* g = opaque(modl) + bidx * 6144 + 2048 + col0;
        f32x4 gv[2][2];
#pragma unroll
        for (int bj = 0; bj < 2; ++bj) { gv[bj][0] = *(const f32x4*)(g + bj * 128); gv[bj][1] = *(const f32x4*)(g + bj * 128 + 4); }
#pragma unroll
        for (int ai = 0; ai < 2; ++ai)
#pragma unroll
            for (int m = 0; m < 4; ++m) { const unsigned ob = (unsigned)((row0 + ai * 128 + m * 16) * 1024 + col0) * 2u;
#pragma unroll
                for (int bj = 0; bj < 2; ++bj) *(u32x4*)((char*)Y + (ob + bj * 256u)) = pack8(acc[ai][bj][m][0] * gv[bj][0], acc[ai][bj][m][1] * gv[bj][1]); }
    }
};
__device__ __forceinline__ f32x4 swiglu4(const f32x4 g, const f32x4 u) {
    f32x4 gt, up, e, r;
#pragma unroll
    for (int j = 0; j < 4; ++j) { gt[j] = fminf(g[j], 7.0f); up[j] = __builtin_amdgcn_fmed3f(u[j], -7.0f, 7.0f); }
    const f32x4 z = gt * -2.4554669595930157f;
#pragma unroll
    for (int j = 0; j < 4; ++j) e[j] = __builtin_amdgcn_exp2f(z[j]);
    const f32x4 d = e + 1.0f;
#pragma unroll
    for (int j = 0; j < 4; ++j) r[j] = __builtin_amdgcn_rcpf(d[j]);
    return (gt * r) * (up + 1.0f);
}
struct EpiMoe1 {
    static constexpr bool PERM = true;
    bf16_t* ACT; const float* bgu;
    __device__ __forceinline__ void operator()(const f32x4 (&acc)[2][2][4][2], const pg8::Unit& u, int wr, int wc, int fr, int fq) const {
        const int row0 = u.pm * 256 + wr * 64 + fr, c0 = u.pn * 128 + wc * 32 + 8 * fq;
        bf16_t* ACT = opaque(this->ACT);
        const float* bg = opaque(bgu) + (size_t)u.e * 2048 + c0; const float* bu = bg + 1024;
        const f32x4 g0 = *(const f32x4*)bg, g1 = *(const f32x4*)(bg + 4), u0 = *(const f32x4*)bu, u1 = *(const f32x4*)(bu + 4);
#pragma unroll
        for (int ai = 0; ai < 2; ++ai)
#pragma unroll
            for (int m = 0; m < 4; ++m) {
                const f32x4 ga = acc[ai][0][m][0] + g0, gb = acc[ai][0][m][1] + g1, ua = acc[ai][1][m][0] + u0, ub = acc[ai][1][m][1] + u1;
                const f32x4 ra = swiglu4(ga, ua), rb = swiglu4(gb, ub);
                const float r[8] = {ra[0], ra[1], ra[2], ra[3], rb[0], rb[1], rb[2], rb[3]};
                u32x4 w; w.x = pk2(r[0], r[1]); w.y = pk2(r[2], r[3]); w.z = pk2(r[4], r[5]); w.w = pk2(r[6], r[7]);
                *(u32x4*)((char*)ACT + (unsigned)((row0 + ai * 128 + m * 16) * 1024 + c0) * 2u) = w;
            }
    }
};
struct EpiMoe2 {
    static constexpr bool PERM = true;
    bf16_t* YS; const float* bd;
    __device__ __forceinline__ void operator()(const f32x4 (&acc)[2][2][4][2], const pg8::Unit& u, int wr, int wc, int fr, int fq) const {
        const int row0 = u.pm * 256 + wr * 64 + fr, col0 = u.pn * 256 + wc * 32 + 8 * fq;
        bf16_t* YS = opaque(this->YS);
        const float* b = opaque(bd) + (size_t)u.e * 1024 + col0;
        f32x4 bv[2][2];
#pragma unroll
        for (int bj = 0; bj < 2; ++bj) { bv[bj][0] = *(const f32x4*)(b + bj * 128); bv[bj][1] = *(const f32x4*)(b + bj * 128 + 4); }
#pragma unroll
        for (int ai = 0; ai < 2; ++ai)
#pragma unroll
            for (int m = 0; m < 4; ++m) { const unsigned ob = (unsigned)((row0 + ai * 128 + m * 16) * 1024 + col0) * 2u;
#pragma unroll
                for (int bj = 0; bj < 2; ++bj) *(u32x4*)((char*)YS + (ob + bj * 256u)) = pack8(acc[ai][bj][m][0] + bv[bj][0], acc[ai][bj][m][1] + bv[bj][1]); }
    }
};

__device__ __forceinline__ void transpose_item(const float* W, int K, int N, bf16_t* WT, int drow0, LAS float* scr, int k0, int n0, int lane) {
    const int n = n0 + (lane & 31); const bool ok = n < N;
#pragma unroll 8
    for (int i = 0; i < 32; ++i) { const int kk = 2 * i + (lane >> 5); scr[kk * 33 + (lane & 31)] = ok ? __builtin_nontemporal_load(W + (size_t)(k0 + kk) * N + n) : 0.f; }
    asm volatile("s_waitcnt lgkmcnt(0)" ::: "memory");
    const int c = lane & 7;
#pragma unroll
    for (int j = 0; j < 4; ++j) { const int nn = (lane >> 3) + 8 * j; const LAS float* s = scr + (8 * c) * 33 + nn;
        u32x4 o; o.x = pk2(s[0 * 33], s[1 * 33]); o.y = pk2(s[2 * 33], s[3 * 33]); o.z = pk2(s[4 * 33], s[5 * 33]); o.w = pk2(s[6 * 33], s[7 * 33]);
        __builtin_nontemporal_store(o, (u32x4*)(WT + (size_t)(drow0 + nn) * K + k0 + 8 * c)); }
    asm volatile("s_waitcnt lgkmcnt(0)" ::: "memory");
}
__device__ __forceinline__ void phase_prologue(Frame& F) {
    {
        LAS float* s = (LAS float*)(F.lds);
        LAS float* part = (LAS float*)(F.lds + 32768);
        bool have_s = false;
        for (int item = F.bid; item < 384; item += F.G) {
            if (!have_s) {
                for (int i = F.tid; i < 5 * 1024; i += 512) { const int b = i >> 10, k = i & 1023; const float c = b < 4 ? INP(1)[b * 1024 + k] : INP(3)[k]; s[i] = siluf_(c); }
                have_s = true;
            }
            __syncthreads();
            const int l = item / 96, n0 = (item % 96) * 64, ci = F.tid & 63, kg = F.tid >> 6;
            const float* w = INP(4) + ((size_t)l * 1024 + kg * 128) * 6144 + n0 + ci;
            float a0 = 0.f, a1 = 0.f, a2 = 0.f, a3 = 0.f, a4 = 0.f;
#pragma unroll 8
            for (int k = 0; k < 128; ++k) { const float wv = w[(size_t)k * 6144]; const int kk = kg * 128 + k;
                a0 += s[kk] * wv; a1 += s[1024 + kk] * wv; a2 += s[2048 + kk] * wv; a3 += s[3072 + kk] * wv; a4 += s[4096 + kk] * wv; }
            part[(kg * 5 + 0) * 64 + ci] = a0; part[(kg * 5 + 1) * 64 + ci] = a1; part[(kg * 5 + 2) * 64 + ci] = a2; part[(kg * 5 + 3) * 64 + ci] = a3; part[(kg * 5 + 4) * 64 + ci] = a4;
            __syncthreads();
            if (F.tid < 320) { const int b = F.tid >> 6, c2 = F.tid & 63; float sum = INP(5)[l * 6144 + n0 + c2];
#pragma unroll
                for (int g = 0; g < 8; ++g) sum += part[(g * 5 + b) * 64 + c2];
                WSP(float, WS_MOD)[(l * 5 + b) * 6144 + n0 + c2] = sum; }
        }
        __syncthreads();
        if (F.bid == (F.G > 1 ? F.G - 1 : 0)) {
            const int c = F.tid; const float* hl = INP(11);
            const float v0 = hl[c], v1 = hl[512 + c], v2 = hl[1024 + c], v3 = hl[1536 + c];
            const float mx = fmaxf(fmaxf(v0, v1), fmaxf(v2, v3));
            const float e0 = expf(v0 - mx), e1 = expf(v1 - mx), e2 = expf(v2 - mx), e3 = expf(v3 - mx); const float inv = 1.0f / (e0 + e1 + e2 + e3);
            float* LB = WSP(float, WS_LB);
            LB[c] = 0.f; LB[512 + c] = fmaxf(e1 * inv, 0.f); LB[1024 + c] = fmaxf((e1 + e2) * inv, 0.f); LB[1536 + c] = fmaxf((e1 + e2 + e3) * inv, 0.f);
        }
        if (F.bid == (F.G > 2 ? F.G - 2 : 0)) {
            for (int i = F.tid; i < 2048; i += 512) { const int pos = i >> 4, q = i & 15; const float inv = powf(10000.0f, -(float)q / 16.0f); const float ang = (float)pos * inv;
                WSP(f32x2, WS_ROPE)[i] = (f32x2){cosf(ang), sinf(ang)}; }
        }
        __syncthreads();
    }
    LAS float* scr = (LAS float*)(F.lds + F.wave * 16384);
    const int gw = F.bid * 8 + F.wave, NGW = F.G * 8;
    constexpr int I_WIN = 16 * 136, I_SQ = 16 * 32, I_QKV = 16 * 96, I_GU = 16 * 64;
    constexpr int N0 = 2 * I_WIN, N1 = N0 + 2 * I_SQ, N2 = N1 + 2 * I_QKV, N3 = N2 + 2 * I_SQ, N4 = N3 + 128 * I_GU, N5 = N4 + 128 * I_SQ;
    for (int it = gw; it < N5; it += NGW) {
        if (it < N0) { const int j = it / I_WIN, r = it % I_WIN, kb = r / 136, nb = r % 136;
            transpose_item(INP(8) + (size_t)j * 1024 * 4112, 1024, 4112, WSP(bf16_t, WS_WIN) + (size_t)j * NREC * 1024, nb * 32, scr, kb * 64, nb * 32, F.lane); }
        else if (it < N1) { const int q = it - N0, j = q / I_SQ, r = q % I_SQ, kb = r / 32, nb = r % 32;
            transpose_item(INP(10) + (size_t)j * 1024 * 1024, 1024, 1024, WSP(bf16_t, WS_WROUT) + (size_t)j * 1024 * 1024, nb * 32, scr, kb * 64, nb * 32, F.lane); }
        else if (it < N2) { const int q = it - N1, j = q / I_QKV, r = q % I_QKV, kb = r / 96, nb = r % 96;
            transpose_item(INP(14) + (size_t)j * 1024 * 3072, 1024, 3072, WSP(bf16_t, WS_WQKV) + (size_t)j * 3072 * 1024, nb * 32, scr, kb * 64, nb * 32, F.lane); }
        else if (it < N3) { const int q = it - N2, j = q / I_SQ, r = q % I_SQ, kb = r / 32, nb = r % 32;
            transpose_item(INP(15) + (size_t)j * 1024 * 1024, 1024, 1024, WSP(bf16_t, WS_WNOUT) + (size_t)j * 1024 * 1024, nb * 32, scr, kb * 64, nb * 32, F.lane); }
        else if (it < N4) { const int q = it - N3, j = q / I_GU, r = q % I_GU, kb = r / 64, nb = r % 64; const int n0 = nb * 32;
            const int nn = n0 & 1023; const int drow = 256 * (nn >> 7) + (n0 >= 1024 ? 128 : 0) + (nn & 127);
            transpose_item(INP(21) + (size_t)j * 1024 * 2048, 1024, 2048, WSP(bf16_t, WS_WGU) + (size_t)j * 2048 * 1024, drow, scr, kb * 64, n0, F.lane); }
        else { const int q = it - N4, j = q / I_SQ, r = q % I_SQ, kb = r / 32, nb = r % 32;
            transpose_item(INP(23) + (size_t)j * 1024 * 1024, 1024, 1024, WSP(bf16_t, WS_WD) + (size_t)j * 1024 * 1024, nb * 32, scr, kb * 64, nb * 32, F.lane); }
    }
    __syncthreads();
}

__device__ __forceinline__ void expert_prefix(const Frame& F, int l, LAS int* base_out, LAS int* cnt_out, int scale, bool total) {
    if (F.tid < 64) {
        const int e = F.tid & 31;
        const int c = (int)F.ctl[CW_CNT + (l * 32 + e) * 64];
        const int t = (F.tid < 32) ? ((c + 255) >> 8) : 0;
        int incl = t;
#pragma unroll
        for (int o = 1; o < 32; o <<= 1) { const int y = __builtin_amdgcn_ds_bpermute(((F.tid - o) & 63) << 2, incl); if (F.tid >= o) incl += y; }
        if (F.tid < 32) { base_out[e] = (incl - t) * scale; if (cnt_out) cnt_out[e] = c; }
        if (total && F.tid == 31) base_out[32] = incl * scale;
    }
}
template <int MODE>
__device__ __forceinline__ void phase_norm1(Frame& F, int l) {
    LAS int* sbase = (LAS int*)(F.lds + MISC_OFF + 1024);
    if (MODE != 0) {
        expert_prefix(F, l - 1, sbase, (LAS int*)0, 256, false);
        __syncthreads();
    }
    const int gw = F.bid * 8 + F.wave, NGW = F.G * 8;
    bf16_t* X = WSP(bf16_t, WS_X); bf16_t* H = WSP(bf16_t, WS_H); const bf16_t* YS = WSP(bf16_t, WS_YS);
    const float* MOD = WSP(float, WS_MOD);
    const int* TE = WSP(int, WS_TOKE); const int* TP = WSP(int, WS_TOKP); const float* TW = WSP(float, WS_TOKW);
    const int nrows = (MODE == 2) ? RL : NR;
    for (int pr = gw; pr < nrows / 2; pr += NGW) {
        const int row0 = 2 * pr; const int bidx = row_bidx(row0);
        f32x4 v[2][4];
#pragma unroll
        for (int rr = 0; rr < 2; ++rr) { const int row = row0 + rr;
            if (MODE == 0) { const float* src = row < RL ? INP(0) + (size_t)row * 1024 : INP(2) + (size_t)(row - RL) * 1024;
#pragma unroll
                for (int j = 0; j < 4; ++j) v[rr][j] = __builtin_nontemporal_load((const f32x4*)(src + 4 * F.lane + 256 * j)); }
            else { const bf16_t* src = X + (size_t)row * 1024;
#pragma unroll
                for (int j = 0; j < 4; ++j) v[rr][j] = h4_to_f4(__builtin_nontemporal_load((const u32x2*)(src + 4 * F.lane + 256 * j))); } }
        if (MODE != 0) {
            u32x2 ys[2][4][4]; float wk[2][4];
#pragma unroll
            for (int rr = 0; rr < 2; ++rr)
#pragma unroll
                for (int k = 0; k < 4; ++k) { const int row = row0 + rr; const int e = TE[row * 4 + k], p = TP[row * 4 + k]; wk[rr][k] = TW[row * 4 + k];
                    const bf16_t* yr = YS + (size_t)(sbase[e] + p) * 1024 + 4 * F.lane;
#pragma unroll
                    for (int j = 0; j < 4; ++j) ys[rr][k][j] = __builtin_nontemporal_load((const u32x2*)(yr + 256 * j)); }
            const float* g2 = MOD + ((l - 1) * 5 + bidx) * 6144 + 5120 + 4 * F.lane;
#pragma unroll
            for (int j = 0; j < 4; ++j) { const f32x4 gg = *(const f32x4*)(g2 + 256 * j);
#pragma unroll
                for (int rr = 0; rr < 2; ++rr) { f32x4 f = (f32x4){0.f, 0.f, 0.f, 0.f};
#pragma unroll
                    for (int k = 0; k < 4; ++k) { const u32x2 q = ys[rr][k][j]; f += wk[rr][k] * (f32x4){bf2f(q.x & 0xffffu), bf2f(q.x >> 16), bf2f(q.y & 0xffffu), bf2f(q.y >> 16)}; }
                    v[rr][j] += gg * f; } }
        }
        if (MODE == 2) {
#pragma unroll
            for (int rr = 0; rr < 2; ++rr)
#pragma unroll
                for (int j = 0; j < 4; ++j) __builtin_nontemporal_store(v[rr][j], (f32x4*)(F.out + (size_t)(row0 + rr) * 1024 + 4 * F.lane + 256 * j));
            continue;
        }
        if (F.lane < 32) WSP(float, WS_SSK)[row0 * 16 + F.lane] = 0.f;
        float rstd[2];
#pragma unroll
        for (int rr = 0; rr < 2; ++rr) { float ss = 0.f;
#pragma unroll
            for (int j = 0; j < 4; ++j) { __builtin_nontemporal_store(f4_to_h4(v[rr][j]), (u32x2*)(X + (size_t)(row0 + rr) * 1024 + 4 * F.lane + 256 * j));
                ss += (v[rr][j][0] * v[rr][j][0] + v[rr][j][1] * v[rr][j][1]) + (v[rr][j][2] * v[rr][j][2] + v[rr][j][3] * v[rr][j][3]); }
            rstd[rr] = rsqrtf(wave_sum(ss, F.lane) * (1.0f / 1024.0f) + EPS); }
        const float* gm = INP(6) + l * 1024; const float* sh = MOD + (l * 5 + bidx) * 6144; const float* sc = sh + 1024;
#pragma unroll
        for (int j = 0; j < 4; ++j) { const int c = 4 * F.lane + 256 * j;
            const f32x4 g = *(const f32x4*)(gm + c), s1 = *(const f32x4*)(sc + c), s0 = *(const f32x4*)(sh + c); const f32x4 gs = g * (1.0f + s1);
#pragma unroll
            for (int rr = 0; rr < 2; ++rr) { const f32x4 h = v[rr][j] * rstd[rr] * gs + s0;
                u32x2 w; w.x = pk2(h[0], h[1]); w.y = pk2(h[2], h[3]);
                *(u32x2*)(H + (size_t)(row0 + rr) * 1024 + c) = w; } }
    }
}

__device__ __forceinline__ void router_finish(Frame& F, float (&lg)[32], int row, int r0, const float* br, LAS int* hist, LAS int* sel, float* TW) {
#pragma unroll
    for (int s5 = 0; s5 < 5; ++s5) { const int half = 16 >> s5; const bool up = (F.lane >> (5 - s5)) & 1;
#pragma unroll
        for (int i = 0; i < half; ++i) { const float a2 = lg[i], b2 = lg[i + half]; const float send = up ? a2 : b2, keep = up ? b2 : a2; lg[i] = keep + shx(send, 32 >> s5, F.lane); } }
    float logit = lg[0] + shx(lg[0], 1, F.lane);
    const int myE = F.lane >> 1;
    logit += br[myE];
    int rank = 0;
#pragma unroll
    for (int e = 0; e < 32; ++e) { const float le = __int_as_float(__builtin_amdgcn_readlane(__float_as_int(logit), 2 * e)); rank += (le > logit || (le == logit && e < myE)) ? 1 : 0; }
    float tv[4]; int ti[4];
#pragma unroll
    for (int k = 0; k < 4; ++k) { const unsigned long long bm = __ballot(rank == k); const int src = __builtin_amdgcn_readfirstlane((int)__builtin_ctzll(bm));
        tv[k] = __int_as_float(__builtin_amdgcn_readlane(__float_as_int(logit), src)); ti[k] = src >> 1; }
    const float e1 = __expf(tv[1] - tv[0]), e2 = __expf(tv[2] - tv[0]), e3 = __expf(tv[3] - tv[0]); const float inv = 1.0f / (1.0f + e1 + e2 + e3);
    if (F.lane < 4) { const int k = F.lane; const int e = k == 0 ? ti[0] : k == 1 ? ti[1] : k == 2 ? ti[2] : ti[3]; const float w = (k == 0 ? 1.0f : k == 1 ? e1 : k == 2 ? e2 : e3) * inv;
        const int lpos = atomicAdd((int*)&hist[e], 1);
        sel[(row - r0) * 4 + k] = e | (lpos << 8);
        TW[row * 4 + k] = w; }
}
__device__ __forceinline__ void phase_router(Frame& F, int l) {
    LAS float* wr = (LAS float*)F.lds;
    LAS int* hist = (LAS int*)(F.lds + MISC_OFF + 1024);
    LAS int* gbase = hist + 32;
    LAS int* sel = gbase + 32;
    const float* wsrc = INP(19) + (size_t)l * 1024 * 32;
    for (int i = F.tid; i < 1024 * 8; i += 512) { const int k = i >> 3, ch = i & 7; const f32x4 w = *(const f32x4*)(wsrc + k * 32 + ch * 4);
        const int p = (k >> 2) + 256 * (k & 3); *(LAS f32x4*)(wr + p * 32 + 4 * ((ch + (p >> 1)) & 7)) = w; }
    if (F.tid < 32) hist[F.tid] = 0;
    __syncthreads();
    const int NRr = (l == 3) ? RL : NR;
    const int RPB = (((NRr + F.G - 1) / F.G) + 1) & ~1;
    const int r0 = min(F.bid * RPB, NRr), r1 = min(r0 + RPB, NRr);
    bf16_t* X = WSP(bf16_t, WS_X); bf16_t* H = WSP(bf16_t, WS_H); const float* MOD = WSP(float, WS_MOD);
    int* TE = WSP(int, WS_TOKE); int* TP = WSP(int, WS_TOKP); float* TW = WSP(float, WS_TOKW); int* LIST = WSP(int, WS_LIST);
    const float* br = INP(20) + l * 32;
    const int rotl = F.lane >> 1;
    const LAS float* wbase = wr + F.lane * 32; int roff[8];
#pragma unroll
    for (int ch = 0; ch < 8; ++ch) roff[ch] = 4 * ((ch + rotl) & 7);
    for (int rowA = r0 + 2 * F.wave; rowA < r1; rowA += 16) {
        const bool hasB = rowA + 1 < r1; const int rowB = hasB ? rowA + 1 : rowA;
        const int bidx = row_bidx(rowA);
        bf16_t* xa = X + (size_t)rowA * 1024 + 4 * F.lane; bf16_t* xb = X + (size_t)rowB * 1024 + 4 * F.lane;
        const bf16_t* ya = WSP(bf16_t, WS_Y) + (size_t)rowA * 1024 + 4 * F.lane; const bf16_t* yb = WSP(bf16_t, WS_Y) + (size_t)rowB * 1024 + 4 * F.lane;
        float ssa = 0.f, ssb = 0.f;
#pragma unroll
        for (int j = 0; j < 4; ++j) { f32x4 va = h4_to_f4(*(const u32x2*)(xa + 256 * j)), vb = h4_to_f4(*(const u32x2*)(xb + 256 * j));
            { const u32x2 q = __builtin_nontemporal_load((const u32x2*)(ya + 256 * j)); va += (f32x4){bf2f(q.x & 0xffffu), bf2f(q.x >> 16), bf2f(q.y & 0xffffu), bf2f(q.y >> 16)}; *(u32x2*)(xa + 256 * j) = f4_to_h4(va); }
            if (hasB) { const u32x2 q = __builtin_nontemporal_load((const u32x2*)(yb + 256 * j)); vb += (f32x4){bf2f(q.x & 0xffffu), bf2f(q.x >> 16), bf2f(q.y & 0xffffu), bf2f(q.y >> 16)}; *(u32x2*)(xb + 256 * j) = f4_to_h4(vb); }
            ssa += (va[0] * va[0] + va[1] * va[1]) + (va[2] * va[2] + va[3] * va[3]); ssb += (vb[0] * vb[0] + vb[1] * vb[1]) + (vb[2] * vb[2] + vb[3] * vb[3]); }
        const float rsa = rsqrtf(wave_sum(ssa, F.lane) * (1.0f / 1024.0f) + EPS), rsb = rsqrtf(wave_sum(ssb, F.lane) * (1.0f / 1024.0f) + EPS);
        const float* gm = INP(7) + l * 1024 + 4 * F.lane; const float* sh = MOD + (l * 5 + bidx) * 6144 + 3072 + 4 * F.lane; const float* sc = sh + 1024;
        float lga[32], lgb[32];
#pragma unroll
        for (int e = 0; e < 32; ++e) { lga[e] = 0.f; lgb[e] = 0.f; }
#pragma unroll 1
        for (int j = 0; j < 4; ++j) { const int c = 256 * j;
            const f32x4 va = h4_to_f4(*(const u32x2*)(xa + c)), vb = h4_to_f4(*(const u32x2*)(xb + c));
            const f32x4 g = *(const f32x4*)(gm + c), s1 = *(const f32x4*)(sc + c), s0 = *(const f32x4*)(sh + c); const f32x4 gs = g * (1.0f + s1);
            const f32x4 ha = va * rsa * gs + s0, hb = vb * rsb * gs + s0;
            { u32x2 w; w.x = pk2(ha[0], ha[1]); w.y = pk2(ha[2], ha[3]); *(u32x2*)(H + (size_t)rowA * 1024 + 4 * F.lane + c) = w; }
            if (hasB) { u32x2 w; w.x = pk2(hb[0], hb[1]); w.y = pk2(hb[2], hb[3]); *(u32x2*)(H + (size_t)rowB * 1024 + 4 * F.lane + c) = w; }
            const LAS float* wj = wbase + (64 * j) * 32;
#pragma unroll
            for (int cc = 0; cc < 4; ++cc) {
                const LAS float* wp = wj + (256 * cc) * 32; const float hva = ha[cc], hvb = hb[cc];
#pragma unroll
                for (int ch = 0; ch < 8; ++ch) { const f32x4 w4 = *(const LAS f32x4*)(wp + roff[ch]);
                    lga[4 * ch + 0] += hva * w4[0]; lga[4 * ch + 1] += hva * w4[1]; lga[4 * ch + 2] += hva * w4[2]; lga[4 * ch + 3] += hva * w4[3];
                    lgb[4 * ch + 0] += hvb * w4[0]; lgb[4 * ch + 1] += hvb * w4[1]; lgb[4 * ch + 2] += hvb * w4[2]; lgb[4 * ch + 3] += hvb * w4[3]; }
            }
        }
        router_finish(F, lga, rowA, r0, br, hist, sel, TW);
        if (hasB) router_finish(F, lgb, rowB, r0, br, hist, sel, TW);
    }
    __syncthreads();
    if (F.tid < 32) gbase[F.tid] = (int)atomicAdd(F.ctl + CW_CNT + (l * 32 + F.tid) * 64, (unsigned)hist[F.tid]);
    __syncthreads();
    for (int i = F.tid; i < (r1 - r0) * 4; i += 512) { const int s = sel[i], e = s & 255, pos = gbase[e] + (s >> 8); const int row = r0 + (i >> 2);
        TE[row * 4 + (i & 3)] = e; TP[row * 4 + (i & 3)] = pos; LIST[(size_t)e * CAP + pos] = row; }
    __syncthreads();
}

__device__ __forceinline__ bf16x8 lds_frag(const LAS unsigned char* p) { return *(const LAS bf16x8*)p; }
#define ATT_SHIFT 8.0f
__device__ __forceinline__ void phase_attn(Frame& F, int jl  , bool last) {
    LAS unsigned char* QS = F.lds;
    LAS float* RPB = (LAS float*)(F.lds + 16384);
    LAS float* RK = (LAS float*)(F.lds + 19456);
    LAS unsigned char* KT = F.lds + 24576;
    LAS unsigned char* VT = F.lds + 24576 + 40960;
    const bf16_t* QKV = WSP(bf16_t, WS_QKV); bf16_t* OUT = WSP(bf16_t, WS_MERGED); const bf16_t* VTG = WSP(bf16_t, WS_VTG); const float* SSK = WSP(float, WS_SSK);
    const float* qg = INP(16) + jl * 64; const float* kg = INP(17) + jl * 64; const float* rpb = INP(18) + (size_t)jl * 16 * 465;
    const int w = F.wave, qt = w & 3, qr = w >> 2;
    const bool xmap = (F.G == 256);
    for (int i_ = 0; ; ++i_) {
        int u, bh;
        if (xmap) { const int li = (F.bid >> 3) + 32 * i_; if (li >= 528) break;
            if (li < 512) { bh = (F.bid & 7) * 8 + (li >> 6); u = li & 63; } else { bh = (F.bid & 7) * 8 + ((li - 512) >> 1); u = 64 + ((li - 512) & 1); } }
        else { const int it = F.bid + i_ * F.G; if (it >= NB * 16 * 66) break; u = it % 66; bh = it / 66; }
        int tid_ = F.tid; asm volatile("" : "+v"(tid_));
        const int lane_ = tid_ & 63, ln = lane_ & 15, g = lane_ >> 4;
        const int lkey = tid_ >> 3, lc = tid_ & 7;
        const int h = bh & 15, b = bh >> 4;
        const bool lat = u < 64;
        if (last && !lat) continue;
        const int r0 = 2 * u, rs0 = min(max(r0 - 4, 0), 120), rs1 = min(max(r0 - 3, 0), 120);
        const int urow = r0 + qr, off = qr ? rs1 - rs0 : 0;
        const int rd_first = lat ? 0 : 2;
        u32x4 pkr[5], pvr[5]; float pss[5];
#define ATT_ISSUE(rd_) do { int lk_ = lkey, lc_ = lc; asm volatile("" : "+v"(lk_), "+v"(lc_));   \
            _Pragma("unroll") for (int s5 = 0; s5 < 5; ++s5) { if (s5 == 4 && (rd_) != 0) break; \
            const int gr_ = min(rs0 + (rd_) * 5 + s5, 127); \
            const int krow0 = (rd_) == 2 ? (RL + b * TC + s5 * 64) : (b * TL + gr_ * 64); const int tt0 = (rd_) == 2 ? (TL + s5 * 64) : gr_ * 64; \
            pkr[s5] = *(const u32x4*)((const unsigned char*)QKV + (size_t)krow0 * 6144 + 2048 + h * 128 + (unsigned)(lk_ * 6144 + lc_ * 16)); \
            pvr[s5] = *(const u32x4*)((const unsigned char*)VTG + ((size_t)((b * 16 + h) * 64) * TT + tt0) * 2 + (unsigned)(lk_ * (TT * 2) + lc_ * 16)); \
            pss[s5] = *(const float*)((const unsigned char*)SSK + (size_t)(krow0 * 16 + h) * 4 + (unsigned)(lk_ * 64)); } } while (0)
        if (lat) ATT_ISSUE(0); else ATT_ISSUE(2);
#pragma unroll
        for (int p = 0; p < 2; ++p) {
            const int ql = p * 64 + lkey;
            const int qrow = lat ? (b * TL + (r0 + p) * 64 + lkey) : (RL + b * TC + (u - 64) * 128 + ql);
            const u32x4 raw = *(const u32x4*)(QKV + (size_t)qrow * 3072 + h * 64 + lc * 8);
            float x[8] = {bf2f(raw.x & 0xffffu), bf2f(raw.x >> 16), bf2f(raw.y & 0xffffu), bf2f(raw.y >> 16), bf2f(raw.z & 0xffffu), bf2f(raw.z >> 16), bf2f(raw.w & 0xffffu), bf2f(raw.w >> 16)};
            float ss = 0.f;
#pragma unroll
            for (int i = 0; i < 8; ++i) ss += x[i] * x[i];
            ss += shx(ss, 1, lane_); ss += shx(ss, 2, lane_); ss += shx(ss, 4, lane_);
            const float r = rsqrtf(ss * (1.0f / 64.0f) + EPS) * (0.125f * 1.4426950408889634f);
            const f32x4 g0 = *(const f32x4*)(qg + lc * 8) * *(const f32x4*)(kg + lc * 8), g1 = *(const f32x4*)(qg + lc * 8 + 4) * *(const f32x4*)(kg + lc * 8 + 4);
            u32x4 o; o.x = pk2(x[0] * r * g0[0], x[1] * r * g0[1]); o.y = pk2(x[2] * r * g0[2], x[3] * r * g0[3]); o.z = pk2(x[4] * r * g1[0], x[5] * r * g1[1]); o.w = pk2(x[6] * r * g1[2], x[7] * r * g1[3]);
            *(LAS u32x4*)(QS + ql * 128 + lc * 16) = o;
        }
        for (int i = tid_; i < 15 * 48; i += 512) { const int rr = i / 48, cc = i % 48 - 8; RPB[i] = (cc >= 0 && cc < 31) ? rpb[h * 465 + rr * 31 + cc] * 1.4426950408889634f - ATT_SHIFT : 0.f; }
        f32x4 O[4]; float l_run = 0.f;
#pragma unroll
        for (int e = 0; e < 4; ++e) O[e] = (f32x4){0.f, 0.f, 0.f, 0.f};
        bf16x8 qf[2];
#pragma unroll 1
        for (int rd = rd_first; rd < 3; ++rd) {
            const int nslot = rd == 0 ? 5 : 4;
#pragma unroll
            for (int s5 = 0; s5 < 5; ++s5) {
                if (s5 < nslot) {
                *(LAS u32x4*)(KT + s5 * 8192 + lkey * 128 + ((lc ^ (lkey & 7)) * 16)) = pkr[s5];
                *(LAS u32x4*)(VT + s5 * 8192 + lkey * 128 + ((lc ^ ((lkey ^ (lkey >> 3)) & 7)) * 16)) = pvr[s5];
                if (lc == 0) RK[s5 * 64 + lkey] = rsqrtf(pss[s5] * (1.0f / 64.0f) + EPS);
                }
            }
            __syncthreads();
            if (rd == 0) ATT_ISSUE(1); else if (rd == 1) ATT_ISSUE(2);
            if (rd == rd_first) {
#pragma unroll
                for (int ks = 0; ks < 2; ++ks) qf[ks] = lds_frag(QS + (w * 16 + ln) * 128 + (ks * 4 + g) * 16);
            }
            {
                int t2_ = tid_; asm volatile("" : "+v"(t2_));
                const int ln = t2_ & 15, g = (t2_ & 63) >> 4;
                if (rd < 2) {
                    const int thr = qt == 0 ? max(ln, 8) : qt == 3 ? min(ln, 8) : ln;
                    const int c0 = max(2 * qt - 1 + (g >> 1), 0), c1 = min(2 * qt + 1 + (g >> 1), 7);
                    const int key0 = min(max(16 * qt - 8 + ln, 0), 63), key1 = min(16 * qt + 8 + ln, 63);
                    const int rkb0 = min(max(16 * qt - 8 + 4 * g, 0), 60), rkb1 = min(16 * qt + 8 + 4 * g, 60);
                    bf16x8 ka[2][4]; float rbv[2][8]; f32x4 rkl[2][2];
#define ATT_LOADL(st, s5_) do { const LAS unsigned char* kt_ = KT + (s5_) * 8192; \
                        ka[st][0] = lds_frag(kt_ + key0 * 128 + (((0 + g) ^ (key0 & 7)) * 16)); ka[st][1] = lds_frag(kt_ + key0 * 128 + (((4 + g) ^ (key0 & 7)) * 16)); \
                        ka[st][2] = lds_frag(kt_ + key1 * 128 + (((0 + g) ^ (key1 & 7)) * 16)); ka[st][3] = lds_frag(kt_ + key1 * 128 + (((4 + g) ^ (key1 & 7)) * 16)); \
                        const int rrow_ = min(max(rs0 + rd * 5 + (s5_) - urow + 7, 0), 14); const LAS float* rb_ = RPB + rrow_ * 48 + 15 - ln + 4 * g; \
                        _Pragma("unroll") for (int j = 0; j < 4; ++j) { rbv[st][j] = rb_[j]; rbv[st][4 + j] = rb_[16 + j]; } \
                        rkl[st][0] = *(const LAS f32x4*)(RK + (s5_) * 64 + rkb0); rkl[st][1] = *(const LAS f32x4*)(RK + (s5_) * 64 + rkb1); \
                        } while (0)
#define ATT_LOADLV(s5_) do { const LAS unsigned char* vt_ = VT + (s5_) * 8192; \
                        _Pragma("unroll") for (int et = 0; et < 4; ++et) { const int e = et * 16 + ln; const int sw = (e ^ (e >> 3)) & 7; \
                            vfa[et] = *(const LAS u32x2*)(vt_ + e * 128 + ((c0 ^ sw) * 16) + (g & 1) * 8); vfb[et] = *(const LAS u32x2*)(vt_ + e * 128 + ((c1 ^ sw) * 16) + (g & 1) * 8); } } while (0)
                    ATT_LOADL(0, 0);
#pragma unroll
                    for (int s5 = 0; s5 < 5; ++s5) {
                        if (s5 == 4 && rd != 0) break;
                        const int st = s5 & 1;
                        u32x2 vfa[4], vfb[4];
                        ATT_LOADLV(s5);
                        if (s5 + 1 < 5 && !(s5 + 1 == 4 && rd != 0)) ATT_LOADL(st ^ 1, s5 + 1);
                        __builtin_amdgcn_sched_barrier(0);
                        const int t = rd * 5 + s5;
                        const bool mine = (t >= off) && (t <= off + 7);
                        f32x4 sc0 = (f32x4){0.f, 0.f, 0.f, 0.f}, sc1 = (f32x4){0.f, 0.f, 0.f, 0.f};
                        sc0 = __builtin_amdgcn_mfma_f32_16x16x32_bf16(ka[st][0], qf[0], sc0, 0, 0, 0);
                        sc1 = __builtin_amdgcn_mfma_f32_16x16x32_bf16(ka[st][2], qf[0], sc1, 0, 0, 0);
                        sc0 = __builtin_amdgcn_mfma_f32_16x16x32_bf16(ka[st][1], qf[1], sc0, 0, 0, 0);
                        sc1 = __builtin_amdgcn_mfma_f32_16x16x32_bf16(ka[st][3], qf[1], sc1, 0, 0, 0);
#pragma unroll
                        for (int j = 0; j < 4; ++j) { const int kk = 4 * g + j;
                            const float p0 = (mine && kk >= thr) ? __builtin_amdgcn_exp2f(sc0[j] * rkl[st][0][j] + rbv[st][j]) : 0.f;
                            const float p1 = (mine && kk < thr) ? __builtin_amdgcn_exp2f(sc1[j] * rkl[st][1][j] + rbv[st][4 + j]) : 0.f;
                            sc0[j] = p0; sc1[j] = p1; l_run += p0 + p1; }
                        u32x4 pw; pw.x = pk2(sc0[0], sc0[1]); pw.y = pk2(sc0[2], sc0[3]); pw.z = pk2(sc1[0], sc1[1]); pw.w = pk2(sc1[2], sc1[3]);
                        const bf16x8 pf = __builtin_bit_cast(bf16x8, pw);
#pragma unroll
                        for (int et = 0; et < 4; ++et) { u32x4 vw; vw.x = vfa[et].x; vw.y = vfa[et].y; vw.z = vfb[et].x; vw.w = vfb[et].y;
                            O[et] = __builtin_amdgcn_mfma_f32_16x16x32_bf16(__builtin_bit_cast(bf16x8, vw), pf, O[et], 0, 0, 0); }
                    }
#undef ATT_LOADL
#undef ATT_LOADLV
                } else {
                    bf16x8 kc[2][4][2]; f32x4 rkv[2][4];
#define ATT_LOADCK(st, s5_) do { const LAS unsigned char* kt_ = KT + (s5_) * 8192; \
                        _Pragma("unroll") for (int kt = 0; kt < 4; ++kt) { const int key = kt * 16 + ln; \
                            kc[st][kt][0] = lds_frag(kt_ + key * 128 + (((0 + g) ^ (key & 7)) * 16)); kc[st][kt][1] = lds_frag(kt_ + key * 128 + (((4 + g) ^ (key & 7)) * 16)); \
                            rkv[st][kt] = *(const LAS f32x4*)(RK + (s5_) * 64 + 16 * kt + 4 * g); } } while (0)
                    ATT_LOADCK(0, 0);
#pragma unroll
                    for (int s5 = 0; s5 < 4; ++s5) {
                        const int st = s5 & 1;
                        const LAS unsigned char* vt_ = VT + s5 * 8192;
                        u32x2 vfa[2][4], vfb[2][4];
#pragma unroll
                        for (int ks2 = 0; ks2 < 2; ++ks2)
#pragma unroll
                            for (int et = 0; et < 4; ++et) { const int e = et * 16 + ln; const int sw = (e ^ (e >> 3)) & 7;
                                vfa[ks2][et] = *(const LAS u32x2*)(vt_ + e * 128 + (((4 * ks2 + (g >> 1)) ^ sw) * 16) + (g & 1) * 8);
                                vfb[ks2][et] = *(const LAS u32x2*)(vt_ + e * 128 + (((4 * ks2 + 2 + (g >> 1)) ^ sw) * 16) + (g & 1) * 8); }
                        if (s5 + 1 < 4) ATT_LOADCK(st ^ 1, s5 + 1);
                        __builtin_amdgcn_sched_barrier(0);
                        f32x4 sc[4];
#pragma unroll
                        for (int kt = 0; kt < 4; ++kt) sc[kt] = __builtin_amdgcn_mfma_f32_16x16x32_bf16(kc[st][kt][0], qf[0], (f32x4){0.f, 0.f, 0.f, 0.f}, 0, 0, 0);
#pragma unroll
                        for (int kt = 0; kt < 4; ++kt) sc[kt] = __builtin_amdgcn_mfma_f32_16x16x32_bf16(kc[st][kt][1], qf[1], sc[kt], 0, 0, 0);
#pragma unroll
                        for (int kt = 0; kt < 4; ++kt)
#pragma unroll
                            for (int j = 0; j < 4; ++j) { const float p = __builtin_amdgcn_exp2f(sc[kt][j] * rkv[st][kt][j] - ATT_SHIFT); sc[kt][j] = p; l_run += p; }
#pragma unroll
                        for (int ks2 = 0; ks2 < 2; ++ks2) {
                            u32x4 pw; pw.x = pk2(sc[2 * ks2][0], sc[2 * ks2][1]); pw.y = pk2(sc[2 * ks2][2], sc[2 * ks2][3]); pw.z = pk2(sc[2 * ks2 + 1][0], sc[2 * ks2 + 1][1]); pw.w = pk2(sc[2 * ks2 + 1][2], sc[2 * ks2 + 1][3]);
                            const bf16x8 pf = __builtin_bit_cast(bf16x8, pw);
#pragma unroll
                            for (int et = 0; et < 4; ++et) { u32x4 vw; vw.x = vfa[ks2][et].x; vw.y = vfa[ks2][et].y; vw.z = vfb[ks2][et].x; vw.w = vfb[ks2][et].y;
                                O[et] = __builtin_amdgcn_mfma_f32_16x16x32_bf16(__builtin_bit_cast(bf16x8, vw), pf, O[et], 0, 0, 0); }
                        }
                    }
#undef ATT_LOADCK
                }
            }
            __syncthreads();
        }
        l_run += shx(l_run, 16, lane_); l_run += shx(l_run, 32, lane_);
        {
            const float inv = 1.0f / l_run;
            const int qrow = lat ? (b * TL + urow * 64 + qt * 16 + ln) : (RL + b * TC + (u - 64) * 128 + w * 16 + ln);
#pragma unroll
            for (int e = 0; e < 4; ++e) { u32x2 wv; wv.x = pk2(O[e][0] * inv, O[e][1] * inv); wv.y = pk2(O[e][2] * inv, O[e][3] * inv);
                *(u32x2*)(OUT + (size_t)qrow * 1024 + h * 64 + e * 16 + 4 * g) = wv; }
        }
    }
#undef ATT_ISSUE
}

constexpr size_t WS_GH = WS_ACT, WS_GM = WS_ACT + 72 * MiB, WS_SH = WS_ACT + 128 * MiB, WS_SM = WS_SH + 72 * MiB;
constexpr size_t WS_DECH = WS_YS, WS_DECM = WS_YS + 1 * MiB;
constexpr size_t WS_OTH = WS_OHF, WS_OTM = WS_OMF;
static_assert(WS_GM + (size_t)1056 * 10240 * 4 <= WS_SH && WS_SM + (size_t)1056 * 10240 * 4 <= WS_YS, "scan dumps");
template <int KIND> struct ScanCfg {
    static constexpr int DK = KIND ? 64 : 128, RBQ = DK * 2, CMQ = DK / 8 - 1, KST = DK / 32, NEXT = KIND ? 144 : 128, OBS = KIND ? 148 : 132;
    static constexpr int OFF_OB = 0;
    static constexpr int OFF_QP = KIND ? 36864 : 0, OFF_KP = OFF_QP + 64 * RBQ, OFF_KPT = OFF_KP + 64 * RBQ, OFF_VT = OFF_KPT + DK * 128, OFF_PP = OFF_VT + 20480, OFF_SST = OFF_PP + 8192;
    static constexpr int OFF_SM = 114688;
    static constexpr int GSTRIDE = KIND ? 10240 : 16384;
};
__device__ __forceinline__ int sc_row(int b, int sct, int t) { return sct == 0 ? (RL + b * TC + t) : (b * TL + (sct - 1) * 256 + t); }
__device__ __forceinline__ float exp_c(float x) { return __expf(fminf(fmaxf(x, -80.f), 80.f)); }
template <int KIND> __device__ __forceinline__ int st_n0(int w) { return KIND ? (w >> 2) * 4 : 0; }
template <int KIND> __device__ __forceinline__ int st_nc(int w) { return KIND ? ((w >> 2) ? 5 : 4) : 8; }
template <int KIND> __device__ __forceinline__ int st_mt(int w) { return KIND ? (w & 3) : w; }
template <int KIND> __device__ __forceinline__ int ot_n0(int w) { return (w >> 2) * 4; }
template <int KIND> __device__ __forceinline__ int ot_nc(int w) { return KIND ? ((w >> 2) ? 5 : 4) : 4; }

template <int KIND, int PASS>
__device__ __forceinline__ void scan_super(Frame& F, int jl, int b, int h, int sct, int dir, f32x4 (&S)[8]) {
    typedef ScanCfg<KIND> C;
    LAS unsigned char* L = F.lds;
    LAS float* TOT = (LAS float*)(L + C::OFF_SM); LAS float* EM = TOT + 512; LAS float* E2 = EM + 128; LAS float* BT = E2 + 128; LAS float* RQ = BT + 128; LAS float* CK = RQ + 64; LAS float* SCAL = CK + 64;
    const int w = F.wave;
    const bf16_t* Qg = KIND ? WSP(bf16_t, WS_MQ) : WSP(bf16_t, WS_Q);
    const bf16_t* Kg = KIND ? WSP(bf16_t, WS_MK) : WSP(bf16_t, dir ? WS_KB : WS_KF);
    const bf16_t* Vg = KIND ? WSP(bf16_t, WS_MV) : WSP(bf16_t, WS_V);
    const int hq = h * C::DK;
    u32x4 rq[2], rk[2], rv[2]; float rl[16]; float rg0 = 0.f, rg1 = 0.f;
    const float* LAg = WSP(float, dir ? WS_LAB : WS_LAF); const float* GTg = WSP(float, WS_GATES);
#define SC_ISSUE(ci_, TID) do { const int cN = dir ? 3 - (ci_) : (ci_); const int tN = cN * 64; \
        if (KIND == 0) { const int d_ = (TID) & 127, part_ = (TID) >> 7; \
            _Pragma("unroll") for (int i = 0; i < 16; ++i) rl[i] = LAg[(size_t)sc_row(b, sct, tN + part_ * 16 + i) * 512 + hq + d_]; \
            _Pragma("unroll") for (int p = 0; p < 2; ++p) { const size_t ro = (size_t)sc_row(b, sct, tN + p * 32 + ((TID) >> 4)) * 512 + hq + 8 * ((TID) & 15); \
                if (PASS == 3) rq[p] = *(const u32x4*)(Qg + ro); rk[p] = *(const u32x4*)(Kg + ro); rv[p] = *(const u32x4*)(Vg + ro); } } \
        else { { const size_t ro = (size_t)sc_row(b, sct, tN + ((TID) >> 3)) * 256 + hq + 8 * ((TID) & 7); if (PASS == 3) rq[0] = *(const u32x4*)(Qg + ro); rk[0] = *(const u32x4*)(Kg + ro); } \
            _Pragma("unroll") for (int p = 0; p < 2; ++p) rv[p] = *(const u32x4*)(Vg + (size_t)sc_row(b, sct, tN + p * 32 + ((TID) >> 4)) * 512 + h * 128 + 8 * ((TID) & 15)); \
            if ((TID) < 64) { const size_t go = (size_t)sc_row(b, sct, tN + (TID)) * 16 + h; rg0 = GTg[go + (dir ? 12 : 4)]; rg1 = GTg[go + (dir ? 8 : 0)]; } } } while (0)
    SC_ISSUE(0, F.tid);
#pragma unroll 1
    for (int ci = 0; ci < 4; ++ci) {
        const int c = dir ? 3 - ci : ci; const int t0 = c * 64;
        int tid_ = F.tid; asm volatile("" : "+v"(tid_));
        const int lane_ = tid_ & 63, ln = lane_ & 15, g = lane_ >> 4;
        LAS unsigned char* VRAW = L + C::OFF_SST;
        if (KIND == 0) {
            const int d = tid_ & 127, part = tid_ >> 7;
            if (!dir) {
#pragma unroll
                for (int i = 1; i < 16; ++i) rl[i] += rl[i - 1];
                TOT[part * 128 + d] = rl[15];
            } else {
#pragma unroll
                for (int i = 14; i >= 0; --i) rl[i] += rl[i + 1];
                TOT[part * 128 + d] = rl[0];
            }
#pragma unroll
            for (int p = 0; p < 2; ++p) { const int t = p * 32 + (tid_ >> 4), cc = tid_ & 15;
                if (PASS == 3) *(LAS u32x4*)(L + C::OFF_QP + t * 256 + ((cc ^ (t & 15)) * 16)) = rq[p];
                *(LAS u32x4*)(L + C::OFF_KP + t * 256 + ((cc ^ (t & 15)) * 16)) = rk[p];
                *(LAS u32x4*)(VRAW + t * 256 + cc * 16) = rv[p]; }
        } else {
            { const int t = tid_ >> 3, cc = tid_ & 7;
                if (PASS == 3) *(LAS u32x4*)(L + C::OFF_QP + t * 128 + ((cc ^ (t & 7)) * 16)) = rq[0];
                *(LAS u32x4*)(L + C::OFF_KP + t * 128 + ((cc ^ (t & 7)) * 16)) = rk[0]; }
#pragma unroll
            for (int p = 0; p < 2; ++p) { const int t = p * 32 + (tid_ >> 4), cc = tid_ & 15; *(LAS u32x4*)(VRAW + t * 256 + cc * 16) = rv[p]; }
            if (tid_ < 64) { const int t = tid_;
                float x = rg0; const float ig = rg1;
#pragma unroll
                for (int o = 1; o < 64; o <<= 1) { const int src = dir ? t + o : t - o; const float y = __int_as_float(__builtin_amdgcn_ds_bpermute((src & 63) << 2, __float_as_int(x))); if (src >= 0 && src < 64) x += y; }
                const float ref = __int_as_float(__builtin_amdgcn_readlane(__float_as_int(x), dir ? 32 : 31));
                const float btot = __int_as_float(__builtin_amdgcn_readlane(__float_as_int(x), dir ? 0 : 63));
                RQ[t] = exp_c(x - ref); CK[t] = exp_c(ref - x + ig);
                if (t == 0) { SCAL[0] = __expf(ref); SCAL[1] = __expf(btot - ref); if (PASS == 1) SCAL[2] = (ci == 0 ? 0.f : SCAL[2]) + btot; } }
            if (tid_ < 128) { const int row = 128 + (tid_ >> 3), ch = tid_ & 7; const unsigned one = (row == 128) ? 0x3f803f80u : 0u;
                *(LAS u32x4*)(L + C::OFF_VT + row * 128 + ((ch ^ (row & 7)) * 16)) = (u32x4){one, one, one, one}; }
        }
        __syncthreads();
        if (KIND == 0) {
            const int d = tid_ & 127, part = tid_ >> 7;
            const float t0v = TOT[d], t1v = TOT[128 + d], t2v = TOT[256 + d], t3v = TOT[384 + d];
            const float btot = (t0v + t1v) + (t2v + t3v);
            const float ref = dir ? (t2v + t3v) : (t0v + t1v);
            float off;
            if (!dir) off = part == 0 ? 0.f : part == 1 ? t0v : part == 2 ? (t0v + t1v) : (t0v + t1v + t2v);
            else off = part == 3 ? 0.f : part == 2 ? t3v : part == 1 ? (t3v + t2v) : (t3v + t2v + t1v);
            if (part == 0) { EM[d] = __expf(ref); E2[d] = __expf(btot - ref); if (PASS == 1) BT[d] = (ci == 0 ? 0.f : BT[d]) + btot; }
            unsigned kt[8];
            const float c0 = (off - ref) * 1.4426950408889634f;
#pragma unroll
            for (int ip = 0; ip < 8; ++ip) { const int ta = part * 16 + 2 * ip, tb2 = ta + 1;
                const int ad0 = ta * 256 + (((d >> 3) ^ (ta & 15)) * 16) + (d & 7) * 2, ad1 = tb2 * 256 + (((d >> 3) ^ (tb2 & 15)) * 16) + (d & 7) * 2;
                const float bm0 = __builtin_amdgcn_fmed3f(__builtin_fmaf(rl[2 * ip], 1.4426950408889634f, c0), -115.0f, 115.0f);
                const float bm1 = __builtin_amdgcn_fmed3f(__builtin_fmaf(rl[2 * ip + 1], 1.4426950408889634f, c0), -115.0f, 115.0f);
                const float k0 = bf2f(*(const LAS bf16_t*)(L + C::OFF_KP + ad0)) * __builtin_amdgcn_exp2f(-bm0), k1 = bf2f(*(const LAS bf16_t*)(L + C::OFF_KP + ad1)) * __builtin_amdgcn_exp2f(-bm1);
                const unsigned kw = pk2(k0, k1); kt[ip] = kw;
                if (PASS == 3) { const float q0 = bf2f(*(const LAS bf16_t*)(L + C::OFF_QP + ad0)) * __builtin_amdgcn_exp2f(bm0), q1 = bf2f(*(const LAS bf16_t*)(L + C::OFF_QP + ad1)) * __builtin_amdgcn_exp2f(bm1);
                    const unsigned qw = pk2(q0, q1);
                    *(LAS bf16_t*)(L + C::OFF_QP + ad0) = (bf16_t)qw; *(LAS bf16_t*)(L + C::OFF_QP + ad1) = (bf16_t)(qw >> 16);
                    *(LAS bf16_t*)(L + C::OFF_KP + ad0) = (bf16_t)kw; *(LAS bf16_t*)(L + C::OFF_KP + ad1) = (bf16_t)(kw >> 16); } }
            *(LAS u32x4*)(L + C::OFF_KPT + d * 128 + (((part * 2) ^ (d & 7)) * 16)) = (u32x4){kt[0], kt[1], kt[2], kt[3]};
            *(LAS u32x4*)(L + C::OFF_KPT + d * 128 + (((part * 2 + 1) ^ (d & 7)) * 16)) = (u32x4){kt[4], kt[5], kt[6], kt[7]};
        } else {
            const int d = tid_ & 63, part = tid_ >> 6;
            unsigned kt[4];
#pragma unroll
            for (int ip = 0; ip < 4; ++ip) { const int ta = part * 8 + 2 * ip, tb2 = ta + 1;
                const int ad0 = ta * 128 + (((d >> 3) ^ (ta & 7)) * 16) + (d & 7) * 2, ad1 = tb2 * 128 + (((d >> 3) ^ (tb2 & 7)) * 16) + (d & 7) * 2;
                const float k0 = bf2f(*(const LAS bf16_t*)(L + C::OFF_KP + ad0)) * CK[ta], k1 = bf2f(*(const LAS bf16_t*)(L + C::OFF_KP + ad1)) * CK[tb2];
                const unsigned kw = pk2(k0, k1); kt[ip] = kw;
                if (PASS == 3) { const float q0 = bf2f(*(const LAS bf16_t*)(L + C::OFF_QP + ad0)) * RQ[ta], q1 = bf2f(*(const LAS bf16_t*)(L + C::OFF_QP + ad1)) * RQ[tb2];
                    const unsigned qw = pk2(q0, q1);
                    *(LAS bf16_t*)(L + C::OFF_QP + ad0) = (bf16_t)qw; *(LAS bf16_t*)(L + C::OFF_QP + ad1) = (bf16_t)(qw >> 16);
                    *(LAS bf16_t*)(L + C::OFF_KP + ad0) = (bf16_t)kw; *(LAS bf16_t*)(L + C::OFF_KP + ad1) = (bf16_t)(kw >> 16); } }
            *(LAS u32x4*)(L + C::OFF_KPT + d * 128 + ((part ^ (d & 7)) * 16)) = (u32x4){kt[0], kt[1], kt[2], kt[3]};
        }
        {
            const int e = tid_ & 127, part = tid_ >> 7; unsigned vt[8];
#pragma unroll
            for (int i = 0; i < 16; ++i) { const unsigned vb = *(const LAS bf16_t*)(VRAW + (part * 16 + i) * 256 + e * 2); if (i & 1) vt[i >> 1] |= vb << 16; else vt[i >> 1] = vb; }
            *(LAS u32x4*)(L + C::OFF_VT + e * 128 + (((part * 2) ^ (e & 7)) * 16)) = (u32x4){vt[0], vt[1], vt[2], vt[3]};
            *(LAS u32x4*)(L + C::OFF_VT + e * 128 + (((part * 2 + 1) ^ (e & 7)) * 16)) = (u32x4){vt[4], vt[5], vt[6], vt[7]};
        }
        if (ci < 3) SC_ISSUE(ci + 1, tid_);
        __syncthreads();
        const int smt = st_mt<KIND>(w), sn0 = st_n0<KIND>(w), snc = st_nc<KIND>(w), onc = KIND ? snc : 4;
#define SC_ET(n) (KIND ? (sn0 + (n)) : (((((n) >> 2) ^ (w >> 2)) << 2) + ((n) & 3)))
        {
            f32x4 em;
            if (KIND == 0) em = *(const LAS f32x4*)(EM + smt * 16 + 4 * g); else { const float s0 = SCAL[0]; em = (f32x4){s0, s0, s0, s0}; }
#pragma unroll
            for (int n = 0; n < 8; ++n) if (n < snc) { S[n] *= em;
                if (PASS == 3) { const int e = SC_ET(n) * 16 + ln; u32x2 wv; wv.x = pk2(S[n][0], S[n][1]); wv.y = pk2(S[n][2], S[n][3]);
                    *(LAS u32x2*)(L + C::OFF_SST + e * C::RBQ + (((2 * smt + (g >> 1)) ^ (e & C::CMQ)) * 16) + (g & 1) * 8) = wv; } }
        }
        constexpr int NVT = KIND ? 5 : 8;
        bf16x8 vt[NVT][2], kf[2];
#pragma unroll
        for (int n = 0; n < NVT; ++n) if (n < snc) { const int e = SC_ET(n) * 16 + ln;
#pragma unroll
            for (int ks = 0; ks < 2; ++ks) vt[n][ks] = lds_frag(L + C::OFF_VT + e * 128 + (((ks * 4 + g) ^ (e & 7)) * 16)); }
        { const int d_row = smt * 16 + ln;
#pragma unroll
            for (int ks = 0; ks < 2; ++ks) kf[ks] = lds_frag(L + C::OFF_KPT + d_row * 128 + (((ks * 4 + g) ^ (d_row & 7)) * 16)); }
        f32x4 e2;
        if (KIND == 0) e2 = *(const LAS f32x4*)(E2 + smt * 16 + 4 * g); else { const float s1 = SCAL[1]; e2 = (f32x4){s1, s1, s1, s1}; }
        f32x4 oacc[5];
        if (PASS == 3) {
            {
                const int st = w & 3, s_row = st * 16 + ln;
                bf16x8 af[C::KST], qfr[2][C::KST];
#pragma unroll
                for (int ks = 0; ks < C::KST; ++ks) af[ks] = lds_frag(L + C::OFF_KP + s_row * C::RBQ + (((ks * 4 + g) ^ (s_row & C::CMQ)) * 16));
#pragma unroll
                for (int tq = 0; tq < 2; ++tq) { const int t_row = ((w >> 2) * 2 + tq) * 16 + ln;
#pragma unroll
                    for (int ks = 0; ks < C::KST; ++ks) qfr[tq][ks] = lds_frag(L + C::OFF_QP + t_row * C::RBQ + (((ks * 4 + g) ^ (t_row & C::CMQ)) * 16)); }
                __builtin_amdgcn_sched_barrier(0);
#pragma unroll
                for (int tq = 0; tq < 2; ++tq) { const int tt = (w >> 2) * 2 + tq, t_row = tt * 16 + ln;
                    f32x4 acc = (f32x4){0.f, 0.f, 0.f, 0.f};
#pragma unroll
                    for (int ks = 0; ks < C::KST; ++ks) acc = __builtin_amdgcn_mfma_f32_16x16x32_bf16(af[ks], qfr[tq][ks], acc, 0, 0, 0);
#pragma unroll
                    for (int j = 0; j < 4; ++j) { const int sidx = st * 16 + 4 * g + j; const bool keep = dir ? (sidx >= t_row) : (sidx <= t_row); acc[j] = keep ? acc[j] : 0.f; }
                    u32x2 wv; wv.x = pk2(acc[0], acc[1]); wv.y = pk2(acc[2], acc[3]);
                    *(LAS u32x2*)(L + C::OFF_PP + t_row * 128 + (((2 * st + (g >> 1)) ^ (t_row & 7)) * 16) + (g & 1) * 8) = wv; }
            }
        } else __builtin_amdgcn_sched_barrier(0);
#pragma unroll
        for (int n = 0; n < NVT; ++n) if (n < snc) {
#pragma unroll
            for (int ks = 0; ks < 2; ++ks) S[n] = __builtin_amdgcn_mfma_f32_16x16x32_bf16(kf[ks], vt[n][ks], S[n], 0, 0, 0);
            S[n] *= e2; }
        if (PASS == 3) {
            __syncthreads();
            {
                const int tt = w & 3, t_row = tt * 16 + ln;
                bf16x8 pf[2], qf2[C::KST], sst[5][C::KST];
#pragma unroll
                for (int ks = 0; ks < 2; ++ks) pf[ks] = lds_frag(L + C::OFF_PP + t_row * 128 + (((ks * 4 + g) ^ (t_row & 7)) * 16));
#pragma unroll
                for (int ks = 0; ks < C::KST; ++ks) qf2[ks] = lds_frag(L + C::OFF_QP + t_row * C::RBQ + (((ks * 4 + g) ^ (t_row & C::CMQ)) * 16));
#pragma unroll
                for (int n = 0; n < 5; ++n) if (n < onc) { const int e = SC_ET(n) * 16 + ln;
#pragma unroll
                    for (int ks = 0; ks < C::KST; ++ks) sst[n][ks] = lds_frag(L + C::OFF_SST + e * C::RBQ + (((ks * 4 + g) ^ (e & C::CMQ)) * 16)); }
                __builtin_amdgcn_sched_barrier(0);
#pragma unroll
                for (int n = 0; n < 5; ++n) if (n < onc) { f32x4 acc = (f32x4){0.f, 0.f, 0.f, 0.f};
#pragma unroll
                    for (int ks = 0; ks < 2; ++ks) acc = __builtin_amdgcn_mfma_f32_16x16x32_bf16(pf[ks], vt[n][ks], acc, 0, 0, 0);
#pragma unroll
                    for (int ks = 0; ks < C::KST; ++ks) acc = __builtin_amdgcn_mfma_f32_16x16x32_bf16(qf2[ks], sst[n][ks], acc, 0, 0, 0);
                    oacc[n] = acc; }
            }
        }
        __syncthreads();
        if (PASS == 3) {
            LAS float* OB = (LAS float*)(L + C::OFF_OB);
            {
                const int tt = w & 3, on0 = ot_n0<KIND>(w), onc = ot_nc<KIND>(w);
#pragma unroll
                for (int n = 0; n < 5; ++n) if (n < onc) { const int e = (on0 + n) * 16 + ln;
#pragma unroll
                    for (int j = 0; j < 4; ++j) OB[(tt * 16 + 4 * g + j) * C::OBS + e] = oacc[n][j]; }
            }
            __syncthreads();
            {
                const int t = tid_ >> 3, seg = tid_ & 7; const int row = sc_row(b, sct, t0 + t);
                const LAS float* ob = OB + t * C::OBS + seg * 16;
                f32x4 v[4];
#pragma unroll
                for (int q = 0; q < 4; ++q) v[q] = *(const LAS f32x4*)(ob + 4 * q);
                if (KIND == 1) { const float den = OB[t * C::OBS + 128]; const float inv = 1.0f / fmaxf(fabsf(den), 1.0f);
#pragma unroll
                    for (int q = 0; q < 4; ++q) v[q] *= inv; }
                float* ot = WSP(float, KIND ? WS_OTM : WS_OTH) + (size_t)row * 512 + h * 128 + seg * 16;
                if (!dir) {
#pragma unroll
                    for (int q = 0; q < 4; ++q) *(f32x4*)(ot + 4 * q) = v[q];
                } else {
                    float ss = 0.f;
#pragma unroll
                    for (int q = 0; q < 4; ++q) { v[q] += *(const f32x4*)(ot + 4 * q); ss += (v[q][0] * v[q][0] + v[q][1] * v[q][1]) + (v[q][2] * v[q][2] + v[q][3] * v[q][3]); }
                    ss += shx(ss, 1, lane_); ss += shx(ss, 2, lane_); ss += shx(ss, 4, lane_);
                    const float r = rsqrtf(ss * (1.0f / 128.0f) + EPS);
                    const float* gn = INP(KIND ? 13 : 12) + jl * 512 + h * 128 + seg * 16;
                    const bf16_t* gate = WSP(bf16_t, KIND ? WS_MO : WS_HG) + (size_t)row * 512 + h * 128 + seg * 16;
                    const u32x4 ga = *(const u32x4*)gate, gb = *(const u32x4*)(gate + 8);
                    const unsigned gw[8] = {ga.x, ga.y, ga.z, ga.w, gb.x, gb.y, gb.z, gb.w};
                    unsigned ow[8];
#pragma unroll
                    for (int q = 0; q < 4; ++q) { const f32x4 gq = *(const f32x4*)(gn + 4 * q);
                        const float y0 = v[q][0] * r * gq[0] * bf2f(gw[2 * q] & 0xffffu), y1 = v[q][1] * r * gq[1] * bf2f(gw[2 * q] >> 16);
                        const float y2 = v[q][2] * r * gq[2] * bf2f(gw[2 * q + 1] & 0xffffu), y3 = v[q][3] * r * gq[3] * bf2f(gw[2 * q + 1] >> 16);
                        ow[2 * q] = pk2(y0, y1); ow[2 * q + 1] = pk2(y2, y3); }
                    bf16_t* mg = WSP(bf16_t, WS_MERGED) + (size_t)row * 1024 + KIND * 512 + h * 128 + seg * 16;
                    *(u32x4*)mg = (u32x4){ow[0], ow[1], ow[2], ow[3]}; *(u32x4*)(mg + 8) = (u32x4){ow[4], ow[5], ow[6], ow[7]};
                }
            }
            __syncthreads();
        }
    }
}
#undef SC_ISSUE
#undef SC_ET
__device__ __forceinline__ void phase_scan1(Frame& F) {
    for (int it = F.bid; it < 2 * 32 * 32; it += F.G) {
        const int cpos = it & 31, ch = (it >> 5) & 31, kind = it >> 10; const int dir = ch & 1, h = (ch >> 1) & 3, b = ch >> 3;
        const int sct = cpos == 0 ? 0 : (dir ? 33 - cpos : cpos);
        f32x4 S[8];
#pragma unroll
        for (int n = 0; n < 8; ++n) S[n] = (f32x4){0.f, 0.f, 0.f, 0.f};
        if (kind == 0) { scan_super<0, 1>(F, 0, b, h, sct, dir, S);
            float* G = WSP(float, WS_GH) + (size_t)(ch * 33 + cpos) * 16384;
#pragma unroll
            for (int n = 0; n < 8; ++n) *(f32x4*)(G + (n * 512 + F.tid) * 4) = S[n];
            if (F.tid < 128) WSP(float, WS_DECH)[(ch * 33 + cpos) * 128 + F.tid] = __expf(((const LAS float*)(F.lds + ScanCfg<0>::OFF_SM))[768 + F.tid]);
        } else { scan_super<1, 1>(F, 0, b, h, sct, dir, S);
            float* G = WSP(float, WS_GM) + (size_t)(ch * 33 + cpos) * 10240;
#pragma unroll
            for (int n = 0; n < 5; ++n) *(f32x4*)(G + (n * 512 + F.tid) * 4) = S[n];
            if (F.tid == 0) WSP(float, WS_DECM)[ch * 33 + cpos] = __expf(((const LAS float*)(F.lds + ScanCfg<1>::OFF_SM))[1024 + 2]);
        }
        __syncthreads();
    }
}
__device__ __forceinline__ void phase_scan23(Frame& F, int jl, int pass) {
    if (pass == 0) {
        const int nb0 = (F.G > 64) ? 32 : 0;
        if (F.bid >= nb0) {
            const int gt = (F.bid - nb0) * 512 + F.tid, NT = (F.G - nb0) * 512;
            for (int i = gt; i < 32 * 4096 + 32 * 2560; i += NT) {
                if (i < 32 * 4096) { const int ch = i >> 12, q = i & 4095, tid = q & 511; const int d0 = 16 * (tid >> 6) + 4 * ((tid & 63) >> 4);
                    const float* G = WSP(float, WS_GH) + (size_t)ch * 33 * 16384 + q * 4; bf16_t* SI = WSP(bf16_t, WS_SH) + (size_t)ch * 33 * 16384 + q * 4; const float* DC = WSP(float, WS_DECH) + ch * 33 * 128 + d0;
                    f32x4 s4 = (f32x4){0.f, 0.f, 0.f, 0.f};
#pragma unroll 4
                    for (int cp = 0; cp < 32; ++cp) { s4 = *(const f32x4*)(DC + cp * 128) * s4 + *(const f32x4*)(G + (size_t)cp * 16384); u32x2 w; w.x = pk2(s4[0], s4[1]); w.y = pk2(s4[2], s4[3]); *(u32x2*)(SI + (size_t)(cp + 1) * 16384) = w; }
                } else { const int k = i - 32 * 4096, ch = k / 2560, q = k % 2560;
                    const float* G = WSP(float, WS_GM) + (size_t)ch * 33 * 10240 + q * 4; bf16_t* SI = WSP(bf16_t, WS_SM) + (size_t)ch * 33 * 10240 + q * 4; const float* DC = WSP(float, WS_DECM) + ch * 33;
                    f32x4 s4 = (f32x4){0.f, 0.f, 0.f, 0.f};
#pragma unroll 4
                    for (int cp = 0; cp < 32; ++cp) { s4 = DC[cp] * s4 + *(const f32x4*)(G + (size_t)cp * 10240); u32x2 w; w.x = pk2(s4[0], s4[1]); w.y = pk2(s4[2], s4[3]); *(u32x2*)(SI + (size_t)(cp + 1) * 10240) = w; }
                }
            }
        }
    }
    const int count = pass == 0 ? 32 : 1024;
    for (int q = F.bid; q < count; q += F.G) {
        const int kind = q & 1, r = q >> 1;
        const int sct = pass == 0 ? 0 : 1 + (r & 31), bh = pass == 0 ? r : (r >> 5), h = bh & 3, b = bh >> 2;
#pragma unroll 1
        for (int dir = 0; dir < 2; ++dir) {
            const int ch = (b * 4 + h) * 2 + dir; const int cpos = sct == 0 ? 0 : (dir ? 33 - sct : sct);
            f32x4 S[8];
            if (kind == 0) { const bf16_t* SI = WSP(bf16_t, WS_SH) + (size_t)(ch * 33 + cpos) * 16384;
#pragma unroll
                for (int n = 0; n < 8; ++n) S[n] = cpos ? ld_bf4(SI + (n * 512 + F.tid) * 4) : (f32x4){0.f, 0.f, 0.f, 0.f};
                scan_super<0, 3>(F, jl, b, h, sct, dir, S);
            } else { const bf16_t* SI = WSP(bf16_t, WS_SM) + (size_t)(ch * 33 + cpos) * 10240;
#pragma unroll
                for (int n = 0; n < 8; ++n) S[n] = (cpos && n < 5) ? ld_bf4(SI + (n * 512 + F.tid) * 4) : (f32x4){0.f, 0.f, 0.f, 0.f};
                scan_super<1, 3>(F, jl, b, h, sct, dir, S);
            }
        }
    }
}

template <int PHMASK_T>
__global__ void __launch_bounds__(512, 2) mk_fwd(Args args) {
    extern __shared__ __attribute__((aligned(16))) unsigned char lds_raw[];
    Frame F;
    F.lds = (LAS unsigned char*)lds_raw;
    F.tid = threadIdx.x; F.lane = F.tid & 63; F.wave = __builtin_amdgcn_readfirstlane(F.tid >> 6);
    F.G = gridDim.x; F.bid = blockIdx.x;
    F.out = args.out; F.ws = args.ws; F.ctl = (unsigned*)(args.ws + WS_CTL);
    volatile LAS unsigned* MISC = (volatile LAS unsigned*)(F.lds + MISC_OFF);
    if (F.tid < 64) MISC[F.tid] = 0u;
    if (F.tid >= 64 && F.tid < 64 + 25) { const unsigned long long p = (unsigned long long)args.in[F.tid - 64]; MISC[64 + 2 * (F.tid - 64)] = (unsigned)p; MISC[65 + 2 * (F.tid - 64)] = (unsigned)(p >> 32); }
    __syncthreads();
    const int lo = args.ph_lo, hi = args.ph_hi;
    if (hi - lo > 1) (void)xcd_barrier_post(F.ctl + CW_BAR, MISC + 8);
#define EN(b) ((PHMASK_T >> (b)) & 1)
#define IN(k) (lo <= (k) && (k) < hi)
#if MK_ONE_LAUNCH
#define SEAM(k) do { if (IN(k) && IN((k) + 1)) { XcdBarrier bar_; bar_.bar = (unsigned*)(args.ws + WS_CTL) + CW_BAR; bar_.x = xb_xcc_id(); bar_.st = (volatile LAS unsigned*)(F.lds + MISC_OFF) + 8; xcd_barrier(bar_); } } while (0)
#else
#define SEAM(k) do { } while (0)
#endif
    LAS int* tb = (LAS int*)(F.lds + MISC_OFF + 2048);
    LAS int* cnts = tb + 40;

    if (EN(0) && IN(0)) { _Pragma("unroll 1") for (int rp = 0; rp < REP_PRO; ++rp) { Frame P = fresh(F); phase_prologue(P); } }
    SEAM(0);
    for (int l0 = 0; l0 < 4; ++l0) {
        const int pb = 1 + 10 * l0; const bool rec = (l0 & 1) == 0;
        if (EN(1) && IN(pb + 0)) { Frame P = fresh(F); const int l = fresh_i(l0); if (l0 == 0) phase_norm1<0>(P, l); else phase_norm1<1>(P, l); }
        SEAM(pb + 0);
        if (rec) {
            if (EN(2) && IN(pb + 1)) _Pragma("unroll 1") for (int rp = 0; rp < REP_GIN; ++rp) {
                Frame P = fresh(F); const int l = fresh_i(l0), j = l >> 1;
                pg8::StaticOrder S; S.init(NR, NREC, P.G, P.bid);
                EpiRec E{P.ws, inp_ptr(P, 9) + (size_t)j * 4112, (float*)(P.ws + WS_LB) + l * 512, l};
                pg8::gemm_phase(P.lds, (const bf16_t*)(P.ws + WS_H), (const bf16_t*)(P.ws + WS_WIN) + (size_t)j * NREC * 1024, 1024, 0, S, E, pg8::RowIdentity{}, P.tid);
            }
            SEAM(pb + 1);
            if (EN(3) && IN(pb + 2)) { _Pragma("unroll 1") for (int rp = 0; rp < REP_SCAN1; ++rp) { Frame P = fresh(F); phase_scan1(P); } }
            SEAM(pb + 2);
#pragma unroll 1
            for (int pass = 0; pass < 2; ++pass) {
                if (EN(4) && IN(pb + 3 + pass)) { Frame P = fresh(F); phase_scan23(P, fresh_i(l0) >> 1, fresh_i(pass)); }
                SEAM(pb + 3 + pass);
            }
        } else {
            if (EN(5) && IN(pb + 1)) _Pragma("unroll 1") for (int rp = 0; rp < REP_GIN; ++rp) {
                Frame P = fresh(F); const int l = fresh_i(l0), j = l >> 1;
                pg8::StaticOrder S; S.init(NR, 3072, P.G, P.bid);
                EpiQKV E{P.ws};
                pg8::gemm_phase(P.lds, (const bf16_t*)(P.ws + WS_H), (const bf16_t*)(P.ws + WS_WQKV) + (size_t)j * 3072 * 1024, 1024, 0, S, E, pg8::RowIdentity{}, P.tid);
            }
            SEAM(pb + 1);
            if (EN(6) && IN(pb + 2)) { _Pragma("unroll 1") for (int rp = 0; rp < REP_ATT; ++rp) { Frame P = fresh(F); phase_attn(P, fresh_i(l0) >> 1, l0 == 3); } }
            SEAM(pb + 2);
        }
        if (EN(7) && IN(pb + 5)) {
            Frame P = fresh(F); const int l = fresh_i(l0), j = l >> 1;
            pg8::StaticOrder S; S.init(l0 == 3 ? RL : NR, 1024, P.G, P.bid);
            EpiResid E{(bf16_t*)(P.ws + WS_Y), (const float*)(P.ws + WS_MOD) + l * 5 * 6144};
            pg8::gemm_phase(P.lds, (const bf16_t*)(P.ws + WS_MERGED), (const bf16_t*)(P.ws + ((l & 1) ? WS_WNOUT : WS_WROUT)) + (size_t)j * 1024 * 1024, 1024, 0, S, E, pg8::RowIdentity{}, P.tid);
        }
        SEAM(pb + 5);
        if (EN(8) && IN(pb + 6)) { Frame P = fresh(F); phase_router(P, fresh_i(l0)); }
        SEAM(pb + 6);
        if ((EN(9) && IN(pb + 7)) || (EN(10) && IN(pb + 8))) {
            Frame P = fresh(F); const int l = fresh_i(l0);
            expert_prefix(P, l, tb, cnts, 1, true);
            __syncthreads();
        }
        if (EN(9) && IN(pb + 7)) _Pragma("unroll 1") for (int rp = 0; rp < REP_MOE; ++rp) {
            Frame P = fresh(F); const int l = fresh_i(l0);
            pg8::MoeOrder S{tb, tb[32], 3, P.G, P.bid};
            EpiMoe1 E{(bf16_t*)(P.ws + WS_ACT), inp_ptr(P, 22) + (size_t)l * 32 * 2048};
            pg8::RowGather AO{(const int*)(P.ws + WS_LIST), cnts};
            pg8::gemm_phase(P.lds, (const bf16_t*)(P.ws + WS_H), (const bf16_t*)(P.ws + WS_WGU) + (size_t)l * 32 * 2048 * 1024, 1024, (size_t)2048 * 1024 * 2, S, E, AO, P.tid);
        }
        SEAM(pb + 7);
        if (EN(10) && IN(pb + 8)) _Pragma("unroll 1") for (int rp = 0; rp < REP_MOE; ++rp) {
            Frame P = fresh(F); const int l = fresh_i(l0);
            pg8::MoeOrder S{tb, tb[32], 2, P.G, P.bid};
            EpiMoe2 E{(bf16_t*)(P.ws + WS_YS), inp_ptr(P, 24) + (size_t)l * 32 * 1024};
            pg8::gemm_phase(P.lds, (const bf16_t*)(P.ws + WS_ACT), (const bf16_t*)(P.ws + WS_WD) + (size_t)l * 32 * 1024 * 1024, 1024, (size_t)1024 * 1024 * 2, S, E, pg8::RowIdentity{}, P.tid);
        }
        SEAM(pb + 8);
    }
    if (EN(11) && IN(41)) { Frame P = fresh(F); phase_norm1<2>(P, fresh_i(4)); }
#undef IN
#undef SEAM
}

typedef void (*kern_t)(Args);
static int phase_bit(int p) {
    if (p == 0) return 0; if (p == 41) return 11;
    const int l = (p - 1) / 10, k = (p - 1) % 10; const bool rec = (l & 1) == 0;
    switch (k) { case 0: return 1; case 1: return rec ? 2 : 5; case 2: return rec ? 3 : 6; case 3: return rec ? 3 : -1; case 4: return rec ? 4 : -1; case 5: return 7; case 6: return 8; case 7: return 9; case 8: return 10; default: return -1; }
}
extern "C" void kernel_launch(void* const* d_in, const int* in_sizes, int n_in, void* d_out, int out_size, void* d_ws, size_t ws_size, hipStream_t stream) {
    static int grid = 0;
#if MK_ONE_LAUNCH
    #ifndef ONE_MASK
#define ONE_MASK 0xfff
#endif
    static const kern_t kerns[1] = { mk_fwd<ONE_MASK> };
    const int nk = 1;
#else
    static const kern_t kerns[12] = { mk_fwd<1>, mk_fwd<2>, mk_fwd<4>, mk_fwd<8>, mk_fwd<16>, mk_fwd<32>, mk_fwd<64>, mk_fwd<128>, mk_fwd<256>, mk_fwd<512>, mk_fwd<1024>, mk_fwd<2048> };
    const int nk = 12;
#endif
    if (grid == 0) {
        if (n_in != 25 || out_size != RL * D || ws_size < WS_END) { fprintf(stderr, "kernel_launch: unexpected shapes (n_in %d out %d ws %zu)\n", n_in, out_size, ws_size); grid = -1; return; }
        int dev = 0, cus = 0;
        if (hipGetDevice(&dev) != hipSuccess || hipDeviceGetAttribute(&cus, hipDeviceAttributeMultiprocessorCount, dev) != hipSuccess) { grid = -1; return; }
        for (int i = 0; i < nk; ++i)
            if (hipFuncSetAttribute((const void*)kerns[i], hipFuncAttributeMaxDynamicSharedMemorySize, LDS_BYTES) != hipSuccess) { fprintf(stderr, "kernel_launch: hipFuncSetAttribute failed\n"); grid = -1; return; }
        (void)hipGetLastError();
        grid = cus;
    }
    if (grid < 0) return;
    (void)hipMemsetAsync((char*)d_ws + WS_CTL, 0, CTL_BYTES, stream);
    Args a{};
    for (int i = 0; i < 25; ++i) a.in[i] = (const float*)d_in[i];
    a.out = (float*)d_out; a.ws = (unsigned char*)d_ws;
#if MK_ONE_LAUNCH
    a.ph_lo = 0; a.ph_hi = NPHASE;
    hipLaunchKernelGGL(kerns[0], dim3(grid), dim3(512), LDS_BYTES, stream, a);
#else
    for (int p = 0; p < NPHASE; ++p) {
        const int bit = phase_bit(p); if (bit < 0) continue;
        a.ph_lo = p; a.ph_hi = p + 1;
        hipLaunchKernelGGL(kerns[bit], dim3(grid), dim3(512), LDS_BYTES, stream, a);
    }
#endif
}
```

```cpp
#include <hip/hip_runtime.h>
#include <stdint.h>
#include <stdio.h>

#ifndef MK_ONE_LAUNCH
#define MK_ONE_LAUNCH 1
#endif
#ifndef REP_PRO
#define REP_PRO 1
#endif
#ifndef REP_SCAN1
#define REP_SCAN1 1
#endif
#ifndef REP_SCAN2
#define REP_SCAN2 1
#endif
#ifndef REP_SCAN3
#define REP_SCAN3 1
#endif
#ifndef REP_ATT
#define REP_ATT 1
#endif
#ifndef REP_MOE
#define REP_MOE 1
#endif
#ifndef REP_GIN
#define REP_GIN 1
#endif
#define LAS __attribute__((address_space(3)))
#define GAS __attribute__((address_space(1)))
typedef unsigned short bf16_t;
typedef short bf16x8 __attribute__((ext_vector_type(8)));
typedef float f32x4 __attribute__((ext_vector_type(4)));
typedef float f32x2 __attribute__((ext_vector_type(2)));
typedef unsigned u32x4 __attribute__((ext_vector_type(4)));
typedef unsigned u32x2 __attribute__((ext_vector_type(2)));

constexpr int D = 1024, NB = 4, TL = 8192, TC = 256;
constexpr int RL = NB * TL;
constexpr int RC = NB * TC;
constexpr int NR = RL + RC;
constexpr int NREC = 4352;
constexpr int NE = 32, DFF = 1024;
constexpr int CAP = NR;
constexpr int SLOT_ROWS = 143360;
constexpr float EPS = 1e-6f;
constexpr int NPHASE = 42;

constexpr size_t MiB = 1u << 20;
constexpr size_t WS_CTL = 0, CTL_BYTES = 1 * MiB;
constexpr size_t WS_MOD = 1 * MiB;
constexpr size_t WS_LB = WS_MOD + 512 * 1024;
constexpr size_t WS_ROPE = WS_LB + 8 * 1024;
constexpr size_t WS_WIN = 2 * MiB;
constexpr size_t WS_WROUT = 19 * MiB;
constexpr size_t WS_WQKV = 23 * MiB;
constexpr size_t WS_WNOUT = 35 * MiB;
constexpr size_t WS_WGU = 40 * MiB;
constexpr size_t WS_WD = 552 * MiB;
constexpr size_t WS_X = 808 * MiB;
constexpr size_t WS_H = 940 * MiB;
constexpr size_t WS_MERGED = 1006 * MiB;
constexpr size_t WS_STREAM = 1072 * MiB;
constexpr size_t SZ_B512 = (size_t)NR * 512 * 2;
constexpr size_t SZ_F512 = (size_t)NR * 512 * 4;
constexpr size_t WS_Q = WS_STREAM, WS_KF = WS_Q + SZ_B512, WS_KB = WS_KF + SZ_B512, WS_V = WS_KB + SZ_B512, WS_HG = WS_V + SZ_B512;
constexpr size_t WS_MV = WS_HG + SZ_B512, WS_MO = WS_MV + SZ_B512, WS_MQ = WS_MO + SZ_B512, WS_MK = WS_MQ + SZ_B512 / 2;
constexpr size_t WS_LAF = WS_MK + SZ_B512 / 2, WS_LAB = WS_LAF + SZ_F512, WS_GATES = WS_LAB + SZ_F512;
constexpr size_t WS_OHF = WS_GATES + 3 * MiB, WS_OHB = WS_OHF + SZ_F512, WS_OMF = WS_OHB + SZ_F512, WS_OMB = WS_OMF + SZ_F512;
constexpr size_t WS_STREAM_END = WS_OMB + SZ_F512;
constexpr size_t WS_Y = WS_STREAM;
constexpr size_t WS_QKV = WS_STREAM;
constexpr int TT = TL + TC;
constexpr size_t WS_VTG = WS_STREAM + 200 * MiB;
constexpr size_t WS_SSK = WS_STREAM + 272 * MiB;
constexpr size_t WS_TOKE = 1744 * MiB, WS_TOKP = WS_TOKE + 1 * MiB, WS_TOKW = WS_TOKP + 1 * MiB, WS_LIST = WS_TOKW + 1 * MiB;
constexpr size_t WS_ACT = 1752 * MiB;
constexpr size_t WS_YS = 2032 * MiB;
constexpr size_t WS_END = 2312 * MiB;
static_assert(WS_STREAM_END <= WS_TOKE && WS_QKV + (size_t)NR * 3072 * 2 <= WS_TOKE, "stream region");
static_assert(WS_LIST + (size_t)NE * CAP * 4 <= WS_ACT && WS_ACT + (size_t)SLOT_ROWS * 1024 * 2 <= WS_YS && WS_YS + (size_t)SLOT_ROWS * 1024 * 2 <= WS_END, "moe region");
static_assert(WS_WIN + (size_t)2 * NREC * 1024 * 2 <= WS_WROUT && WS_WGU + (size_t)128 * 2048 * 1024 * 2 <= WS_WD && WS_WD + (size_t)128 * 1024 * 1024 * 2 <= WS_X, "weights");
constexpr int CW_BAR = 4096;
constexpr int CW_CNT = 16384;

constexpr int RING_BYTES = 131072;
constexpr int MISC_OFF = RING_BYTES;
constexpr int LDS_BYTES = 147456;

__device__ __forceinline__ float bf2f(unsigned b) { return __uint_as_float(b << 16); }
typedef _Float16 f16x4 __attribute__((ext_vector_type(4)));
__device__ __forceinline__ f32x4 h4_to_f4(u32x2 q) { return __builtin_convertvector(__builtin_bit_cast(f16x4, q), f32x4); }
__device__ __forceinline__ u32x2 f4_to_h4(f32x4 v) { f32x4 c; c[0] = __builtin_amdgcn_fmed3f(v[0], -65504.f, 65504.f); c[1] = __builtin_amdgcn_fmed3f(v[1], -65504.f, 65504.f); c[2] = __builtin_amdgcn_fmed3f(v[2], -65504.f, 65504.f); c[3] = __builtin_amdgcn_fmed3f(v[3], -65504.f, 65504.f);
    return __builtin_bit_cast(u32x2, __builtin_convertvector(c, f16x4)); }
__device__ __forceinline__ f32x4 ld_bf4(const bf16_t* p) { const u32x2 q = *(const u32x2*)p; return (f32x4){bf2f(q.x & 0xffffu), bf2f(q.x >> 16), bf2f(q.y & 0xffffu), bf2f(q.y >> 16)}; }
__device__ __forceinline__ unsigned f2bf(float f) { unsigned u = __float_as_uint(f); return (u + 0x7fffu + ((u >> 16) & 1u)) >> 16; }
__device__ __forceinline__ unsigned pk2(float lo, float hi) { unsigned r; asm("v_cvt_pk_bf16_f32 %0, %1, %2" : "=v"(r) : "v"(lo), "v"(hi)); return r; }
__device__ __forceinline__ float shx(float v, int o, int lane) { return __int_as_float(__builtin_amdgcn_ds_bpermute((lane ^ o) << 2, __float_as_int(v))); }
__device__ __forceinline__ int shxi(int v, int o, int lane) { return __builtin_amdgcn_ds_bpermute((lane ^ o) << 2, v); }
__device__ __forceinline__ float wave_sum(float v, int) {
    v += __int_as_float(__builtin_amdgcn_update_dpp(0, __float_as_int(v), 0xB1, 0xF, 0xF, true));
    v += __int_as_float(__builtin_amdgcn_update_dpp(0, __float_as_int(v), 0x4E, 0xF, 0xF, true));
    v += __int_as_float(__builtin_amdgcn_update_dpp(0, __float_as_int(v), 0x141, 0xF, 0xF, true));
    v += __int_as_float(__builtin_amdgcn_update_dpp(0, __float_as_int(v), 0x140, 0xF, 0xF, true));
    const float r0 = __int_as_float(__builtin_amdgcn_readlane(__float_as_int(v), 0)), r1 = __int_as_float(__builtin_amdgcn_readlane(__float_as_int(v), 16));
    const float r2 = __int_as_float(__builtin_amdgcn_readlane(__float_as_int(v), 32)), r3 = __int_as_float(__builtin_amdgcn_readlane(__float_as_int(v), 48));
    return (r0 + r1) + (r2 + r3);
}
__device__ __forceinline__ float wave_max(float v, int lane) {
#pragma unroll
    for (int o = 1; o < 64; o <<= 1) v = fmaxf(v, shx(v, o, lane));
    return v;
}
__device__ __forceinline__ int lane_id_volatile() { int l; asm volatile("v_mbcnt_lo_u32_b32 %0, -1, 0\n\tv_mbcnt_hi_u32_b32 %0, -1, %0" : "=v"(l)); return l; }
__device__ __forceinline__ float sigmoidf_(float x) { return __builtin_amdgcn_rcpf(1.0f + __builtin_amdgcn_exp2f(x * -1.4426950408889634f)); }
__device__ __forceinline__ float siluf_(float x) { return x * sigmoidf_(x); }
__device__ __forceinline__ float logsigmoidf_(float x) { return fminf(x, 0.f) - 0.6931471805599453f * __builtin_amdgcn_logf(1.0f + __builtin_amdgcn_exp2f(fabsf(x) * -1.4426950408889634f)); }
__device__ __forceinline__ int row_bidx(int r) { return r < RL ? (r >> 13) : 4; }

#define XB_TMO      128
#define XB_XCNT(j)  (256  + 64 * (j))
#define XB_XSUB(j)  (1280 + 64 * (j))
#define XB_XGEN(j)  (2304 + 64 * (j))
#define XB_TOP      3328
#define XB_TOPGEN   3392
#define XCD_BAR_WORDS 3456
#define XB_SPIN_CAP (1u << 18)
__device__ __forceinline__ unsigned xb_ld(unsigned* p)              { return __hip_atomic_load((GAS unsigned*)p, __ATOMIC_RELAXED, __HIP_MEMORY_SCOPE_AGENT); }
__device__ __forceinline__ unsigned xb_add(unsigned* p, unsigned v) { return __hip_atomic_fetch_add((GAS unsigned*)p, v, __ATOMIC_RELAXED, __HIP_MEMORY_SCOPE_AGENT); }
__device__ __forceinline__ unsigned xb_xcc_id() { return (unsigned)__builtin_amdgcn_s_getreg((3 << 11) | 20) & 0xFu; }
#define XB_SPIN(cond, bar) do { unsigned _sp = 0; while (cond) { __builtin_amdgcn_s_sleep(1); \
    if ((++_sp & 255u) == 0u) { if (xb_ld(&(bar)[XB_TMO])) break; if (_sp > XB_SPIN_CAP) { (void)xb_add(&(bar)[XB_TMO], 1u); break; } } } } while (0)
struct XcdBarrier { unsigned* bar; unsigned x; volatile LAS unsigned* st; };
__device__ __forceinline__ XcdBarrier xcd_barrier_post(unsigned* bar, volatile LAS unsigned* st) {
    XcdBarrier b; b.bar = bar; b.x = xb_xcc_id(); b.st = st;
    if (threadIdx.x == 0) (void)xb_add(&bar[XB_XCNT(b.x)], 1u);
    return b;
}
__device__ __forceinline__ void xcd_barrier_complete(unsigned* bar, unsigned x, unsigned& nloc, unsigned& nx) {
    const unsigned G = gridDim.x * gridDim.y * gridDim.z;
    unsigned sum, cnt, mine, sp = 0u;
    for (;;) {
        sum = 0u; cnt = 0u; mine = 0u;
#pragma unroll
        for (unsigned j = 0; j < 16; ++j) { const unsigned c = xb_ld(&bar[XB_XCNT(j)]); sum += c; cnt += (c > 0u) ? 1u : 0u; mine = (j == x) ? c : mine; }
        if (sum == G) break;
        __builtin_amdgcn_s_sleep(1);
        if ((++sp & 255u) == 0u) { if (xb_ld(&bar[XB_TMO])) break; if (sp > XB_SPIN_CAP) { (void)xb_add(&bar[XB_TMO], 1u); break; } }
    }
    nloc = mine > 0u ? mine : 1u; nx = cnt > 0u ? cnt : 1u;
}
__device__ __noinline__ void xcd_barrier(const XcdBarrier b) {
    asm volatile("s_waitcnt vmcnt(0)" ::: "memory");
    __syncthreads();
    if (threadIdx.x == 0) {
        unsigned* bar = b.bar;
        __builtin_amdgcn_s_waitcnt(0);
        unsigned nloc = b.st[0], nx = b.st[1];
        if (nloc == 0u) { xcd_barrier_complete(bar, b.x, nloc, nx); b.st[0] = nloc; b.st[1] = nx; }
        const unsigned old = xb_add(&bar[XB_XSUB(b.x)], 1u);
        const unsigned gen = old / nloc;
        if (old + 1u == (gen + 1u) * nloc) {
            __builtin_amdgcn_fence(__ATOMIC_RELEASE, "agent");
            asm volatile("s_waitcnt vmcnt(0)" ::: "memory");
            const unsigned og = xb_add(&bar[XB_TOP], 1u);
            const unsigned tg = og / nx;
            if (og + 1u == (tg + 1u) * nx) xb_add(&bar[XB_TOPGEN], 1u);
            else XB_SPIN(xb_ld(&bar[XB_TOPGEN]) == tg, bar);
            __builtin_amdgcn_fence(__ATOMIC_ACQUIRE, "agent");
            xb_add(&bar[XB_XGEN(b.x)], 1u);
            asm volatile("s_waitcnt vmcnt(0)" ::: "memory");
        } else {
            XB_SPIN(xb_ld(&bar[XB_XGEN(b.x)]) == gen, bar);
            __builtin_amdgcn_fence(__ATOMIC_ACQUIRE, "agent");
            asm volatile("s_waitcnt vmcnt(0)" ::: "memory");
        }
    }
    __syncthreads();
}

namespace pg8 {
constexpr int BM = 256, BK = 64, HALF = 128, HTB = HALF * BK * 2, STAGE_BYTES = 8 * HTB, NXCD = 8, WGM = 8;
__host__ __device__ __forceinline__ int lds_byte(int r, int c) { const int st = (r >> 4) * 2 + (c >> 5), rr = r & 15, cc = c & 31, ob = rr * 64 + cc * 2; return st * 1024 + (ob ^ (((ob >> 9) & 1) << 5)); }
__host__ __device__ __forceinline__ void stage_rc(int b, int& R, int& C) { const int st = b / 1024, sb = b % 1024, swz = sb ^ (((sb >> 9) & 1) << 5); R = (st >> 1) * 16 + swz / 64; C = (st & 1) * 32 + (swz % 64) / 2; }
__host__ __device__ __forceinline__ int perm32(int rho) { const int n = rho >> 4, i = rho & 15; return 8 * (i >> 2) + 4 * n + (i & 3); }
struct Unit { int pm, pn, e, mt; };
struct StaticOrder {
    int nM, nN, nwg, G, c;
    __device__ void init(int M, int N, int G_, int c_) { nM = M / BM; nN = N / BM; nwg = nM * nN; G = G_; c = c_; }
    __device__ bool next(int i, Unit& u) const {
        const long L = (long)i * G + c; if (L >= nwg) return false;
        int wgid = (int)L; { const int q = nwg / NXCD, r = nwg % NXCD, xcd = wgid % NXCD, off = wgid / NXCD; wgid = (xcd < r ? xcd * (q + 1) : r * (q + 1) + (xcd - r) * q) + off; }
        const int nig = WGM * nN, gid = wgid / nig, fm = gid * WGM, gsz = (nM - fm) < WGM ? (nM - fm) : WGM;
        u.pm = fm + ((wgid % nig) % gsz); u.pn = (wgid % nig) / gsz; u.e = 0; u.mt = 0; return true;
    }
};
struct MoeOrder {
    const LAS int* tb; int T, lg, G, c;
    __device__ bool next(int i, Unit& u) const {
        int tile, pn; const int npn = 1 << lg;
        if (G == 256) { const int x = c & 7, j = c >> 3, tpx = 32 >> lg; tile = (i * 8 + x) * tpx + (j >> lg); pn = j & (npn - 1); }
        else { const long L = (long)i * G + c; tile = (int)(L >> lg); pn = (int)(L & (npn - 1)); }
        if (tile >= T) return false;
        int ln_; asm volatile("v_mbcnt_lo_u32_b32 %0, -1, 0\n\tv_mbcnt_hi_u32_b32 %0, -1, %0" : "=v"(ln_));
        const int e = (int)__builtin_popcountll(__ballot(ln_ < 31 && tb[(ln_ < 31 ? ln_ : 31) + 1] <= tile));
        u.e = e; u.mt = tile - tb[e]; u.pm = tile; u.pn = pn; return true;
    }
};
struct RowIdentity { static constexpr bool GATHER = false; __device__ __forceinline__ int row(const Unit& u, int r) const { return r; } };
struct RowGather { static constexpr bool GATHER = true; const int* list; const LAS int* cnt; __device__ __forceinline__ int row(const Unit& u, int r) const { const int p = u.mt * BM + r; return p < cnt[u.e] ? list[(size_t)u.e * CAP + p] : 0; } };

__device__ __forceinline__ unsigned cvt_pk_bf16(float lo, float hi) { unsigned r; asm volatile("v_cvt_pk_bf16_f32 %0, %1, %2" : "=v"(r) : "v"(lo), "v"(hi)); return r; }

template <class Epi, class Sched, class AOff>
__device__ __forceinline__ void gemm_phase(LAS unsigned char* lds, const bf16_t* A, const bf16_t* Bt, const int K, const size_t estride  , const Sched& S, const Epi& E, const AOff& AO, const int tid) {
    const int wid = __builtin_amdgcn_readfirstlane(tid >> 6), lane = tid & 63, wr = wid >> 2, wc = wid & 3, fr = lane & 15, fq = lane >> 4;
    const int nt = K / BK;
    int Rr[2], Cc[2]; unsigned voffB[2];
#pragma unroll
    for (int i = 0; i < 2; ++i) { int R, C; stage_rc(tid * 16 + i * 8192, R, C); const int Rb = Epi::PERM ? ((R & ~31) + perm32(R & 31)) : R;
        Rr[i] = R; Cc[i] = C; voffB[i] = (unsigned)(Rb * K + C) * 2u; }
    const size_t kstep = (size_t)(BK * 2);
    const size_t hstep = (size_t)HALF * K * 2;
    const size_t tstep = 2 * hstep;
    const unsigned ldsw = (unsigned)wid * 1024u;
    const int aoff = lds_byte(wr * 64 + fr, fq * 8), boff = lds_byte(wc * 32 + fr, fq * 8);
#define PG8_SA(b, h) (((b) * 2 + (h)) * HTB)
#define PG8_SB(b, h) ((4 + (b) * 2 + (h)) * HTB)
#define PG8_STAGE(bufoff, gbase, voff) do { _Pragma("unroll") for (int _i = 0; _i < 2; ++_i) \
        __builtin_amdgcn_global_load_lds((const unsigned*)((const char*)(gbase) + (voff)[_i]), (LAS unsigned*)(lds + (bufoff) + ldsw + _i * 8192), 16, 0, 0); } while (0)
#define PG8_STAGE2(bufoff, gbase, v0, v1) do { \
        __builtin_amdgcn_global_load_lds((const unsigned*)((const char*)(gbase) + (v0)), (LAS unsigned*)(lds + (bufoff) + ldsw), 16, 0, 0); \
        __builtin_amdgcn_global_load_lds((const unsigned*)((const char*)(gbase) + (v1)), (LAS unsigned*)(lds + (bufoff) + ldsw + 8192), 16, 0, 0); } while (0)
#define PG8_LDA(dst, b, h) do { _Pragma("unroll") for (int m = 0; m < 4; ++m) _Pragma("unroll") for (int k = 0; k < 2; ++k) dst[m][k] = *(const LAS bf16x8*)(lds + PG8_SA(b, h) + aoff + m * 2048 + k * 1024); } while (0)
#define PG8_LDB(dst, b, h) do { _Pragma("unroll") for (int n = 0; n < 2; ++n) _Pragma("unroll") for (int k = 0; k < 2; ++k) dst[n][k] = *(const LAS bf16x8*)(lds + PG8_SB(b, h) + boff + n * 2048 + k * 1024); } while (0)
#define PG8_MMA(ai, bj, At, Bt_) do { __builtin_amdgcn_s_setprio(1); _Pragma("unroll") for (int m = 0; m < 4; ++m) _Pragma("unroll") for (int n = 0; n < 2; ++n) _Pragma("unroll") for (int k = 0; k < 2; ++k) \
        acc[ai][bj][m][n] = __builtin_amdgcn_mfma_f32_16x16x32_bf16(Bt_[n][k], At[m][k], acc[ai][bj][m][n], 0, 0, 0); __builtin_amdgcn_s_setprio(0); } while (0)
#define PG8_WAIT_V(n) asm volatile("s_waitcnt vmcnt(" #n ")" ::: "memory")
#define PG8_WAIT_L(n) asm volatile("s_waitcnt lgkmcnt(" #n ")" ::: "memory")
#define PG8_BAR __builtin_amdgcn_s_barrier()
#define PG8_SCHED __builtin_amdgcn_sched_barrier(0)
#define PG8_AOFFS(dst, u) do { _Pragma("unroll") for (int _h = 0; _h < 2; ++_h) _Pragma("unroll") for (int _i = 0; _i < 2; ++_i) \
        dst[_h][_i] = ((unsigned)AO.row(u, _h * HALF + Rr[_i]) * (unsigned)K + (unsigned)Cc[_i]) * 2u; } while (0)
    Unit cur, nxt; int ui = 0;
    if (!S.next(0, cur)) return;
    f32x4 acc[2][2][4][2];
#pragma unroll
    for (int a = 0; a < 2; ++a)
#pragma unroll
        for (int b = 0; b < 2; ++b)
#pragma unroll
            for (int m = 0; m < 4; ++m)
#pragma unroll
                for (int n = 0; n < 2; ++n) acc[a][b][m][n] = (f32x4){0.f, 0.f, 0.f, 0.f};
    bf16x8 At[4][2], B0[2][2], B1[2][2];
    unsigned vc[2][2], vn[2][2];
    PG8_AOFFS(vc, cur);
    const char* Ab = (const char*)A;
    const char* aC = AOff::GATHER ? Ab : Ab + (size_t)cur.pm * tstep;
    const char* cB = (const char*)Bt + (size_t)cur.e * estride + (size_t)cur.pn * tstep;
    PG8_STAGE(PG8_SB(0, 0), cB, voffB); PG8_STAGE2(PG8_SA(0, 0), aC, vc[0][0], vc[0][1]); PG8_STAGE(PG8_SB(0, 1), cB + hstep, voffB); PG8_STAGE2(PG8_SA(0, 1), aC, vc[1][0], vc[1][1]);
    if (wr == 1) PG8_BAR;
    PG8_WAIT_V(4); PG8_BAR;
    PG8_STAGE(PG8_SB(1, 0), cB + kstep, voffB); PG8_STAGE2(PG8_SA(1, 0), aC + kstep, vc[0][0], vc[0][1]); PG8_STAGE(PG8_SB(1, 1), cB + hstep + kstep, voffB);
    PG8_WAIT_V(6); PG8_BAR;
    for (;;) {
        const bool has_next = S.next(ui + 1, nxt);
        if (AOff::GATHER && has_next) { PG8_AOFFS(vn, nxt); }
        else {
#pragma unroll
            for (int _h = 0; _h < 2; ++_h)
#pragma unroll
                for (int _i = 0; _i < 2; ++_i) vn[_h][_i] = vc[_h][_i];
        }
        const char* nB = has_next ? (const char*)Bt + (size_t)nxt.e * estride + (size_t)nxt.pn * tstep : cB;
        const char* aN = (AOff::GATHER || !has_next) ? aC : Ab + (size_t)nxt.pm * tstep;
        for (int t = 0; t < nt; t += 2) {
            const bool last = (t == nt - 2);
            const char* a1 = aC + (size_t)(t + 1) * kstep;
            const char* a2 = last ? aN : aC + (size_t)(t + 2) * kstep; const char* b2 = last ? nB : cB + (size_t)(t + 2) * kstep;
            const char* a3 = a2 + kstep; const char* b3 = b2 + kstep;
            const unsigned x00 = last ? vn[0][0] : vc[0][0], x01 = last ? vn[0][1] : vc[0][1], x10 = last ? vn[1][0] : vc[1][0], x11 = last ? vn[1][1] : vc[1][1];
            PG8_LDB(B0, 0, 0); PG8_SCHED; PG8_LDA(At, 0, 0); PG8_STAGE2(PG8_SA(1, 1), a1, vc[1][0], vc[1][1]);
            PG8_WAIT_L(8); PG8_BAR; PG8_WAIT_L(0); PG8_MMA(0, 0, At, B0); PG8_BAR; PG8_SCHED;
            PG8_LDB(B1, 0, 1); PG8_STAGE(PG8_SB(0, 0), b2, voffB);
            PG8_BAR; PG8_WAIT_L(0); PG8_MMA(0, 1, At, B1); PG8_BAR;
            PG8_LDA(At, 0, 1); PG8_STAGE2(PG8_SA(0, 0), a2, x00, x01);
            PG8_BAR; PG8_WAIT_L(0); PG8_MMA(1, 0, At, B0); PG8_BAR; PG8_SCHED;
            PG8_STAGE(PG8_SB(0, 1), b2 + hstep, voffB);
            PG8_WAIT_V(6); PG8_BAR; PG8_MMA(1, 1, At, B1); PG8_BAR;
            PG8_LDB(B0, 1, 0); PG8_SCHED; PG8_LDA(At, 1, 0); PG8_STAGE2(PG8_SA(0, 1), a2, x10, x11);
            PG8_WAIT_L(8); PG8_BAR; PG8_WAIT_L(0); PG8_MMA(0, 0, At, B0); PG8_BAR; PG8_SCHED;
            PG8_LDB(B1, 1, 1); PG8_STAGE(PG8_SB(1, 0), b3, voffB);
            PG8_BAR; PG8_WAIT_L(0); PG8_MMA(0, 1, At, B1); PG8_BAR;
            PG8_LDA(At, 1, 1); PG8_STAGE2(PG8_SA(1, 0), a3, x00, x01);
            PG8_BAR; PG8_WAIT_L(0); PG8_MMA(1, 0, At, B0); PG8_BAR; PG8_SCHED;
            PG8_STAGE(PG8_SB(1, 1), b3 + hstep, voffB);
            PG8_WAIT_V(6); PG8_BAR; PG8_MMA(1, 1, At, B1); PG8_BAR;
        }
        E(acc, cur, wr, wc, fr, fq);
        if (!has_next) break;
#pragma unroll
        for (int a = 0; a < 2; ++a)
#pragma unroll
            for (int b = 0; b < 2; ++b)
#pragma unroll
                for (int m = 0; m < 4; ++m)
#pragma unroll
                    for (int n = 0; n < 2; ++n) acc[a][b][m][n] = (f32x4){0.f, 0.f, 0.f, 0.f};
        cur = nxt; cB = nB; aC = aN; ++ui;
#pragma unroll
        for (int _h = 0; _h < 2; ++_h)
#pragma unroll
            for (int _i = 0; _i < 2; ++_i) vc[_h][_i] = vn[_h][_i];
    }
    PG8_WAIT_V(0);
    if (wr == 0) PG8_BAR;
    PG8_BAR;
#undef PG8_SA
#undef PG8_SB
#undef PG8_STAGE
#undef PG8_STAGE2
#undef PG8_LDA
#undef PG8_LDB
#undef PG8_MMA
#undef PG8_WAIT_V
#undef PG8_WAIT_L
#undef PG8_BAR
#undef PG8_SCHED
#undef PG8_AOFFS
}
}

struct Args { const float* in[25]; float* out; unsigned char* ws; int ph_lo, ph_hi; };
struct Frame {
    LAS unsigned char* lds; int tid, lane, wave, G, bid;
    float* out; unsigned char* ws; unsigned* ctl;
};
__device__ __forceinline__ const float* inp_ptr(const Frame& F, int k) {
    const LAS unsigned* t = (const LAS unsigned*)(F.lds + MISC_OFF + 256) + 2 * k;
    const unsigned lo = __builtin_amdgcn_readfirstlane(t[0]), hi = __builtin_amdgcn_readfirstlane(t[1]);
    return (const float*)(const GAS float*)(((unsigned long long)hi << 32) | lo);
}
#define INP(k) inp_ptr(F, (k))
__device__ __forceinline__ Frame fresh(const Frame& F) {
    Frame P = F;
    int z = 0;
    asm volatile("" : "+s"(z), "+s"(P.G), "+s"(P.bid), "+s"(P.wave));
    P.lane = lane_id_volatile() & 63; P.tid = (P.wave << 6) | P.lane;
    P.ws = F.ws + z; P.out = F.out + z;
    P.wave &= 7; P.ctl = (unsigned*)(P.ws + WS_CTL);
    return P;
}
__device__ __forceinline__ int fresh_i(int v) { asm volatile("" : "+s"(v)); return v; }
#define WSP(T, off) ((T*)(F.ws + (off)))

template <class T> __device__ __forceinline__ T* opaque(T* p) { int z = 0; asm volatile("" : "+s"(z)); return p + z; }
__device__ __forceinline__ u32x4 pack8(const f32x4 a, const f32x4 b) { u32x4 w; w.x = pk2(a[0], a[1]); w.y = pk2(a[2], a[3]); w.z = pk2(b[0], b[1]); w.w = pk2(b[2], b[3]); return w; }
__device__ __forceinline__ f32x4 sigm4(const f32x4 a) { const f32x4 z = a * -1.4426950408889634f; f32x4 e, r;
#pragma unroll
    for (int j = 0; j < 4; ++j) e[j] = __builtin_amdgcn_exp2f(z[j]);
    const f32x4 d = e + 1.0f;
#pragma unroll
    for (int j = 0; j < 4; ++j) r[j] = __builtin_amdgcn_rcpf(d[j]);
    return r; }
__device__ __forceinline__ f32x4 silu4(const f32x4 a) { return a * sigm4(a); }
__device__ __forceinline__ f32x4 lsig4(const f32x4 a) { return (f32x4){logsigmoidf_(a[0]), logsigmoidf_(a[1]), logsigmoidf_(a[2]), logsigmoidf_(a[3])}; }
__device__ __forceinline__ void fgate4(const f32x4 x, const f32x4 lbv, f32x4& kk, f32x4& la) {
    const f32x4 z = x * -1.4426950408889634f; f32x4 e, sg, lg;
#pragma unroll
    for (int j = 0; j < 4; ++j) e[j] = __builtin_amdgcn_exp2f(fminf(z[j], 125.0f));
    const f32x4 d = e + 1.0f;
#pragma unroll
    for (int j = 0; j < 4; ++j) sg[j] = __builtin_amdgcn_rcpf(d[j]);
    const f32x4 om = 1.0f - lbv;
    const f32x4 f = lbv + om * sg;
    kk = om * (1.0f - sg);
#pragma unroll
    for (int j = 0; j < 4; ++j) lg[j] = __builtin_amdgcn_logf(f[j]);
    la = lg * 0.6931471805599453f;
}
template <int KIND>
__device__ __forceinline__ void rec_group(unsigned char* ws, const float* bias, const float* lb, f32x4 v0, f32x4 v1, int row, int gc, int sc, int ct, int wc, int fq, int fr, bool latent) {
    const bool gate_lane = (KIND != 9) || (ct < 16);
    const int gcs = gate_lane ? gc : 0;
    v0 += *(const f32x4*)((const char*)bias + (unsigned)(gcs * 4)); v1 += *(const f32x4*)((const char*)bias + (unsigned)(gcs * 4 + 16));
    if (KIND == 0) {
        *(u32x4*)(ws + WS_Q + (unsigned)(row * 1024 + sc * 2)) = pack8(silu4(v0) * 0.08838834764831845f, silu4(v1) * 0.08838834764831845f);
    } else if (KIND == 1 || KIND == 2) {
        f32x4 k0, k1, l0, l1;
        fgate4(v0, *(const f32x4*)((const char*)lb + (unsigned)(sc * 4)), k0, l0); fgate4(v1, *(const f32x4*)((const char*)lb + (unsigned)(sc * 4 + 16)), k1, l1);
        *(u32x4*)(ws + (KIND == 1 ? WS_KF : WS_KB) + (unsigned)(row * 1024 + sc * 2)) = pack8(k0, k1);
        float* lp = (float*)(ws + (KIND == 1 ? WS_LAF : WS_LAB) + (unsigned)(row * 2048 + sc * 4));
        *(f32x4*)lp = l0; *(f32x4*)(lp + 4) = l1;
    } else if (KIND == 3 || KIND == 4 || KIND == 7 || KIND == 8) {
        if (KIND == 4) { v0 = silu4(v0); v1 = silu4(v1); }
        if (KIND == 8) { v0 = sigm4(v0); v1 = sigm4(v1); }
        const size_t off = KIND == 3 ? WS_V : KIND == 4 ? WS_HG : KIND == 7 ? WS_MV : WS_MO;
        *(u32x4*)(ws + off + (unsigned)(row * 1024 + sc * 2)) = pack8(v0, v1);
    } else if (KIND == 5 || KIND == 6) {
        if (KIND == 6) { v0 *= 0.125f; v1 *= 0.125f; }
        f32x4 p0, p1;
#pragma unroll
        for (int j = 0; j < 4; ++j) { p0[j] = shx(v0[j], 32, fq * 16 + fr); p1[j] = shx(v1[j], 32, fq * 16 + fr); }
        if (latent) {
            const int t = row & 8191; const int pos = (wc & 1) ? (t & 63) : (t >> 6);
            const f32x4* rp = (const f32x4*)((const f32x2*)(ws + WS_ROPE) + pos * 16 + 8 * (fq & 1));
            const f32x4 c01 = rp[0], c23 = rp[1], c45 = rp[2], c67 = rp[3];
            const f32x4 cs0 = (f32x4){c01[0], c01[2], c23[0], c23[2]}, sn0 = (f32x4){c01[1], c01[3], c23[1], c23[3]};
            const f32x4 cs1 = (f32x4){c45[0], c45[2], c67[0], c67[2]}, sn1 = (f32x4){c45[1], c45[3], c67[1], c67[3]};
            const float sg = (fq >= 2) ? 1.0f : -1.0f;
            v0 = v0 * cs0 + sg * (p0 * sn0); v1 = v1 * cs1 + sg * (p1 * sn1);
        }
        *(u32x4*)(ws + (KIND == 5 ? WS_MQ : WS_MK) + (unsigned)(row * 512 + sc * 2)) = pack8(v0, v1);
    } else {
        if (gate_lane) { float* gp = (float*)(ws + WS_GATES + (unsigned)(row * 64 + ct * 4)); *(f32x4*)gp = v0; *(f32x4*)(gp + 4) = lsig4(v1); }
    }
}
struct EpiRec {
    static constexpr bool PERM = true;
    unsigned char* ws; const float* bias; const float* lb; int layer;
    template <int KIND>
    __device__ __forceinline__ void run(const f32x4 (&acc)[2][2][4][2], const pg8::Unit& u, int wr, int wc, int fr, int fq, int cbase  ) const {
        const int row0 = u.pm * 256 + wr * 64 + fr;
        const bool latent = u.pm < 128;
#define REC_G(ai, m) { const int row = row0 + (ai) * 128 + (m) * 16; \
        { const int ct = wc * 32 + 8 * fq; rec_group<KIND>(ws, bias, lb, acc[ai][0][m][0], acc[ai][0][m][1], row, u.pn * 256 + ct, cbase + ct, ct, wc, fq, fr, latent); } \
        if (KIND != 9) { const int ct = 128 + wc * 32 + 8 * fq; rec_group<KIND>(ws, bias, lb, acc[ai][1][m][0], acc[ai][1][m][1], row, u.pn * 256 + ct, cbase + ct, ct, wc, fq, fr, latent); } if ((m) == 3) asm volatile("" ::: "memory"); }
        REC_G(0, 0) REC_G(0, 1) REC_G(0, 2) REC_G(0, 3) REC_G(1, 0) REC_G(1, 1) REC_G(1, 2) REC_G(1, 3)
#undef REC_G
    }
    __device__ __forceinline__ void operator()(const f32x4 (&acc)[2][2][4][2], const pg8::Unit& u, int wr, int wc, int fr, int fq) const {
        const int pn = u.pn;
        EpiRec o{opaque(ws), opaque(bias), opaque(lb), layer};
        asm volatile("" : "+v"(fr), "+v"(fq));
        o.dispatch(acc, u, wr, wc, fr, fq, pn);
    }
    __device__ __forceinline__ void dispatch(const f32x4 (&acc)[2][2][4][2], const pg8::Unit& u, int wr, int wc, int fr, int fq, int pn) const {
        if (pn < 2) run<0>(acc, u, wr, wc, fr, fq, pn * 256);
        else if (pn < 4) run<1>(acc, u, wr, wc, fr, fq, (pn - 2) * 256);
        else if (pn < 6) run<2>(acc, u, wr, wc, fr, fq, (pn - 4) * 256);
        else if (pn < 8) run<3>(acc, u, wr, wc, fr, fq, (pn - 6) * 256);
        else if (pn < 10) run<4>(acc, u, wr, wc, fr, fq, (pn - 8) * 256);
        else if (pn == 10) run<5>(acc, u, wr, wc, fr, fq, 0);
        else if (pn == 11) run<6>(acc, u, wr, wc, fr, fq, 0);
        else if (pn < 14) run<7>(acc, u, wr, wc, fr, fq, (pn - 12) * 256);
        else if (pn < 16) run<8>(acc, u, wr, wc, fr, fq, (pn - 14) * 256);
        else run<9>(acc, u, wr, wc, fr, fq, 0);
    }
};
struct EpiQKV {
    static constexpr bool PERM = true;
    unsigned char* ws;
    __device__ __forceinline__ void operator()(const f32x4 (&acc)[2][2][4][2], const pg8::Unit& u, int wr, int wc, int fr, int fq) const {
        const int row0 = u.pm * 256 + wr * 64 + fr;
        unsigned char* w_ = opaque(ws);
        asm volatile("" : "+v"(fr), "+v"(fq));
        if (u.pn < 8) {
            const int col0 = u.pn * 256 + wc * 32 + 8 * fq;
#pragma unroll
            for (int ai = 0; ai < 2; ++ai)
#pragma unroll
                for (int m = 0; m < 4; ++m) { const int row = row0 + ai * 128 + m * 16; const unsigned ob = (unsigned)(row * 3072 + col0) * 2u;
#pragma unroll
                    for (int bj = 0; bj < 2; ++bj) { const f32x4 v0 = acc[ai][bj][m][0], v1 = acc[ai][bj][m][1];
                        *(u32x4*)(w_ + WS_QKV + (ob + bj * 256u)) = pack8(v0, v1);
                        if (u.pn >= 4) {
                            float ss = (v0[0] * v0[0] + v0[1] * v0[1]) + (v0[2] * v0[2] + v0[3] * v0[3]) + (v1[0] * v1[0] + v1[1] * v1[1]) + (v1[2] * v1[2] + v1[3] * v1[3]);
                            const int lane = fq * 16 + fr; ss += shx(ss, 16, lane); ss += shx(ss, 32, lane);
                            if (fq == 0) atomicAdd((float*)(w_ + WS_SSK) + row * 16 + (((u.pn - 4) * 256 + bj * 128 + wc * 32) >> 6), ss); } } }
        } else {
            const int b = u.pm < 128 ? (u.pm >> 5) : (u.pm - 128); const int tt0 = u.pm < 128 ? ((u.pm & 31) * 256) : TL;
#pragma unroll
            for (int ai = 0; ai < 2; ++ai)
#pragma unroll
                for (int m = 0; m < 4; ++m) { const int tt = tt0 + wr * 64 + fr + ai * 128 + m * 16;
#pragma unroll
                    for (int bj = 0; bj < 2; ++bj) { const int c = (u.pn - 8) * 256 + bj * 128 + wc * 32 + 8 * fq;
                        const unsigned base = (unsigned)(((b * 16 + (c >> 6)) * 64 + (c & 63)) * TT + tt) * 2u;
                        const u32x4 pk = pack8(acc[ai][bj][m][0], acc[ai][bj][m][1]); const unsigned pw[4] = {pk.x, pk.y, pk.z, pk.w};
#pragma unroll
                        for (int q = 0; q < 8; ++q) *(bf16_t*)(w_ + WS_VTG + (base + (unsigned)q * (TT * 2u))) = (bf16_t)((q & 1) ? (pw[q >> 1] >> 16) : (pw[q >> 1] & 0xffffu)); } }
        }
    }
};
struct EpiResid {
    static constexpr bool PERM = true;
    bf16_t* Y; const float* modl;
    __device__ __forceinline__ void operator()(const f32x4 (&acc)[2][2][4][2], const pg8::Unit& u, int wr, int wc, int fr, int fq) const {
        const int row0 = u.pm * 256 + wr * 64 + fr, col0 = u.pn * 256 + wc * 32 + 8 * fq;
        const int bidx = u.pm < 128 ? (u.pm >> 5) : 4;
        bf16_t* Y = opaque(this->Y);
        const float* g = opaque(modl) + bidx * 6144 + 2048 + col0;
        f32x4 gv[2][2];
#pragma unroll
        for (int bj = 0; bj < 2; ++bj) { gv[bj][0] = *(const f32x4*)(g + bj * 128); gv[bj][1] = *(const f32x4*)(g + bj * 128 + 4); }
#pragma unroll
        for (int ai = 0; ai < 2; ++ai)
#pragma unroll
            for (int m = 0; m < 4; ++m) { const unsigned ob = (unsigned)((row0 + ai * 128 + m * 16) * 1024 + col0) * 2u;
#pragma unroll
                for (int bj = 0; bj < 2; ++bj) *(u32x4*)((char*)Y + (ob + bj * 256u)) = pack8(acc[ai][bj][m][0] * gv[bj][0], acc[ai][bj][m][1] * gv[bj][1]); }
    }
};
__device__ __forceinline__ f32x4 swiglu4(const f32x4 g, const f32x4 u) {
    f32x4 gt, up, e, r;
#pragma unroll
    for (int j = 0; j < 4; ++j) { gt[j] = fminf(g[j], 7.0f); up[j] = __builtin_amdgcn_fmed3f(u[j], -7.0f, 7.0f); }
    const f32x4 z = gt * -2.4554669595930157f;
#pragma unroll
    for (int j = 0; j < 4; ++j) e[j] = __builtin_amdgcn_exp2f(z[j]);
    const f32x4 d = e + 1.0f;
#pragma unroll
    for (int j = 0; j < 4; ++j) r[j] = __builtin_amdgcn_rcpf(d[j]);
    return (gt * r) * (up + 1.0f);
}
struct EpiMoe1 {
    static constexpr bool PERM = true;
    bf16_t* ACT; const float* bgu;
    __device__ __forceinline__ void operator()(const f32x4 (&acc)[2][2][4][2], const pg8::Unit& u, int wr, int wc, int fr, int fq) const {
        const int row0 = u.pm * 256 + wr * 64 + fr, c0 = u.pn * 128 + wc * 32 + 8 * fq;
        bf16_t* ACT = opaque(this->ACT);
        const float* bg = opaque(bgu) + (size_t)u.e * 2048 + c0; const float* bu = bg + 1024;
        const f32x4 g0 = *(const f32x4*)bg, g1 = *(const f32x4*)(bg + 4), u0 = *(const f32x4*)bu, u1 = *(const f32x4*)(bu + 4);
#pragma unroll
        for (int ai = 0; ai < 2; ++ai)
#pragma unroll
            for (int m = 0; m < 4; ++m) {
                const f32x4 ga = acc[ai][0][m][0] + g0, gb = acc[ai][0][m][1] + g1, ua = acc[ai][1][m][0] + u0, ub = acc[ai][1][m][1] + u1;
                const f32x4 ra = swiglu4(ga, ua), rb = swiglu4(gb, ub);
                const float r[8] = {ra[0], ra[1], ra[2], ra[3], rb[0], rb[1], rb[2], rb[3]};
                u32x4 w; w.x = pk2(r[0], r[1]); w.y = pk2(r[2], r[3]); w.z = pk2(r[4], r[5]); w.w = pk2(r[6], r[7]);
                *(u32x4*)((char*)ACT + (unsigned)((row0 + ai * 128 + m * 16) * 1024 + c0) * 2u) = w;
            }
    }
};
struct EpiMoe2 {
    static constexpr bool PERM = true;
    bf16_t* YS; const float* bd;
    __device__ __forceinline__ void operator()(const f32x4 (&acc)[2][2][4][2], const pg8::Unit& u, int wr, int wc, int fr, int fq) const {
        const int row0 = u.pm * 256 + wr * 64 + fr, col0 = u.pn * 256 + wc * 32 + 8 * fq;
        bf16_t* YS = opaque(this->YS);
        const float* b = opaque(bd) + (size_t)u.e * 1024 + col0;
        f32x4 bv[2][2];
#pragma unroll
        for (int bj = 0; bj < 2; ++bj) { bv[bj][0] = *(const f32x4*)(b + bj * 128); bv[bj][1] = *(const f32x4*)(b + bj * 128 + 4); }
#pragma unroll
        for (int ai = 0; ai < 2; ++ai)
#pragma unroll
            for (int m = 0; m < 4; ++m) { const unsigned ob = (unsigned)((row0 + ai * 128 + m * 16) * 1024 + col0) * 2u;
#pragma unroll
                for (int bj = 0; bj < 2; ++bj) *(u32x4*)((char*)YS + (ob + bj * 256u)) = pack8(acc[ai][bj][m][0] + bv[bj][0], acc[ai][bj][m][1] + bv[bj][1]); }
    }
};

__device__ __forceinline__ void transpose_item(const float* W, int K, int N, bf16_t* WT, int drow0, LAS float* scr, int k0, int n0, int lane) {
    const int n = n0 + (lane & 31); const bool ok = n < N;
#pragma unroll 8
    for (int i = 0; i < 32; ++i) { const int kk = 2 * i + (lane >> 5); scr[kk * 33 + (lane & 31)] = ok ? __builtin_nontemporal_load(W + (size_t)(k0 + kk) * N + n) : 0.f; }
    asm volatile("s_waitcnt lgkmcnt(0)" ::: "memory");
    const int c = lane & 7;
#pragma unroll
    for (int j = 0; j < 4; ++j) { const int nn = (lane >> 3) + 8 * j; const LAS float* s = scr + (8 * c) * 33 + nn;
        u32x4 o; o.x = pk2(s[0 * 33], s[1 * 33]); o.y = pk2(s[2 * 33], s[3 * 33]); o.z = pk2(s[4 * 33], s[5 * 33]); o.w = pk2(s[6 * 33], s[7 * 33]);
        __builtin_nontemporal_store(o, (u32x4*)(WT + (size_t)(drow0 + nn) * K + k0 + 8 * c)); }
    asm volatile("s_waitcnt lgkmcnt(0)" ::: "memory");
}
__device__ __forceinline__ void phase_prologue(Frame& F) {
    {
        LAS float* s = (LAS float*)(F.lds);
        LAS float* part = (LAS float*)(F.lds + 32768);
        bool have_s = false;
        for (int item = F.bid; item < 384; item += F.G) {
            if (!have_s) {
                for (int i = F.tid; i < 5 * 1024; i += 512) { const int b = i >> 10, k = i & 1023; const float c = b < 4 ? INP(1)[b * 1024 + k] : INP(3)[k]; s[i] = siluf_(c); }
                have_s = true;
            }
            __syncthreads();
            const int l = item / 96, n0 = (item % 96) * 64, ci = F.tid & 63, kg = F.tid >> 6;
            const float* w = INP(4) + ((size_t)l * 1024 + kg * 128) * 6144 + n0 + ci;
            float a0 = 0.f, a1 = 0.f, a2 = 0.f, a3 = 0.f, a4 = 0.f;
#pragma unroll 8
            for (int k = 0; k < 128; ++k) { const float wv = w[(size_t)k * 6144]; const int kk = kg * 128 + k;
                a0 += s[kk] * wv; a1 += s[1024 + kk] * wv; a2 += s[2048 + kk] * wv; a3 += s[3072 + kk] * wv; a4 += s[4096 + kk] * wv; }
            part[(kg * 5 + 0) * 64 + ci] = a0; part[(kg * 5 + 1) * 64 + ci] = a1; part[(kg * 5 + 2) * 64 + ci] = a2; part[(kg * 5 + 3) * 64 + ci] = a3; part[(kg * 5 + 4) * 64 + ci] = a4;
            __syncthreads();
            if (F.tid < 320) { const int b = F.tid >> 6, c2 = F.tid & 63; float sum = INP(5)[l * 6144 + n0 + c2];
#pragma unroll
                for (int g = 0; g < 8; ++g) sum += part[(g * 5 + b) * 64 + c2];
                WSP(float, WS_MOD)[(l * 5 + b) * 6144 + n0 + c2] = sum; }
        }
        __syncthreads();
        if (F.bid == (F.G > 1 ? F.G - 1 : 0)) {
            const int c = F.tid; const float* hl = INP(11);
            const float v0 = hl[c], v1 = hl[512 + c], v2 = hl[1024 + c], v3 = hl[1536 + c];
            const float mx = fmaxf(fmaxf(v0, v1), fmaxf(v2, v3));
            const float e0 = expf(v0 - mx), e1 = expf(v1 - mx), e2 = expf(v2 - mx), e3 = expf(v3 - mx); const float inv = 1.0f / (e0 + e1 + e2 + e3);
            float* LB = WSP(float, WS_LB);
            LB[c] = 0.f; LB[512 + c] = fmaxf(e1 * inv, 0.f); LB[1024 + c] = fmaxf((e1 + e2) * inv, 0.f); LB[1536 + c] = fmaxf((e1 + e2 + e3) * inv, 0.f);
        }
        if (F.bid == (F.G > 2 ? F.G - 2 : 0)) {
            for (int i = F.tid; i < 2048; i += 512) { const int pos = i >> 4, q = i & 15; const float inv = powf(10000.0f, -(float)q / 16.0f); const float ang = (float)pos * inv;
                WSP(f32x2, WS_ROPE)[i] = (f32x2){cosf(ang), sinf(ang)}; }
        }
        __syncthreads();
    }
    LAS float* scr = (LAS float*)(F.lds + F.wave * 16384);
    const int gw = F.bid * 8 + F.wave, NGW = F.G * 8;
    constexpr int I_WIN = 16 * 136, I_SQ = 16 * 32, I_QKV = 16 * 96, I_GU = 16 * 64;
    constexpr int N0 = 2 * I_WIN, N1 = N0 + 2 * I_SQ, N2 = N1 + 2 * I_QKV, N3 = N2 + 2 * I_SQ, N4 = N3 + 128 * I_GU, N5 = N4 + 128 * I_SQ;
    for (int it = gw; it < N5; it += NGW) {
        if (it < N0) { const int j = it / I_WIN, r = it % I_WIN, kb = r / 136, nb = r % 136;
            transpose_item(INP(8) + (size_t)j * 1024 * 4112, 1024, 4112, WSP(bf16_t, WS_WIN) + (size_t)j * NREC * 1024, nb * 32, scr, kb * 64, nb * 32, F.lane); }
        else if (it < N1) { const int q = it - N0, j = q / I_SQ, r = q % I_SQ, kb = r / 32, nb = r % 32;
            transpose_item(INP(10) + (size_t)j * 1024 * 1024, 1024, 1024, WSP(bf16_t, WS_WROUT) + (size_t)j * 1024 * 1024, nb * 32, scr, kb * 64, nb * 32, F.lane); }
        else if (it < N2) { const int q = it - N1, j = q / I_QKV, r = q % I_QKV, kb = r / 96, nb = r % 96;
            transpose_item(INP(14) + (size_t)j * 1024 * 3072, 1024, 3072, WSP(bf16_t, WS_WQKV) + (size_t)j * 3072 * 1024, nb * 32, scr, kb * 64, nb * 32, F.lane); }
        else if (it < N3) { const int q = it - N2, j = q / I_SQ, r = q % I_SQ, kb = r / 32, nb = r % 32;
            transpose_item(INP(15) + (size_t)j * 1024 * 1024, 1024, 1024, WSP(bf16_t, WS_WNOUT) + (size_t)j * 1024 * 1024, nb * 32, scr, kb * 64, nb * 32, F.lane); }
        else if (it < N4) { const int q = it - N3, j = q / I_GU, r = q % I_GU, kb = r / 64, nb = r % 64; const int n0 = nb * 32;
            const int nn = n0 & 1023; const int drow = 256 * (nn >> 7) + (n0 >= 1024 ? 128 : 0) + (nn & 127);
            transpose_item(INP(21) + (size_t)j * 1024 * 2048, 1024, 2048, WSP(bf16_t, WS_WGU) + (size_t)j * 2048 * 1024, drow, scr, kb * 64, n0, F.lane); }
        else { const int q = it - N4, j = q / I_SQ, r = q % I_SQ, kb = r / 32, nb = r % 32;
            transpose_item(INP(23) + (size_t)j * 1024 * 1024, 1024, 1024, WSP(bf16_t, WS_WD) + (size_t)j * 1024 * 1024, nb * 32, scr, kb * 64, nb * 32, F.lane); }
    }
    __syncthreads();
}

__device__ __forceinline__ void expert_prefix(const Frame& F, int l, LAS int* base_out, LAS int* cnt_out, int scale, bool total) {
    if (F.tid < 64) {
        const int e = F.tid & 31;
        const int c = (int)F.ctl[CW_CNT + (l * 32 + e) * 64];
        const int t = (F.tid < 32) ? ((c + 255) >> 8) : 0;
        int incl = t;
#pragma unroll
        for (int o = 1; o < 32; o <<= 1) { const int y = __builtin_amdgcn_ds_bpermute(((F.tid - o) & 63) << 2, incl); if (F.tid >= o) incl += y; }
        if (F.tid < 32) { base_out[e] = (incl - t) * scale; if (cnt_out) cnt_out[e] = c; }
        if (total && F.tid == 31) base_out[32] = incl * scale;
    }
}
template <int MODE>
__device__ __forceinline__ void phase_norm1(Frame& F, int l) {
    LAS int* sbase = (LAS int*)(F.lds + MISC_OFF + 1024);
    if (MODE != 0) {
        expert_prefix(F, l - 1, sbase, (LAS int*)0, 256, false);
        __syncthreads();
    }
    const int gw = F.bid * 8 + F.wave, NGW = F.G * 8;
    bf16_t* X = WSP(bf16_t, WS_X); bf16_t* H = WSP(bf16_t, WS_H); const bf16_t* YS = WSP(bf16_t, WS_YS);
    const float* MOD = WSP(float, WS_MOD);
    const int* TE = WSP(int, WS_TOKE); const int* TP = WSP(int, WS_TOKP); const float* TW = WSP(float, WS_TOKW);
    const int nrows = (MODE == 2) ? RL : NR;
    for (int pr = gw; pr < nrows / 2; pr += NGW) {
        const int row0 = 2 * pr; const int bidx = row_bidx(row0);
        f32x4 v[2][4];
#pragma unroll
        for (int rr = 0; rr < 2; ++rr) { const int row = row0 + rr;
            if (MODE == 0) { const float* src = row < RL ? INP(0) + (size_t)row * 1024 : INP(2) + (size_t)(row - RL) * 1024;
#pragma unroll
                for (int j = 0; j < 4; ++j) v[rr][j] = __builtin_nontemporal_load((const f32x4*)(src + 4 * F.lane + 256 * j)); }
            else { const bf16_t* src = X + (size_t)row * 1024;
#pragma unroll
                for (int j = 0; j < 4; ++j) v[rr][j] = h4_to_f4(__builtin_nontemporal_load((const u32x2*)(src + 4 * F.lane + 256 * j))); } }
        if (MODE != 0) {
            u32x2 ys[2][4][4]; float wk[2][4];
#pragma unroll
            for (int rr = 0; rr < 2; ++rr)
#pragma unroll
                for (int k = 0; k < 4; ++k) { const int row = row0 + rr; const int e = TE[row * 4 + k], p = TP[row * 4 + k]; wk[rr][k] = TW[row * 4 + k];
                    const bf16_t* yr = YS + (size_t)(sbase[e] + p) * 1024 + 4 * F.lane;
#pragma unroll
                    for (int j = 0; j < 4; ++j) ys[rr][k][j] = __builtin_nontemporal_load((const u32x2*)(yr + 256 * j)); }
            const float* g2 = MOD + ((l - 1) * 5 + bidx) * 6144 + 5120 + 4 * F.lane;
#pragma unroll
            for (int j = 0; j < 4; ++j) { const f32x4 gg = *(const f32x4*)(g2 + 256 * j);
#pragma unroll
                for (int rr = 0; rr < 2; ++rr) { f32x4 f = (f32x4){0.f, 0.f, 0.f, 0.f};
#pragma unroll
                    for (int k = 0; k < 4; ++k) { const u32x2 q = ys[rr][k][j]; f += wk[rr][k] * (f32x4){bf2f(q.x & 0xffffu), bf2f(q.x >> 16), bf2f(q.y & 0xffffu), bf2f(q.y >> 16)}; }
                    v[rr][j] += gg * f; } }
        }
        if (MODE == 2) {
#pragma unroll
            for (int rr = 0; rr < 2; ++rr)
#pragma unroll
                for (int j = 0; j < 4; ++j) __builtin_nontemporal_store(v[rr][j], (f32x4*)(F.out + (size_t)(row0 + rr) * 1024 + 4 * F.lane + 256 * j));
            continue;
        }
        if (F.lane < 32) WSP(float, WS_SSK)[row0 * 16 + F.lane] = 0.f;
        float rstd[2];
#pragma unroll
        for (int rr = 0; rr < 2; ++rr) { float ss = 0.f;
#pragma unroll
            for (int j = 0; j < 4; ++j) { __builtin_nontemporal_store(f4_to_h4(v[rr][j]), (u32x2*)(X + (size_t)(row0 + rr) * 1024 + 4 * F.lane + 256 * j));
                ss += (v[rr][j][0] * v[rr][j][0] + v[rr][j][1] * v[rr][j][1]) + (v[rr][j][2] * v[rr][j][2] + v[rr][j][3] * v[rr][j][3]); }
            rstd[rr] = rsqrtf(wave_sum(ss, F.lane) * (1.0f / 1024.0f) + EPS); }
        const float* gm = INP(6) + l * 1024; const float* sh = MOD + (l * 5 + bidx) * 6144; const float* sc = sh + 1024;
#pragma unroll
        for (int j = 0; j < 4; ++j) { const int c = 4 * F.lane + 256 * j;
            const f32x4 g = *(const f32x4*)(gm + c), s1 = *(const f32x4*)(sc + c), s0 = *(const f32x4*)(sh + c); const f32x4 gs = g * (1.0f + s1);
#pragma unroll
            for (int rr = 0; rr < 2; ++rr) { const f32x4 h = v[rr][j] * rstd[rr] * gs + s0;
                u32x2 w; w.x = pk2(h[0], h[1]); w.y = pk2(h[2], h[3]);
                *(u32x2*)(H + (size_t)(row0 + rr) * 1024 + c) = w; } }
    }
}

__device__ __forceinline__ void router_finish(Frame& F, float (&lg)[32], int row, int r0, const float* br, LAS int* hist, LAS int* sel, float* TW) {
#pragma unroll
    for (int s5 = 0; s5 < 5; ++s5) { const int half = 16 >> s5; const bool up = (F.lane >> (5 - s5)) & 1;
#pragma unroll
        for (int i = 0; i < half; ++i) { const float a2 = lg[i], b2 = lg[i + half]; const float send = up ? a2 : b2, keep = up ? b2 : a2; lg[i] = keep + shx(send, 32 >> s5, F.lane); } }
    float logit = lg[0] + shx(lg[0], 1, F.lane);
    const int myE = F.lane >> 1;
    logit += br[myE];
    int rank = 0;
#pragma unroll
    for (int e = 0; e < 32; ++e) { const float le = __int_as_float(__builtin_amdgcn_readlane(__float_as_int(logit), 2 * e)); rank += (le > logit || (le == logit && e < myE)) ? 1 : 0; }
    float tv[4]; int ti[4];
#pragma unroll
    for (int k = 0; k < 4; ++k) { const unsigned long long bm = __ballot(rank == k); const int src = __builtin_amdgcn_readfirstlane((int)__builtin_ctzll(bm));
        tv[k] = __int_as_float(__builtin_amdgcn_readlane(__float_as_int(logit), src)); ti[k] = src >> 1; }
    const float e1 = __expf(tv[1] - tv[0]), e2 = __expf(tv[2] - tv[0]), e3 = __expf(tv[3] - tv[0]); const float inv = 1.0f / (1.0f + e1 + e2 + e3);
    if (F.lane < 4) { const int k = F.lane; const int e = k == 0 ? ti[0] : k == 1 ? ti[1] : k == 2 ? ti[2] : ti[3]; const float w = (k == 0 ? 1.0f : k == 1 ? e1 : k == 2 ? e2 : e3) * inv;
        const int lpos = atomicAdd((int*)&hist[e], 1);
        sel[(row - r0) * 4 + k] = e | (lpos << 8);
        TW[row * 4 + k] = w; }
}
__device__ __forceinline__ void phase_router(Frame& F, int l) {
    LAS float* wr = (LAS float*)F.lds;
    LAS int* hist = (LAS int*)(F.lds + MISC_OFF + 1024);
    LAS int* gbase = hist + 32;
    LAS int* sel = gbase + 32;
    const float* wsrc = INP(19) + (size_t)l * 1024 * 32;
    for (int i = F.tid; i < 1024 * 8; i += 512) { const int k = i >> 3, ch = i & 7; const f32x4 w = *(const f32x4*)(wsrc + k * 32 + ch * 4);
        const int p = (k >> 2) + 256 * (k & 3); *(LAS f32x4*)(wr + p * 32 + 4 * ((ch + (p >> 1)) & 7)) = w; }
    if (F.tid < 32) hist[F.tid] = 0;
    __syncthreads();
    const int NRr = (l == 3) ? RL : NR;
    const int RPB = (((NRr + F.G - 1) / F.G) + 1) & ~1;
    const int r0 = min(F.bid * RPB, NRr), r1 = min(r0 + RPB, NRr);
    bf16_t* X = WSP(bf16_t, WS_X); bf16_t* H = WSP(bf16_t, WS_H); const float* MOD = WSP(float, WS_MOD);
    int* TE = WSP(int, WS_TOKE); int* TP = WSP(int, WS_TOKP); float* TW = WSP(float, WS_TOKW); int* LIST = WSP(int, WS_LIST);
    const float* br = INP(20) + l * 32;
    const int rotl = F.lane >> 1;
    const LAS float* wbase = wr + F.lane * 32; int roff[8];
#pragma unroll
    for (int ch = 0; ch < 8; ++ch) roff[ch] = 4 * ((ch + rotl) & 7);
    for (int rowA = r0 + 2 * F.wave; rowA < r1; rowA += 16) {
        const bool hasB = rowA + 1 < r1; const int rowB = hasB ? rowA + 1 : rowA;
        const int bidx = row_bidx(rowA);
        bf16_t* xa = X + (size_t)rowA * 1024 + 4 * F.lane; bf16_t* xb = X + (size_t)rowB * 1024 + 4 * F.lane;
        const bf16_t* ya = WSP(bf16_t, WS_Y) + (size_t)rowA * 1024 + 4 * F.lane; const bf16_t* yb = WSP(bf16_t, WS_Y) + (size_t)rowB * 1024 + 4 * F.lane;
        float ssa = 0.f, ssb = 0.f;
#pragma unroll
        for (int j = 0; j < 4; ++j) { f32x4 va = h4_to_f4(*(const u32x2*)(xa + 256 * j)), vb = h4_to_f4(*(const u32x2*)(xb + 256 * j));
            { const u32x2 q = __builtin_nontemporal_load((const u32x2*)(ya + 256 * j)); va += (f32x4){bf2f(q.x & 0xffffu), bf2f(q.x >> 16), bf2f(q.y & 0xffffu), bf2f(q.y >> 16)}; *(u32x2*)(xa + 256 * j) = f4_to_h4(va); }
            if (hasB) { const u32x2 q = __builtin_nontemporal_load((const u32x2*)(yb + 256 * j)); vb += (f32x4){bf2f(q.x & 0xffffu), bf2f(q.x >> 16), bf2f(q.y & 0xffffu), bf2f(q.y >> 16)}; *(u32x2*)(xb + 256 * j) = f4_to_h4(vb); }
            ssa += (va[0] * va[0] + va[1] * va[1]) + (va[2] * va[2] + va[3] * va[3]); ssb += (vb[0] * vb[0] + vb[1] * vb[1]) + (vb[2] * vb[2] + vb[3] * vb[3]); }
        const float rsa = rsqrtf(wave_sum(ssa, F.lane) * (1.0f / 1024.0f) + EPS), rsb = rsqrtf(wave_sum(ssb, F.lane) * (1.0f / 1024.0f) + EPS);
        const float* gm = INP(7) + l * 1024 + 4 * F.lane; const float* sh = MOD + (l * 5 + bidx) * 6144 + 3072 + 4 * F.lane; const float* sc = sh + 1024;
        float lga[32], lgb[32];
#pragma unroll
        for (int e = 0; e < 32; ++e) { lga[e] = 0.f; lgb[e] = 0.f; }
#pragma unroll 1
        for (int j = 0; j < 4; ++j) { const int c = 256 * j;
            const f32x4 va = h4_to_f4(*(const u32x2*)(xa + c)), vb = h4_to_f4(*(const u32x2*)(xb + c));
            const f32x4 g = *(const f32x4*)(gm + c), s1 = *(const f32x4*)(sc + c), s0 = *(const f32x4*)(sh + c); const f32x4 gs = g * (1.0f + s1);
            const f32x4 ha = va * rsa * gs + s0, hb = vb * rsb * gs + s0;
            { u32x2 w; w.x = pk2(ha[0], ha[1]); w.y = pk2(ha[2], ha[3]); *(u32x2*)(H + (size_t)rowA * 1024 + 4 * F.lane + c) = w; }
            if (hasB) { u32x2 w; w.x = pk2(hb[0], hb[1]); w.y = pk2(hb[2], hb[3]); *(u32x2*)(H + (size_t)rowB * 1024 + 4 * F.lane + c) = w; }
            const LAS float* wj = wbase + (64 * j) * 32;
#pragma unroll
            for (int cc = 0; cc < 4; ++cc) {
                const LAS float* wp = wj + (256 * cc) * 32; const float hva = ha[cc], hvb = hb[cc];
#pragma unroll
                for (int ch = 0; ch < 8; ++ch) { const f32x4 w4 = *(const LAS f32x4*)(wp + roff[ch]);
                    lga[4 * ch + 0] += hva * w4[0]; lga[4 * ch + 1] += hva * w4[1]; lga[4 * ch + 2] += hva * w4[2]; lga[4 * ch + 3] += hva * w4[3];
                    lgb[4 * ch + 0] += hvb * w4[0]; lgb[4 * ch + 1] += hvb * w4[1]; lgb[4 * ch + 2] += hvb * w4[2]; lgb[4 * ch + 3] += hvb * w4[3]; }
            }
        }
        router_finish(F, lga, rowA, r0, br, hist, sel, TW);
        if (hasB) router_finish(F, lgb, rowB, r0, br, hist, sel, TW);
    }
    __syncthreads();
    if (F.tid < 32) gbase[F.tid] = (int)atomicAdd(F.ctl + CW_CNT + (l * 32 + F.tid) * 64, (unsigned)hist[F.tid]);
    __syncthreads();
    for (int i = F.tid; i < (r1 - r0) * 4; i += 512) { const int s = sel[i], e = s & 255, pos = gbase[e] + (s >> 8); const int row = r0 + (i >> 2);
        TE[row * 4 + (i & 3)] = e; TP[row * 4 + (i & 3)] = pos; LIST[(size_t)e * CAP + pos] = row; }
    __syncthreads();
}

__device__ __forceinline__ bf16x8 lds_frag(const LAS unsigned char* p) { return *(const LAS bf16x8*)p; }
#define ATT_SHIFT 8.0f
__device__ __forceinline__ void phase_attn(Frame& F, int jl  , bool last) {
    LAS unsigned char* QS = F.lds;
    LAS float* RPB = (LAS float*)(F.lds + 16384);
    LAS float* RK = (LAS float*)(F.lds + 19456);
    LAS unsigned char* KT = F.lds + 24576;
    LAS unsigned char* VT = F.lds + 24576 + 40960;
    const bf16_t* QKV = WSP(bf16_t, WS_QKV); bf16_t* OUT = WSP(bf16_t, WS_MERGED); const bf16_t* VTG = WSP(bf16_t, WS_VTG); const float* SSK = WSP(float, WS_SSK);
    const float* qg = INP(16) + jl * 64; const float* kg = INP(17) + jl * 64; const float* rpb = INP(18) + (size_t)jl * 16 * 465;
    const int w = F.wave, qt = w & 3, qr = w >> 2;
    const bool xmap = (F.G == 256);
    for (int i_ = 0; ; ++i_) {
        int u, bh;
        if (xmap) { const int li = (F.bid >> 3) + 32 * i_; if (li >= 528) break;
            if (li < 512) { bh = (F.bid & 7) * 8 + (li >> 6); u = li & 63; } else { bh = (F.bid & 7) * 8 + ((li - 512) >> 1); u = 64 + ((li - 512) & 1); } }
        else { const int it = F.bid + i_ * F.G; if (it >= NB * 16 * 66) break; u = it % 66; bh = it / 66; }
        int tid_ = F.tid; asm volatile("" : "+v"(tid_));
        const int lane_ = tid_ & 63, ln = lane_ & 15, g = lane_ >> 4;
        const int lkey = tid_ >> 3, lc = tid_ & 7;
        const int h = bh & 15, b = bh >> 4;
        const bool lat = u < 64;
        if (last && !lat) continue;
        const int r0 = 2 * u, rs0 = min(max(r0 - 4, 0), 120), rs1 = min(max(r0 - 3, 0), 120);
        const int urow = r0 + qr, off = qr ? rs1 - rs0 : 0;
        const int rd_first = lat ? 0 : 2;
        u32x4 pkr[5], pvr[5]; float pss[5];
#define ATT_ISSUE(rd_) do { int lk_ = lkey, lc_ = lc; asm volatile("" : "+v"(lk_), "+v"(lc_));   \
            _Pragma("unroll") for (int s5 = 0; s5 < 5; ++s5) { if (s5 == 4 && (rd_) != 0) break; \
            const int gr_ = min(rs0 + (rd_) * 5 + s5, 127); \
            const int krow0 = (rd_) == 2 ? (RL + b * TC + s5 * 64) : (b * TL + gr_ * 64); const int tt0 = (rd_) == 2 ? (TL + s5 * 64) : gr_ * 64; \
            pkr[s5] = *(const u32x4*)((const unsigned char*)QKV + (size_t)krow0 * 6144 + 2048 + h * 128 + (unsigned)(lk_ * 6144 + lc_ * 16)); \
            pvr[s5] = *(const u32x4*)((const unsigned char*)VTG + ((size_t)((b * 16 + h) * 64) * TT + tt0) * 2 + (unsigned)(lk_ * (TT * 2) + lc_ * 16)); \
            pss[s5] = *(const float*)((const unsigned char*)SSK + (size_t)(krow0 * 16 + h) * 4 + (unsigned)(lk_ * 64)); } } while (0)
        if (lat) ATT_ISSUE(0); else ATT_ISSUE(2);
#pragma unroll
        for (int p = 0; p < 2; ++p) {
            const int ql = p * 64 + lkey;
            const int qrow = lat ? (b * TL + (r0 + p) * 64 + lkey) : (RL + b * TC + (u - 64) * 128 + ql);
            const u32x4 raw = *(const u32x4*)(QKV + (size_t)qrow * 3072 + h * 64 + lc * 8);
            float x[8] = {bf2f(raw.x & 0xffffu), bf2f(raw.x >> 16), bf2f(raw.y & 0xffffu), bf2f(raw.y >> 16), bf2f(raw.z & 0xffffu), bf2f(raw.z >> 16), bf2f(raw.w & 0xffffu), bf2f(raw.w >> 16)};
            float ss = 0.f;
#pragma unroll
            for (int i = 0; i < 8; ++i) ss += x[i] * x[i];
            ss += shx(ss, 1, lane_); ss += shx(ss, 2, lane_); ss += shx(ss, 4, lane_);
            const float r = rsqrtf(ss * (1.0f / 64.0f) + EPS) * (0.125f * 1.4426950408889634f);
            const f32x4 g0 = *(const f32x4*)(qg + lc * 8) * *(const f32x4*)(kg + lc * 8), g1 = *(const f32x4*)(qg + lc * 8 + 4) * *(const f32x4*)(kg + lc * 8 + 4);
            u32x4 o; o.x = pk2(x[0] * r * g0[0], x[1] * r * g0[1]); o.y = pk2(x[2] * r * g0[2], x[3] * r * g0[3]); o.z = pk2(x[4] * r * g1[0], x[5] * r * g1[1]); o.w = pk2(x[6] * r * g1[2], x[7] * r * g1[3]);
            *(LAS u32x4*)(QS + ql * 128 + lc * 16) = o;
        }
        for (int i = tid_; i < 15 * 48; i += 512) { const int rr = i / 48, cc = i % 48 - 8; RPB[i] = (cc >= 0 && cc < 31) ? rpb[h * 465 + rr * 31 + cc] * 1.4426950408889634f - ATT_SHIFT : 0.f; }
        f32x4 O[4]; float l_run = 0.f;
#pragma unroll
        for (int e = 0; e < 4; ++e) O[e] = (f32x4){0.f, 0.f, 0.f, 0.f};
        bf16x8 qf[2];
#pragma unroll 1
        for (int rd = rd_first; rd < 3; ++rd) {
            const int nslot = rd == 0 ? 5 : 4;
#pragma unroll
            for (int s5 = 0; s5 < 5; ++s5) {
                if (s5 < nslot) {
                *(LAS u32x4*)(KT + s5 * 8192 + lkey * 128 + ((lc ^ (lkey & 7)) * 16)) = pkr[s5];
                *(LAS u32x4*)(VT + s5 * 8192 + lkey * 128 + ((lc ^ ((lkey ^ (lkey >> 3)) & 7)) * 16)) = pvr[s5];
                if (lc == 0) RK[s5 * 64 + lkey] = rsqrtf(pss[s5] * (1.0f / 64.0f) + EPS);
                }
            }
            __syncthreads();
            if (rd == 0) ATT_ISSUE(1); else if (rd == 1) ATT_ISSUE(2);
            if (rd == rd_first) {
#pragma unroll
                for (int ks = 0; ks < 2; ++ks) qf[ks] = lds_frag(QS + (w * 16 + ln) * 128 + (ks * 4 + g) * 16);
            }
            {
                int t2_ = tid_; asm volatile("" : "+v"(t2_));
                const int ln = t2_ & 15, g = (t2_ & 63) >> 4;
                if (rd < 2) {
                    const int thr = qt == 0 ? max(ln, 8) : qt == 3 ? min(ln, 8) : ln;
                    const int c0 = max(2 * qt - 1 + (g >> 1), 0), c1 = min(2 * qt + 1 + (g >> 1), 7);
                    const int key0 = min(max(16 * qt - 8 + ln, 0), 63), key1 = min(16 * qt + 8 + ln, 63);
                    const int rkb0 = min(max(16 * qt - 8 + 4 * g, 0), 60), rkb1 = min(16 * qt + 8 + 4 * g, 60);
                    bf16x8 ka[2][4]; float rbv[2][8]; f32x4 rkl[2][2];
#define ATT_LOADL(st, s5_) do { const LAS unsigned char* kt_ = KT + (s5_) * 8192; \
                        ka[st][0] = lds_frag(kt_ + key0 * 128 + (((0 + g) ^ (key0 & 7)) * 16)); ka[st][1] = lds_frag(kt_ + key0 * 128 + (((4 + g) ^ (key0 & 7)) * 16)); \
                        ka[st][2] = lds_frag(kt_ + key1 * 128 + (((0 + g) ^ (key1 & 7)) * 16)); ka[st][3] = lds_frag(kt_ + key1 * 128 + (((4 + g) ^ (key1 & 7)) * 16)); \
                        const int rrow_ = min(max(rs0 + rd * 5 + (s5_) - urow + 7, 0), 14); const LAS float* rb_ = RPB + rrow_ * 48 + 15 - ln + 4 * g; \
                        _Pragma("unroll") for (int j = 0; j < 4; ++j) { rbv[st][j] = rb_[j]; rbv[st][4 + j] = rb_[16 + j]; } \
                        rkl[st][0] = *(const LAS f32x4*)(RK + (s5_) * 64 + rkb0); rkl[st][1] = *(const LAS f32x4*)(RK + (s5_) * 64 + rkb1); \
                        } while (0)
#define ATT_LOADLV(s5_) do { const LAS unsigned char* vt_ = VT + (s5_) * 8192; \
                        _Pragma("unroll") for (int et = 0; et < 4; ++et) { const int e = et * 16 + ln; const int sw = (e ^ (e >> 3)) & 7; \
                            vfa[et] = *(const LAS u32x2*)(vt_ + e * 128 + ((c0 ^ sw) * 16) + (g & 1) * 8); vfb[et] = *(const LAS u32x2*)(vt_ + e * 128 + ((c1 ^ sw) * 16) + (g & 1) * 8); } } while (0)
                    ATT_LOADL(0, 0);
#pragma unroll
                    for (int s5 = 0; s5 < 5; ++s5) {
                        if (s5 == 4 && rd != 0) break;
                        const int st = s5 & 1;
                        u32x2 vfa[4], vfb[4];
                        ATT_LOADLV(s5);
                        if (s5 + 1 < 5 && !(s5 + 1 == 4 && rd != 0)) ATT_LOADL(st ^ 1, s5 + 1);
                        __builtin_amdgcn_sched_barrier(0);
                        const int t = rd * 5 + s5;
                        const bool mine = (t >= off) && (t <= off + 7);
                        f32x4 sc0 = (f32x4){0.f, 0.f, 0.f, 0.f}, sc1 = (f32x4){0.f, 0.f, 0.f, 0.f};
                        sc0 = __builtin_amdgcn_mfma_f32_16x16x32_bf16(ka[st][0], qf[0], sc0, 0, 0, 0);
                        sc1 = __builtin_amdgcn_mfma_f32_16x16x32_bf16(ka[st][2], qf[0], sc1, 0, 0, 0);
                        sc0 = __builtin_amdgcn_mfma_f32_16x16x32_bf16(ka[st][1], qf[1], sc0, 0, 0, 0);
                        sc1 = __builtin_amdgcn_mfma_f32_16x16x32_bf16(ka[st][3], qf[1], sc1, 0, 0, 0);
#pragma unroll
                        for (int j = 0; j < 4; ++j) { const int kk = 4 * g + j;
                            const float p0 = (mine && kk >= thr) ? __builtin_amdgcn_exp2f(sc0[j] * rkl[st][0][j] + rbv[st][j]) : 0.f;
                            const float p1 = (mine && kk < thr) ? __builtin_amdgcn_exp2f(sc1[j] * rkl[st][1][j] + rbv[st][4 + j]) : 0.f;
                            sc0[j] = p0; sc1[j] = p1; l_run += p0 + p1; }
                        u32x4 pw; pw.x = pk2(sc0[0], sc0[1]); pw.y = pk2(sc0[2], sc0[3]); pw.z = pk2(sc1[0], sc1[1]); pw.w = pk2(sc1[2], sc1[3]);
                        const bf16x8 pf = __builtin_bit_cast(bf16x8, pw);
#pragma unroll
                        for (int et = 0; et < 4; ++et) { u32x4 vw; vw.x = vfa[et].x; vw.y = vfa[et].y; vw.z = vfb[et].x; vw.w = vfb[et].y;
                            O[et] = __builtin_amdgcn_mfma_f32_16x16x32_bf16(__builtin_bit_cast(bf16x8, vw), pf, O[et], 0, 0, 0); }
                    }
#undef ATT_LOADL
#undef ATT_LOADLV
                } else {
                    bf16x8 kc[2][4][2]; f32x4 rkv[2][4];
#define ATT_LOADCK(st, s5_) do { const LAS unsigned char* kt_ = KT + (s5_) * 8192; \
                        _Pragma("unroll") for (int kt = 0; kt < 4; ++kt) { const int key = kt * 16 + ln; \
                            kc[st][kt][0] = lds_frag(kt_ + key * 128 + (((0 + g) ^ (key & 7)) * 16)); kc[st][kt][1] = lds_frag(kt_ + key * 128 + (((4 + g) ^ (key & 7)) * 16)); \
                            rkv[st][kt] = *(const LAS f32x4*)(RK + (s5_) * 64 + 16 * kt + 4 * g); } } while (0)
                    ATT_LOADCK(0, 0);
#pragma unroll
                    for (int s5 = 0; s5 < 4; ++s5) {
                        const int st = s5 & 1;
                        const LAS unsigned char* vt_ = VT + s5 * 8192;
                        u32x2 vfa[2][4], vfb[2][4];
#pragma unroll
                        for (int ks2 = 0; ks2 < 2; ++ks2)
#pragma unroll
                            for (int et = 0; et < 4; ++et) { const int e = et * 16 + ln; const int sw = (e ^ (e >> 3)) & 7;
                                vfa[ks2][et] = *(const LAS u32x2*)(vt_ + e * 128 + (((4 * ks2 + (g >> 1)) ^ sw) * 16) + (g & 1) * 8);
                                vfb[ks2][et] = *(const LAS u32x2*)(vt_ + e * 128 + (((4 * ks2 + 2 + (g >> 1)) ^ sw) * 16) + (g & 1) * 8); }
                        if (s5 + 1 < 4) ATT_LOADCK(st ^ 1, s5 + 1);
                        __builtin_amdgcn_sched_barrier(0);
                        f32x4 sc[4];
#pragma unroll
                        for (int kt = 0; kt < 4; ++kt) sc[kt] = __builtin_amdgcn_mfma_f32_16x16x32_bf16(kc[st][kt][0], qf[0], (f32x4){0.f, 0.f, 0.f, 0.f}, 0, 0, 0);
#pragma unroll
                        for (int kt = 0; kt < 4; ++kt) sc[kt] = __builtin_amdgcn_mfma_f32_16x16x32_bf16(kc[st][kt][1], qf[1], sc[kt], 0, 0, 0);
#pragma unroll
                        for (int kt = 0; kt < 4; ++kt)
#pragma unroll
                            for (int j = 0; j < 4; ++j) { const float p = __builtin_amdgcn_exp2f(sc[kt][j] * rkv[st][kt][j] - ATT_SHIFT); sc[kt][j] = p; l_run += p; }
#pragma unroll
                        for (int ks2 = 0; ks2 < 2; ++ks2) {
                            u32x4 pw; pw.x = pk2(sc[2 * ks2][0], sc[2 * ks2][1]); pw.y = pk2(sc[2 * ks2][2], sc[2 * ks2][3]); pw.z = pk2(sc[2 * ks2 + 1][0], sc[2 * ks2 + 1][1]); pw.w = pk2(sc[2 * ks2 + 1][2], sc[2 * ks2 + 1][3]);
                            const bf16x8 pf = __builtin_bit_cast(bf16x8, pw);
#pragma unroll
                            for (int et = 0; et < 4; ++et) { u32x4 vw; vw.x = vfa[ks2][et].x; vw.y = vfa[ks2][et].y; vw.z = vfb[ks2][et].x; vw.w = vfb[ks2][et].y;
                                O[et] = __builtin_amdgcn_mfma_f32_16x16x32_bf16(__builtin_bit_cast(bf16x8, vw), pf, O[et], 0, 0, 0); }
                        }
                    }
#undef ATT_LOADCK
                }
            }
            __syncthreads();
        }
        l_run += shx(l_run, 16, lane_); l_run += shx(l_run, 32, lane_);
        {
            const float inv = 1.0f / l_run;
            const int qrow = lat ? (b * TL + urow * 64 + qt * 16 + ln) : (RL + b * TC + (u - 64) * 128 + w * 16 + ln);
#pragma unroll
            for (int e = 0; e < 4; ++e) { u32x2 wv; wv.x = pk2(O[e][0] * inv, O[e][1] * inv); wv.y = pk2(O[e][2] * inv, O[e][3] * inv);
                *(u32x2*)(OUT + (size_t)qrow * 1024 + h * 64 + e * 16 + 4 * g) = wv; }
        }
    }
#undef ATT_ISSUE
}

constexpr size_t WS_GH = WS_ACT, WS_GM = WS_ACT + 72 * MiB, WS_SH = WS_ACT + 128 * MiB, WS_SM = WS_SH + 72 * MiB;
constexpr size_t WS_DECH = WS_YS, WS_DECM = WS_YS + 1 * MiB;
constexpr size_t WS_OTH = WS_OHF, WS_OTM = WS_OMF;
static_assert(WS_GM + (size_t)1056 * 10240 * 4 <= WS_SH && WS_SM + (size_t)1056 * 10240 * 4 <= WS_YS, "scan dumps");
template <int KIND> struct ScanCfg {
    static constexpr int DK = KIND ? 64 : 128, RBQ = DK * 2, CMQ = DK / 8 - 1, KST = DK / 32, NEXT = KIND ? 144 : 128, OBS = KIND ? 148 : 132;
    static constexpr int OFF_OB = 0;
    static constexpr int OFF_QP = KIND ? 36864 : 0, OFF_KP = OFF_QP + 64 * RBQ, OFF_KPT = OFF_KP + 64 * RBQ, OFF_VT = OFF_KPT + DK * 128, OFF_PP = OFF_VT + 20480, OFF_SST = OFF_PP + 8192;
    static constexpr int OFF_SM = 114688;
    static constexpr int GSTRIDE = KIND ? 10240 : 16384;
};
__device__ __forceinline__ int sc_row(int b, int sct, int t) { return sct == 0 ? (RL + b * TC + t) : (b * TL + (sct - 1) * 256 + t); }
__device__ __forceinline__ float exp_c(float x) { return __expf(fminf(fmaxf(x, -80.f), 80.f)); }
template <int KIND> __device__ __forceinline__ int st_n0(int w) { return KIND ? (w >> 2) * 4 : 0; }
template <int KIND> __device__ __forceinline__ int st_nc(int w) { return KIND ? ((w >> 2) ? 5 : 4) : 8; }
template <int KIND> __device__ __forceinline__ int st_mt(int w) { return KIND ? (w & 3) : w; }
template <int KIND> __device__ __forceinline__ int ot_n0(int w) { return (w >> 2) * 4; }
template <int KIND> __device__ __forceinline__ int ot_nc(int w) { return KIND ? ((w >> 2) ? 5 : 4) : 4; }

template <int KIND, int PASS>
__device__ __forceinline__ void scan_super(Frame& F, int jl, int b, int h, int sct, int dir, f32x4 (&S)[8], bool split = false) {
    typedef ScanCfg<KIND> C;
    LAS unsigned char* L = F.lds;
    LAS float* TOT = (LAS float*)(L + C::OFF_SM); LAS float* EM = TOT + 512; LAS float* E2 = EM + 128; LAS float* BT = E2 + 128; LAS float* RQ = BT + 128; LAS float* CK = RQ + 64; LAS float* SCAL = CK + 64;
    const int w = F.wave;
    const bf16_t* Qg = KIND ? WSP(bf16_t, WS_MQ) : WSP(bf16_t, WS_Q);
    const bf16_t* Kg = KIND ? WSP(bf16_t, WS_MK) : WSP(bf16_t, dir ? WS_KB : WS_KF);
    const bf16_t* Vg = KIND ? WSP(bf16_t, WS_MV) : WSP(bf16_t, WS_V);
    const int hq = h * C::DK;
    u32x4 rq[2], rk[2], rv[2]; float rl[16]; float rg0 = 0.f, rg1 = 0.f;
    const float* LAg = WSP(float, dir ? WS_LAB : WS_LAF); const float* GTg = WSP(float, WS_GATES);
#define SC_ISSUE(ci_, TID) do { const int cN = dir ? 3 - (ci_) : (ci_); const int tN = cN * 64; \
        if (KIND == 0) { const int d_ = (TID) & 127, part_ = (TID) >> 7; \
            _Pragma("unroll") for (int i = 0; i < 16; ++i) rl[i] = LAg[(size_t)sc_row(b, sct, tN + part_ * 16 + i) * 512 + hq + d_]; \
            _Pragma("unroll") for (int p = 0; p < 2; ++p) { const size_t ro = (size_t)sc_row(b, sct, tN + p * 32 + ((TID) >> 4)) * 512 + hq + 8 * ((TID) & 15); \
                if (PASS == 3) rq[p] = *(const u32x4*)(Qg + ro); rk[p] = *(const u32x4*)(Kg + ro); rv[p] = *(const u32x4*)(Vg + ro); } } \
        else { { const size_t ro = (size_t)sc_row(b, sct, tN + ((TID) >> 3)) * 256 + hq + 8 * ((TID) & 7); if (PASS == 3) rq[0] = *(const u32x4*)(Qg + ro); rk[0] = *(const u32x4*)(Kg + ro); } \
            _Pragma("unroll") for (int p = 0; p < 2; ++p) rv[p] = *(const u32x4*)(Vg + (size_t)sc_row(b, sct, tN + p * 32 + ((TID) >> 4)) * 512 + h * 128 + 8 * ((TID) & 15)); \
            if ((TID) < 64) { const size_t go = (size_t)sc_row(b, sct, tN + (TID)) * 16 + h; rg0 = GTg[go + (dir ? 12 : 4)]; rg1 = GTg[go + (dir ? 8 : 0)]; } } } while (0)
    SC_ISSUE(0, F.tid);
#pragma unroll 1
    for (int ci = 0; ci < 4; ++ci) {
        const int c = dir ? 3 - ci : ci; const int t0 = c * 64;
        int tid_ = F.tid; asm volatile("" : "+v"(tid_));
        const int lane_ = tid_ & 63, ln = lane_ & 15, g = lane_ >> 4;
        LAS unsigned char* VRAW = L + C::OFF_SST;
        if (KIND == 0) {
            const int d = tid_ & 127, part = tid_ >> 7;
            if (!dir) {
#pragma unroll
                for (int i = 1; i < 16; ++i) rl[i] += rl[i - 1];
                TOT[part * 128 + d] = rl[15];
            } else {
#pragma unroll
                for (int i = 14; i >= 0; --i) rl[i] += rl[i + 1];
                TOT[part * 128 + d] = rl[0];
            }
#pragma unroll
            for (int p = 0; p < 2; ++p) { const int t = p * 32 + (tid_ >> 4), cc = tid_ & 15;
                if (PASS == 3) *(LAS u32x4*)(L + C::OFF_QP + t * 256 + ((cc ^ (t & 15)) * 16)) = rq[p];
                *(LAS u32x4*)(L + C::OFF_KP + t * 256 + ((cc ^ (t & 15)) * 16)) = rk[p];
                *(LAS u32x4*)(VRAW + t * 256 + cc * 16) = rv[p]; }
        } else {
            { const int t = tid_ >> 3, cc = tid_ & 7;
                if (PASS == 3) *(LAS u32x4*)(L + C::OFF_QP + t * 128 + ((cc ^ (t & 7)) * 16)) = rq[0];
                *(LAS u32x4*)(L + C::OFF_KP + t * 128 + ((cc ^ (t & 7)) * 16)) = rk[0]; }
#pragma unroll
            for (int p = 0; p < 2; ++p) { const int t = p * 32 + (tid_ >> 4), cc = tid_ & 15; *(LAS u32x4*)(VRAW + t * 256 + cc * 16) = rv[p]; }
            if (tid_ < 64) { const int t = tid_;
                float x = rg0; const float ig = rg1;
#pragma unroll
                for (int o = 1; o < 64; o <<= 1) { const int src = dir ? t + o : t - o; const float y = __int_as_float(__builtin_amdgcn_ds_bpermute((src & 63) << 2, __float_as_int(x))); if (src >= 0 && src < 64) x += y; }
                const float ref = __int_as_float(__builtin_amdgcn_readlane(__float_as_int(x), dir ? 32 : 31));
                const float btot = __int_as_float(__builtin_amdgcn_readlane(__float_as_int(x), dir ? 0 : 63));
                RQ[t] = exp_c(x - ref); CK[t] = exp_c(ref - x + ig);
                if (t == 0) { SCAL[0] = __expf(ref); SCAL[1] = __expf(btot - ref); if (PASS == 1) SCAL[2] = (ci == 0 ? 0.f : SCAL[2]) + btot; } }
            if (tid_ < 128) { const int row = 128 + (tid_ >> 3), ch = tid_ & 7; const unsigned one = (row == 128) ? 0x3f803f80u : 0u;
                *(LAS u32x4*)(L + C::OFF_VT + row * 128 + ((ch ^ (row & 7)) * 16)) = (u32x4){one, one, one, one}; }
        }
        __syncthreads();
        if (KIND == 0) {
            const int d = tid_ & 127, part = tid_ >> 7;
            const float t0v = TOT[d], t1v = TOT[128 + d], t2v = TOT[256 + d], t3v = TOT[384 + d];
            const float btot = (t0v + t1v) + (t2v + t3v);
            const float ref = dir ? (t2v + t3v) : (t0v + t1v);
            float off;
            if (!dir) off = part == 0 ? 0.f : part == 1 ? t0v : part == 2 ? (t0v + t1v) : (t0v + t1v + t2v);
            else off = part == 3 ? 0.f : part == 2 ? t3v : part == 1 ? (t3v + t2v) : (t3v + t2v + t1v);
            if (part == 0) { EM[d] = __expf(ref); E2[d] = __expf(btot - ref); if (PASS == 1) BT[d] = (ci == 0 ? 0.f : BT[d]) + btot; }
            unsigned kt[8];
#pragma unroll
            for (int i = 0; i < 16; ++i) { const int t = part * 16 + i; const int ad = t * 256 + (((d >> 3) ^ (t & 15)) * 16) + (d & 7) * 2;
                const float bb = rl[i] + off - ref;
                const float kv = bf2f(*(const LAS bf16_t*)(L + C::OFF_KP + ad)) * exp_c(-bb); const unsigned kb = pk2(kv, kv) & 0xffffu;
                if (PASS == 3) { const float qv = bf2f(*(const LAS bf16_t*)(L + C::OFF_QP + ad)) * exp_c(bb);
                    *(LAS bf16_t*)(L + C::OFF_QP + ad) = (bf16_t)(pk2(qv, qv) & 0xffffu);
                    *(LAS bf16_t*)(L + C::OFF_KP + ad) = (bf16_t)kb; }
                if (i & 1) kt[i >> 1] |= kb << 16; else kt[i >> 1] = kb; }
            *(LAS u32x4*)(L + C::OFF_KPT + d * 128 + (((part * 2) ^ (d & 7)) * 16)) = (u32x4){kt[0], kt[1], kt[2], kt[3]};
            *(LAS u32x4*)(L + C::OFF_KPT + d * 128 + (((part * 2 + 1) ^ (d & 7)) * 16)) = (u32x4){kt[4], kt[5], kt[6], kt[7]};
        } else {
            const int d = tid_ & 63, part = tid_ >> 6;
            unsigned kt[4];
#pragma unroll
            for (int i = 0; i < 8; ++i) { const int t = part * 8 + i; const int ad = t * 128 + (((d >> 3) ^ (t & 7)) * 16) + (d & 7) * 2;
                const float kv = bf2f(*(const LAS bf16_t*)(L + C::OFF_KP + ad)) * CK[t]; const unsigned kb = pk2(kv, kv) & 0xffffu;
                if (PASS == 3) { const float qv = bf2f(*(const LAS bf16_t*)(L + C::OFF_QP + ad)) * RQ[t];
                    *(LAS bf16_t*)(L + C::OFF_QP + ad) = (bf16_t)(pk2(qv, qv) & 0xffffu);
                    *(LAS bf16_t*)(L + C::OFF_KP + ad) = (bf16_t)kb; }
                if (i & 1) kt[i >> 1] |= kb << 16; else kt[i >> 1] = kb; }
            *(LAS u32x4*)(L + C::OFF_KPT + d * 128 + ((part ^ (d & 7)) * 16)) = (u32x4){kt[0], kt[1], kt[2], kt[3]};
        }
        {
            const int e = tid_ & 127, part = tid_ >> 7; unsigned vt[8];
#pragma unroll
            for (int i = 0; i < 16; ++i) { const unsigned vb = *(const LAS bf16_t*)(VRAW + (part * 16 + i) * 256 + e * 2); if (i & 1) vt[i >> 1] |= vb << 16; else vt[i >> 1] = vb; }
            *(LAS u32x4*)(L + C::OFF_VT + e * 128 + (((part * 2) ^ (e & 7)) * 16)) = (u32x4){vt[0], vt[1], vt[2], vt[3]};
            *(LAS u32x4*)(L + C::OFF_VT + e * 128 + (((part * 2 + 1) ^ (e & 7)) * 16)) = (u32x4){vt[4], vt[5], vt[6], vt[7]};
        }
        if (ci < 3) SC_ISSUE(ci + 1, tid_);
        __syncthreads();
        const int smt = st_mt<KIND>(w), sn0 = st_n0<KIND>(w), snc = st_nc<KIND>(w), onc = KIND ? snc : 4;
#define SC_ET(n) (KIND ? (sn0 + (n)) : (((((n) >> 2) ^ (w >> 2)) << 2) + ((n) & 3)))
        {
            f32x4 em;
            if (KIND == 0) em = *(const LAS f32x4*)(EM + smt * 16 + 4 * g); else { const float s0 = SCAL[0]; em = (f32x4){s0, s0, s0, s0}; }
#pragma unroll
            for (int n = 0; n < 8; ++n) if (n < snc) { S[n] *= em;
                if (PASS == 3) { const int e = SC_ET(n) * 16 + ln; u32x2 wv; wv.x = pk2(S[n][0], S[n][1]); wv.y = pk2(S[n][2], S[n][3]);
                    *(LAS u32x2*)(L + C::OFF_SST + e * C::RBQ + (((2 * smt + (g >> 1)) ^ (e & C::CMQ)) * 16) + (g & 1) * 8) = wv; } }
        }
        constexpr int NVT = KIND ? 5 : 8;
        bf16x8 vt[NVT][2], kf[2];
#pragma unroll
        for (int n = 0; n < NVT; ++n) if (n < snc) { const int e = SC_ET(n) * 16 + ln;
#pragma unroll
            for (int ks = 0; ks < 2; ++ks) vt[n][ks] = lds_frag(L + C::OFF_VT + e * 128 + (((ks * 4 + g) ^ (e & 7)) * 16)); }
        { const int d_row = smt * 16 + ln;
#pragma unroll
            for (int ks = 0; ks < 2; ++ks) kf[ks] = lds_frag(L + C::OFF_KPT + d_row * 128 + (((ks * 4 + g) ^ (d_row & 7)) * 16)); }
        f32x4 e2;
        if (KIND == 0) e2 = *(const LAS f32x4*)(E2 + smt * 16 + 4 * g); else { const float s1 = SCAL[1]; e2 = (f32x4){s1, s1, s1, s1}; }
        f32x4 oacc[5];
        if (PASS == 3) {
            {
                const int st = w & 3, s_row = st * 16 + ln;
                bf16x8 af[C::KST], qfr[2][C::KST];
#pragma unroll
                for (int ks = 0; ks < C::KST; ++ks) af[ks] = lds_frag(L + C::OFF_KP + s_row * C::RBQ + (((ks * 4 + g) ^ (s_row & C::CMQ)) * 16));
#pragma unroll
                for (int tq = 0; tq < 2; ++tq) { const int t_row = ((w >> 2) * 2 + tq) * 16 + ln;
#pragma unroll
                    for (int ks = 0; ks < C::KST; ++ks) qfr[tq][ks] = lds_frag(L + C::OFF_QP + t_row * C::RBQ + (((ks * 4 + g) ^ (t_row & C::CMQ)) * 16)); }
                __builtin_amdgcn_sched_barrier(0);
#pragma unroll
                for (int tq = 0; tq < 2; ++tq) { const int tt = (w >> 2) * 2 + tq, t_row = tt * 16 + ln;
                    f32x4 acc = (f32x4){0.f, 0.f, 0.f, 0.f};
#pragma unroll
                    for (int ks = 0; ks < C::KST; ++ks) acc = __builtin_amdgcn_mfma_f32_16x16x32_bf16(af[ks], qfr[tq][ks], acc, 0, 0, 0);
#pragma unroll
                    for (int j = 0; j < 4; ++j) { const int sidx = st * 16 + 4 * g + j; const bool keep = dir ? (sidx >= t_row) : (sidx <= t_row); acc[j] = keep ? acc[j] : 0.f; }
                    u32x2 wv; wv.x = pk2(acc[0], acc[1]); wv.y = pk2(acc[2], acc[3]);
                    *(LAS u32x2*)(L + C::OFF_PP + t_row * 128 + (((2 * st + (g >> 1)) ^ (t_row & 7)) * 16) + (g & 1) * 8) = wv; }
            }
        } else __builtin_amdgcn_sched_barrier(0);
#pragma unroll
        for (int n = 0; n < NVT; ++n) if (n < snc) {
#pragma unroll
            for (int ks = 0; ks < 2; ++ks) S[n] = __builtin_amdgcn_mfma_f32_16x16x32_bf16(kf[ks], vt[n][ks], S[n], 0, 0, 0);
            S[n] *= e2; }
        if (PASS == 3) {
            __syncthreads();
            {
                const int tt = w & 3, t_row = tt * 16 + ln;
                bf16x8 pf[2], qf2[C::KST], sst[5][C::KST];
#pragma unroll
                for (int ks = 0; ks < 2; ++ks) pf[ks] = lds_frag(L + C::OFF_PP + t_row * 128 + (((ks * 4 + g) ^ (t_row & 7)) * 16));
#pragma unroll
                for (int ks = 0; ks < C::KST; ++ks) qf2[ks] = lds_frag(L + C::OFF_QP + t_row * C::RBQ + (((ks * 4 + g) ^ (t_row & C::CMQ)) * 16));
#pragma unroll
                for (int n = 0; n < 5; ++n) if (n < onc) { const int e = SC_ET(n) * 16 + ln;
#pragma unroll
                    for (int ks = 0; ks < C::KST; ++ks) sst[n][ks] = lds_frag(L + C::OFF_SST + e * C::RBQ + (((ks * 4 + g) ^ (e & C::CMQ)) * 16)); }
                __builtin_amdgcn_sched_barrier(0);
#pragma unroll
                for (int n = 0; n < 5; ++n) if (n < onc) { f32x4 acc = (f32x4){0.f, 0.f, 0.f, 0.f};
#pragma unroll
                    for (int ks = 0; ks < 2; ++ks) acc = __builtin_amdgcn_mfma_f32_16x16x32_bf16(pf[ks], vt[n][ks], acc, 0, 0, 0);
#pragma unroll
                    for (int ks = 0; ks < C::KST; ++ks) acc = __builtin_amdgcn_mfma_f32_16x16x32_bf16(qf2[ks], sst[n][ks], acc, 0, 0, 0);
                    oacc[n] = acc; }
            }
        }
        __syncthreads();
        if (PASS == 3) {
            LAS float* OB = (LAS float*)(L + C::OFF_OB);
            {
                const int tt = w & 3, on0 = ot_n0<KIND>(w), onc = ot_nc<KIND>(w);
#pragma unroll
                for (int n = 0; n < 5; ++n) if (n < onc) { const int e = (on0 + n) * 16 + ln;
#pragma unroll
                    for (int j = 0; j < 4; ++j) OB[(tt * 16 + 4 * g + j) * C::OBS + e] = oacc[n][j]; }
            }
            __syncthreads();
            {
                const int t = tid_ >> 3, seg = tid_ & 7; const int row = sc_row(b, sct, t0 + t);
                const LAS float* ob = OB + t * C::OBS + seg * 16;
                f32x4 v[4];
#pragma unroll
                for (int q = 0; q < 4; ++q) v[q] = *(const LAS f32x4*)(ob + 4 * q);
                if (KIND == 1) { const float den = OB[t * C::OBS + 128]; const float inv = 1.0f / fmaxf(fabsf(den), 1.0f);
#pragma unroll
                    for (int q = 0; q < 4; ++q) v[q] *= inv; }
                float* ot = WSP(float, (split && dir) ? (KIND ? WS_OMB : WS_OHB) : (KIND ? WS_OTM : WS_OTH)) + (size_t)row * 512 + h * 128 + seg * 16;
                if (!dir || split) {
#pragma unroll
                    for (int q = 0; q < 4; ++q) *(f32x4*)(ot + 4 * q) = v[q];
                } else {
                    float ss = 0.f;
#pragma unroll
                    for (int q = 0; q < 4; ++q) { v[q] += *(const f32x4*)(ot + 4 * q); ss += (v[q][0] * v[q][0] + v[q][1] * v[q][1]) + (v[q][2] * v[q][2] + v[q][3] * v[q][3]); }
                    ss += shx(ss, 1, lane_); ss += shx(ss, 2, lane_); ss += shx(ss, 4, lane_);
                    const float r = rsqrtf(ss * (1.0f / 128.0f) + EPS);
                    const float* gn = INP(KIND ? 13 : 12) + jl * 512 + h * 128 + seg * 16;
                    const bf16_t* gate = WSP(bf16_t, KIND ? WS_MO : WS_HG) + (size_t)row * 512 + h * 128 + seg * 16;
                    const u32x4 ga = *(const u32x4*)gate, gb = *(const u32x4*)(gate + 8);
                    const unsigned gw[8] = {ga.x, ga.y, ga.z, ga.w, gb.x, gb.y, gb.z, gb.w};
                    unsigned ow[8];
#pragma unroll
                    for (int q = 0; q < 4; ++q) { const f32x4 gq = *(const f32x4*)(gn + 4 * q);
                        const float y0 = v[q][0] * r * gq[0] * bf2f(gw[2 * q] & 0xffffu), y1 = v[q][1] * r * gq[1] * bf2f(gw[2 * q] >> 16);
                        const float y2 = v[q][2] * r * gq[2] * bf2f(gw[2 * q + 1] & 0xffffu), y3 = v[q][3] * r * gq[3] * bf2f(gw[2 * q + 1] >> 16);
                        ow[2 * q] = pk2(y0, y1); ow[2 * q + 1] = pk2(y2, y3); }
                    bf16_t* mg = WSP(bf16_t, WS_MERGED) + (size_t)row * 1024 + KIND * 512 + h * 128 + seg * 16;
                    *(u32x4*)mg = (u32x4){ow[0], ow[1], ow[2], ow[3]}; *(u32x4*)(mg + 8) = (u32x4){ow[4], ow[5], ow[6], ow[7]};
                }
            }
            __syncthreads();
        }
    }
}
#undef SC_ISSUE
#undef SC_ET
__device__ __forceinline__ void phase_scan1(Frame& F) {
    for (int it = F.bid; it < 2 * 32 * 32; it += F.G) {
        const int cpos = it & 31, ch = (it >> 5) & 31, kind = it >> 10; const int dir = ch & 1, h = (ch >> 1) & 3, b = ch >> 3;
        const int sct = cpos == 0 ? 0 : (dir ? 33 - cpos : cpos);
        f32x4 S[8];
#pragma unroll
        for (int n = 0; n < 8; ++n) S[n] = (f32x4){0.f, 0.f, 0.f, 0.f};
        if (kind == 0) { scan_super<0, 1>(F, 0, b, h, sct, dir, S);
            float* G = WSP(float, WS_GH) + (size_t)(ch * 33 + cpos) * 16384;
#pragma unroll
            for (int n = 0; n < 8; ++n) *(f32x4*)(G + (n * 512 + F.tid) * 4) = S[n];
            if (F.tid < 128) WSP(float, WS_DECH)[(ch * 33 + cpos) * 128 + F.tid] = __expf(((const LAS float*)(F.lds + ScanCfg<0>::OFF_SM))[768 + F.tid]);
        } else { scan_super<1, 1>(F, 0, b, h, sct, dir, S);
            float* G = WSP(float, WS_GM) + (size_t)(ch * 33 + cpos) * 10240;
#pragma unroll
            for (int n = 0; n < 5; ++n) *(f32x4*)(G + (n * 512 + F.tid) * 4) = S[n];
            if (F.tid == 0) WSP(float, WS_DECM)[ch * 33 + cpos] = __expf(((const LAS float*)(F.lds + ScanCfg<1>::OFF_SM))[1024 + 2]);
        }
        __syncthreads();
    }
}
__device__ __forceinline__ void ctx_finalize(Frame& F, int jl) {
    for (int it = F.bid; it < 128; it += F.G) {
        const int rb = it & 15, kind = (it >> 4) & 1, h = it >> 5;
        const int t = F.tid >> 3, seg = F.tid & 7; const int row = RL + rb * 64 + t; const int lane_ = F.tid & 63;
        const float* of = WSP(float, kind ? WS_OTM : WS_OTH) + (size_t)row * 512 + h * 128 + seg * 16;
        const float* ob = WSP(float, kind ? WS_OMB : WS_OHB) + (size_t)row * 512 + h * 128 + seg * 16;
        f32x4 v[4]; float ss = 0.f;
#pragma unroll
        for (int q = 0; q < 4; ++q) { v[q] = *(const f32x4*)(of + 4 * q) + *(const f32x4*)(ob + 4 * q); ss += (v[q][0] * v[q][0] + v[q][1] * v[q][1]) + (v[q][2] * v[q][2] + v[q][3] * v[q][3]); }
        ss += shx(ss, 1, lane_); ss += shx(ss, 2, lane_); ss += shx(ss, 4, lane_);
        const float r = rsqrtf(ss * (1.0f / 128.0f) + EPS);
        const float* gn = INP(kind ? 13 : 12) + jl * 512 + h * 128 + seg * 16;
        const bf16_t* gate = WSP(bf16_t, kind ? WS_MO : WS_HG) + (size_t)row * 512 + h * 128 + seg * 16;
        const u32x4 ga = *(const u32x4*)gate, gb = *(const u32x4*)(gate + 8);
        const unsigned gw[8] = {ga.x, ga.y, ga.z, ga.w, gb.x, gb.y, gb.z, gb.w};
        unsigned ow[8];
#pragma unroll
        for (int q = 0; q < 4; ++q) { const f32x4 gq = *(const f32x4*)(gn + 4 * q);
            const float y0 = v[q][0] * r * gq[0] * bf2f(gw[2 * q] & 0xffffu), y1 = v[q][1] * r * gq[1] * bf2f(gw[2 * q] >> 16);
            const float y2 = v[q][2] * r * gq[2] * bf2f(gw[2 * q + 1] & 0xffffu), y3 = v[q][3] * r * gq[3] * bf2f(gw[2 * q + 1] >> 16);
            ow[2 * q] = pk2(y0, y1); ow[2 * q + 1] = pk2(y2, y3); }
        bf16_t* mg = WSP(bf16_t, WS_MERGED) + (size_t)row * 1024 + kind * 512 + h * 128 + seg * 16;
        *(u32x4*)mg = (u32x4){ow[0], ow[1], ow[2], ow[3]}; *(u32x4*)(mg + 8) = (u32x4){ow[4], ow[5], ow[6], ow[7]};
    }
}
__device__ __forceinline__ void phase_scan23(Frame& F, int jl, int pass) {
    if (pass == 0) {
        const int nb0 = (F.G > 128) ? 64 : 0;
        if (F.bid >= nb0) {
            const int gt = (F.bid - nb0) * 512 + F.tid, NT = (F.G - nb0) * 512;
            for (int i = gt; i < 32 * 4096 + 32 * 2560; i += NT) {
                if (i < 32 * 4096) { const int ch = i >> 12, q = i & 4095, tid = q & 511; const int d0 = 16 * (tid >> 6) + 4 * ((tid & 63) >> 4);
                    const float* G = WSP(float, WS_GH) + (size_t)ch * 33 * 16384 + q * 4; bf16_t* SI = WSP(bf16_t, WS_SH) + (size_t)ch * 33 * 16384 + q * 4; const float* DC = WSP(float, WS_DECH) + ch * 33 * 128 + d0;
                    f32x4 s4 = (f32x4){0.f, 0.f, 0.f, 0.f};
#pragma unroll 4
                    for (int cp = 0; cp < 32; ++cp) { s4 = *(const f32x4*)(DC + cp * 128) * s4 + *(const f32x4*)(G + (size_t)cp * 16384); u32x2 w; w.x = pk2(s4[0], s4[1]); w.y = pk2(s4[2], s4[3]); *(u32x2*)(SI + (size_t)(cp + 1) * 16384) = w; }
                } else { const int k = i - 32 * 4096, ch = k / 2560, q = k % 2560;
                    const float* G = WSP(float, WS_GM) + (size_t)ch * 33 * 10240 + q * 4; bf16_t* SI = WSP(bf16_t, WS_SM) + (size_t)ch * 33 * 10240 + q * 4; const float* DC = WSP(float, WS_DECM) + ch * 33;
                    f32x4 s4 = (f32x4){0.f, 0.f, 0.f, 0.f};
#pragma unroll 4
                    for (int cp = 0; cp < 32; ++cp) { s4 = DC[cp] * s4 + *(const f32x4*)(G + (size_t)cp * 10240); u32x2 w; w.x = pk2(s4[0], s4[1]); w.y = pk2(s4[2], s4[3]); *(u32x2*)(SI + (size_t)(cp + 1) * 10240) = w; }
                }
            }
        }
    }
    if (pass == 1) ctx_finalize(F, jl);
    const int count = pass == 0 ? 64 : 1024;
    for (int q = F.bid; q < count; q += F.G) {
        const int kind = pass == 0 ? ((q >> 1) & 1) : (q & 1), r = q >> 1;
        const int sct = pass == 0 ? 0 : 1 + (r & 31), bh = pass == 0 ? (q >> 2) : (r >> 5), h = bh & 3, b = bh >> 2;
        const bool split = pass == 0; const int dlo = split ? (q & 1) : 0, dhi = split ? (q & 1) + 1 : 2;
#pragma unroll 1
        for (int dir = dlo; dir < dhi; ++dir) {
            const int ch = (b * 4 + h) * 2 + dir; const int cpos = sct == 0 ? 0 : (dir ? 33 - sct : sct);
            f32x4 S[8];
            if (kind == 0) { const bf16_t* SI = WSP(bf16_t, WS_SH) + (size_t)(ch * 33 + cpos) * 16384;
#pragma unroll
                for (int n = 0; n < 8; ++n) S[n] = cpos ? ld_bf4(SI + (n * 512 + F.tid) * 4) : (f32x4){0.f, 0.f, 0.f, 0.f};
                scan_super<0, 3>(F, jl, b, h, sct, dir, S, split);
            } else { const bf16_t* SI = WSP(bf16_t, WS_SM) + (size_t)(ch * 33 + cpos) * 10240;
#pragma unroll
                for (int n = 0; n < 8; ++n) S[n] = (cpos && n < 5) ? ld_bf4(SI + (n * 512 + F.tid) * 4) : (f32x4){0.f, 0.f, 0.f, 0.f};
                scan_super<1, 3>(F, jl, b, h, sct, dir, S, split);
            }
        }
    }
}

template <int PHMASK_T>
__global__ void __launch_bounds__(512, 2) mk_fwd(Args args) {
    extern __shared__ __attribute__((aligned(16))) unsigned char lds_raw[];
    Frame F;
    F.lds = (LAS unsigned char*)lds_raw;
    F.tid = threadIdx.x; F.lane = F.tid & 63; F.wave = __builtin_amdgcn_readfirstlane(F.tid >> 6);
    F.G = gridDim.x; F.bid = blockIdx.x;
    F.out = args.out; F.ws = args.ws; F.ctl = (unsigned*)(args.ws + WS_CTL);
    volatile LAS unsigned* MISC = (volatile LAS unsigned*)(F.lds + MISC_OFF);
    if (F.tid < 64) MISC[F.tid] = 0u;
    if (F.tid >= 64 && F.tid < 64 + 25) { const unsigned long long p = (unsigned long long)args.in[F.tid - 64]; MISC[64 + 2 * (F.tid - 64)] = (unsigned)p; MISC[65 + 2 * (F.tid - 64)] = (unsigned)(p >> 32); }
    __syncthreads();
    const int lo = args.ph_lo, hi = args.ph_hi;
    if (hi - lo > 1) (void)xcd_barrier_post(F.ctl + CW_BAR, MISC + 8);
#define EN(b) ((PHMASK_T >> (b)) & 1)
#define IN(k) (lo <= (k) && (k) < hi)
#if MK_ONE_LAUNCH
#define SEAM(k) do { if (IN(k) && IN((k) + 1)) { XcdBarrier bar_; bar_.bar = (unsigned*)(args.ws + WS_CTL) + CW_BAR; bar_.x = xb_xcc_id(); bar_.st = (volatile LAS unsigned*)(F.lds + MISC_OFF) + 8; xcd_barrier(bar_); } } while (0)
#else
#define SEAM(k) do { } while (0)
#endif
    LAS int* tb = (LAS int*)(F.lds + MISC_OFF + 2048);
    LAS int* cnts = tb + 40;

    if (EN(0) && IN(0)) { _Pragma("unroll 1") for (int rp = 0; rp < REP_PRO; ++rp) { Frame P = fresh(F); phase_prologue(P); } }
    SEAM(0);
    for (int l0 = 0; l0 < 4; ++l0) {
        const int pb = 1 + 10 * l0; const bool rec = (l0 & 1) == 0;
        if (EN(1) && IN(pb + 0)) { Frame P = fresh(F); const int l = fresh_i(l0); if (l0 == 0) phase_norm1<0>(P, l); else phase_norm1<1>(P, l); }
        SEAM(pb + 0);
        if (rec) {
            if (EN(2) && IN(pb + 1)) _Pragma("unroll 1") for (int rp = 0; rp < REP_GIN; ++rp) {
                Frame P = fresh(F); const int l = fresh_i(l0), j = l >> 1;
                pg8::StaticOrder S; S.init(NR, NREC, P.G, P.bid);
                EpiRec E{P.ws, inp_ptr(P, 9) + (size_t)j * 4112, (float*)(P.ws + WS_LB) + l * 512, l};
                pg8::gemm_phase(P.lds, (const bf16_t*)(P.ws + WS_H), (const bf16_t*)(P.ws + WS_WIN) + (size_t)j * NREC * 1024, 1024, 0, S, E, pg8::RowIdentity{}, P.tid);
            }
            SEAM(pb + 1);
            if (EN(3) && IN(pb + 2)) { _Pragma("unroll 1") for (int rp = 0; rp < REP_SCAN1; ++rp) { Frame P = fresh(F); phase_scan1(P); } }
            SEAM(pb + 2);
#pragma unroll 1
            for (int pass = 0; pass < 2; ++pass) {
                if (EN(4) && IN(pb + 3 + pass)) { Frame P = fresh(F); phase_scan23(P, fresh_i(l0) >> 1, fresh_i(pass)); }
                SEAM(pb + 3 + pass);
            }
        } else {
            if (EN(5) && IN(pb + 1)) _Pragma("unroll 1") for (int rp = 0; rp < REP_GIN; ++rp) {
                Frame P = fresh(F); const int l = fresh_i(l0), j = l >> 1;
                pg8::StaticOrder S; S.init(NR, 3072, P.G, P.bid);
                EpiQKV E{P.ws};
                pg8::gemm_phase(P.lds, (const bf16_t*)(P.ws + WS_H), (const bf16_t*)(P.ws + WS_WQKV) + (size_t)j * 3072 * 1024, 1024, 0, S, E, pg8::RowIdentity{}, P.tid);
            }
            SEAM(pb + 1);
            if (EN(6) && IN(pb + 2)) { _Pragma("unroll 1") for (int rp = 0; rp < REP_ATT; ++rp) { Frame P = fresh(F); phase_attn(P, fresh_i(l0) >> 1, l0 == 3); } }
            SEAM(pb + 2);
        }
        if (EN(7) && IN(pb + 5)) {
            Frame P = fresh(F); const int l = fresh_i(l0), j = l >> 1;
            pg8::StaticOrder S; S.init(l0 == 3 ? RL : NR, 1024, P.G, P.bid);
            EpiResid E{(bf16_t*)(P.ws + WS_Y), (const float*)(P.ws + WS_MOD) + l * 5 * 6144};
            pg8::gemm_phase(P.lds, (const bf16_t*)(P.ws + WS_MERGED), (const bf16_t*)(P.ws + ((l & 1) ? WS_WNOUT : WS_WROUT)) + (size_t)j * 1024 * 1024, 1024, 0, S, E, pg8::RowIdentity{}, P.tid);
        }
        SEAM(pb + 5);
        if (EN(8) && IN(pb + 6)) { Frame P = fresh(F); phase_router(P, fresh_i(l0)); }
        SEAM(pb + 6);
        if ((EN(9) && IN(pb + 7)) || (EN(10) && IN(pb + 8))) {
            Frame P = fresh(F); const int l = fresh_i(l0);
            expert_prefix(P, l, tb, cnts, 1, true);
            __syncthreads();
        }
        if (EN(9) && IN(pb + 7)) _Pragma("unroll 1") for (int rp = 0; rp < REP_MOE; ++rp) {
            Frame P = fresh(F); const int l = fresh_i(l0);
            pg8::MoeOrder S{tb, tb[32], 3, P.G, P.bid};
            EpiMoe1 E{(bf16_t*)(P.ws + WS_ACT), inp_ptr(P, 22) + (size_t)l * 32 * 2048};
            pg8::RowGather AO{(const int*)(P.ws + WS_LIST), cnts};
            pg8::gemm_phase(P.lds, (const bf16_t*)(P.ws + WS_H), (const bf16_t*)(P.ws + WS_WGU) + (size_t)l * 32 * 2048 * 1024, 1024, (size_t)2048 * 1024 * 2, S, E, AO, P.tid);
        }
        SEAM(pb + 7);
        if (EN(10) && IN(pb + 8)) _Pragma("unroll 1") for (int rp = 0; rp < REP_MOE; ++rp) {
            Frame P = fresh(F); const int l = fresh_i(l0);
            pg8::MoeOrder S{tb, tb[32], 2, P.G, P.bid};
            EpiMoe2 E{(bf16_t*)(P.ws + WS_YS), inp_ptr(P, 24) + (size_t)l * 32 * 1024};
            pg8::gemm_phase(P.lds, (const bf16_t*)(P.ws + WS_ACT), (const bf16_t*)(P.ws + WS_WD) + (size_t)l * 32 * 1024 * 1024, 1024, (size_t)1024 * 1024 * 2, S, E, pg8::RowIdentity{}, P.tid);
        }
        SEAM(pb + 8);
    }
    if (EN(11) && IN(41)) { Frame P = fresh(F); phase_norm1<2>(P, fresh_i(4)); }
#undef IN
#undef SEAM
}

typedef void (*kern_t)(Args);
static int phase_bit(int p) {
    if (p == 0) return 0; if (p == 41) return 11;
    const int l = (p - 1) / 10, k = (p - 1) % 10; const bool rec = (l & 1) == 0;
    switch (k) { case 0: return 1; case 1: return rec ? 2 : 5; case 2: return rec ? 3 : 6; case 3: return rec ? 3 : -1; case 4: return rec ? 4 : -1; case 5: return 7; case 6: return 8; case 7: return 9; case 8: return 10; default: return -1; }
}
extern "C" void kernel_launch(void* const* d_in, const int* in_sizes, int n_in, void* d_out, int out_size, void* d_ws, size_t ws_size, hipStream_t stream) {
    static int grid = 0;
#if MK_ONE_LAUNCH
    #ifndef ONE_MASK
#define ONE_MASK 0xfff
#endif
    static const kern_t kerns[1] = { mk_fwd<ONE_MASK> };
    const int nk = 1;
#else
    static const kern_t kerns[12] = { mk_fwd<1>, mk_fwd<2>, mk_fwd<4>, mk_fwd<8>, mk_fwd<16>, mk_fwd<32>, mk_fwd<64>, mk_fwd<128>, mk_fwd<256>, mk_fwd<512>, mk_fwd<1024>, mk_fwd<2048> };
    const int nk = 12;
#endif
    if (grid == 0) {
        if (n_in != 25 || out_size != RL * D || ws_size < WS_END) { fprintf(stderr, "kernel_launch: unexpected shapes (n_in %d out %d ws %zu)\n", n_in, out_size, ws_size); grid = -1; return; }
        int dev = 0, cus = 0;
        if (hipGetDevice(&dev) != hipSuccess || hipDeviceGetAttribute(&cus, hipDeviceAttributeMultiprocessorCount, dev) != hipSuccess) { grid = -1; return; }
        for (int i = 0; i < nk; ++i)
            if (hipFuncSetAttribute((const void*)kerns[i], hipFuncAttributeMaxDynamicSharedMemorySize, LDS_BYTES) != hipSuccess) { fprintf(stderr, "kernel_launch: hipFuncSetAttribute failed\n"); grid = -1; return; }
        (void)hipGetLastError();
        grid = cus;
    }
    if (grid < 0) return;
    (void)hipMemsetAsync((char*)d_ws + WS_CTL, 0, CTL_BYTES, stream);
    Args a{};
    for (int i = 0; i < 25; ++i) a.in[i] = (const float*)d_in[i];
    a.out = (float*)d_out; a.ws = (unsigned char*)d_ws;
#if MK_ONE_LAUNCH
    a.ph_lo = 0; a.ph_hi = NPHASE;
    hipLaunchKernelGGL(kerns[0], dim3(grid), dim3(512), LDS_BYTES, stream, a);
#else
    for (int p = 0; p < NPHASE; ++p) {
        const int bit = phase_bit(p); if (bit < 0) continue;
        a.ph_lo = p; a.ph_hi = p + 1;
        hipLaunchKernelGGL(kerns[bit], dim3(grid), dim3(512), LDS_BYTES, stream, a);
    }
#endif
}
```

```cpp
#include <hip/hip_runtime.h>
#include <stdint.h>
#include <stdio.h>

#ifndef MK_ONE_LAUNCH
#define MK_ONE_LAUNCH 1
#endif
#ifndef REP_PRO
#define REP_PRO 1
#endif
#ifndef REP_SCAN1
#define REP_SCAN1 1
#endif
#ifndef REP_SCAN2
#define REP_SCAN2 1
#endif
#ifndef REP_SCAN3
#define REP_SCAN3 1
#endif
#ifndef REP_ATT
#define REP_ATT 1
#endif
#ifndef REP_MOE
#define REP_MOE 1
#endif
#ifndef REP_GIN
#define REP_GIN 1
#endif
#define LAS __attribute__((address_space(3)))
#define GAS __attribute__((address_space(1)))
typedef unsigned short bf16_t;
typedef short bf16x8 __attribute__((ext_vector_type(8)));
typedef float f32x4 __attribute__((ext_vector_type(4)));
typedef float f32x2 __attribute__((ext_vector_type(2)));
typedef unsigned u32x4 __attribute__((ext_vector_type(4)));
typedef unsigned u32x2 __attribute__((ext_vector_type(2)));

constexpr int D = 1024, NB = 4, TL = 8192, TC = 256;
constexpr int RL = NB * TL;
constexpr int RC = NB * TC;
constexpr int NR = RL + RC;
constexpr int NREC = 4352;
constexpr int NE = 32, DFF = 1024;
constexpr int CAP = NR;
constexpr int SLOT_ROWS = 143360;
constexpr float EPS = 1e-6f;
constexpr int NPHASE = 42;

constexpr size_t MiB = 1u << 20;
constexpr size_t WS_CTL = 0, CTL_BYTES = 1 * MiB;
constexpr size_t WS_MOD = 1 * MiB;
constexpr size_t WS_LB = WS_MOD + 512 * 1024;
constexpr size_t WS_ROPE = WS_LB + 8 * 1024;
constexpr size_t WS_WIN = 2 * MiB;
constexpr size_t WS_WROUT = 19 * MiB;
constexpr size_t WS_WQKV = 23 * MiB;
constexpr size_t WS_WNOUT = 35 * MiB;
constexpr size_t WS_WGU = 40 * MiB;
constexpr size_t WS_WD = 552 * MiB;
constexpr size_t WS_X = 808 * MiB;
constexpr size_t WS_H = 940 * MiB;
constexpr size_t WS_MERGED = 1006 * MiB;
constexpr size_t WS_STREAM = 1072 * MiB;
constexpr size_t SZ_B512 = (size_t)NR * 512 * 2;
constexpr size_t SZ_F512 = (size_t)NR * 512 * 4;
constexpr size_t WS_Q = WS_STREAM, WS_KF = WS_Q + SZ_B512, WS_KB = WS_KF + SZ_B512, WS_V = WS_KB + SZ_B512, WS_HG = WS_V + SZ_B512;
constexpr size_t WS_MV = WS_HG + SZ_B512, WS_MO = WS_MV + SZ_B512, WS_MQ = WS_MO + SZ_B512, WS_MK = WS_MQ + SZ_B512 / 2;
constexpr size_t WS_LAF = WS_MK + SZ_B512 / 2, WS_LAB = WS_LAF + SZ_F512, WS_GATES = WS_LAB + SZ_F512;
constexpr size_t WS_OHF = WS_GATES + 3 * MiB, WS_OHB = WS_OHF + SZ_F512, WS_OMF = WS_OHB + SZ_F512, WS_OMB = WS_OMF + SZ_F512;
constexpr size_t WS_STREAM_END = WS_OMB + SZ_F512;
constexpr size_t WS_Y = WS_STREAM;
constexpr size_t WS_QKV = WS_STREAM;
constexpr int TT = TL + TC;
constexpr size_t WS_VTG = WS_STREAM + 200 * MiB;
constexpr size_t WS_SSK = WS_STREAM + 272 * MiB;
constexpr size_t WS_TOKE = 1744 * MiB, WS_TOKP = WS_TOKE + 1 * MiB, WS_TOKW = WS_TOKP + 1 * MiB, WS_LIST = WS_TOKW + 1 * MiB;
constexpr size_t WS_ACT = 1752 * MiB;
constexpr size_t WS_YS = 2032 * MiB;
constexpr size_t WS_END = 2312 * MiB;
static_assert(WS_STREAM_END <= WS_TOKE && WS_QKV + (size_t)NR * 3072 * 2 <= WS_TOKE, "stream region");
static_assert(WS_LIST + (size_t)NE * CAP * 4 <= WS_ACT && WS_ACT + (size_t)SLOT_ROWS * 1024 * 2 <= WS_YS && WS_YS + (size_t)SLOT_ROWS * 1024 * 2 <= WS_END, "moe region");
static_assert(WS_WIN + (size_t)2 * NREC * 1024 * 2 <= WS_WROUT && WS_WGU + (size_t)128 * 2048 * 1024 * 2 <= WS_WD && WS_WD + (size_t)128 * 1024 * 1024 * 2 <= WS_X, "weights");
constexpr int CW_BAR = 4096;
constexpr int CW_CNT = 16384;

constexpr int RING_BYTES = 131072;
constexpr int MISC_OFF = RING_BYTES;
constexpr int LDS_BYTES = 147456;

__device__ __forceinline__ float bf2f(unsigned b) { return __uint_as_float(b << 16); }
typedef _Float16 f16x4 __attribute__((ext_vector_type(4)));
__device__ __forceinline__ f32x4 h4_to_f4(u32x2 q) { return __builtin_convertvector(__builtin_bit_cast(f16x4, q), f32x4); }
__device__ __forceinline__ u32x2 f4_to_h4(f32x4 v) { f32x4 c; c[0] = __builtin_amdgcn_fmed3f(v[0], -65504.f, 65504.f); c[1] = __builtin_amdgcn_fmed3f(v[1], -65504.f, 65504.f); c[2] = __builtin_amdgcn_fmed3f(v[2], -65504.f, 65504.f); c[3] = __builtin_amdgcn_fmed3f(v[3], -65504.f, 65504.f);
    return __builtin_bit_cast(u32x2, __builtin_convertvector(c, f16x4)); }
__device__ __forceinline__ f32x4 ld_bf4(const bf16_t* p) { const u32x2 q = *(const u32x2*)p; return (f32x4){bf2f(q.x & 0xffffu), bf2f(q.x >> 16), bf2f(q.y & 0xffffu), bf2f(q.y >> 16)}; }
__device__ __forceinline__ unsigned f2bf(float f) { unsigned u = __float_as_uint(f); return (u + 0x7fffu + ((u >> 16) & 1u)) >> 16; }
__device__ __forceinline__ unsigned pk2(float lo, float hi) { unsigned r; asm("v_cvt_pk_bf16_f32 %0, %1, %2" : "=v"(r) : "v"(lo), "v"(hi)); return r; }
__device__ __forceinline__ float shx(float v, int o, int lane) { return __int_as_float(__builtin_amdgcn_ds_bpermute((lane ^ o) << 2, __float_as_int(v))); }
__device__ __forceinline__ int shxi(int v, int o, int lane) { return __builtin_amdgcn_ds_bpermute((lane ^ o) << 2, v); }
__device__ __forceinline__ float wave_sum(float v, int) {
    v += __int_as_float(__builtin_amdgcn_update_dpp(0, __float_as_int(v), 0xB1, 0xF, 0xF, true));
    v += __int_as_float(__builtin_amdgcn_update_dpp(0, __float_as_int(v), 0x4E, 0xF, 0xF, true));
    v += __int_as_float(__builtin_amdgcn_update_dpp(0, __float_as_int(v), 0x141, 0xF, 0xF, true));
    v += __int_as_float(__builtin_amdgcn_update_dpp(0, __float_as_int(v), 0x140, 0xF, 0xF, true));
    const float r0 = __int_as_float(__builtin_amdgcn_readlane(__float_as_int(v), 0)), r1 = __int_as_float(__builtin_amdgcn_readlane(__float_as_int(v), 16));
    const float r2 = __int_as_float(__builtin_amdgcn_readlane(__float_as_int(v), 32)), r3 = __int_as_float(__builtin_amdgcn_readlane(__float_as_int(v), 48));
    return (r0 + r1) + (r2 + r3);
}
__device__ __forceinline__ float wave_max(float v, int lane) {
#pragma unroll
    for (int o = 1; o < 64; o <<= 1) v = fmaxf(v, shx(v, o, lane));
    return v;
}
__device__ __forceinline__ int lane_id_volatile() { int l; asm volatile("v_mbcnt_lo_u32_b32 %0, -1, 0\n\tv_mbcnt_hi_u32_b32 %0, -1, %0" : "=v"(l)); return l; }
__device__ __forceinline__ float sigmoidf_(float x) { return __builtin_amdgcn_rcpf(1.0f + __builtin_amdgcn_exp2f(x * -1.4426950408889634f)); }
__device__ __forceinline__ float siluf_(float x) { return x * sigmoidf_(x); }
__device__ __forceinline__ float logsigmoidf_(float x) { return fminf(x, 0.f) - 0.6931471805599453f * __builtin_amdgcn_logf(1.0f + __builtin_amdgcn_exp2f(fabsf(x) * -1.4426950408889634f)); }
__device__ __forceinline__ int row_bidx(int r) { return r < RL ? (r >> 13) : 4; }

#define XB_TMO      128
#define XB_XCNT(j)  (256  + 64 * (j))
#define XB_XSUB(j)  (1280 + 64 * (j))
#define XB_XGEN(j)  (2304 + 64 * (j))
#define XB_TOP      3328
#define XB_TOPGEN   3392
#define XCD_BAR_WORDS 3456
#define XB_SPIN_CAP (1u << 18)
__device__ __forceinline__ unsigned xb_ld(unsigned* p)              { return __hip_atomic_load((GAS unsigned*)p, __ATOMIC_RELAXED, __HIP_MEMORY_SCOPE_AGENT); }
__device__ __forceinline__ unsigned xb_add(unsigned* p, unsigned v) { return __hip_atomic_fetch_add((GAS unsigned*)p, v, __ATOMIC_RELAXED, __HIP_MEMORY_SCOPE_AGENT); }
__device__ __forceinline__ unsigned xb_xcc_id() { return (unsigned)__builtin_amdgcn_s_getreg((3 << 11) | 20) & 0xFu; }
#define XB_SPIN(cond, bar) do { unsigned _sp = 0; while (cond) { __builtin_amdgcn_s_sleep(1); \
    if ((++_sp & 255u) == 0u) { if (xb_ld(&(bar)[XB_TMO])) break; if (_sp > XB_SPIN_CAP) { (void)xb_add(&(bar)[XB_TMO], 1u); break; } } } } while (0)
struct XcdBarrier { unsigned* bar; unsigned x; volatile LAS unsigned* st; int leader; };
__device__ __forceinline__ XcdBarrier xcd_barrier_post(unsigned* bar, volatile LAS unsigned* st) {
    XcdBarrier b; b.bar = bar; b.x = xb_xcc_id(); b.st = st;
    if (threadIdx.x == 0) (void)xb_add(&bar[XB_XCNT(b.x)], 1u);
    return b;
}
__device__ __forceinline__ void xcd_barrier_complete(unsigned* bar, unsigned x, unsigned& nloc, unsigned& nx) {
    const unsigned G = gridDim.x * gridDim.y * gridDim.z;
    unsigned sum, cnt, mine, sp = 0u;
    for (;;) {
        sum = 0u; cnt = 0u; mine = 0u;
#pragma unroll
        for (unsigned j = 0; j < 16; ++j) { const unsigned c = xb_ld(&bar[XB_XCNT(j)]); sum += c; cnt += (c > 0u) ? 1u : 0u; mine = (j == x) ? c : mine; }
        if (sum == G) break;
        __builtin_amdgcn_s_sleep(1);
        if ((++sp & 255u) == 0u) { if (xb_ld(&bar[XB_TMO])) break; if (sp > XB_SPIN_CAP) { (void)xb_add(&bar[XB_TMO], 1u); break; } }
    }
    nloc = mine > 0u ? mine : 1u; nx = cnt > 0u ? cnt : 1u;
}
__device__ __noinline__ void xcd_barrier(const XcdBarrier b) {
    asm volatile("s_waitcnt vmcnt(0)" ::: "memory");
    __syncthreads();
    if (b.leader) {
        unsigned* bar = b.bar;
        __builtin_amdgcn_s_waitcnt(0);
        unsigned nloc = b.st[0], nx = b.st[1];
        if (nloc == 0u) { xcd_barrier_complete(bar, b.x, nloc, nx); b.st[0] = nloc; b.st[1] = nx; }
        const unsigned old = xb_add(&bar[XB_XSUB(b.x)], 1u);
        const unsigned gen = old / nloc;
        if (old + 1u == (gen + 1u) * nloc) {
            __builtin_amdgcn_fence(__ATOMIC_RELEASE, "agent");
            asm volatile("s_waitcnt vmcnt(0)" ::: "memory");
            const unsigned og = xb_add(&bar[XB_TOP], 1u);
            const unsigned tg = og / nx;
            if (og + 1u == (tg + 1u) * nx) xb_add(&bar[XB_TOPGEN], 1u);
            else XB_SPIN(xb_ld(&bar[XB_TOPGEN]) == tg, bar);
            __builtin_amdgcn_fence(__ATOMIC_ACQUIRE, "agent");
            xb_add(&bar[XB_XGEN(b.x)], 1u);
            asm volatile("s_waitcnt vmcnt(0)" ::: "memory");
        } else {
            XB_SPIN(xb_ld(&bar[XB_XGEN(b.x)]) == gen, bar);
            __builtin_amdgcn_fence(__ATOMIC_ACQUIRE, "agent");
            asm volatile("s_waitcnt vmcnt(0)" ::: "memory");
        }
    }
    __syncthreads();
}

namespace pg8 {
constexpr int BM = 256, BK = 64, HALF = 128, HTB = HALF * BK * 2, STAGE_BYTES = 8 * HTB, NXCD = 8, WGM = 8;
__host__ __device__ __forceinline__ int lds_byte(int r, int c) { const int st = (r >> 4) * 2 + (c >> 5), rr = r & 15, cc = c & 31, ob = rr * 64 + cc * 2; return st * 1024 + (ob ^ (((ob >> 9) & 1) << 5)); }
__host__ __device__ __forceinline__ void stage_rc(int b, int& R, int& C) { const int st = b / 1024, sb = b % 1024, swz = sb ^ (((sb >> 9) & 1) << 5); R = (st >> 1) * 16 + swz / 64; C = (st & 1) * 32 + (swz % 64) / 2; }
__host__ __device__ __forceinline__ int perm32(int rho) { const int n = rho >> 4, i = rho & 15; return 8 * (i >> 2) + 4 * n + (i & 3); }
struct Unit { int pm, pn, e, mt; };
struct StaticOrder {
    int nM, nN, nwg, G, c;
    __device__ void init(int M, int N, int G_, int c_) { nM = M / BM; nN = N / BM; nwg = nM * nN; G = G_; c = c_; }
    __device__ bool next(int i, Unit& u) const {
        const long L = (long)i * G + c; if (L >= nwg) return false;
        int wgid = (int)L; { const int q = nwg / NXCD, r = nwg % NXCD, xcd = wgid % NXCD, off = wgid / NXCD; wgid = (xcd < r ? xcd * (q + 1) : r * (q + 1) + (xcd - r) * q) + off; }
        const int nig = WGM * nN, gid = wgid / nig, fm = gid * WGM, gsz = (nM - fm) < WGM ? (nM - fm) : WGM;
        u.pm = fm + ((wgid % nig) % gsz); u.pn = (wgid % nig) / gsz; u.e = 0; u.mt = 0; return true;
    }
};
struct MoeOrder {
    const LAS int* tb; int T, lg, G, c;
    __device__ bool next(int i, Unit& u) const {
        int tile, pn; const int npn = 1 << lg;
        if (G == 256) { const int x = c & 7, j = c >> 3, tpx = 32 >> lg; tile = (i * 8 + x) * tpx + (j >> lg); pn = j & (npn - 1); }
        else { const long L = (long)i * G + c; tile = (int)(L >> lg); pn = (int)(L & (npn - 1)); }
        if (tile >= T) return false;
        int ln_; asm volatile("v_mbcnt_lo_u32_b32 %0, -1, 0\n\tv_mbcnt_hi_u32_b32 %0, -1, %0" : "=v"(ln_));
        const int e = (int)__builtin_popcountll(__ballot(ln_ < 31 && tb[(ln_ < 31 ? ln_ : 31) + 1] <= tile));
        u.e = e; u.mt = tile - tb[e]; u.pm = tile; u.pn = pn; return true;
    }
};
struct RowIdentity { static constexpr bool GATHER = false; __device__ __forceinline__ int row(const Unit& u, int r) const { return r; } };
struct RowGather { static constexpr bool GATHER = true; const int* list; const LAS int* cnt; __device__ __forceinline__ int row(const Unit& u, int r) const { const int p = u.mt * BM + r; return p < cnt[u.e] ? list[(size_t)u.e * CAP + p] : 0; } };

__device__ __forceinline__ unsigned cvt_pk_bf16(float lo, float hi) { unsigned r; asm volatile("v_cvt_pk_bf16_f32 %0, %1, %2" : "=v"(r) : "v"(lo), "v"(hi)); return r; }

template <class Epi, class Sched, class AOff>
__device__ __forceinline__ void gemm_phase(LAS unsigned char* lds, const bf16_t* A, const bf16_t* Bt, const int K, const size_t estride  , const Sched& S, const Epi& E, const AOff& AO, const int tid) {
    const int wid = __builtin_amdgcn_readfirstlane(tid >> 6), lane = tid & 63, wr = wid >> 2, wc = wid & 3, fr = lane & 15, fq = lane >> 4;
    const int nt = K / BK;
    int Rr[2], Cc[2]; unsigned voffB[2];
#pragma unroll
    for (int i = 0; i < 2; ++i) { int R, C; stage_rc(tid * 16 + i * 8192, R, C); const int Rb = Epi::PERM ? ((R & ~31) + perm32(R & 31)) : R;
        Rr[i] = R; Cc[i] = C; voffB[i] = (unsigned)(Rb * K + C) * 2u; }
    const size_t kstep = (size_t)(BK * 2);
    const size_t hstep = (size_t)HALF * K * 2;
    const size_t tstep = 2 * hstep;
    const unsigned ldsw = (unsigned)wid * 1024u;
    const int aoff = lds_byte(wr * 64 + fr, fq * 8), boff = lds_byte(wc * 32 + fr, fq * 8);
#define PG8_SA(b, h) (((b) * 2 + (h)) * HTB)
#define PG8_SB(b, h) ((4 + (b) * 2 + (h)) * HTB)
#define PG8_STAGE(bufoff, gbase, voff) do { _Pragma("unroll") for (int _i = 0; _i < 2; ++_i) \
        __builtin_amdgcn_global_load_lds((const unsigned*)((const char*)(gbase) + (voff)[_i]), (LAS unsigned*)(lds + (bufoff) + ldsw + _i * 8192), 16, 0, 0); } while (0)
#define PG8_STAGE2(bufoff, gbase, v0, v1) do { \
        __builtin_amdgcn_global_load_lds((const unsigned*)((const char*)(gbase) + (v0)), (LAS unsigned*)(lds + (bufoff) + ldsw), 16, 0, 0); \
        __builtin_amdgcn_global_load_lds((const unsigned*)((const char*)(gbase) + (v1)), (LAS unsigned*)(lds + (bufoff) + ldsw + 8192), 16, 0, 0); } while (0)
#define PG8_LDA(dst, b, h) do { _Pragma("unroll") for (int m = 0; m < 4; ++m) _Pragma("unroll") for (int k = 0; k < 2; ++k) dst[m][k] = *(const LAS bf16x8*)(lds + PG8_SA(b, h) + aoff + m * 2048 + k * 1024); } while (0)
#define PG8_LDB(dst, b, h) do { _Pragma("unroll") for (int n = 0; n < 2; ++n) _Pragma("unroll") for (int k = 0; k < 2; ++k) dst[n][k] = *(const LAS bf16x8*)(lds + PG8_SB(b, h) + boff + n * 2048 + k * 1024); } while (0)
#define PG8_MMA(ai, bj, At, Bt_) do { __builtin_amdgcn_s_setprio(1); _Pragma("unroll") for (int m = 0; m < 4; ++m) _Pragma("unroll") for (int n = 0; n < 2; ++n) _Pragma("unroll") for (int k = 0; k < 2; ++k) \
        acc[ai][bj][m][n] = __builtin_amdgcn_mfma_f32_16x16x32_bf16(Bt_[n][k], At[m][k], acc[ai][bj][m][n], 0, 0, 0); __builtin_amdgcn_s_setprio(0); } while (0)
#define PG8_WAIT_V(n) asm volatile("s_waitcnt vmcnt(" #n ")" ::: "memory")
#define PG8_WAIT_L(n) asm volatile("s_waitcnt lgkmcnt(" #n ")" ::: "memory")
#define PG8_BAR __builtin_amdgcn_s_barrier()
#define PG8_SCHED __builtin_amdgcn_sched_barrier(0)
#define PG8_AOFFS(dst, u) do { _Pragma("unroll") for (int _h = 0; _h < 2; ++_h) _Pragma("unroll") for (int _i = 0; _i < 2; ++_i) \
        dst[_h][_i] = ((unsigned)AO.row(u, _h * HALF + Rr[_i]) * (unsigned)K + (unsigned)Cc[_i]) * 2u; } while (0)
    Unit cur, nxt; int ui = 0;
    if (!S.next(0, cur)) return;
    f32x4 acc[2][2][4][2];
#pragma unroll
    for (int a = 0; a < 2; ++a)
#pragma unroll
        for (int b = 0; b < 2; ++b)
#pragma unroll
            for (int m = 0; m < 4; ++m)
#pragma unroll
                for (int n = 0; n < 2; ++n) acc[a][b][m][n] = (f32x4){0.f, 0.f, 0.f, 0.f};
    bf16x8 At[4][2], B0[2][2], B1[2][2];
    unsigned vc[2][2], vn[2][2];
    PG8_AOFFS(vc, cur);
    const char* Ab = (const char*)A;
    const char* aC = AOff::GATHER ? Ab : Ab + (size_t)cur.pm * tstep;
    const char* cB = (const char*)Bt + (size_t)cur.e * estride + (size_t)cur.pn * tstep;
    PG8_STAGE(PG8_SB(0, 0), cB, voffB); PG8_STAGE2(PG8_SA(0, 0), aC, vc[0][0], vc[0][1]); PG8_STAGE(PG8_SB(0, 1), cB + hstep, voffB); PG8_STAGE2(PG8_SA(0, 1), aC, vc[1][0], vc[1][1]);
    if (wr == 1) PG8_BAR;
    PG8_WAIT_V(4); PG8_BAR;
    PG8_STAGE(PG8_SB(1, 0), cB + kstep, voffB); PG8_STAGE2(PG8_SA(1, 0), aC + kstep, vc[0][0], vc[0][1]); PG8_STAGE(PG8_SB(1, 1), cB + hstep + kstep, voffB);
    PG8_WAIT_V(6); PG8_BAR;
    for (;;) {
        const bool has_next = S.next(ui + 1, nxt);
        if (AOff::GATHER && has_next) { PG8_AOFFS(vn, nxt); }
        else {
#pragma unroll
            for (int _h = 0; _h < 2; ++_h)
#pragma unroll
                for (int _i = 0; _i < 2; ++_i) vn[_h][_i] = vc[_h][_i];
        }
        const char* nB = has_next ? (const char*)Bt + (size_t)nxt.e * estride + (size_t)nxt.pn * tstep : cB;
        const char* aN = (AOff::GATHER || !has_next) ? aC : Ab + (size_t)nxt.pm * tstep;
        for (int t = 0; t < nt; t += 2) {
            const bool last = (t == nt - 2);
            const char* a1 = aC + (size_t)(t + 1) * kstep;
            const char* a2 = last ? aN : aC + (size_t)(t + 2) * kstep; const char* b2 = last ? nB : cB + (size_t)(t + 2) * kstep;
            const char* a3 = a2 + kstep; const char* b3 = b2 + kstep;
            const unsigned x00 = last ? vn[0][0] : vc[0][0], x01 = last ? vn[0][1] : vc[0][1], x10 = last ? vn[1][0] : vc[1][0], x11 = last ? vn[1][1] : vc[1][1];
            PG8_LDB(B0, 0, 0); PG8_SCHED; PG8_LDA(At, 0, 0); PG8_STAGE2(PG8_SA(1, 1), a1, vc[1][0], vc[1][1]);
            PG8_WAIT_L(8); PG8_BAR; PG8_WAIT_L(0); PG8_MMA(0, 0, At, B0); PG8_BAR; PG8_SCHED;
            PG8_LDB(B1, 0, 1); PG8_STAGE(PG8_SB(0, 0), b2, voffB);
            PG8_BAR; PG8_WAIT_L(0); PG8_MMA(0, 1, At, B1); PG8_BAR;
            PG8_LDA(At, 0, 1); PG8_STAGE2(PG8_SA(0, 0), a2, x00, x01);
            PG8_BAR; PG8_WAIT_L(0); PG8_MMA(1, 0, At, B0); PG8_BAR; PG8_SCHED;
            PG8_STAGE(PG8_SB(0, 1), b2 + hstep, voffB);
            PG8_WAIT_V(6); PG8_BAR; PG8_MMA(1, 1, At, B1); PG8_BAR;
            PG8_LDB(B0, 1, 0); PG8_SCHED; PG8_LDA(At, 1, 0); PG8_STAGE2(PG8_SA(0, 1), a2, x10, x11);
            PG8_WAIT_L(8); PG8_BAR; PG8_WAIT_L(0); PG8_MMA(0, 0, At, B0); PG8_BAR; PG8_SCHED;
            PG8_LDB(B1, 1, 1); PG8_STAGE(PG8_SB(1, 0), b3, voffB);
            PG8_BAR; PG8_WAIT_L(0); PG8_MMA(0, 1, At, B1); PG8_BAR;
            PG8_LDA(At, 1, 1); PG8_STAGE2(PG8_SA(1, 0), a3, x00, x01);
            PG8_BAR; PG8_WAIT_L(0); PG8_MMA(1, 0, At, B0); PG8_BAR; PG8_SCHED;
            PG8_STAGE(PG8_SB(1, 1), b3 + hstep, voffB);
            PG8_WAIT_V(6); PG8_BAR; PG8_MMA(1, 1, At, B1); PG8_BAR;
        }
        E(acc, cur, wr, wc, fr, fq);
        if (!has_next) break;
#pragma unroll
        for (int a = 0; a < 2; ++a)
#pragma unroll
            for (int b = 0; b < 2; ++b)
#pragma unroll
                for (int m = 0; m < 4; ++m)
#pragma unroll
                    for (int n = 0; n < 2; ++n) acc[a][b][m][n] = (f32x4){0.f, 0.f, 0.f, 0.f};
        cur = nxt; cB = nB; aC = aN; ++ui;
#pragma unroll
        for (int _h = 0; _h < 2; ++_h)
#pragma unroll
            for (int _i = 0; _i < 2; ++_i) vc[_h][_i] = vn[_h][_i];
    }
    PG8_WAIT_V(0);
    if (wr == 0) PG8_BAR;
    PG8_BAR;
#undef PG8_SA
#undef PG8_SB
#undef PG8_STAGE
#undef PG8_STAGE2
#undef PG8_LDA
#undef PG8_LDB
#undef PG8_MMA
#undef PG8_WAIT_V
#undef PG8_WAIT_L
#undef PG8_BAR
#undef PG8_SCHED
#undef PG8_AOFFS
}
}

struct Args { const float* in[25]; float* out; unsigned char* ws; int ph_lo, ph_hi; };
struct Frame {
    LAS unsigned char* lds; int tid, lane, wave, G, bid;
    float* out; unsigned char* ws; unsigned* ctl;
};
__device__ __forceinline__ const float* inp_ptr(const Frame& F, int k) {
    const LAS unsigned* t = (const LAS unsigned*)(F.lds + MISC_OFF + 256) + 2 * k;
    const unsigned lo = __builtin_amdgcn_readfirstlane(t[0]), hi = __builtin_amdgcn_readfirstlane(t[1]);
    return (const float*)(const GAS float*)(((unsigned long long)hi << 32) | lo);
}
#define INP(k) inp_ptr(F, (k))
__device__ __forceinline__ Frame fresh(const Frame& F) {
    Frame P = F;
    int z = 0;
    asm volatile("" : "+s"(z), "+s"(P.G), "+s"(P.bid), "+s"(P.wave));
    P.lane = lane_id_volatile() & 63; P.tid = (P.wave << 6) | P.lane;
    P.ws = F.ws + z; P.out = F.out + z;
    P.wave &= 7; P.ctl = (unsigned*)(P.ws + WS_CTL);
    return P;
}
__device__ __forceinline__ int fresh_i(int v) { asm volatile("" : "+s"(v)); return v; }
#define WSP(T, off) ((T*)(F.ws + (off)))

template <class T> __device__ __forceinline__ T* opaque(T* p) { int z = 0; asm volatile("" : "+s"(z)); return p + z; }
__device__ __forceinline__ u32x4 pack8(const f32x4 a, const f32x4 b) { u32x4 w; w.x = pk2(a[0], a[1]); w.y = pk2(a[2], a[3]); w.z = pk2(b[0], b[1]); w.w = pk2(b[2], b[3]); return w; }
__device__ __forceinline__ f32x4 sigm4(const f32x4 a) { const f32x4 z = a * -1.4426950408889634f; f32x4 e, r;
#pragma unroll
    for (int j = 0; j < 4; ++j) e[j] = __builtin_amdgcn_exp2f(z[j]);
    const f32x4 d = e + 1.0f;
#pragma unroll
    for (int j = 0; j < 4; ++j) r[j] = __builtin_amdgcn_rcpf(d[j]);
    return r; }
__device__ __forceinline__ f32x4 silu4(const f32x4 a) { return a * sigm4(a); }
__device__ __forceinline__ f32x4 lsig4(const f32x4 a) { return (f32x4){logsigmoidf_(a[0]), logsigmoidf_(a[1]), logsigmoidf_(a[2]), logsigmoidf_(a[3])}; }
__device__ __forceinline__ void fgate4(const f32x4 x, const f32x4 lbv, f32x4& kk, f32x4& la) {
    const f32x4 z = x * -1.4426950408889634f; f32x4 e, sg, lg;
#pragma unroll
    for (int j = 0; j < 4; ++j) e[j] = __builtin_amdgcn_exp2f(fminf(z[j], 125.0f));
    const f32x4 d = e + 1.0f;
#pragma unroll
    for (int j = 0; j < 4; ++j) sg[j] = __builtin_amdgcn_rcpf(d[j]);
    const f32x4 om = 1.0f - lbv;
    const f32x4 f = lbv + om * sg;
    kk = om * (1.0f - sg);
#pragma unroll
    for (int j = 0; j < 4; ++j) lg[j] = __builtin_amdgcn_logf(f[j]);
    la = lg * 0.6931471805599453f;
}
template <int KIND>
__device__ __forceinline__ void rec_group(unsigned char* ws, const float* bias, const float* lb, f32x4 v0, f32x4 v1, int row, int gc, int sc, int ct, int wc, int fq, int fr, bool latent) {
    const bool gate_lane = (KIND != 9) || (ct < 16);
    const int gcs = gate_lane ? gc : 0;
    v0 += *(const f32x4*)((const char*)bias + (unsigned)(gcs * 4)); v1 += *(const f32x4*)((const char*)bias + (unsigned)(gcs * 4 + 16));
    if (KIND == 0) {
        *(u32x4*)(ws + WS_Q + (unsigned)(row * 1024 + sc * 2)) = pack8(silu4(v0) * 0.08838834764831845f, silu4(v1) * 0.08838834764831845f);
    } else if (KIND == 1 || KIND == 2) {
        f32x4 k0, k1, l0, l1;
        fgate4(v0, *(const f32x4*)((const char*)lb + (unsigned)(sc * 4)), k0, l0); fgate4(v1, *(const f32x4*)((const char*)lb + (unsigned)(sc * 4 + 16)), k1, l1);
        *(u32x4*)(ws + (KIND == 1 ? WS_KF : WS_KB) + (unsigned)(row * 1024 + sc * 2)) = pack8(k0, k1);
        float* lp = (float*)(ws + (KIND == 1 ? WS_LAF : WS_LAB) + (unsigned)(row * 2048 + sc * 4));
        *(f32x4*)lp = l0; *(f32x4*)(lp + 4) = l1;
    } else if (KIND == 3 || KIND == 4 || KIND == 7 || KIND == 8) {
        if (KIND == 4) { v0 = silu4(v0); v1 = silu4(v1); }
        if (KIND == 8) { v0 = sigm4(v0); v1 = sigm4(v1); }
        const size_t off = KIND == 3 ? WS_V : KIND == 4 ? WS_HG : KIND == 7 ? WS_MV : WS_MO;
        *(u32x4*)(ws + off + (unsigned)(row * 1024 + sc * 2)) = pack8(v0, v1);
    } else if (KIND == 5 || KIND == 6) {
        if (KIND == 6) { v0 *= 0.125f; v1 *= 0.125f; }
        f32x4 p0, p1;
#pragma unroll
        for (int j = 0; j < 4; ++j) { p0[j] = shx(v0[j], 32, fq * 16 + fr); p1[j] = shx(v1[j], 32, fq * 16 + fr); }
        if (latent) {
            const int t = row & 8191; const int pos = (wc & 1) ? (t & 63) : (t >> 6);
            const f32x4* rp = (const f32x4*)((const f32x2*)(ws + WS_ROPE) + pos * 16 + 8 * (fq & 1));
            const f32x4 c01 = rp[0], c23 = rp[1], c45 = rp[2], c67 = rp[3];
            const f32x4 cs0 = (f32x4){c01[0], c01[2], c23[0], c23[2]}, sn0 = (f32x4){c01[1], c01[3], c23[1], c23[3]};
            const f32x4 cs1 = (f32x4){c45[0], c45[2], c67[0], c67[2]}, sn1 = (f32x4){c45[1], c45[3], c67[1], c67[3]};
            const float sg = (fq >= 2) ? 1.0f : -1.0f;
            v0 = v0 * cs0 + sg * (p0 * sn0); v1 = v1 * cs1 + sg * (p1 * sn1);
        }
        *(u32x4*)(ws + (KIND == 5 ? WS_MQ : WS_MK) + (unsigned)(row * 512 + sc * 2)) = pack8(v0, v1);
    } else {
        if (gate_lane) { float* gp = (float*)(ws + WS_GATES + (unsigned)(row * 64 + ct * 4)); *(f32x4*)gp = v0; *(f32x4*)(gp + 4) = lsig4(v1); }
    }
}
struct EpiRec {
    static constexpr bool PERM = true;
    unsigned char* ws; const float* bias; const float* lb; int layer;
    template <int KIND>
    __device__ __forceinline__ void run(const f32x4 (&acc)[2][2][4][2], const pg8::Unit& u, int wr, int wc, int fr, int fq, int cbase  ) const {
        const int row0 = u.pm * 256 + wr * 64 + fr;
        const bool latent = u.pm < 128;
#define REC_G(ai, m) { const int row = row0 + (ai) * 128 + (m) * 16; \
        { const int ct = wc * 32 + 8 * fq; rec_group<KIND>(ws, bias, lb, acc[ai][0][m][0], acc[ai][0][m][1], row, u.pn * 256 + ct, cbase + ct, ct, wc, fq, fr, latent); } \
        if (KIND != 9) { const int ct = 128 + wc * 32 + 8 * fq; rec_group<KIND>(ws, bias, lb, acc[ai][1][m][0], acc[ai][1][m][1], row, u.pn * 256 + ct, cbase + ct, ct, wc, fq, fr, latent); } if ((m) == 3) asm volatile("" ::: "memory"); }
        REC_G(0, 0) REC_G(0, 1) REC_G(0, 2) REC_G(0, 3) REC_G(1, 0) REC_G(1, 1) REC_G(1, 2) REC_G(1, 3)
#undef REC_G
    }
    __device__ __forceinline__ void operator()(const f32x4 (&acc)[2][2][4][2], const pg8::Unit& u, int wr, int wc, int fr, int fq) const {
        const int pn = u.pn;
        EpiRec o{opaque(ws), opaque(bias), opaque(lb), layer};
        asm volatile("" : "+v"(fr), "+v"(fq));
        o.dispatch(acc, u, wr, wc, fr, fq, pn);
    }
    __device__ __forceinline__ void dispatch(const f32x4 (&acc)[2][2][4][2], const pg8::Unit& u, int wr, int wc, int fr, int fq, int pn) const {
        if (pn < 2) run<0>(acc, u, wr, wc, fr, fq, pn * 256);
        else if (pn < 4) run<1>(acc, u, wr, wc, fr, fq, (pn - 2) * 256);
        else if (pn < 6) run<2>(acc, u, wr, wc, fr, fq, (pn - 4) * 256);
        else if (pn < 8) run<3>(acc, u, wr, wc, fr, fq, (pn - 6) * 256);
        else if (pn < 10) run<4>(acc, u, wr, wc, fr, fq, (pn - 8) * 256);
        else if (pn == 10) run<5>(acc, u, wr, wc, fr, fq, 0);
        else if (pn == 11) run<6>(acc, u, wr, wc, fr, fq, 0);
        else if (pn < 14) run<7>(acc, u, wr, wc, fr, fq, (pn - 12) * 256);
        else if (pn < 16) run<8>(acc, u, wr, wc, fr, fq, (pn - 14) * 256);
        else run<9>(acc, u, wr, wc, fr, fq, 0);
    }
};
struct EpiQKV {
    static constexpr bool PERM = true;
    unsigned char* ws;
    __device__ __forceinline__ void operator()(const f32x4 (&acc)[2][2][4][2], const pg8::Unit& u, int wr, int wc, int fr, int fq) const {
        const int row0 = u.pm * 256 + wr * 64 + fr;
        unsigned char* w_ = opaque(ws);
        asm volatile("" : "+v"(fr), "+v"(fq));
        if (u.pn < 8) {
            const int col0 = u.pn * 256 + wc * 32 + 8 * fq;
#pragma unroll
            for (int ai = 0; ai < 2; ++ai)
#pragma unroll
                for (int m = 0; m < 4; ++m) { const int row = row0 + ai * 128 + m * 16; const unsigned ob = (unsigned)(row * 3072 + col0) * 2u;
#pragma unroll
                    for (int bj = 0; bj < 2; ++bj) { const f32x4 v0 = acc[ai][bj][m][0], v1 = acc[ai][bj][m][1];
                        *(u32x4*)(w_ + WS_QKV + (ob + bj * 256u)) = pack8(v0, v1);
                        if (u.pn >= 4) {
                            float ss = (v0[0] * v0[0] + v0[1] * v0[1]) + (v0[2] * v0[2] + v0[3] * v0[3]) + (v1[0] * v1[0] + v1[1] * v1[1]) + (v1[2] * v1[2] + v1[3] * v1[3]);
                            const int lane = fq * 16 + fr; ss += shx(ss, 16, lane); ss += shx(ss, 32, lane);
                            if (fq == 0) atomicAdd((float*)(w_ + WS_SSK) + row * 16 + (((u.pn - 4) * 256 + bj * 128 + wc * 32) >> 6), ss); } } }
        } else {
            const int b = u.pm < 128 ? (u.pm >> 5) : (u.pm - 128); const int tt0 = u.pm < 128 ? ((u.pm & 31) * 256) : TL;
#pragma unroll
            for (int ai = 0; ai < 2; ++ai)
#pragma unroll
                for (int m = 0; m < 4; ++m) { const int tt = tt0 + wr * 64 + fr + ai * 128 + m * 16;
#pragma unroll
                    for (int bj = 0; bj < 2; ++bj) { const int c = (u.pn - 8) * 256 + bj * 128 + wc * 32 + 8 * fq;
                        const unsigned base = (unsigned)(((b * 16 + (c >> 6)) * 64 + (c & 63)) * TT + tt) * 2u;
                        const u32x4 pk = pack8(acc[ai][bj][m][0], acc[ai][bj][m][1]); const unsigned pw[4] = {pk.x, pk.y, pk.z, pk.w};
#pragma unroll
                        for (int q = 0; q < 8; ++q) *(bf16_t*)(w_ + WS_VTG + (base + (unsigned)q * (TT * 2u))) = (bf16_t)((q & 1) ? (pw[q >> 1] >> 16) : (pw[q >> 1] & 0xffffu)); } }
        }
    }
};
struct EpiResid {
    static constexpr bool PERM = true;
    bf16_t* Y; const float* modl;
    __device__ __forceinline__ void operator()(const f32x4 (&acc)[2][2][4][2], const pg8::Unit& u, int wr, int wc, int fr, int fq) const {
        const int row0 = u.pm * 256 + wr * 64 + fr, col0 = u.pn * 256 + wc * 32 + 8 * fq;
        const int bidx = u.pm < 128 ? (u.pm >> 5) : 4;
        bf16_t* Y = opaque(this->Y);
        const float* g = opaque(modl) + bidx * 6144 + 2048 + col0;
        f32x4 gv[2][2];
#pragma unroll
        for (int bj = 0; bj < 2; ++bj) { gv[bj][0] = *(const f32x4*)(g + bj * 128); gv[bj][1] = *(const f32x4*)(g + bj * 128 + 4); }
#pragma unroll
        for (int ai = 0; ai < 2; ++ai)
#pragma unroll
            for (int m = 0; m < 4; ++m) { const unsigned ob = (unsigned)((row0 + ai * 128 + m * 16) * 1024 + col0) * 2u;
#pragma unroll
                for (int bj = 0; bj < 2; ++bj) *(u32x4*)((char*)Y + (ob + bj * 256u)) = pack8(acc[ai][bj][m][0] * gv[bj][0], acc[ai][bj][m][1] * gv[bj][1]); }
    }
};
__device__ __forceinline__ f32x4 swiglu4(const f32x4 g, const f32x4 u) {
    f32x4 gt, up, e, r;
#pragma unroll
    for (int j = 0; j < 4; ++j) { gt[j] = fminf(g[j], 7.0f); up[j] = __builtin_amdgcn_fmed3f(u[j], -7.0f, 7.0f); }
    const f32x4 z = gt * -2.4554669595930157f;
#pragma unroll
    for (int j = 0; j < 4; ++j) e[j] = __builtin_amdgcn_exp2f(z[j]);
    const f32x4 d = e + 1.0f;
#pragma unroll
    for (int j = 0; j < 4; ++j) r[j] = __builtin_amdgcn_rcpf(d[j]);
    return (gt * r) * (up + 1.0f);
}
struct EpiMoe1 {
    static constexpr bool PERM = true;
    bf16_t* ACT; const float* bgu;
    __device__ __forceinline__ void operator()(const f32x4 (&acc)[2][2][4][2], const pg8::Unit& u, int wr, int wc, int fr, int fq) const {
        const int row0 = u.pm * 256 + wr * 64 + fr, c0 = u.pn * 128 + wc * 32 + 8 * fq;
        bf16_t* ACT = opaque(this->ACT);
        const float* bg = opaque(bgu) + (size_t)u.e * 2048 + c0; const float* bu = bg + 1024;
        const f32x4 g0 = *(const f32x4*)bg, g1 = *(const f32x4*)(bg + 4), u0 = *(const f32x4*)bu, u1 = *(const f32x4*)(bu + 4);
#pragma unroll
        for (int ai = 0; ai < 2; ++ai)
#pragma unroll
            for (int m = 0; m < 4; ++m) {
                const f32x4 ga = acc[ai][0][m][0] + g0, gb = acc[ai][0][m][1] + g1, ua = acc[ai][1][m][0] + u0, ub = acc[ai][1][m][1] + u1;
                const f32x4 ra = swiglu4(ga, ua), rb = swiglu4(gb, ub);
                const float r[8] = {ra[0], ra[1], ra[2], ra[3], rb[0], rb[1], rb[2], rb[3]};
                u32x4 w; w.x = pk2(r[0], r[1]); w.y = pk2(r[2], r[3]); w.z = pk2(r[4], r[5]); w.w = pk2(r[6], r[7]);
                *(u32x4*)((char*)ACT + (unsigned)((row0 + ai * 128 + m * 16) * 1024 + c0) * 2u) = w;
            }
    }
};
struct EpiMoe2 {
    static constexpr bool PERM = true;
    bf16_t* YS; const float* bd;
    __device__ __forceinline__ void operator()(const f32x4 (&acc)[2][2][4][2], const pg8::Unit& u, int wr, int wc, int fr, int fq) const {
        const int row0 = u.pm * 256 + wr * 64 + fr, col0 = u.pn * 256 + wc * 32 + 8 * fq;
        bf16_t* YS = opaque(this->YS);
        const float* b = opaque(bd) + (size_t)u.e * 1024 + col0;
        f32x4 bv[2][2];
#pragma unroll
        for (int bj = 0; bj < 2; ++bj) { bv[bj][0] = *(const f32x4*)(b + bj * 128); bv[bj][1] = *(const f32x4*)(b + bj * 128 + 4); }
#pragma unroll
        for (int ai = 0; ai < 2; ++ai)
#pragma unroll
            for (int m = 0; m < 4; ++m) { const unsigned ob = (unsigned)((row0 + ai * 128 + m * 16) * 1024 + col0) * 2u;
#pragma unroll
                for (int bj = 0; bj < 2; ++bj) *(u32x4*)((char*)YS + (ob + bj * 256u)) = pack8(acc[ai][bj][m][0] + bv[bj][0], acc[ai][bj][m][1] + bv[bj][1]); }
    }
};

__device__ __forceinline__ void transpose_item(const float* W, int K, int N, bf16_t* WT, int drow0, LAS float* scr, int k0, int n0, int lane) {
    const int n = n0 + (lane & 31); const bool ok = n < N;
#pragma unroll 8
    for (int i = 0; i < 32; ++i) { const int kk = 2 * i + (lane >> 5); scr[kk * 33 + (lane & 31)] = ok ? __builtin_nontemporal_load(W + (size_t)(k0 + kk) * N + n) : 0.f; }
    asm volatile("s_waitcnt lgkmcnt(0)" ::: "memory");
    const int c = lane & 7;
#pragma unroll
    for (int j = 0; j < 4; ++j) { const int nn = (lane >> 3) + 8 * j; const LAS float* s = scr + (8 * c) * 33 + nn;
        u32x4 o; o.x = pk2(s[0 * 33], s[1 * 33]); o.y = pk2(s[2 * 33], s[3 * 33]); o.z = pk2(s[4 * 33], s[5 * 33]); o.w = pk2(s[6 * 33], s[7 * 33]);
        __builtin_nontemporal_store(o, (u32x4*)(WT + (size_t)(drow0 + nn) * K + k0 + 8 * c)); }
    asm volatile("s_waitcnt lgkmcnt(0)" ::: "memory");
}
__device__ __forceinline__ void phase_prologue(Frame& F) {
    {
        LAS float* s = (LAS float*)(F.lds);
        LAS float* part = (LAS float*)(F.lds + 32768);
        bool have_s = false;
        for (int item = F.bid; item < 384; item += F.G) {
            if (!have_s) {
                for (int i = F.tid; i < 5 * 1024; i += 512) { const int b = i >> 10, k = i & 1023; const float c = b < 4 ? INP(1)[b * 1024 + k] : INP(3)[k]; s[i] = siluf_(c); }
                have_s = true;
            }
            __syncthreads();
            const int l = item / 96, n0 = (item % 96) * 64, ci = F.tid & 63, kg = F.tid >> 6;
            const float* w = INP(4) + ((size_t)l * 1024 + kg * 128) * 6144 + n0 + ci;
            float a0 = 0.f, a1 = 0.f, a2 = 0.f, a3 = 0.f, a4 = 0.f;
#pragma unroll 8
            for (int k = 0; k < 128; ++k) { const float wv = w[(size_t)k * 6144]; const int kk = kg * 128 + k;
                a0 += s[kk] * wv; a1 += s[1024 + kk] * wv; a2 += s[2048 + kk] * wv; a3 += s[3072 + kk] * wv; a4 += s[4096 + kk] * wv; }
            part[(kg * 5 + 0) * 64 + ci] = a0; part[(kg * 5 + 1) * 64 + ci] = a1; part[(kg * 5 + 2) * 64 + ci] = a2; part[(kg * 5 + 3) * 64 + ci] = a3; part[(kg * 5 + 4) * 64 + ci] = a4;
            __syncthreads();
            if (F.tid < 320) { const int b = F.tid >> 6, c2 = F.tid & 63; float sum = INP(5)[l * 6144 + n0 + c2];
#pragma unroll
                for (int g = 0; g < 8; ++g) sum += part[(g * 5 + b) * 64 + c2];
                WSP(float, WS_MOD)[(l * 5 + b) * 6144 + n0 + c2] = sum; }
        }
        __syncthreads();
        if (F.bid == (F.G > 1 ? F.G - 1 : 0)) {
            const int c = F.tid; const float* hl = INP(11);
            const float v0 = hl[c], v1 = hl[512 + c], v2 = hl[1024 + c], v3 = hl[1536 + c];
            const float mx = fmaxf(fmaxf(v0, v1), fmaxf(v2, v3));
            const float e0 = expf(v0 - mx), e1 = expf(v1 - mx), e2 = expf(v2 - mx), e3 = expf(v3 - mx); const float inv = 1.0f / (e0 + e1 + e2 + e3);
            float* LB = WSP(float, WS_LB);
            LB[c] = 0.f; LB[512 + c] = fmaxf(e1 * inv, 0.f); LB[1024 + c] = fmaxf((e1 + e2) * inv, 0.f); LB[1536 + c] = fmaxf((e1 + e2 + e3) * inv, 0.f);
        }
        if (F.bid == (F.G > 2 ? F.G - 2 : 0)) {
            for (int i = F.tid; i < 2048; i += 512) { const int pos = i >> 4, q = i & 15; const float inv = powf(10000.0f, -(float)q / 16.0f); const float ang = (float)pos * inv;
                WSP(f32x2, WS_ROPE)[i] = (f32x2){cosf(ang), sinf(ang)}; }
        }
        __syncthreads();
    }
    LAS float* scr = (LAS float*)(F.lds + F.wave * 16384);
    const int gw = F.bid * 8 + F.wave, NGW = F.G * 8;
    constexpr int I_WIN = 16 * 136, I_SQ = 16 * 32, I_QKV = 16 * 96, I_GU = 16 * 64;
    constexpr int N0 = 2 * I_WIN, N1 = N0 + 2 * I_SQ, N2 = N1 + 2 * I_QKV, N3 = N2 + 2 * I_SQ, N4 = N3 + 128 * I_GU, N5 = N4 + 128 * I_SQ;
    for (int it = gw; it < N5; it += NGW) {
        if (it < N0) { const int j = it / I_WIN, r = it % I_WIN, kb = r / 136, nb = r % 136;
            transpose_item(INP(8) + (size_t)j * 1024 * 4112, 1024, 4112, WSP(bf16_t, WS_WIN) + (size_t)j * NREC * 1024, nb * 32, scr, kb * 64, nb * 32, F.lane); }
        else if (it < N1) { const int q = it - N0, j = q / I_SQ, r = q % I_SQ, kb = r / 32, nb = r % 32;
            transpose_item(INP(10) + (size_t)j * 1024 * 1024, 1024, 1024, WSP(bf16_t, WS_WROUT) + (size_t)j * 1024 * 1024, nb * 32, scr, kb * 64, nb * 32, F.lane); }
        else if (it < N2) { const int q = it - N1, j = q / I_QKV, r = q % I_QKV, kb = r / 96, nb = r % 96;
            transpose_item(INP(14) + (size_t)j * 1024 * 3072, 1024, 3072, WSP(bf16_t, WS_WQKV) + (size_t)j * 3072 * 1024, nb * 32, scr, kb * 64, nb * 32, F.lane); }
        else if (it < N3) { const int q = it - N2, j = q / I_SQ, r = q % I_SQ, kb = r / 32, nb = r % 32;
            transpose_item(INP(15) + (size_t)j * 1024 * 1024, 1024, 1024, WSP(bf16_t, WS_WNOUT) + (size_t)j * 1024 * 1024, nb * 32, scr, kb * 64, nb * 32, F.lane); }
        else if (it < N4) { const int q = it - N3, j = q / I_GU, r = q % I_GU, kb = r / 64, nb = r % 64; const int n0 = nb * 32;
            const int nn = n0 & 1023; const int drow = 256 * (nn >> 7) + (n0 >= 1024 ? 128 : 0) + (nn & 127);
            transpose_item(INP(21) + (size_t)j * 1024 * 2048, 1024, 2048, WSP(bf16_t, WS_WGU) + (size_t)j * 2048 * 1024, drow, scr, kb * 64, n0, F.lane); }
        else { const int q = it - N4, j = q / I_SQ, r = q % I_SQ, kb = r / 32, nb = r % 32;
            transpose_item(INP(23) + (size_t)j * 1024 * 1024, 1024, 1024, WSP(bf16_t, WS_WD) + (size_t)j * 1024 * 1024, nb * 32, scr, kb * 64, nb * 32, F.lane); }
    }
    __syncthreads();
}

__device__ __forceinline__ void expert_prefix(const Frame& F, int l, LAS int* base_out, LAS int* cnt_out, int scale, bool total) {
    if (F.tid < 64) {
        const int e = F.tid & 31;
        const int c = (int)F.ctl[CW_CNT + (l * 32 + e) * 64];
        const int t = (F.tid < 32) ? ((c + 255) >> 8) : 0;
        int incl = t;
#pragma unroll
        for (int o = 1; o < 32; o <<= 1) { const int y = __builtin_amdgcn_ds_bpermute(((F.tid - o) & 63) << 2, incl); if (F.tid >= o) incl += y; }
        if (F.tid < 32) { base_out[e] = (incl - t) * scale; if (cnt_out) cnt_out[e] = c; }
        if (total && F.tid == 31) base_out[32] = incl * scale;
    }
}
template <int MODE>
__device__ __forceinline__ void phase_norm1(Frame& F, int l) {
    LAS int* sbase = (LAS int*)(F.lds + MISC_OFF + 1024);
    if (MODE != 0) {
        expert_prefix(F, l - 1, sbase, (LAS int*)0, 256, false);
        __syncthreads();
    }
    const int gw = F.bid * 8 + F.wave, NGW = F.G * 8;
    bf16_t* X = WSP(bf16_t, WS_X); bf16_t* H = WSP(bf16_t, WS_H); const bf16_t* YS = WSP(bf16_t, WS_YS);
    const float* MOD = WSP(float, WS_MOD);
    const int* TE = WSP(int, WS_TOKE); const int* TP = WSP(int, WS_TOKP); const float* TW = WSP(float, WS_TOKW);
    const int nrows = (MODE == 2) ? RL : NR;
    for (int pr = gw; pr < nrows / 2; pr += NGW) {
        const int row0 = 2 * pr; const int bidx = row_bidx(row0);
        f32x4 v[2][4];
#pragma unroll
        for (int rr = 0; rr < 2; ++rr) { const int row = row0 + rr;
            if (MODE == 0) { const float* src = row < RL ? INP(0) + (size_t)row * 1024 : INP(2) + (size_t)(row - RL) * 1024;
#pragma unroll
                for (int j = 0; j < 4; ++j) v[rr][j] = __builtin_nontemporal_load((const f32x4*)(src + 4 * F.lane + 256 * j)); }
            else { const bf16_t* src = X + (size_t)row * 1024;
#pragma unroll
                for (int j = 0; j < 4; ++j) v[rr][j] = h4_to_f4(__builtin_nontemporal_load((const u32x2*)(src + 4 * F.lane + 256 * j))); } }
        if (MODE != 0) {
            u32x2 ys[2][4][4]; float wk[2][4];
#pragma unroll
            for (int rr = 0; rr < 2; ++rr)
#pragma unroll
                for (int k = 0; k < 4; ++k) { const int row = row0 + rr; const int e = TE[row * 4 + k], p = TP[row * 4 + k]; wk[rr][k] = TW[row * 4 + k];
                    const bf16_t* yr = YS + (size_t)(sbase[e] + p) * 1024 + 4 * F.lane;
#pragma unroll
                    for (int j = 0; j < 4; ++j) ys[rr][k][j] = __builtin_nontemporal_load((const u32x2*)(yr + 256 * j)); }
            const float* g2 = MOD + ((l - 1) * 5 + bidx) * 6144 + 5120 + 4 * F.lane;
#pragma unroll
            for (int j = 0; j < 4; ++j) { const f32x4 gg = *(const f32x4*)(g2 + 256 * j);
#pragma unroll
                for (int rr = 0; rr < 2; ++rr) { f32x4 f = (f32x4){0.f, 0.f, 0.f, 0.f};
#pragma unroll
                    for (int k = 0; k < 4; ++k) { const u32x2 q = ys[rr][k][j]; f += wk[rr][k] * (f32x4){bf2f(q.x & 0xffffu), bf2f(q.x >> 16), bf2f(q.y & 0xffffu), bf2f(q.y >> 16)}; }
                    v[rr][j] += gg * f; } }
        }
        if (MODE == 2) {
#pragma unroll
            for (int rr = 0; rr < 2; ++rr)
#pragma unroll
                for (int j = 0; j < 4; ++j) __builtin_nontemporal_store(v[rr][j], (f32x4*)(F.out + (size_t)(row0 + rr) * 1024 + 4 * F.lane + 256 * j));
            continue;
        }
        if (F.lane < 32) WSP(float, WS_SSK)[row0 * 16 + F.lane] = 0.f;
        float rstd[2];
#pragma unroll
        for (int rr = 0; rr < 2; ++rr) { float ss = 0.f;
#pragma unroll
            for (int j = 0; j < 4; ++j) { __builtin_nontemporal_store(f4_to_h4(v[rr][j]), (u32x2*)(X + (size_t)(row0 + rr) * 1024 + 4 * F.lane + 256 * j));
                ss += (v[rr][j][0] * v[rr][j][0] + v[rr][j][1] * v[rr][j][1]) + (v[rr][j][2] * v[rr][j][2] + v[rr][j][3] * v[rr][j][3]); }
            rstd[rr] = rsqrtf(wave_sum(ss, F.lane) * (1.0f / 1024.0f) + EPS); }
        const float* gm = INP(6) + l * 1024; const float* sh = MOD + (l * 5 + bidx) * 6144; const float* sc = sh + 1024;
#pragma unroll
        for (int j = 0; j < 4; ++j) { const int c = 4 * F.lane + 256 * j;
            const f32x4 g = *(const f32x4*)(gm + c), s1 = *(const f32x4*)(sc + c), s0 = *(const f32x4*)(sh + c); const f32x4 gs = g * (1.0f + s1);
#pragma unroll
            for (int rr = 0; rr < 2; ++rr) { const f32x4 h = v[rr][j] * rstd[rr] * gs + s0;
                u32x2 w; w.x = pk2(h[0], h[1]); w.y = pk2(h[2], h[3]);
                *(u32x2*)(H + (size_t)(row0 + rr) * 1024 + c) = w; } }
    }
}

__device__ __forceinline__ void router_finish(Frame& F, float (&lg)[32], int row, int r0, const float* br, LAS int* hist, LAS int* sel, float* TW) {
#pragma unroll
    for (int s5 = 0; s5 < 5; ++s5) { const int half = 16 >> s5; const bool up = (F.lane >> (5 - s5)) & 1;
#pragma unroll
        for (int i = 0; i < half; ++i) { const float a2 = lg[i], b2 = lg[i + half]; const float send = up ? a2 : b2, keep = up ? b2 : a2; lg[i] = keep + shx(send, 32 >> s5, F.lane); } }
    float logit = lg[0] + shx(lg[0], 1, F.lane);
    const int myE = F.lane >> 1;
    logit += br[myE];
    int rank = 0;
#pragma unroll
    for (int e = 0; e < 32; ++e) { const float le = __int_as_float(__builtin_amdgcn_readlane(__float_as_int(logit), 2 * e)); rank += (le > logit || (le == logit && e < myE)) ? 1 : 0; }
    float tv[4]; int ti[4];
#pragma unroll
    for (int k = 0; k < 4; ++k) { const unsigned long long bm = __ballot(rank == k); const int src = __builtin_amdgcn_readfirstlane((int)__builtin_ctzll(bm));
        tv[k] = __int_as_float(__builtin_amdgcn_readlane(__float_as_int(logit), src)); ti[k] = src >> 1; }
    const float e1 = __expf(tv[1] - tv[0]), e2 = __expf(tv[2] - tv[0]), e3 = __expf(tv[3] - tv[0]); const float inv = 1.0f / (1.0f + e1 + e2 + e3);
    if (F.lane < 4) { const int k = F.lane; const int e = k == 0 ? ti[0] : k == 1 ? ti[1] : k == 2 ? ti[2] : ti[3]; const float w = (k == 0 ? 1.0f : k == 1 ? e1 : k == 2 ? e2 : e3) * inv;
        const int lpos = atomicAdd((int*)&hist[e], 1);
        sel[(row - r0) * 4 + k] = e | (lpos << 8);
        TW[row * 4 + k] = w; }
}
__device__ __forceinline__ void phase_router(Frame& F, int l) {
    LAS float* wr = (LAS float*)F.lds;
    LAS int* hist = (LAS int*)(F.lds + MISC_OFF + 1024);
    LAS int* gbase = hist + 32;
    LAS int* sel = gbase + 32;
    const float* wsrc = INP(19) + (size_t)l * 1024 * 32;
    for (int i = F.tid; i < 1024 * 8; i += 512) { const int k = i >> 3, ch = i & 7; const f32x4 w = *(const f32x4*)(wsrc + k * 32 + ch * 4);
        const int p = (k >> 2) + 256 * (k & 3); *(LAS f32x4*)(wr + p * 32 + 4 * ((ch + (p >> 1)) & 7)) = w; }
    if (F.tid < 32) hist[F.tid] = 0;
    __syncthreads();
    const int NRr = (l == 3) ? RL : NR;
    const int RPB = (((NRr + F.G - 1) / F.G) + 1) & ~1;
    const int r0 = min(F.bid * RPB, NRr), r1 = min(r0 + RPB, NRr);
    bf16_t* X = WSP(bf16_t, WS_X); bf16_t* H = WSP(bf16_t, WS_H); const float* MOD = WSP(float, WS_MOD);
    int* TE = WSP(int, WS_TOKE); int* TP = WSP(int, WS_TOKP); float* TW = WSP(float, WS_TOKW); int* LIST = WSP(int, WS_LIST);
    const float* br = INP(20) + l * 32;
    const int rotl = F.lane >> 1;
    const LAS float* wbase = wr + F.lane * 32; int roff[8];
#pragma unroll
    for (int ch = 0; ch < 8; ++ch) roff[ch] = 4 * ((ch + rotl) & 7);
    for (int rowA = r0 + 2 * F.wave; rowA < r1; rowA += 16) {
        const bool hasB = rowA + 1 < r1; const int rowB = hasB ? rowA + 1 : rowA;
        const int bidx = row_bidx(rowA);
        bf16_t* xa = X + (size_t)rowA * 1024 + 4 * F.lane; bf16_t* xb = X + (size_t)rowB * 1024 + 4 * F.lane;
        const bf16_t* ya = WSP(bf16_t, WS_Y) + (size_t)rowA * 1024 + 4 * F.lane; const bf16_t* yb = WSP(bf16_t, WS_Y) + (size_t)rowB * 1024 + 4 * F.lane;
        float ssa = 0.f, ssb = 0.f;
#pragma unroll
        for (int j = 0; j < 4; ++j) { f32x4 va = h4_to_f4(*(const u32x2*)(xa + 256 * j)), vb = h4_to_f4(*(const u32x2*)(xb + 256 * j));
            { const u32x2 q = __builtin_nontemporal_load((const u32x2*)(ya + 256 * j)); va += (f32x4){bf2f(q.x & 0xffffu), bf2f(q.x >> 16), bf2f(q.y & 0xffffu), bf2f(q.y >> 16)}; *(u32x2*)(xa + 256 * j) = f4_to_h4(va); }
            if (hasB) { const u32x2 q = __builtin_nontemporal_load((const u32x2*)(yb + 256 * j)); vb += (f32x4){bf2f(q.x & 0xffffu), bf2f(q.x >> 16), bf2f(q.y & 0xffffu), bf2f(q.y >> 16)}; *(u32x2*)(xb + 256 * j) = f4_to_h4(vb); }
            ssa += (va[0] * va[0] + va[1] * va[1]) + (va[2] * va[2] + va[3] * va[3]); ssb += (vb[0] * vb[0] + vb[1] * vb[1]) + (vb[2] * vb[2] + vb[3] * vb[3]); }
        const float rsa = rsqrtf(wave_sum(ssa, F.lane) * (1.0f / 1024.0f) + EPS), rsb = rsqrtf(wave_sum(ssb, F.lane) * (1.0f / 1024.0f) + EPS);
        const float* gm = INP(7) + l * 1024 + 4 * F.lane; const float* sh = MOD + (l * 5 + bidx) * 6144 + 3072 + 4 * F.lane; const float* sc = sh + 1024;
        float lga[32], lgb[32];
#pragma unroll
        for (int e = 0; e < 32; ++e) { lga[e] = 0.f; lgb[e] = 0.f; }
#pragma unroll 1
        for (int j = 0; j < 4; ++j) { const int c = 256 * j;
            const f32x4 va = h4_to_f4(*(const u32x2*)(xa + c)), vb = h4_to_f4(*(const u32x2*)(xb + c));
            const f32x4 g = *(const f32x4*)(gm + c), s1 = *(const f32x4*)(sc + c), s0 = *(const f32x4*)(sh + c); const f32x4 gs = g * (1.0f + s1);
            const f32x4 ha = va * rsa * gs + s0, hb = vb * rsb * gs + s0;
            { u32x2 w; w.x = pk2(ha[0], ha[1]); w.y = pk2(ha[2], ha[3]); *(u32x2*)(H + (size_t)rowA * 1024 + 4 * F.lane + c) = w; }
            if (hasB) { u32x2 w; w.x = pk2(hb[0], hb[1]); w.y = pk2(hb[2], hb[3]); *(u32x2*)(H + (size_t)rowB * 1024 + 4 * F.lane + c) = w; }
            const LAS float* wj = wbase + (64 * j) * 32;
#pragma unroll
            for (int cc = 0; cc < 4; ++cc) {
                const LAS float* wp = wj + (256 * cc) * 32; const float hva = ha[cc], hvb = hb[cc];
#pragma unroll
                for (int ch = 0; ch < 8; ++ch) { const f32x4 w4 = *(const LAS f32x4*)(wp + roff[ch]);
                    lga[4 * ch + 0] += hva * w4[0]; lga[4 * ch + 1] += hva * w4[1]; lga[4 * ch + 2] += hva * w4[2]; lga[4 * ch + 3] += hva * w4[3];
                    lgb[4 * ch + 0] += hvb * w4[0]; lgb[4 * ch + 1] += hvb * w4[1]; lgb[4 * ch + 2] += hvb * w4[2]; lgb[4 * ch + 3] += hvb * w4[3]; }
            }
        }
        router_finish(F, lga, rowA, r0, br, hist, sel, TW);
        if (hasB) router_finish(F, lgb, rowB, r0, br, hist, sel, TW);
    }
    __syncthreads();
    if (F.tid < 32) gbase[F.tid] = (int)atomicAdd(F.ctl + CW_CNT + (l * 32 + F.tid) * 64, (unsigned)hist[F.tid]);
    __syncthreads();
    for (int i = F.tid; i < (r1 - r0) * 4; i += 512) { const int s = sel[i], e = s & 255, pos = gbase[e] + (s >> 8); const int row = r0 + (i >> 2);
        TE[row * 4 + (i & 3)] = e; TP[row * 4 + (i & 3)] = pos; LIST[(size_t)e * CAP + pos] = row; }
    __syncthreads();
}

__device__ __forceinline__ bf16x8 lds_frag(const LAS unsigned char* p) { return *(const LAS bf16x8*)p; }
#define ATT_SHIFT 8.0f
__device__ __forceinline__ void phase_attn(Frame& F, int jl  , bool last) {
    LAS unsigned char* QS = F.lds;
    LAS float* RPB = (LAS float*)(F.lds + 16384);
    LAS float* RK = (LAS float*)(F.lds + 19456);
    LAS unsigned char* KT = F.lds + 24576;
    LAS unsigned char* VT = F.lds + 24576 + 40960;
    const bf16_t* QKV = WSP(bf16_t, WS_QKV); bf16_t* OUT = WSP(bf16_t, WS_MERGED); const bf16_t* VTG = WSP(bf16_t, WS_VTG); const float* SSK = WSP(float, WS_SSK);
    const float* qg = INP(16) + jl * 64; const float* kg = INP(17) + jl * 64; const float* rpb = INP(18) + (size_t)jl * 16 * 465;
    const int w = F.wave, qt = w & 3, qr = w >> 2;
    const bool xmap = (F.G == 256);
    for (int i_ = 0; ; ++i_) {
        int u, bh;
        if (xmap) { const int li = (F.bid >> 3) + 32 * i_; if (li >= 528) break;
            if (li < 512) { bh = (F.bid & 7) * 8 + (li >> 6); u = li & 63; } else { bh = (F.bid & 7) * 8 + ((li - 512) >> 1); u = 64 + ((li - 512) & 1); } }
        else { const int it = F.bid + i_ * F.G; if (it >= NB * 16 * 66) break; u = it % 66; bh = it / 66; }
        int tid_ = F.tid; asm volatile("" : "+v"(tid_));
        const int lane_ = tid_ & 63, ln = lane_ & 15, g = lane_ >> 4;
        const int lkey = tid_ >> 3, lc = tid_ & 7;
        const int h = bh & 15, b = bh >> 4;
        const bool lat = u < 64;
        if (last && !lat) continue;
        const int r0 = 2 * u, rs0 = min(max(r0 - 4, 0), 120), rs1 = min(max(r0 - 3, 0), 120);
        const int urow = r0 + qr, off = qr ? rs1 - rs0 : 0;
        const int rd_first = lat ? 0 : 2;
        u32x4 pkr[5], pvr[5]; float pss[5];
#define ATT_ISSUE(rd_) do { int lk_ = lkey, lc_ = lc; asm volatile("" : "+v"(lk_), "+v"(lc_));   \
            _Pragma("unroll") for (int s5 = 0; s5 < 5; ++s5) { if (s5 == 4 && (rd_) != 0) break; \
            const int gr_ = min(rs0 + (rd_) * 5 + s5, 127); \
            const int krow0 = (rd_) == 2 ? (RL + b * TC + s5 * 64) : (b * TL + gr_ * 64); const int tt0 = (rd_) == 2 ? (TL + s5 * 64) : gr_ * 64; \
            pkr[s5] = *(const u32x4*)((const unsigned char*)QKV + (size_t)krow0 * 6144 + 2048 + h * 128 + (unsigned)(lk_ * 6144 + lc_ * 16)); \
            pvr[s5] = *(const u32x4*)((const unsigned char*)VTG + ((size_t)((b * 16 + h) * 64) * TT + tt0) * 2 + (unsigned)(lk_ * (TT * 2) + lc_ * 16)); \
            pss[s5] = *(const float*)((const unsigned char*)SSK + (size_t)(krow0 * 16 + h) * 4 + (unsigned)(lk_ * 64)); } } while (0)
        if (lat) ATT_ISSUE(0); else ATT_ISSUE(2);
#pragma unroll
        for (int p = 0; p < 2; ++p) {
            const int ql = p * 64 + lkey;
            const int qrow = lat ? (b * TL + (r0 + p) * 64 + lkey) : (RL + b * TC + (u - 64) * 128 + ql);
            const u32x4 raw = *(const u32x4*)(QKV + (size_t)qrow * 3072 + h * 64 + lc * 8);
            float x[8] = {bf2f(raw.x & 0xffffu), bf2f(raw.x >> 16), bf2f(raw.y & 0xffffu), bf2f(raw.y >> 16), bf2f(raw.z & 0xffffu), bf2f(raw.z >> 16), bf2f(raw.w & 0xffffu), bf2f(raw.w >> 16)};
            float ss = 0.f;
#pragma unroll
            for (int i = 0; i < 8; ++i) ss += x[i] * x[i];
            ss += shx(ss, 1, lane_); ss += shx(ss, 2, lane_); ss += shx(ss, 4, lane_);
            const float r = rsqrtf(ss * (1.0f / 64.0f) + EPS) * (0.125f * 1.4426950408889634f);
            const f32x4 g0 = *(const f32x4*)(qg + lc * 8) * *(const f32x4*)(kg + lc * 8), g1 = *(const f32x4*)(qg + lc * 8 + 4) * *(const f32x4*)(kg + lc * 8 + 4);
            u32x4 o; o.x = pk2(x[0] * r * g0[0], x[1] * r * g0[1]); o.y = pk2(x[2] * r * g0[2], x[3] * r * g0[3]); o.z = pk2(x[4] * r * g1[0], x[5] * r * g1[1]); o.w = pk2(x[6] * r * g1[2], x[7] * r * g1[3]);
            *(LAS u32x4*)(QS + ql * 128 + lc * 16) = o;
        }
        for (int i = tid_; i < 15 * 48; i += 512) { const int rr = i / 48, cc = i % 48 - 8; RPB[i] = (cc >= 0 && cc < 31) ? rpb[h * 465 + rr * 31 + cc] * 1.4426950408889634f - ATT_SHIFT : 0.f; }
        f32x4 O[4]; float l_run = 0.f;
#pragma unroll
        for (int e = 0; e < 4; ++e) O[e] = (f32x4){0.f, 0.f, 0.f, 0.f};
        bf16x8 qf[2];
#pragma unroll 1
        for (int rd = rd_first; rd < 3; ++rd) {
            const int nslot = rd == 0 ? 5 : 4;
#pragma unroll
            for (int s5 = 0; s5 < 5; ++s5) {
                if (s5 < nslot) {
                *(LAS u32x4*)(KT + s5 * 8192 + lkey * 128 + ((lc ^ (lkey & 7)) * 16)) = pkr[s5];
                *(LAS u32x4*)(VT + s5 * 8192 + lkey * 128 + ((lc ^ ((lkey ^ (lkey >> 3)) & 7)) * 16)) = pvr[s5];
                if (lc == 0) RK[s5 * 64 + lkey] = rsqrtf(pss[s5] * (1.0f / 64.0f) + EPS);
                }
            }
            __syncthreads();
            if (rd == 0) ATT_ISSUE(1); else if (rd == 1) ATT_ISSUE(2);
            if (rd == rd_first) {
#pragma unroll
                for (int ks = 0; ks < 2; ++ks) qf[ks] = lds_frag(QS + (w * 16 + ln) * 128 + (ks * 4 + g) * 16);
            }
            {
                int t2_ = tid_; asm volatile("" : "+v"(t2_));
                const int ln = t2_ & 15, g = (t2_ & 63) >> 4;
                if (rd < 2) {
                    const int thr = qt == 0 ? max(ln, 8) : qt == 3 ? min(ln, 8) : ln;
                    const int c0 = max(2 * qt - 1 + (g >> 1), 0), c1 = min(2 * qt + 1 + (g >> 1), 7);
                    const int key0 = min(max(16 * qt - 8 + ln, 0), 63), key1 = min(16 * qt + 8 + ln, 63);
                    const int rkb0 = min(max(16 * qt - 8 + 4 * g, 0), 60), rkb1 = min(16 * qt + 8 + 4 * g, 60);
                    bf16x8 ka[2][4]; float rbv[2][8]; f32x4 rkl[2][2];
#define ATT_LOADL(st, s5_) do { const LAS unsigned char* kt_ = KT + (s5_) * 8192; \
                        ka[st][0] = lds_frag(kt_ + key0 * 128 + (((0 + g) ^ (key0 & 7)) * 16)); ka[st][1] = lds_frag(kt_ + key0 * 128 + (((4 + g) ^ (key0 & 7)) * 16)); \
                        ka[st][2] = lds_frag(kt_ + key1 * 128 + (((0 + g) ^ (key1 & 7)) * 16)); ka[st][3] = lds_frag(kt_ + key1 * 128 + (((4 + g) ^ (key1 & 7)) * 16)); \
                        const int rrow_ = min(max(rs0 + rd * 5 + (s5_) - urow + 7, 0), 14); const LAS float* rb_ = RPB + rrow_ * 48 + 15 - ln + 4 * g; \
                        _Pragma("unroll") for (int j = 0; j < 4; ++j) { rbv[st][j] = rb_[j]; rbv[st][4 + j] = rb_[16 + j]; } \
                        rkl[st][0] = *(const LAS f32x4*)(RK + (s5_) * 64 + rkb0); rkl[st][1] = *(const LAS f32x4*)(RK + (s5_) * 64 + rkb1); \
                        } while (0)
#define ATT_LOADLV(s5_) do { const LAS unsigned char* vt_ = VT + (s5_) * 8192; \
                        _Pragma("unroll") for (int et = 0; et < 4; ++et) { const int e = et * 16 + ln; const int sw = (e ^ (e >> 3)) & 7; \
                            vfa[et] = *(const LAS u32x2*)(vt_ + e * 128 + ((c0 ^ sw) * 16) + (g & 1) * 8); vfb[et] = *(const LAS u32x2*)(vt_ + e * 128 + ((c1 ^ sw) * 16) + (g & 1) * 8); } } while (0)
                    ATT_LOADL(0, 0);
#pragma unroll
                    for (int s5 = 0; s5 < 5; ++s5) {
                        if (s5 == 4 && rd != 0) break;
                        const int st = s5 & 1;
                        u32x2 vfa[4], vfb[4];
                        ATT_LOADLV(s5);
                        if (s5 + 1 < 5 && !(s5 + 1 == 4 && rd != 0)) ATT_LOADL(st ^ 1, s5 + 1);
                        __builtin_amdgcn_sched_barrier(0);
                        const int t = rd * 5 + s5;
                        const bool mine = (t >= off) && (t <= off + 7);
                        f32x4 sc0 = (f32x4){0.f, 0.f, 0.f, 0.f}, sc1 = (f32x4){0.f, 0.f, 0.f, 0.f};
                        sc0 = __builtin_amdgcn_mfma_f32_16x16x32_bf16(ka[st][0], qf[0], sc0, 0, 0, 0);
                        sc1 = __builtin_amdgcn_mfma_f32_16x16x32_bf16(ka[st][2], qf[0], sc1, 0, 0, 0);
                        sc0 = __builtin_amdgcn_mfma_f32_16x16x32_bf16(ka[st][1], qf[1], sc0, 0, 0, 0);
                        sc1 = __builtin_amdgcn_mfma_f32_16x16x32_bf16(ka[st][3], qf[1], sc1, 0, 0, 0);
#pragma unroll
                        for (int j = 0; j < 4; ++j) { const int kk = 4 * g + j;
                            const float p0 = (mine && kk >= thr) ? __builtin_amdgcn_exp2f(sc0[j] * rkl[st][0][j] + rbv[st][j]) : 0.f;
                            const float p1 = (mine && kk < thr) ? __builtin_amdgcn_exp2f(sc1[j] * rkl[st][1][j] + rbv[st][4 + j]) : 0.f;
                            sc0[j] = p0; sc1[j] = p1; l_run += p0 + p1; }
                        u32x4 pw; pw.x = pk2(sc0[0], sc0[1]); pw.y = pk2(sc0[2], sc0[3]); pw.z = pk2(sc1[0], sc1[1]); pw.w = pk2(sc1[2], sc1[3]);
                        const bf16x8 pf = __builtin_bit_cast(bf16x8, pw);
#pragma unroll
                        for (int et = 0; et < 4; ++et) { u32x4 vw; vw.x = vfa[et].x; vw.y = vfa[et].y; vw.z = vfb[et].x; vw.w = vfb[et].y;
                            O[et] = __builtin_amdgcn_mfma_f32_16x16x32_bf16(__builtin_bit_cast(bf16x8, vw), pf, O[et], 0, 0, 0); }
                    }
#undef ATT_LOADL
#undef ATT_LOADLV
                } else {
                    bf16x8 kc[2][4][2]; f32x4 rkv[2][4];
#define ATT_LOADCK(st, s5_) do { const LAS unsigned char* kt_ = KT + (s5_) * 8192; \
                        _Pragma("unroll") for (int kt = 0; kt < 4; ++kt) { const int key = kt * 16 + ln; \
                            kc[st][kt][0] = lds_frag(kt_ + key * 128 + (((0 + g) ^ (key & 7)) * 16)); kc[st][kt][1] = lds_frag(kt_ + key * 128 + (((4 + g) ^ (key & 7)) * 16)); \
                            rkv[st][kt] = *(const LAS f32x4*)(RK + (s5_) * 64 + 16 * kt + 4 * g); } } while (0)
                    ATT_LOADCK(0, 0);
#pragma unroll
                    for (int s5 = 0; s5 < 4; ++s5) {
                        const int st = s5 & 1;
                        const LAS unsigned char* vt_ = VT + s5 * 8192;
                        u32x2 vfa[2][4], vfb[2][4];
#pragma unroll
                        for (int ks2 = 0; ks2 < 2; ++ks2)
#pragma unroll
                            for (int et = 0; et < 4; ++et) { const int e = et * 16 + ln; const int sw = (e ^ (e >> 3)) & 7;
                                vfa[ks2][et] = *(const LAS u32x2*)(vt_ + e * 128 + (((4 * ks2 + (g >> 1)) ^ sw) * 16) + (g & 1) * 8);
                                vfb[ks2][et] = *(const LAS u32x2*)(vt_ + e * 128 + (((4 * ks2 + 2 + (g >> 1)) ^ sw) * 16) + (g & 1) * 8); }
                        if (s5 + 1 < 4) ATT_LOADCK(st ^ 1, s5 + 1);
                        __builtin_amdgcn_sched_barrier(0);
                        f32x4 sc[4];
#pragma unroll
                        for (int kt = 0; kt < 4; ++kt) sc[kt] = __builtin_amdgcn_mfma_f32_16x16x32_bf16(kc[st][kt][0], qf[0], (f32x4){0.f, 0.f, 0.f, 0.f}, 0, 0, 0);
#pragma unroll
                        for (int kt = 0; kt < 4; ++kt) sc[kt] = __builtin_amdgcn_mfma_f32_16x16x32_bf16(kc[st][kt][1], qf[1], sc[kt], 0, 0, 0);
#pragma unroll
                        for (int kt = 0; kt < 4; ++kt)
#pragma unroll
                            for (int j = 0; j < 4; ++j) { const float p = __builtin_amdgcn_exp2f(sc[kt][j] * rkv[st][kt][j] - ATT_SHIFT); sc[kt][j] = p; l_run += p; }
#pragma unroll
                        for (int ks2 = 0; ks2 < 2; ++ks2) {
                            u32x4 pw; pw.x = pk2(sc[2 * ks2][0], sc[2 * ks2][1]); pw.y = pk2(sc[2 * ks2][2], sc[2 * ks2][3]); pw.z = pk2(sc[2 * ks2 + 1][0], sc[2 * ks2 + 1][1]); pw.w = pk2(sc[2 * ks2 + 1][2], sc[2 * ks2 + 1][3]);
                            const bf16x8 pf = __builtin_bit_cast(bf16x8, pw);
#pragma unroll
                            for (int et = 0; et < 4; ++et) { u32x4 vw; vw.x = vfa[ks2][et].x; vw.y = vfa[ks2][et].y; vw.z = vfb[ks2][et].x; vw.w = vfb[ks2][et].y;
                                O[et] = __builtin_amdgcn_mfma_f32_16x16x32_bf16(__builtin_bit_cast(bf16x8, vw), pf, O[et], 0, 0, 0); }
                        }
                    }
#undef ATT_LOADCK
                }
            }
            __syncthreads();
        }
        l_run += shx(l_run, 16, lane_); l_run += shx(l_run, 32, lane_);
        {
            const float inv = 1.0f / l_run;
            const int qrow = lat ? (b * TL + urow * 64 + qt * 16 + ln) : (RL + b * TC + (u - 64) * 128 + w * 16 + ln);
#pragma unroll
            for (int e = 0; e < 4; ++e) { u32x2 wv; wv.x = pk2(O[e][0] * inv, O[e][1] * inv); wv.y = pk2(O[e][2] * inv, O[e][3] * inv);
                *(u32x2*)(OUT + (size_t)qrow * 1024 + h * 64 + e * 16 + 4 * g) = wv; }
        }
    }
#undef ATT_ISSUE
}

constexpr size_t WS_GH = WS_ACT, WS_GM = WS_ACT + 72 * MiB, WS_SH = WS_ACT + 128 * MiB, WS_SM = WS_SH + 72 * MiB;
constexpr size_t WS_DECH = WS_YS, WS_DECM = WS_YS + 1 * MiB;
constexpr size_t WS_OTH = WS_OHF, WS_OTM = WS_OMF;
static_assert(WS_GM + (size_t)1056 * 10240 * 4 <= WS_SH && WS_SM + (size_t)1056 * 10240 * 4 <= WS_YS, "scan dumps");
template <int KIND> struct ScanCfg {
    static constexpr int DK = KIND ? 64 : 128, RBQ = DK * 2, CMQ = DK / 8 - 1, KST = DK / 32, NEXT = KIND ? 144 : 128, OBS = KIND ? 148 : 132;
    static constexpr int OFF_OB = 0;
    static constexpr int OFF_QP = KIND ? 36864 : 0, OFF_KP = OFF_QP + 64 * RBQ, OFF_KPT = OFF_KP + 64 * RBQ, OFF_VT = OFF_KPT + DK * 128, OFF_PP = OFF_VT + 20480, OFF_SST = OFF_PP + 8192;
    static constexpr int OFF_SM = 114688;
    static constexpr int GSTRIDE = KIND ? 10240 : 16384;
};
__device__ __forceinline__ int sc_row(int b, int sct, int t) { return sct == 0 ? (RL + b * TC + t) : (b * TL + (sct - 1) * 256 + t); }
__device__ __forceinline__ float exp_c(float x) { return __expf(fminf(fmaxf(x, -80.f), 80.f)); }
template <int KIND> __device__ __forceinline__ int st_n0(int w) { return KIND ? (w >> 2) * 4 : 0; }
template <int KIND> __device__ __forceinline__ int st_nc(int w) { return KIND ? ((w >> 2) ? 5 : 4) : 8; }
template <int KIND> __device__ __forceinline__ int st_mt(int w) { return KIND ? (w & 3) : w; }
template <int KIND> __device__ __forceinline__ int ot_n0(int w) { return (w >> 2) * 4; }
template <int KIND> __device__ __forceinline__ int ot_nc(int w) { return KIND ? ((w >> 2) ? 5 : 4) : 4; }

template <int KIND, int PASS>
__device__ __forceinline__ void scan_super(Frame& F, int jl, int b, int h, int sct, int dir, f32x4 (&S)[8]) {
    typedef ScanCfg<KIND> C;
    LAS unsigned char* L = F.lds;
    LAS float* TOT = (LAS float*)(L + C::OFF_SM); LAS float* EM = TOT + 512; LAS float* E2 = EM + 128; LAS float* BT = E2 + 128; LAS float* RQ = BT + 128; LAS float* CK = RQ + 64; LAS float* SCAL = CK + 64;
    const int w = F.wave;
    const bf16_t* Qg = KIND ? WSP(bf16_t, WS_MQ) : WSP(bf16_t, WS_Q);
    const bf16_t* Kg = KIND ? WSP(bf16_t, WS_MK) : WSP(bf16_t, dir ? WS_KB : WS_KF);
    const bf16_t* Vg = KIND ? WSP(bf16_t, WS_MV) : WSP(bf16_t, WS_V);
    const int hq = h * C::DK;
    u32x4 rq[2], rk[2], rv[2]; float rl[16]; float rg0 = 0.f, rg1 = 0.f;
    const float* LAg = WSP(float, dir ? WS_LAB : WS_LAF); const float* GTg = WSP(float, WS_GATES);
#define SC_ISSUE(ci_, TID) do { const int cN = dir ? 3 - (ci_) : (ci_); const int tN = cN * 64; \
        if (KIND == 0) { const int d_ = (TID) & 127, part_ = (TID) >> 7; \
            _Pragma("unroll") for (int i = 0; i < 16; ++i) rl[i] = LAg[(size_t)sc_row(b, sct, tN + part_ * 16 + i) * 512 + hq + d_]; \
            _Pragma("unroll") for (int p = 0; p < 2; ++p) { const size_t ro = (size_t)sc_row(b, sct, tN + p * 32 + ((TID) >> 4)) * 512 + hq + 8 * ((TID) & 15); \
                if (PASS == 3) rq[p] = *(const u32x4*)(Qg + ro); rk[p] = *(const u32x4*)(Kg + ro); rv[p] = *(const u32x4*)(Vg + ro); } } \
        else { { const size_t ro = (size_t)sc_row(b, sct, tN + ((TID) >> 3)) * 256 + hq + 8 * ((TID) & 7); if (PASS == 3) rq[0] = *(const u32x4*)(Qg + ro); rk[0] = *(const u32x4*)(Kg + ro); } \
            _Pragma("unroll") for (int p = 0; p < 2; ++p) rv[p] = *(const u32x4*)(Vg + (size_t)sc_row(b, sct, tN + p * 32 + ((TID) >> 4)) * 512 + h * 128 + 8 * ((TID) & 15)); \
            if ((TID) < 64) { const size_t go = (size_t)sc_row(b, sct, tN + (TID)) * 16 + h; rg0 = GTg[go + (dir ? 12 : 4)]; rg1 = GTg[go + (dir ? 8 : 0)]; } } } while (0)
    SC_ISSUE(0, F.tid);
#pragma unroll 1
    for (int ci = 0; ci < 4; ++ci) {
        const int c = dir ? 3 - ci : ci; const int t0 = c * 64;
        int tid_ = F.tid; asm volatile("" : "+v"(tid_));
        const int lane_ = tid_ & 63, ln = lane_ & 15, g = lane_ >> 4;
        LAS unsigned char* VRAW = L + C::OFF_SST;
        if (KIND == 0) {
            const int d = tid_ & 127, part = tid_ >> 7;
            if (!dir) {
#pragma unroll
                for (int i = 1; i < 16; ++i) rl[i] += rl[i - 1];
                TOT[part * 128 + d] = rl[15];
            } else {
#pragma unroll
                for (int i = 14; i >= 0; --i) rl[i] += rl[i + 1];
                TOT[part * 128 + d] = rl[0];
            }
#pragma unroll
            for (int p = 0; p < 2; ++p) { const int t = p * 32 + (tid_ >> 4), cc = tid_ & 15;
                if (PASS == 3) *(LAS u32x4*)(L + C::OFF_QP + t * 256 + ((cc ^ (t & 15)) * 16)) = rq[p];
                *(LAS u32x4*)(L + C::OFF_KP + t * 256 + ((cc ^ (t & 15)) * 16)) = rk[p];
                *(LAS u32x4*)(VRAW + t * 256 + cc * 16) = rv[p]; }
        } else {
            { const int t = tid_ >> 3, cc = tid_ & 7;
                if (PASS == 3) *(LAS u32x4*)(L + C::OFF_QP + t * 128 + ((cc ^ (t & 7)) * 16)) = rq[0];
                *(LAS u32x4*)(L + C::OFF_KP + t * 128 + ((cc ^ (t & 7)) * 16)) = rk[0]; }
#pragma unroll
            for (int p = 0; p < 2; ++p) { const int t = p * 32 + (tid_ >> 4), cc = tid_ & 15; *(LAS u32x4*)(VRAW + t * 256 + cc * 16) = rv[p]; }
            if (tid_ < 64) { const int t = tid_;
                float x = rg0; const float ig = rg1;
#pragma unroll
                for (int o = 1; o < 64; o <<= 1) { const int src = dir ? t + o : t - o; const float y = __int_as_float(__builtin_amdgcn_ds_bpermute((src & 63) << 2, __float_as_int(x))); if (src >= 0 && src < 64) x += y; }
                const float ref = __int_as_float(__builtin_amdgcn_readlane(__float_as_int(x), dir ? 32 : 31));
                const float btot = __int_as_float(__builtin_amdgcn_readlane(__float_as_int(x), dir ? 0 : 63));
                RQ[t] = exp_c(x - ref); CK[t] = exp_c(ref - x + ig);
                if (t == 0) { SCAL[0] = __expf(ref); SCAL[1] = __expf(btot - ref); if (PASS == 1) SCAL[2] = (ci == 0 ? 0.f : SCAL[2]) + btot; } }
            if (tid_ < 128) { const int row = 128 + (tid_ >> 3), ch = tid_ & 7; const unsigned one = (row == 128) ? 0x3f803f80u : 0u;
                *(LAS u32x4*)(L + C::OFF_VT + row * 128 + ((ch ^ (row & 7)) * 16)) = (u32x4){one, one, one, one}; }
        }
        __syncthreads();
        if (KIND == 0) {
            const int d = tid_ & 127, part = tid_ >> 7;
            const float t0v = TOT[d], t1v = TOT[128 + d], t2v = TOT[256 + d], t3v = TOT[384 + d];
            const float btot = (t0v + t1v) + (t2v + t3v);
            const float ref = dir ? (t2v + t3v) : (t0v + t1v);
            float off;
            if (!dir) off = part == 0 ? 0.f : part == 1 ? t0v : part == 2 ? (t0v + t1v) : (t0v + t1v + t2v);
            else off = part == 3 ? 0.f : part == 2 ? t3v : part == 1 ? (t3v + t2v) : (t3v + t2v + t1v);
            if (part == 0) { EM[d] = __expf(ref); E2[d] = __expf(btot - ref); if (PASS == 1) BT[d] = (ci == 0 ? 0.f : BT[d]) + btot; }
            unsigned kt[8];
#pragma unroll
            for (int i = 0; i < 16; ++i) { const int t = part * 16 + i; const int ad = t * 256 + (((d >> 3) ^ (t & 15)) * 16) + (d & 7) * 2;
                const float bb = rl[i] + off - ref;
                const float kv = bf2f(*(const LAS bf16_t*)(L + C::OFF_KP + ad)) * exp_c(-bb); const unsigned kb = pk2(kv, kv) & 0xffffu;
                if (PASS == 3) { const float qv = bf2f(*(const LAS bf16_t*)(L + C::OFF_QP + ad)) * exp_c(bb);
                    *(LAS bf16_t*)(L + C::OFF_QP + ad) = (bf16_t)(pk2(qv, qv) & 0xffffu);
                    *(LAS bf16_t*)(L + C::OFF_KP + ad) = (bf16_t)kb; }
                if (i & 1) kt[i >> 1] |= kb << 16; else kt[i >> 1] = kb; }
            *(LAS u32x4*)(L + C::OFF_KPT + d * 128 + (((part * 2) ^ (d & 7)) * 16)) = (u32x4){kt[0], kt[1], kt[2], kt[3]};
            *(LAS u32x4*)(L + C::OFF_KPT + d * 128 + (((part * 2 + 1) ^ (d & 7)) * 16)) = (u32x4){kt[4], kt[5], kt[6], kt[7]};
        } else {
            const int d = tid_ & 63, part = tid_ >> 6;
            unsigned kt[4];
#pragma unroll
            for (int i = 0; i < 8; ++i) { const int t = part * 8 + i; const int ad = t * 128 + (((d >> 3) ^ (t & 7)) * 16) + (d & 7) * 2;
                const float kv = bf2f(*(const LAS bf16_t*)(L + C::OFF_KP + ad)) * CK[t]; const unsigned kb = pk2(kv, kv) & 0xffffu;
                if (PASS == 3) { const float qv = bf2f(*(const LAS bf16_t*)(L + C::OFF_QP + ad)) * RQ[t];
                    *(LAS bf16_t*)(L + C::OFF_QP + ad) = (bf16_t)(pk2(qv, qv) & 0xffffu);
                    *(LAS bf16_t*)(L + C::OFF_KP + ad) = (bf16_t)kb; }
                if (i & 1) kt[i >> 1] |= kb << 16; else kt[i >> 1] = kb; }
            *(LAS u32x4*)(L + C::OFF_KPT + d * 128 + ((part ^ (d & 7)) * 16)) = (u32x4){kt[0], kt[1], kt[2], kt[3]};
        }
        {
            const int e = tid_ & 127, part = tid_ >> 7; unsigned vt[8];
#pragma unroll
            for (int i = 0; i < 16; ++i) { const unsigned vb = *(const LAS bf16_t*)(VRAW + (part * 16 + i) * 256 + e * 2); if (i & 1) vt[i >> 1] |= vb << 16; else vt[i >> 1] = vb; }
            *(LAS u32x4*)(L + C::OFF_VT + e * 128 + (((part * 2) ^ (e & 7)) * 16)) = (u32x4){vt[0], vt[1], vt[2], vt[3]};
            *(LAS u32x4*)(L + C::OFF_VT + e * 128 + (((part * 2 + 1) ^ (e & 7)) * 16)) = (u32x4){vt[4], vt[5], vt[6], vt[7]};
        }
        if (ci < 3) SC_ISSUE(ci + 1, tid_);
        __syncthreads();
        const int smt = st_mt<KIND>(w), sn0 = st_n0<KIND>(w), snc = st_nc<KIND>(w), onc = KIND ? snc : 4;
#define SC_ET(n) (KIND ? (sn0 + (n)) : (((((n) >> 2) ^ (w >> 2)) << 2) + ((n) & 3)))
        {
            f32x4 em;
            if (KIND == 0) em = *(const LAS f32x4*)(EM + smt * 16 + 4 * g); else { const float s0 = SCAL[0]; em = (f32x4){s0, s0, s0, s0}; }
#pragma unroll
            for (int n = 0; n < 8; ++n) if (n < snc) { S[n] *= em;
                if (PASS == 3) { const int e = SC_ET(n) * 16 + ln; u32x2 wv; wv.x = pk2(S[n][0], S[n][1]); wv.y = pk2(S[n][2], S[n][3]);
                    *(LAS u32x2*)(L + C::OFF_SST + e * C::RBQ + (((2 * smt + (g >> 1)) ^ (e & C::CMQ)) * 16) + (g & 1) * 8) = wv; } }
        }
        constexpr int NVT = KIND ? 5 : 8;
        bf16x8 vt[NVT][2], kf[2];
#pragma unroll
        for (int n = 0; n < NVT; ++n) if (n < snc) { const int e = SC_ET(n) * 16 + ln;
#pragma unroll
            for (int ks = 0; ks < 2; ++ks) vt[n][ks] = lds_frag(L + C::OFF_VT + e * 128 + (((ks * 4 + g) ^ (e & 7)) * 16)); }
        { const int d_row = smt * 16 + ln;
#pragma unroll
            for (int ks = 0; ks < 2; ++ks) kf[ks] = lds_frag(L + C::OFF_KPT + d_row * 128 + (((ks * 4 + g) ^ (d_row & 7)) * 16)); }
        f32x4 e2;
        if (KIND == 0) e2 = *(const LAS f32x4*)(E2 + smt * 16 + 4 * g); else { const float s1 = SCAL[1]; e2 = (f32x4){s1, s1, s1, s1}; }
        f32x4 oacc[5];
        if (PASS == 3) {
            {
                const int st = w & 3, s_row = st * 16 + ln;
                bf16x8 af[C::KST], qfr[2][C::KST];
#pragma unroll
                for (int ks = 0; ks < C::KST; ++ks) af[ks] = lds_frag(L + C::OFF_KP + s_row * C::RBQ + (((ks * 4 + g) ^ (s_row & C::CMQ)) * 16));
#pragma unroll
                for (int tq = 0; tq < 2; ++tq) { const int t_row = ((w >> 2) * 2 + tq) * 16 + ln;
#pragma unroll
                    for (int ks = 0; ks < C::KST; ++ks) qfr[tq][ks] = lds_frag(L + C::OFF_QP + t_row * C::RBQ + (((ks * 4 + g) ^ (t_row & C::CMQ)) * 16)); }
                __builtin_amdgcn_sched_barrier(0);
#pragma unroll
                for (int tq = 0; tq < 2; ++tq) { const int tt = (w >> 2) * 2 + tq, t_row = tt * 16 + ln;
                    f32x4 acc = (f32x4){0.f, 0.f, 0.f, 0.f};
#pragma unroll
                    for (int ks = 0; ks < C::KST; ++ks) acc = __builtin_amdgcn_mfma_f32_16x16x32_bf16(af[ks], qfr[tq][ks], acc, 0, 0, 0);
#pragma unroll
                    for (int j = 0; j < 4; ++j) { const int sidx = st * 16 + 4 * g + j; const bool keep = dir ? (sidx >= t_row) : (sidx <= t_row); acc[j] = keep ? acc[j] : 0.f; }
                    u32x2 wv; wv.x = pk2(acc[0], acc[1]); wv.y = pk2(acc[2], acc[3]);
                    *(LAS u32x2*)(L + C::OFF_PP + t_row * 128 + (((2 * st + (g >> 1)) ^ (t_row & 7)) * 16) + (g & 1) * 8) = wv; }
            }
        } else __builtin_amdgcn_sched_barrier(0);
#pragma unroll
        for (int n = 0; n < NVT; ++n) if (n < snc) {
#pragma unroll
            for (int ks = 0; ks < 2; ++ks) S[n] = __builtin_amdgcn_mfma_f32_16x16x32_bf16(kf[ks], vt[n][ks], S[n], 0, 0, 0);
            S[n] *= e2; }
        if (PASS == 3) {
            __syncthreads();
            {
                const int tt = w & 3, t_row = tt * 16 + ln;
                bf16x8 pf[2], qf2[C::KST], sst[5][C::KST];
#pragma unroll
                for (int ks = 0; ks < 2; ++ks) pf[ks] = lds_frag(L + C::OFF_PP + t_row * 128 + (((ks * 4 + g) ^ (t_row & 7)) * 16));
#pragma unroll
                for (int ks = 0; ks < C::KST; ++ks) qf2[ks] = lds_frag(L + C::OFF_QP + t_row * C::RBQ + (((ks * 4 + g) ^ (t_row & C::CMQ)) * 16));
#pragma unroll
                for (int n = 0; n < 5; ++n) if (n < onc) { const int e = SC_ET(n) * 16 + ln;
#pragma unroll
                    for (int ks = 0; ks < C::KST; ++ks) sst[n][ks] = lds_frag(L + C::OFF_SST + e * C::RBQ + (((ks * 4 + g) ^ (e & C::CMQ)) * 16)); }
                __builtin_amdgcn_sched_barrier(0);
#pragma unroll
                for (int n = 0; n < 5; ++n) if (n < onc) { f32x4 acc = (f32x4){0.f, 0.f, 0.f, 0.f};
#pragma unroll
                    for (int ks = 0; ks < 2; ++ks) acc = __builtin_amdgcn_mfma_f32_16x16x32_bf16(pf[ks], vt[n][ks], acc, 0, 0, 0);
#pragma unroll
                    for (int ks = 0; ks < C::KST; ++ks) acc = __builtin_amdgcn_mfma_f32_16x16x32_bf16(qf2[ks], sst[n][ks], acc, 0, 0, 0);
                    oacc[n] = acc; }
            }
        }
        __syncthreads();
        if (PASS == 3) {
            LAS float* OB = (LAS float*)(L + C::OFF_OB);
            {
                const int tt = w & 3, on0 = ot_n0<KIND>(w), onc = ot_nc<KIND>(w);
#pragma unroll
                for (int n = 0; n < 5; ++n) if (n < onc) { const int e = (on0 + n) * 16 + ln;
#pragma unroll
                    for (int j = 0; j < 4; ++j) OB[(tt * 16 + 4 * g + j) * C::OBS + e] = oacc[n][j]; }
            }
            __syncthreads();
            {
                const int t = tid_ >> 3, seg = tid_ & 7; const int row = sc_row(b, sct, t0 + t);
                const LAS float* ob = OB + t * C::OBS + seg * 16;
                f32x4 v[4];
#pragma unroll
                for (int q = 0; q < 4; ++q) v[q] = *(const LAS f32x4*)(ob + 4 * q);
                if (KIND == 1) { const float den = OB[t * C::OBS + 128]; const float inv = 1.0f / fmaxf(fabsf(den), 1.0f);
#pragma unroll
                    for (int q = 0; q < 4; ++q) v[q] *= inv; }
                float* ot = WSP(float, KIND ? WS_OTM : WS_OTH) + (size_t)row * 512 + h * 128 + seg * 16;
                if (!dir) {
#pragma unroll
                    for (int q = 0; q < 4; ++q) *(f32x4*)(ot + 4 * q) = v[q];
                } else {
                    float ss = 0.f;
#pragma unroll
                    for (int q = 0; q < 4; ++q) { v[q] += *(const f32x4*)(ot + 4 * q); ss += (v[q][0] * v[q][0] + v[q][1] * v[q][1]) + (v[q][2] * v[q][2] + v[q][3] * v[q][3]); }
                    ss += shx(ss, 1, lane_); ss += shx(ss, 2, lane_); ss += shx(ss, 4, lane_);
                    const float r = rsqrtf(ss * (1.0f / 128.0f) + EPS);
                    const float* gn = INP(KIND ? 13 : 12) + jl * 512 + h * 128 + seg * 16;
                    const bf16_t* gate = WSP(bf16_t, KIND ? WS_MO : WS_HG) + (size_t)row * 512 + h * 128 + seg * 16;
                    const u32x4 ga = *(const u32x4*)gate, gb = *(const u32x4*)(gate + 8);
                    const unsigned gw[8] = {ga.x, ga.y, ga.z, ga.w, gb.x, gb.y, gb.z, gb.w};
                    unsigned ow[8];
#pragma unroll
                    for (int q = 0; q < 4; ++q) { const f32x4 gq = *(const f32x4*)(gn + 4 * q);
                        const float y0 = v[q][0] * r * gq[0] * bf2f(gw[2 * q] & 0xffffu), y1 = v[q][1] * r * gq[1] * bf2f(gw[2 * q] >> 16);
                        const float y2 = v[q][2] * r * gq[2] * bf2f(gw[2 * q + 1] & 0xffffu), y3 = v[q][3] * r * gq[3] * bf2f(gw[2 * q + 1] >> 16);
                        ow[2 * q] = pk2(y0, y1); ow[2 * q + 1] = pk2(y2, y3); }
                    bf16_t* mg = WSP(bf16_t, WS_MERGED) + (size_t)row * 1024 + KIND * 512 + h * 128 + seg * 16;
                    *(u32x4*)mg = (u32x4){ow[0], ow[1], ow[2], ow[3]}; *(u32x4*)(mg + 8) = (u32x4){ow[4], ow[5], ow[6], ow[7]};
                }
            }
            __syncthreads();
        }
    }
}
#undef SC_ISSUE
#undef SC_ET
__device__ __forceinline__ void phase_scan1(Frame& F) {
    for (int it = F.bid; it < 2 * 32 * 32; it += F.G) {
        const int cpos = it & 31, ch = (it >> 5) & 31, kind = it >> 10; const int dir = ch & 1, h = (ch >> 1) & 3, b = ch >> 3;
        const int sct = cpos == 0 ? 0 : (dir ? 33 - cpos : cpos);
        f32x4 S[8];
#pragma unroll
        for (int n = 0; n < 8; ++n) S[n] = (f32x4){0.f, 0.f, 0.f, 0.f};
        if (kind == 0) { scan_super<0, 1>(F, 0, b, h, sct, dir, S);
            float* G = WSP(float, WS_GH) + (size_t)(ch * 33 + cpos) * 16384;
#pragma unroll
            for (int n = 0; n < 8; ++n) *(f32x4*)(G + (n * 512 + F.tid) * 4) = S[n];
            if (F.tid < 128) WSP(float, WS_DECH)[(ch * 33 + cpos) * 128 + F.tid] = __expf(((const LAS float*)(F.lds + ScanCfg<0>::OFF_SM))[768 + F.tid]);
        } else { scan_super<1, 1>(F, 0, b, h, sct, dir, S);
            float* G = WSP(float, WS_GM) + (size_t)(ch * 33 + cpos) * 10240;
#pragma unroll
            for (int n = 0; n < 5; ++n) *(f32x4*)(G + (n * 512 + F.tid) * 4) = S[n];
            if (F.tid == 0) WSP(float, WS_DECM)[ch * 33 + cpos] = __expf(((const LAS float*)(F.lds + ScanCfg<1>::OFF_SM))[1024 + 2]);
        }
        __syncthreads();
    }
}
__device__ __forceinline__ void phase_scan23(Frame& F, int jl, int pass) {
    if (pass == 0) {
        const int nb0 = (F.G > 64) ? 32 : 0;
        if (F.bid >= nb0) {
            const int gt = (F.bid - nb0) * 512 + F.tid, NT = (F.G - nb0) * 512;
            for (int i = gt; i < 32 * 4096 + 32 * 2560; i += NT) {
                if (i < 32 * 4096) { const int ch = i >> 12, q = i & 4095, tid = q & 511; const int d0 = 16 * (tid >> 6) + 4 * ((tid & 63) >> 4);
                    const float* G = WSP(float, WS_GH) + (size_t)ch * 33 * 16384 + q * 4; bf16_t* SI = WSP(bf16_t, WS_SH) + (size_t)ch * 33 * 16384 + q * 4; const float* DC = WSP(float, WS_DECH) + ch * 33 * 128 + d0;
                    f32x4 s4 = (f32x4){0.f, 0.f, 0.f, 0.f};
#pragma unroll 4
                    for (int cp = 0; cp < 32; ++cp) { s4 = *(const f32x4*)(DC + cp * 128) * s4 + *(const f32x4*)(G + (size_t)cp * 16384); u32x2 w; w.x = pk2(s4[0], s4[1]); w.y = pk2(s4[2], s4[3]); *(u32x2*)(SI + (size_t)(cp + 1) * 16384) = w; }
                } else { const int k = i - 32 * 4096, ch = k / 2560, q = k % 2560;
                    const float* G = WSP(float, WS_GM) + (size_t)ch * 33 * 10240 + q * 4; bf16_t* SI = WSP(bf16_t, WS_SM) + (size_t)ch * 33 * 10240 + q * 4; const float* DC = WSP(float, WS_DECM) + ch * 33;
                    f32x4 s4 = (f32x4){0.f, 0.f, 0.f, 0.f};
#pragma unroll 4
                    for (int cp = 0; cp < 32; ++cp) { s4 = DC[cp] * s4 + *(const f32x4*)(G + (size_t)cp * 10240); u32x2 w; w.x = pk2(s4[0], s4[1]); w.y = pk2(s4[2], s4[3]); *(u32x2*)(SI + (size_t)(cp + 1) * 10240) = w; }
                }
            }
        }
    }
    const int count = pass == 0 ? 32 : 1024;
    for (int q = F.bid; q < count; q += F.G) {
        const int kind = q & 1, r = q >> 1;
        const int sct = pass == 0 ? 0 : 1 + (r & 31), bh = pass == 0 ? r : (r >> 5), h = bh & 3, b = bh >> 2;
#pragma unroll 1
        for (int dir = 0; dir < 2; ++dir) {
            const int ch = (b * 4 + h) * 2 + dir; const int cpos = sct == 0 ? 0 : (dir ? 33 - sct : sct);
            f32x4 S[8];
            if (kind == 0) { const bf16_t* SI = WSP(bf16_t, WS_SH) + (size_t)(ch * 33 + cpos) * 16384;
#pragma unroll
                for (int n = 0; n < 8; ++n) S[n] = cpos ? ld_bf4(SI + (n * 512 + F.tid) * 4) : (f32x4){0.f, 0.f, 0.f, 0.f};
                scan_super<0, 3>(F, jl, b, h, sct, dir, S);
            } else { const bf16_t* SI = WSP(bf16_t, WS_SM) + (size_t)(ch * 33 + cpos) * 10240;
#pragma unroll
                for (int n = 0; n < 8; ++n) S[n] = (cpos && n < 5) ? ld_bf4(SI + (n * 512 + F.tid) * 4) : (f32x4){0.f, 0.f, 0.f, 0.f};
                scan_super<1, 3>(F, jl, b, h, sct, dir, S);
            }
        }
    }
}

template <int PHMASK_T>
__global__ void __launch_bounds__(512, 2) mk_fwd(Args args) {
    extern __shared__ __attribute__((aligned(16))) unsigned char lds_raw[];
    Frame F;
    F.lds = (LAS unsigned char*)lds_raw;
    F.tid = threadIdx.x; F.lane = F.tid & 63; F.wave = __builtin_amdgcn_readfirstlane(F.tid >> 6);
    F.G = gridDim.x; F.bid = blockIdx.x;
    F.out = args.out; F.ws = args.ws; F.ctl = (unsigned*)(args.ws + WS_CTL);
    volatile LAS unsigned* MISC = (volatile LAS unsigned*)(F.lds + MISC_OFF);
    if (F.tid < 64) MISC[F.tid] = 0u;
    if (F.tid >= 64 && F.tid < 64 + 25) { const unsigned long long p = (unsigned long long)args.in[F.tid - 64]; MISC[64 + 2 * (F.tid - 64)] = (unsigned)p; MISC[65 + 2 * (F.tid - 64)] = (unsigned)(p >> 32); }
    __syncthreads();
    const int lo = args.ph_lo, hi = args.ph_hi;
    if (hi - lo > 1) (void)xcd_barrier_post(F.ctl + CW_BAR, MISC + 8);
#define EN(b) ((PHMASK_T >> (b)) & 1)
#define IN(k) (lo <= (k) && (k) < hi)
#if MK_ONE_LAUNCH
#define SEAM(k) do { if (IN(k) && IN((k) + 1)) { XcdBarrier bar_; bar_.bar = (unsigned*)(args.ws + WS_CTL) + CW_BAR; bar_.x = xb_xcc_id(); bar_.st = (volatile LAS unsigned*)(F.lds + MISC_OFF) + 8; bar_.leader = (F.wave == 0 && lane_id_volatile() == 0) ? 1 : 0; xcd_barrier(bar_); } } while (0)
#else
#define SEAM(k) do { } while (0)
#endif
    LAS int* tb = (LAS int*)(F.lds + MISC_OFF + 2048);
    LAS int* cnts = tb + 40;

    if (EN(0) && IN(0)) { _Pragma("unroll 1") for (int rp = 0; rp < REP_PRO; ++rp) { Frame P = fresh(F); phase_prologue(P); } }
    SEAM(0);
    for (int l0 = 0; l0 < 4; ++l0) {
        const int pb = 1 + 10 * l0; const bool rec = (l0 & 1) == 0;
        if (EN(1) && IN(pb + 0)) { Frame P = fresh(F); const int l = fresh_i(l0); if (l0 == 0) phase_norm1<0>(P, l); else phase_norm1<1>(P, l); }
        SEAM(pb + 0);
        if (rec) {
            if (EN(2) && IN(pb + 1)) _Pragma("unroll 1") for (int rp = 0; rp < REP_GIN; ++rp) {
                Frame P = fresh(F); const int l = fresh_i(l0), j = l >> 1;
                pg8::StaticOrder S; S.init(NR, NREC, P.G, P.bid);
                EpiRec E{P.ws, inp_ptr(P, 9) + (size_t)j * 4112, (float*)(P.ws + WS_LB) + l * 512, l};
                pg8::gemm_phase(P.lds, (const bf16_t*)(P.ws + WS_H), (const bf16_t*)(P.ws + WS_WIN) + (size_t)j * NREC * 1024, 1024, 0, S, E, pg8::RowIdentity{}, P.tid);
            }
            SEAM(pb + 1);
            if (EN(3) && IN(pb + 2)) { _Pragma("unroll 1") for (int rp = 0; rp < REP_SCAN1; ++rp) { Frame P = fresh(F); phase_scan1(P); } }
            SEAM(pb + 2);
#pragma unroll 1
            for (int pass = 0; pass < 2; ++pass) {
                if (EN(4) && IN(pb + 3 + pass)) { Frame P = fresh(F); phase_scan23(P, fresh_i(l0) >> 1, fresh_i(pass)); }
                SEAM(pb + 3 + pass);
            }
        } else {
            if (EN(5) && IN(pb + 1)) _Pragma("unroll 1") for (int rp = 0; rp < REP_GIN; ++rp) {
                Frame P = fresh(F); const int l = fresh_i(l0), j = l >> 1;
                pg8::StaticOrder S; S.init(NR, 3072, P.G, P.bid);
                EpiQKV E{P.ws};
                pg8::gemm_phase(P.lds, (const bf16_t*)(P.ws + WS_H), (const bf16_t*)(P.ws + WS_WQKV) + (size_t)j * 3072 * 1024, 1024, 0, S, E, pg8::RowIdentity{}, P.tid);
            }
            SEAM(pb + 1);
            if (EN(6) && IN(pb + 2)) { _Pragma("unroll 1") for (int rp = 0; rp < REP_ATT; ++rp) { Frame P = fresh(F); phase_attn(P, fresh_i(l0) >> 1, l0 == 3); } }
            SEAM(pb + 2);
        }
        if (EN(7) && IN(pb + 5)) {
            Frame P = fresh(F); const int l = fresh_i(l0), j = l >> 1;
            pg8::StaticOrder S; S.init(l0 == 3 ? RL : NR, 1024, P.G, P.bid);
            EpiResid E{(bf16_t*)(P.ws + WS_Y), (const float*)(P.ws + WS_MOD) + l * 5 * 6144};
            pg8::gemm_phase(P.lds, (const bf16_t*)(P.ws + WS_MERGED), (const bf16_t*)(P.ws + ((l & 1) ? WS_WNOUT : WS_WROUT)) + (size_t)j * 1024 * 1024, 1024, 0, S, E, pg8::RowIdentity{}, P.tid);
        }
        SEAM(pb + 5);
        if (EN(8) && IN(pb + 6)) { Frame P = fresh(F); phase_router(P, fresh_i(l0)); }
        SEAM(pb + 6);
        if ((EN(9) && IN(pb + 7)) || (EN(10) && IN(pb + 8))) {
            Frame P = fresh(F); const int l = fresh_i(l0);
            expert_prefix(P, l, tb, cnts, 1, true);
            __syncthreads();
        }
        if (EN(9) && IN(pb + 7)) _Pragma("unroll 1") for (int rp = 0; rp < REP_MOE; ++rp) {
            Frame P = fresh(F); const int l = fresh_i(l0);
            pg8::MoeOrder S{tb, tb[32], 3, P.G, P.bid};
            EpiMoe1 E{(bf16_t*)(P.ws + WS_ACT), inp_ptr(P, 22) + (size_t)l * 32 * 2048};
            pg8::RowGather AO{(const int*)(P.ws + WS_LIST), cnts};
            pg8::gemm_phase(P.lds, (const bf16_t*)(P.ws + WS_H), (const bf16_t*)(P.ws + WS_WGU) + (size_t)l * 32 * 2048 * 1024, 1024, (size_t)2048 * 1024 * 2, S, E, AO, P.tid);
        }
        SEAM(pb + 7);
        if (EN(10) && IN(pb + 8)) _Pragma("unroll 1") for (int rp = 0; rp < REP_MOE; ++rp) {
            Frame P = fresh(F); const int l = fresh_i(l0);
            pg8::MoeOrder S{tb, tb[32], 2, P.G, P.bid};
            EpiMoe2 E{(bf16_t*)(P.ws + WS_YS), inp_ptr(P, 24) + (size_t)l * 32 * 1024};
            pg8::gemm_phase(P.lds, (const bf16_t*)(P.ws + WS_ACT), (const bf16_t*)(P.ws + WS_WD) + (size_t)l * 32 * 1024 * 1024, 1024, (size_t)1024 * 1024 * 2, S, E, pg8::RowIdentity{}, P.tid);
        }
        SEAM(pb + 8);
    }
    if (EN(11) && IN(41)) { Frame P = fresh(F); phase_norm1<2>(P, fresh_i(4)); }
#undef IN
#undef SEAM
}

typedef void (*kern_t)(Args);
static int phase_bit(int p) {
    if (p == 0) return 0; if (p == 41) return 11;
    const int l = (p - 1) / 10, k = (p - 1) % 10; const bool rec = (l & 1) == 0;
    switch (k) { case 0: return 1; case 1: return rec ? 2 : 5; case 2: return rec ? 3 : 6; case 3: return rec ? 3 : -1; case 4: return rec ? 4 : -1; case 5: return 7; case 6: return 8; case 7: return 9; case 8: return 10; default: return -1; }
}
extern "C" void kernel_launch(void* const* d_in, const int* in_sizes, int n_in, void* d_out, int out_size, void* d_ws, size_t ws_size, hipStream_t stream) {
    static int grid = 0;
#if MK_ONE_LAUNCH
    #ifndef ONE_MASK
#define ONE_MASK 0xfff
#endif
    static const kern_t kerns[1] = { mk_fwd<ONE_MASK> };
    const int nk = 1;
#else
    static const kern_t kerns[12] = { mk_fwd<1>, mk_fwd<2>, mk_fwd<4>, mk_fwd<8>, mk_fwd<16>, mk_fwd<32>, mk_fwd<64>, mk_fwd<128>, mk_fwd<256>, mk_fwd<512>, mk_fwd<1024>, mk_fwd<2048> };
    const int nk = 12;
#endif
    if (grid == 0) {
        if (n_in != 25 || out_size != RL * D || ws_size < WS_END) { fprintf(stderr, "kernel_launch: unexpected shapes (n_in %d out %d ws %zu)\n", n_in, out_size, ws_size); grid = -1; return; }
        int dev = 0, cus = 0;
        if (hipGetDevice(&dev) != hipSuccess || hipDeviceGetAttribute(&cus, hipDeviceAttributeMultiprocessorCount, dev) != hipSuccess) { grid = -1; return; }
        for (int i = 0; i < nk; ++i)
            if (hipFuncSetAttribute((const void*)kerns[i], hipFuncAttributeMaxDynamicSharedMemorySize, LDS_BYTES) != hipSuccess) { fprintf(stderr, "kernel_launch: hipFuncSetAttribute failed\n"); grid = -1; return; }
        (void)hipGetLastError();
        grid = cus;
    }
    if (grid < 0) return;
    (void)hipMemsetAsync((char*)d_ws + WS_CTL, 0, CTL_BYTES, stream);
    Args a{};
    for (int i = 0; i < 25; ++i) a.in[i] = (const float*)d_in[i];
    a.out = (float*)d_out; a.ws = (unsigned char*)d_ws;
#if MK_ONE_LAUNCH
    a.ph_lo = 0; a.ph_hi = NPHASE;
    hipLaunchKernelGGL(kerns[0], dim3(grid), dim3(512), LDS_BYTES, stream, a);
#else
    for (int p = 0; p < NPHASE; ++p) {
        const int bit = phase_bit(p); if (bit < 0) continue;
        a.ph_lo = p; a.ph_hi = p + 1;
        hipLaunchKernelGGL(kerns[bit], dim3(grid), dim3(512), LDS_BYTES, stream, a);
    }
#endif
}
```

```cpp
#include <hip/hip_runtime.h>
#include <stdint.h>
#include <stdio.h>

#ifndef MK_ONE_LAUNCH
#define MK_ONE_LAUNCH 1
#endif
#ifndef REP_PRO
#define REP_PRO 1
#endif
#ifndef REP_SCAN1
#define REP_SCAN1 1
#endif
#ifndef REP_SCAN2
#define REP_SCAN2 1
#endif
#ifndef REP_SCAN3
#define REP_SCAN3 1
#endif
#ifndef REP_ATT
#define REP_ATT 1
#endif
#ifndef REP_MOE
#define REP_MOE 1
#endif
#ifndef REP_GIN
#define REP_GIN 1
#endif
#define LAS __attribute__((address_space(3)))
#define GAS __attribute__((address_space(1)))
typedef unsigned short bf16_t;
typedef short bf16x8 __attribute__((ext_vector_type(8)));
typedef float f32x4 __attribute__((ext_vector_type(4)));
typedef float f32x2 __attribute__((ext_vector_type(2)));
typedef unsigned u32x4 __attribute__((ext_vector_type(4)));
typedef unsigned u32x2 __attribute__((ext_vector_type(2)));

constexpr int D = 1024, NB = 4, TL = 8192, TC = 256;
constexpr int RL = NB * TL;
constexpr int RC = NB * TC;
constexpr int NR = RL + RC;
constexpr int NREC = 4352;
constexpr int NE = 32, DFF = 1024;
constexpr int CAP = NR;
constexpr int SLOT_ROWS = 143360;
constexpr float EPS = 1e-6f;
constexpr int NPHASE = 42;

constexpr size_t MiB = 1u << 20;
constexpr size_t WS_CTL = 0, CTL_BYTES = 1 * MiB;
constexpr size_t WS_MOD = 1 * MiB;
constexpr size_t WS_LB = WS_MOD + 512 * 1024;
constexpr size_t WS_ROPE = WS_LB + 8 * 1024;
constexpr size_t WS_WIN = 2 * MiB;
constexpr size_t WS_WROUT = 19 * MiB;
constexpr size_t WS_WQKV = 23 * MiB;
constexpr size_t WS_WNOUT = 35 * MiB;
constexpr size_t WS_WGU = 40 * MiB;
constexpr size_t WS_WD = 552 * MiB;
constexpr size_t WS_X = 808 * MiB;
constexpr size_t WS_H = 940 * MiB;
constexpr size_t WS_MERGED = 1006 * MiB;
constexpr size_t WS_STREAM = 1072 * MiB;
constexpr size_t SZ_B512 = (size_t)NR * 512 * 2;
constexpr size_t SZ_F512 = (size_t)NR * 512 * 4;
constexpr size_t WS_Q = WS_STREAM, WS_KF = WS_Q + SZ_B512, WS_KB = WS_KF + SZ_B512, WS_V = WS_KB + SZ_B512, WS_HG = WS_V + SZ_B512;
constexpr size_t WS_MV = WS_HG + SZ_B512, WS_MO = WS_MV + SZ_B512, WS_MQ = WS_MO + SZ_B512, WS_MK = WS_MQ + SZ_B512 / 2;
constexpr size_t WS_LAF = WS_MK + SZ_B512 / 2, WS_LAB = WS_LAF + SZ_F512, WS_GATES = WS_LAB + SZ_F512;
constexpr size_t WS_OHF = WS_GATES + 3 * MiB, WS_OHB = WS_OHF + SZ_F512, WS_OMF = WS_OHB + SZ_F512, WS_OMB = WS_OMF + SZ_F512;
constexpr size_t WS_STREAM_END = WS_OMB + SZ_F512;
constexpr size_t WS_Y = WS_STREAM;
constexpr size_t WS_QKV = WS_STREAM;
constexpr int TT = TL + TC;
constexpr size_t WS_VTG = WS_STREAM + 200 * MiB;
constexpr size_t WS_SSK = WS_STREAM + 272 * MiB;
constexpr size_t WS_TOKE = 1744 * MiB, WS_TOKP = WS_TOKE + 1 * MiB, WS_TOKW = WS_TOKP + 1 * MiB, WS_LIST = WS_TOKW + 1 * MiB;
constexpr size_t WS_ACT = 1752 * MiB;
constexpr size_t WS_YS = 2032 * MiB;
constexpr size_t WS_END = 2312 * MiB;
static_assert(WS_STREAM_END <= WS_TOKE && WS_QKV + (size_t)NR * 3072 * 2 <= WS_TOKE, "stream region");
static_assert(WS_LIST + (size_t)NE * CAP * 4 <= WS_ACT && WS_ACT + (size_t)SLOT_ROWS * 1024 * 2 <= WS_YS && WS_YS + (size_t)SLOT_ROWS * 1024 * 2 <= WS_END, "moe region");
static_assert(WS_WIN + (size_t)2 * NREC * 1024 * 2 <= WS_WROUT && WS_WGU + (size_t)128 * 2048 * 1024 * 2 <= WS_WD && WS_WD + (size_t)128 * 1024 * 1024 * 2 <= WS_X, "weights");
constexpr int CW_BAR = 4096;
constexpr int CW_CNT = 16384;

constexpr int RING_BYTES = 131072;
constexpr int MISC_OFF = RING_BYTES;
constexpr int LDS_BYTES = 147456;

__device__ __forceinline__ float bf2f(unsigned b) { return __uint_as_float(b << 16); }
typedef _Float16 f16x4 __attribute__((ext_vector_type(4)));
__device__ __forceinline__ f32x4 h4_to_f4(u32x2 q) { return __builtin_convertvector(__builtin_bit_cast(f16x4, q), f32x4); }
__device__ __forceinline__ u32x2 f4_to_h4(f32x4 v) { f32x4 c; c[0] = __builtin_amdgcn_fmed3f(v[0], -65504.f, 65504.f); c[1] = __builtin_amdgcn_fmed3f(v[1], -65504.f, 65504.f); c[2] = __builtin_amdgcn_fmed3f(v[2], -65504.f, 65504.f); c[3] = __builtin_amdgcn_fmed3f(v[3], -65504.f, 65504.f);
    return __builtin_bit_cast(u32x2, __builtin_convertvector(c, f16x4)); }
__device__ __forceinline__ f32x4 ld_bf4(const bf16_t* p) { const u32x2 q = *(const u32x2*)p; return (f32x4){bf2f(q.x & 0xffffu), bf2f(q.x >> 16), bf2f(q.y & 0xffffu), bf2f(q.y >> 16)}; }
__device__ __forceinline__ unsigned f2bf(float f) { unsigned u = __float_as_uint(f); return (u + 0x7fffu + ((u >> 16) & 1u)) >> 16; }
__device__ __forceinline__ unsigned pk2(float lo, float hi) { unsigned r; asm("v_cvt_pk_bf16_f32 %0, %1, %2" : "=v"(r) : "v"(lo), "v"(hi)); return r; }
__device__ __forceinline__ float shx(float v, int o, int lane) { return __int_as_float(__builtin_amdgcn_ds_bpermute((lane ^ o) << 2, __float_as_int(v))); }
__device__ __forceinline__ int shxi(int v, int o, int lane) { return __builtin_amdgcn_ds_bpermute((lane ^ o) << 2, v); }
__device__ __forceinline__ float wave_sum(float v, int) {
    v += __int_as_float(__builtin_amdgcn_update_dpp(0, __float_as_int(v), 0xB1, 0xF, 0xF, true));
    v += __int_as_float(__builtin_amdgcn_update_dpp(0, __float_as_int(v), 0x4E, 0xF, 0xF, true));
    v += __int_as_float(__builtin_amdgcn_update_dpp(0, __float_as_int(v), 0x141, 0xF, 0xF, true));
    v += __int_as_float(__builtin_amdgcn_update_dpp(0, __float_as_int(v), 0x140, 0xF, 0xF, true));
    const float r0 = __int_as_float(__builtin_amdgcn_readlane(__float_as_int(v), 0)), r1 = __int_as_float(__builtin_amdgcn_readlane(__float_as_int(v), 16));
    const float r2 = __int_as_float(__builtin_amdgcn_readlane(__float_as_int(v), 32)), r3 = __int_as_float(__builtin_amdgcn_readlane(__float_as_int(v), 48));
    return (r0 + r1) + (r2 + r3);
}
__device__ __forceinline__ float wave_max(float v, int lane) {
#pragma unroll
    for (int o = 1; o < 64; o <<= 1) v = fmaxf(v, shx(v, o, lane));
    return v;
}
__device__ __forceinline__ int lane_id_volatile() { int l; asm volatile("v_mbcnt_lo_u32_b32 %0, -1, 0\n\tv_mbcnt_hi_u32_b32 %0, -1, %0" : "=v"(l)); return l; }
__device__ __forceinline__ float sigmoidf_(float x) { return __builtin_amdgcn_rcpf(1.0f + __builtin_amdgcn_exp2f(x * -1.4426950408889634f)); }
__device__ __forceinline__ float siluf_(float x) { return x * sigmoidf_(x); }
__device__ __forceinline__ float logsigmoidf_(float x) { return fminf(x, 0.f) - 0.6931471805599453f * __builtin_amdgcn_logf(1.0f + __builtin_amdgcn_exp2f(fabsf(x) * -1.4426950408889634f)); }
__device__ __forceinline__ int row_bidx(int r) { return r < RL ? (r >> 13) : 4; }

#define XB_TMO      128
#define XB_XCNT(j)  (256  + 64 * (j))
#define XB_XSUB(j)  (1280 + 64 * (j))
#define XB_XGEN(j)  (2304 + 64 * (j))
#define XB_TOP      3328
#define XB_TOPGEN   3392
#define XCD_BAR_WORDS 3456
#define XB_SPIN_CAP (1u << 18)
__device__ __forceinline__ unsigned xb_ld(unsigned* p)              { return __hip_atomic_load((GAS unsigned*)p, __ATOMIC_RELAXED, __HIP_MEMORY_SCOPE_AGENT); }
__device__ __forceinline__ unsigned xb_add(unsigned* p, unsigned v) { return __hip_atomic_fetch_add((GAS unsigned*)p, v, __ATOMIC_RELAXED, __HIP_MEMORY_SCOPE_AGENT); }
__device__ __forceinline__ unsigned xb_xcc_id() { return (unsigned)__builtin_amdgcn_s_getreg((3 << 11) | 20) & 0xFu; }
#define XB_SPIN(cond, bar) do { unsigned _sp = 0; while (cond) { __builtin_amdgcn_s_sleep(1); \
    if ((++_sp & 255u) == 0u) { if (xb_ld(&(bar)[XB_TMO])) break; if (_sp > XB_SPIN_CAP) { (void)xb_add(&(bar)[XB_TMO], 1u); break; } } } } while (0)
struct XcdBarrier { unsigned* bar; unsigned x; volatile LAS unsigned* st; int leader; };
__device__ __forceinline__ XcdBarrier xcd_barrier_post(unsigned* bar, volatile LAS unsigned* st) {
    XcdBarrier b; b.bar = bar; b.x = xb_xcc_id(); b.st = st;
    if (threadIdx.x == 0) (void)xb_add(&bar[XB_XCNT(b.x)], 1u);
    return b;
}
__device__ __forceinline__ void xcd_barrier_complete(unsigned* bar, unsigned x, unsigned& nloc, unsigned& nx) {
    const unsigned G = gridDim.x * gridDim.y * gridDim.z;
    unsigned sum, cnt, mine, sp = 0u;
    for (;;) {
        sum = 0u; cnt = 0u; mine = 0u;
#pragma unroll
        for (unsigned j = 0; j < 16; ++j) { const unsigned c = xb_ld(&bar[XB_XCNT(j)]); sum += c; cnt += (c > 0u) ? 1u : 0u; mine = (j == x) ? c : mine; }
        if (sum == G) break;
        __builtin_amdgcn_s_sleep(1);
        if ((++sp & 255u) == 0u) { if (xb_ld(&bar[XB_TMO])) break; if (sp > XB_SPIN_CAP) { (void)xb_add(&bar[XB_TMO], 1u); break; } }
    }
    nloc = mine > 0u ? mine : 1u; nx = cnt > 0u ? cnt : 1u;
}
__device__ __noinline__ void xcd_barrier(const XcdBarrier b) {
    asm volatile("s_waitcnt vmcnt(0)" ::: "memory");
    __syncthreads();
    if (b.leader) {
        unsigned* bar = b.bar;
        __builtin_amdgcn_s_waitcnt(0);
        unsigned nloc = b.st[0], nx = b.st[1];
        if (nloc == 0u) { xcd_barrier_complete(bar, b.x, nloc, nx); b.st[0] = nloc; b.st[1] = nx; }
        const unsigned old = xb_add(&bar[XB_XSUB(b.x)], 1u);
        const unsigned gen = old / nloc;
        if (old + 1u == (gen + 1u) * nloc) {
            __builtin_amdgcn_fence(__ATOMIC_RELEASE, "agent");
            asm volatile("s_waitcnt vmcnt(0)" ::: "memory");
            const unsigned og = xb_add(&bar[XB_TOP], 1u);
            const unsigned tg = og / nx;
            if (og + 1u == (tg + 1u) * nx) xb_add(&bar[XB_TOPGEN], 1u);
            else XB_SPIN(xb_ld(&bar[XB_TOPGEN]) == tg, bar);
            __builtin_amdgcn_fence(__ATOMIC_ACQUIRE, "agent");
            xb_add(&bar[XB_XGEN(b.x)], 1u);
            asm volatile("s_waitcnt vmcnt(0)" ::: "memory");
        } else {
            XB_SPIN(xb_ld(&bar[XB_XGEN(b.x)]) == gen, bar);
            __builtin_amdgcn_fence(__ATOMIC_ACQUIRE, "agent");
            asm volatile("s_waitcnt vmcnt(0)" ::: "memory");
        }
    }
    __syncthreads();
}

namespace pg8 {
constexpr int BM = 256, BK = 64, HALF = 128, HTB = HALF * BK * 2, STAGE_BYTES = 8 * HTB, NXCD = 8, WGM = 8;
__host__ __device__ __forceinline__ int lds_byte(int r, int c) { const int st = (r >> 4) * 2 + (c >> 5), rr = r & 15, cc = c & 31, ob = rr * 64 + cc * 2; return st * 1024 + (ob ^ (((ob >> 9) & 1) << 5)); }
__host__ __device__ __forceinline__ void stage_rc(int b, int& R, int& C) { const int st = b / 1024, sb = b % 1024, swz = sb ^ (((sb >> 9) & 1) << 5); R = (st >> 1) * 16 + swz / 64; C = (st & 1) * 32 + (swz % 64) / 2; }
__host__ __device__ __forceinline__ int perm32(int rho) { const int n = rho >> 4, i = rho & 15; return 8 * (i >> 2) + 4 * n + (i & 3); }
struct Unit { int pm, pn, e, mt; };
struct StaticOrder {
    int nM, nN, nwg, G, c;
    __device__ void init(int M, int N, int G_, int c_) { nM = M / BM; nN = N / BM; nwg = nM * nN; G = G_; c = c_; }
    __device__ bool next(int i, Unit& u) const {
        const long L = (long)i * G + c; if (L >= nwg) return false;
        int wgid = (int)L; { const int q = nwg / NXCD, r = nwg % NXCD, xcd = wgid % NXCD, off = wgid / NXCD; wgid = (xcd < r ? xcd * (q + 1) : r * (q + 1) + (xcd - r) * q) + off; }
        const int nig = WGM * nN, gid = wgid / nig, fm = gid * WGM, gsz = (nM - fm) < WGM ? (nM - fm) : WGM;
        u.pm = fm + ((wgid % nig) % gsz); u.pn = (wgid % nig) / gsz; u.e = 0; u.mt = 0; return true;
    }
};
struct MoeOrder {
    const LAS int* tb; int T, lg, G, c;
    __device__ bool next(int i, Unit& u) const {
        int tile, pn; const int npn = 1 << lg;
        if (G == 256) { const int x = c & 7, j = c >> 3, tpx = 32 >> lg; tile = (i * 8 + x) * tpx + (j >> lg); pn = j & (npn - 1); }
        else { const long L = (long)i * G + c; tile = (int)(L >> lg); pn = (int)(L & (npn - 1)); }
        if (tile >= T) return false;
        int ln_; asm volatile("v_mbcnt_lo_u32_b32 %0, -1, 0\n\tv_mbcnt_hi_u32_b32 %0, -1, %0" : "=v"(ln_));
        const int e = (int)__builtin_popcountll(__ballot(ln_ < 31 && tb[(ln_ < 31 ? ln_ : 31) + 1] <= tile));
        u.e = e; u.mt = tile - tb[e]; u.pm = tile; u.pn = pn; return true;
    }
};
struct RowIdentity { static constexpr bool GATHER = false; __device__ __forceinline__ int row(const Unit& u, int r) const { return r; } };
struct RowGather { static constexpr bool GATHER = true; const int* list; const LAS int* cnt; __device__ __forceinline__ int row(const Unit& u, int r) const { const int p = u.mt * BM + r; return p < cnt[u.e] ? list[(size_t)u.e * CAP + p] : 0; } };

__device__ __forceinline__ unsigned cvt_pk_bf16(float lo, float hi) { unsigned r; asm volatile("v_cvt_pk_bf16_f32 %0, %1, %2" : "=v"(r) : "v"(lo), "v"(hi)); return r; }

template <class Epi, class Sched, class AOff>
__device__ __forceinline__ void gemm_phase(LAS unsigned char* lds, const bf16_t* A, const bf16_t* Bt, const int K, const size_t estride  , const Sched& S, const Epi& E, const AOff& AO, const int tid) {
    const int wid = __builtin_amdgcn_readfirstlane(tid >> 6), lane = tid & 63, wr = wid >> 2, wc = wid & 3, fr = lane & 15, fq = lane >> 4;
    const int nt = K / BK;
    int Rr[2], Cc[2]; unsigned voffB[2];
#pragma unroll
    for (int i = 0; i < 2; ++i) { int R, C; stage_rc(tid * 16 + i * 8192, R, C); const int Rb = Epi::PERM ? ((R & ~31) + perm32(R & 31)) : R;
        Rr[i] = R; Cc[i] = C; voffB[i] = (unsigned)(Rb * K + C) * 2u; }
    const size_t kstep = (size_t)(BK * 2);
    const size_t hstep = (size_t)HALF * K * 2;
    const size_t tstep = 2 * hstep;
    const unsigned ldsw = (unsigned)wid * 1024u;
    const int aoff = lds_byte(wr * 64 + fr, fq * 8), boff = lds_byte(wc * 32 + fr, fq * 8);
#define PG8_SA(b, h) (((b) * 2 + (h)) * HTB)
#define PG8_SB(b, h) ((4 + (b) * 2 + (h)) * HTB)
#define PG8_STAGE(bufoff, gbase, voff) do { _Pragma("unroll") for (int _i = 0; _i < 2; ++_i) \
        __builtin_amdgcn_global_load_lds((const unsigned*)((const char*)(gbase) + (voff)[_i]), (LAS unsigned*)(lds + (bufoff) + ldsw + _i * 8192), 16, 0, 0); } while (0)
#define PG8_STAGE2(bufoff, gbase, v0, v1) do { \
        __builtin_amdgcn_global_load_lds((const unsigned*)((const char*)(gbase) + (v0)), (LAS unsigned*)(lds + (bufoff) + ldsw), 16, 0, 0); \
        __builtin_amdgcn_global_load_lds((const unsigned*)((const char*)(gbase) + (v1)), (LAS unsigned*)(lds + (bufoff) + ldsw + 8192), 16, 0, 0); } while (0)
#define PG8_LDA(dst, b, h) do { _Pragma("unroll") for (int m = 0; m < 4; ++m) _Pragma("unroll") for (int k = 0; k < 2; ++k) dst[m][k] = *(const LAS bf16x8*)(lds + PG8_SA(b, h) + aoff + m * 2048 + k * 1024); } while (0)
#define PG8_LDB(dst, b, h) do { _Pragma("unroll") for (int n = 0; n < 2; ++n) _Pragma("unroll") for (int k = 0; k < 2; ++k) dst[n][k] = *(const LAS bf16x8*)(lds + PG8_SB(b, h) + boff + n * 2048 + k * 1024); } while (0)
#define PG8_MMA(ai, bj, At, Bt_) do { __builtin_amdgcn_s_setprio(1); _Pragma("unroll") for (int m = 0; m < 4; ++m) _Pragma("unroll") for (int n = 0; n < 2; ++n) _Pragma("unroll") for (int k = 0; k < 2; ++k) \
        acc[ai][bj][m][n] = __builtin_amdgcn_mfma_f32_16x16x32_bf16(Bt_[n][k], At[m][k], acc[ai][bj][m][n], 0, 0, 0); __builtin_amdgcn_s_setprio(0); } while (0)
#define PG8_WAIT_V(n) asm volatile("s_waitcnt vmcnt(" #n ")" ::: "memory")
#define PG8_WAIT_L(n) asm volatile("s_waitcnt lgkmcnt(" #n ")" ::: "memory")
#define PG8_BAR __builtin_amdgcn_s_barrier()
#define PG8_SCHED __builtin_amdgcn_sched_barrier(0)
#define PG8_AOFFS(dst, u) do { _Pragma("unroll") for (int _h = 0; _h < 2; ++_h) _Pragma("unroll") for (int _i = 0; _i < 2; ++_i) \
        dst[_h][_i] = ((unsigned)AO.row(u, _h * HALF + Rr[_i]) * (unsigned)K + (unsigned)Cc[_i]) * 2u; } while (0)
    Unit cur, nxt; int ui = 0;
    if (!S.next(0, cur)) return;
    f32x4 acc[2][2][4][2];
#pragma unroll
    for (int a = 0; a < 2; ++a)
#pragma unroll
        for (int b = 0; b < 2; ++b)
#pragma unroll
            for (int m = 0; m < 4; ++m)
#pragma unroll
                for (int n = 0; n < 2; ++n) acc[a][b][m][n] = (f32x4){0.f, 0.f, 0.f, 0.f};
    bf16x8 At[4][2], B0[2][2], B1[2][2];
    unsigned vc[2][2], vn[2][2];
    PG8_AOFFS(vc, cur);
    const char* Ab = (const char*)A;
    const char* aC = AOff::GATHER ? Ab : Ab + (size_t)cur.pm * tstep;
    const char* cB = (const char*)Bt + (size_t)cur.e * estride + (size_t)cur.pn * tstep;
    PG8_STAGE(PG8_SB(0, 0), cB, voffB); PG8_STAGE2(PG8_SA(0, 0), aC, vc[0][0], vc[0][1]); PG8_STAGE(PG8_SB(0, 1), cB + hstep, voffB); PG8_STAGE2(PG8_SA(0, 1), aC, vc[1][0], vc[1][1]);
    if (wr == 1) PG8_BAR;
    PG8_WAIT_V(4); PG8_BAR;
    PG8_STAGE(PG8_SB(1, 0), cB + kstep, voffB); PG8_STAGE2(PG8_SA(1, 0), aC + kstep, vc[0][0], vc[0][1]); PG8_STAGE(PG8_SB(1, 1), cB + hstep + kstep, voffB);
    PG8_WAIT_V(6); PG8_BAR;
    for (;;) {
        const bool has_next = S.next(ui + 1, nxt);
        if (AOff::GATHER && has_next) { PG8_AOFFS(vn, nxt); }
        else {
#pragma unroll
            for (int _h = 0; _h < 2; ++_h)
#pragma unroll
                for (int _i = 0; _i < 2; ++_i) vn[_h][_i] = vc[_h][_i];
        }
        const char* nB = has_next ? (const char*)Bt + (size_t)nxt.e * estride + (size_t)nxt.pn * tstep : cB;
        const char* aN = (AOff::GATHER || !has_next) ? aC : Ab + (size_t)nxt.pm * tstep;
        for (int t = 0; t < nt; t += 2) {
            const bool last = (t == nt - 2);
            const char* a1 = aC + (size_t)(t + 1) * kstep;
            const char* a2 = last ? aN : aC + (size_t)(t + 2) * kstep; const char* b2 = last ? nB : cB + (size_t)(t + 2) * kstep;
            const char* a3 = a2 + kstep; const char* b3 = b2 + kstep;
            const unsigned x00 = last ? vn[0][0] : vc[0][0], x01 = last ? vn[0][1] : vc[0][1], x10 = last ? vn[1][0] : vc[1][0], x11 = last ? vn[1][1] : vc[1][1];
            PG8_LDB(B0, 0, 0); PG8_SCHED; PG8_LDA(At, 0, 0); PG8_STAGE2(PG8_SA(1, 1), a1, vc[1][0], vc[1][1]);
            PG8_WAIT_L(8); PG8_BAR; PG8_WAIT_L(0); PG8_MMA(0, 0, At, B0); PG8_BAR; PG8_SCHED;
            PG8_LDB(B1, 0, 1); PG8_STAGE(PG8_SB(0, 0), b2, voffB);
            PG8_BAR; PG8_WAIT_L(0); PG8_MMA(0, 1, At, B1); PG8_BAR;
            PG8_LDA(At, 0, 1); PG8_STAGE2(PG8_SA(0, 0), a2, x00, x01);
            PG8_BAR; PG8_WAIT_L(0); PG8_MMA(1, 0, At, B0); PG8_BAR; PG8_SCHED;
            PG8_STAGE(PG8_SB(0, 1), b2 + hstep, voffB);
            PG8_WAIT_V(6); PG8_BAR; PG8_MMA(1, 1, At, B1); PG8_BAR;
            PG8_LDB(B0, 1, 0); PG8_SCHED; PG8_LDA(At, 1, 0); PG8_STAGE2(PG8_SA(0, 1), a2, x10, x11);
            PG8_WAIT_L(8); PG8_BAR; PG8_WAIT_L(0); PG8_MMA(0, 0, At, B0); PG8_BAR; PG8_SCHED;
            PG8_LDB(B1, 1, 1); PG8_STAGE(PG8_SB(1, 0), b3, voffB);
            PG8_BAR; PG8_WAIT_L(0); PG8_MMA(0, 1, At, B1); PG8_BAR;
            PG8_LDA(At, 1, 1); PG8_STAGE2(PG8_SA(1, 0), a3, x00, x01);
            PG8_BAR; PG8_WAIT_L(0); PG8_MMA(1, 0, At, B0); PG8_BAR; PG8_SCHED;
            PG8_STAGE(PG8_SB(1, 1), b3 + hstep, voffB);
            PG8_WAIT_V(6); PG8_BAR; PG8_MMA(1, 1, At, B1); PG8_BAR;
        }
        E(acc, cur, wr, wc, fr, fq);
        if (!has_next) break;
#pragma unroll
        for (int a = 0; a < 2; ++a)
#pragma unroll
            for (int b = 0; b < 2; ++b)
#pragma unroll
                for (int m = 0; m < 4; ++m)
#pragma unroll
                    for (int n = 0; n < 2; ++n) acc[a][b][m][n] = (f32x4){0.f, 0.f, 0.f, 0.f};
        cur = nxt; cB = nB; aC = aN; ++ui;
#pragma unroll
        for (int _h = 0; _h < 2; ++_h)
#pragma unroll
            for (int _i = 0; _i < 2; ++_i) vc[_h][_i] = vn[_h][_i];
    }
    PG8_WAIT_V(0);
    if (wr == 0) PG8_BAR;
    PG8_BAR;
#undef PG8_SA
#undef PG8_SB
#undef PG8_STAGE
#undef PG8_STAGE2
#undef PG8_LDA
#undef PG8_LDB
#undef PG8_MMA
#undef PG8_WAIT_V
#undef PG8_WAIT_L
#undef PG8_BAR
#undef PG8_SCHED
#undef PG8_AOFFS
}
}

struct Args { const float* in[25]; float* out; unsigned char* ws; int ph_lo, ph_hi; };
struct Frame {
    LAS unsigned char* lds; int tid, lane, wave, G, bid;
    float* out; unsigned char* ws; unsigned* ctl;
};
__device__ __forceinline__ const float* inp_ptr(const Frame& F, int k) {
    const LAS unsigned* t = (const LAS unsigned*)(F.lds + MISC_OFF + 256) + 2 * k;
    const unsigned lo = __builtin_amdgcn_readfirstlane(t[0]), hi = __builtin_amdgcn_readfirstlane(t[1]);
    return (const float*)(const GAS float*)(((unsigned long long)hi << 32) | lo);
}
#define INP(k) inp_ptr(F, (k))
__device__ __forceinline__ Frame fresh(const Frame& F) {
    Frame P = F;
    int z = 0;
    asm volatile("" : "+s"(z), "+s"(P.G), "+s"(P.bid), "+s"(P.wave));
    P.lane = lane_id_volatile() & 63; P.tid = (P.wave << 6) | P.lane;
    P.ws = F.ws + z; P.out = F.out + z;
    P.wave &= 7; P.ctl = (unsigned*)(P.ws + WS_CTL);
    return P;
}
__device__ __forceinline__ int fresh_i(int v) { asm volatile("" : "+s"(v)); return v; }
#define WSP(T, off) ((T*)(F.ws + (off)))

template <class T> __device__ __forceinline__ T* opaque(T* p) { int z = 0; asm volatile("" : "+s"(z)); return p + z; }
__device__ __forceinline__ u32x4 pack8(const f32x4 a, const f32x4 b) { u32x4 w; w.x = pk2(a[0], a[1]); w.y = pk2(a[2], a[3]); w.z = pk2(b[0], b[1]); w.w = pk2(b[2], b[3]); return w; }
__device__ __forceinline__ f32x4 sigm4(const f32x4 a) { const f32x4 z = a * -1.4426950408889634f; f32x4 e, r;
#pragma unroll
    for (int j = 0; j < 4; ++j) e[j] = __builtin_amdgcn_exp2f(z[j]);
    const f32x4 d = e + 1.0f;
#pragma unroll
    for (int j = 0; j < 4; ++j) r[j] = __builtin_amdgcn_rcpf(d[j]);
    return r; }
__device__ __forceinline__ f32x4 silu4(const f32x4 a) { return a * sigm4(a); }
__device__ __forceinline__ f32x4 lsig4(const f32x4 a) { return (f32x4){logsigmoidf_(a[0]), logsigmoidf_(a[1]), logsigmoidf_(a[2]), logsigmoidf_(a[3])}; }
__device__ __forceinline__ void fgate4(const f32x4 x, const f32x4 lbv, f32x4& kk, f32x4& la) {
    const f32x4 z = x * -1.4426950408889634f; f32x4 e, sg, lg;
#pragma unroll
    for (int j = 0; j < 4; ++j) e[j] = __builtin_amdgcn_exp2f(fminf(z[j], 125.0f));
    const f32x4 d = e + 1.0f;
#pragma unroll
    for (int j = 0; j < 4; ++j) sg[j] = __builtin_amdgcn_rcpf(d[j]);
    const f32x4 om = 1.0f - lbv;
    const f32x4 f = lbv + om * sg;
    kk = om * (1.0f - sg);
#pragma unroll
    for (int j = 0; j < 4; ++j) lg[j] = __builtin_amdgcn_logf(f[j]);
    la = lg * 0.6931471805599453f;
}
template <int KIND>
__device__ __forceinline__ void rec_group(unsigned char* ws, const float* bias, const float* lb, f32x4 v0, f32x4 v1, int row, int gc, int sc, int ct, int wc, int fq, int fr, bool latent) {
    const bool gate_lane = (KIND != 9) || (ct < 16);
    const int gcs = gate_lane ? gc : 0;
    v0 += *(const f32x4*)((const char*)bias + (unsigned)(gcs * 4)); v1 += *(const f32x4*)((const char*)bias + (unsigned)(gcs * 4 + 16));
    if (KIND == 0) {
        *(u32x4*)(ws + WS_Q + (unsigned)(row * 1024 + sc * 2)) = pack8(silu4(v0) * 0.08838834764831845f, silu4(v1) * 0.08838834764831845f);
    } else if (KIND == 1 || KIND == 2) {
        f32x4 k0, k1, l0, l1;
        fgate4(v0, *(const f32x4*)((const char*)lb + (unsigned)(sc * 4)), k0, l0); fgate4(v1, *(const f32x4*)((const char*)lb + (unsigned)(sc * 4 + 16)), k1, l1);
        *(u32x4*)(ws + (KIND == 1 ? WS_KF : WS_KB) + (unsigned)(row * 1024 + sc * 2)) = pack8(k0, k1);
        float* lp = (float*)(ws + (KIND == 1 ? WS_LAF : WS_LAB) + (unsigned)(row * 2048 + sc * 4));
        *(f32x4*)lp = l0; *(f32x4*)(lp + 4) = l1;
    } else if (KIND == 3 || KIND == 4 || KIND == 7 || KIND == 8) {
        if (KIND == 4) { v0 = silu4(v0); v1 = silu4(v1); }
        if (KIND == 8) { v0 = sigm4(v0); v1 = sigm4(v1); }
        const size_t off = KIND == 3 ? WS_V : KIND == 4 ? WS_HG : KIND == 7 ? WS_MV : WS_MO;
        *(u32x4*)(ws + off + (unsigned)(row * 1024 + sc * 2)) = pack8(v0, v1);
    } else if (KIND == 5 || KIND == 6) {
        if (KIND == 6) { v0 *= 0.125f; v1 *= 0.125f; }
        f32x4 p0, p1;
#pragma unroll
        for (int j = 0; j < 4; ++j) { p0[j] = shx(v0[j], 32, fq * 16 + fr); p1[j] = shx(v1[j], 32, fq * 16 + fr); }
        if (latent) {
            const int t = row & 8191; const int pos = (wc & 1) ? (t & 63) : (t >> 6);
            const f32x4* rp = (const f32x4*)((const f32x2*)(ws + WS_ROPE) + pos * 16 + 8 * (fq & 1));
            const f32x4 c01 = rp[0], c23 = rp[1], c45 = rp[2], c67 = rp[3];
            const f32x4 cs0 = (f32x4){c01[0], c01[2], c23[0], c23[2]}, sn0 = (f32x4){c01[1], c01[3], c23[1], c23[3]};
            const f32x4 cs1 = (f32x4){c45[0], c45[2], c67[0], c67[2]}, sn1 = (f32x4){c45[1], c45[3], c67[1], c67[3]};
            const float sg = (fq >= 2) ? 1.0f : -1.0f;
            v0 = v0 * cs0 + sg * (p0 * sn0); v1 = v1 * cs1 + sg * (p1 * sn1);
        }
        *(u32x4*)(ws + (KIND == 5 ? WS_MQ : WS_MK) + (unsigned)(row * 512 + sc * 2)) = pack8(v0, v1);
    } else {
        if (gate_lane) { float* gp = (float*)(ws + WS_GATES + (unsigned)(row * 64 + ct * 4)); *(f32x4*)gp = v0; *(f32x4*)(gp + 4) = lsig4(v1); }
    }
}
struct EpiRec {
    static constexpr bool PERM = true;
    unsigned char* ws; const float* bias; const float* lb; int layer;
    template <int KIND>
    __device__ __forceinline__ void run(const f32x4 (&acc)[2][2][4][2], const pg8::Unit& u, int wr, int wc, int fr, int fq, int cbase  ) const {
        const int row0 = u.pm * 256 + wr * 64 + fr;
        const bool latent = u.pm < 128;
#define REC_G(ai, m) { const int row = row0 + (ai) * 128 + (m) * 16; \
        { const int ct = wc * 32 + 8 * fq; rec_group<KIND>(ws, bias, lb, acc[ai][0][m][0], acc[ai][0][m][1], row, u.pn * 256 + ct, cbase + ct, ct, wc, fq, fr, latent); } \
        if (KIND != 9) { const int ct = 128 + wc * 32 + 8 * fq; rec_group<KIND>(ws, bias, lb, acc[ai][1][m][0], acc[ai][1][m][1], row, u.pn * 256 + ct, cbase + ct, ct, wc, fq, fr, latent); } if ((m) == 3) asm volatile("" ::: "memory"); }
        REC_G(0, 0) REC_G(0, 1) REC_G(0, 2) REC_G(0, 3) REC_G(1, 0) REC_G(1, 1) REC_G(1, 2) REC_G(1, 3)
#undef REC_G
    }
    __device__ __forceinline__ void operator()(const f32x4 (&acc)[2][2][4][2], const pg8::Unit& u, int wr, int wc, int fr, int fq) const {
        const int pn = u.pn;
        EpiRec o{opaque(ws), opaque(bias), opaque(lb), layer};
        asm volatile("" : "+v"(fr), "+v"(fq));
        o.dispatch(acc, u, wr, wc, fr, fq, pn);
    }
    __device__ __forceinline__ void dispatch(const f32x4 (&acc)[2][2][4][2], const pg8::Unit& u, int wr, int wc, int fr, int fq, int pn) const {
        if (pn < 2) run<0>(acc, u, wr, wc, fr, fq, pn * 256);
        else if (pn < 4) run<1>(acc, u, wr, wc, fr, fq, (pn - 2) * 256);
        else if (pn < 6) run<2>(acc, u, wr, wc, fr, fq, (pn - 4) * 256);
        else if (pn < 8) run<3>(acc, u, wr, wc, fr, fq, (pn - 6) * 256);
        else if (pn < 10) run<4>(acc, u, wr, wc, fr, fq, (pn - 8) * 256);
        else if (pn == 10) run<5>(acc, u, wr, wc, fr, fq, 0);
        else if (pn == 11) run<6>(acc, u, wr, wc, fr, fq, 0);
        else if (pn < 14) run<7>(acc, u, wr, wc, fr, fq, (pn - 12) * 256);
        else if (pn < 16) run<8>(acc, u, wr, wc, fr, fq, (pn - 14) * 256);
        else run<9>(acc, u, wr, wc, fr, fq, 0);
    }
};
struct EpiQKV {
    static constexpr bool PERM = true;
    unsigned char* ws;
    __device__ __forceinline__ void operator()(const f32x4 (&acc)[2][2][4][2], const pg8::Unit& u, int wr, int wc, int fr, int fq) const {
        const int row0 = u.pm * 256 + wr * 64 + fr;
        unsigned char* w_ = opaque(ws);
        asm volatile("" : "+v"(fr), "+v"(fq));
        if (u.pn < 8) {
            const int col0 = u.pn * 256 + wc * 32 + 8 * fq;
#pragma unroll
            for (int ai = 0; ai < 2; ++ai)
#pragma unroll
                for (int m = 0; m < 4; ++m) { const int row = row0 + ai * 128 + m * 16; const unsigned ob = (unsigned)(row * 3072 + col0) * 2u;
#pragma unroll
                    for (int bj = 0; bj < 2; ++bj) { const f32x4 v0 = acc[ai][bj][m][0], v1 = acc[ai][bj][m][1];
                        *(u32x4*)(w_ + WS_QKV + (ob + bj * 256u)) = pack8(v0, v1);
                        if (u.pn >= 4) {
                            float ss = (v0[0] * v0[0] + v0[1] * v0[1]) + (v0[2] * v0[2] + v0[3] * v0[3]) + (v1[0] * v1[0] + v1[1] * v1[1]) + (v1[2] * v1[2] + v1[3] * v1[3]);
                            const int lane = fq * 16 + fr; ss += shx(ss, 16, lane); ss += shx(ss, 32, lane);
                            if (fq == 0) atomicAdd((float*)(w_ + WS_SSK) + row * 16 + (((u.pn - 4) * 256 + bj * 128 + wc * 32) >> 6), ss); } } }
        } else {
            const int b = u.pm < 128 ? (u.pm >> 5) : (u.pm - 128); const int tt0 = u.pm < 128 ? ((u.pm & 31) * 256) : TL;
#pragma unroll
            for (int ai = 0; ai < 2; ++ai)
#pragma unroll
                for (int m = 0; m < 4; ++m) { const int tt = tt0 + wr * 64 + fr + ai * 128 + m * 16;
#pragma unroll
                    for (int bj = 0; bj < 2; ++bj) { const int c = (u.pn - 8) * 256 + bj * 128 + wc * 32 + 8 * fq;
                        const unsigned base = (unsigned)(((b * 16 + (c >> 6)) * 64 + (c & 63)) * TT + tt) * 2u;
                        const u32x4 pk = pack8(acc[ai][bj][m][0], acc[ai][bj][m][1]); const unsigned pw[4] = {pk.x, pk.y, pk.z, pk.w};
#pragma unroll
                        for (int q = 0; q < 8; ++q) *(bf16_t*)(w_ + WS_VTG + (base + (unsigned)q * (TT * 2u))) = (bf16_t)((q & 1) ? (pw[q >> 1] >> 16) : (pw[q >> 1] & 0xffffu)); } }
        }
    }
};
struct EpiResid {
    static constexpr bool PERM = true;
    bf16_t* Y; const float* modl;
    __device__ __forceinline__ void operator()(const f32x4 (&acc)[2][2][4][2], const pg8::Unit& u, int wr, int wc, int fr, int fq) const {
        const int row0 = u.pm * 256 + wr * 64 + fr, col0 = u.pn * 256 + wc * 32 + 8 * fq;
        const int bidx = u.pm < 128 ? (u.pm >> 5) : 4;
        bf16_t* Y = opaque(this->Y);
        const float* g = opaque(modl) + bidx * 6144 + 2048 + col0;
        f32x4 gv[2][2];
#pragma unroll
        for (int bj = 0; bj < 2; ++bj) { gv[bj][0] = *(const f32x4*)(g + bj * 128); gv[bj][1] = *(const f32x4*)(g + bj * 128 + 4); }
#pragma unroll
        for (int ai = 0; ai < 2; ++ai)
#pragma unroll
            for (int m = 0; m < 4; ++m) { const unsigned ob = (unsigned)((row0 + ai * 128 + m * 16) * 1024 + col0) * 2u;
#pragma unroll
                for (int bj = 0; bj < 2; ++bj) *(u32x4*)((char*)Y + (ob + bj * 256u)) = pack8(acc[ai][bj][m][0] * gv[bj][0], acc[ai][bj][m][1] * gv[bj][1]); }
    }
};
__device__ __forceinline__ f32x4 swiglu4(const f32x4 g, const f32x4 u) {
    f32x4 gt, up, e, r;
#pragma unroll
    for (int j = 0; j < 4; ++j) { gt[j] = fminf(g[j], 7.0f); up[j] = __builtin_amdgcn_fmed3f(u[j], -7.0f, 7.0f); }
    const f32x4 z = gt * -2.4554669595930157f;
#pragma unroll
    for (int j = 0; j < 4; ++j) e[j] = __builtin_amdgcn_exp2f(z[j]);
    const f32x4 d = e + 1.0f;
#pragma unroll
    for (int j = 0; j < 4; ++j) r[j] = __builtin_amdgcn_rcpf(d[j]);
    return (gt * r) * (up + 1.0f);
}
struct EpiMoe1 {
    static constexpr bool PERM = true;
    bf16_t* ACT; const float* bgu;
    __device__ __forceinline__ void operator()(const f32x4 (&acc)[2][2][4][2], const pg8::Unit& u, int wr, int wc, int fr, int fq) const {
        const int row0 = u.pm * 256 + wr * 64 + fr, c0 = u.pn * 128 + wc * 32 + 8 * fq;
        bf16_t* ACT = opaque(this->ACT);
        const float* bg = opaque(bgu) + (size_t)u.e * 2048 + c0; const float* bu = bg + 1024;
        const f32x4 g0 = *(const f32x4*)bg, g1 = *(const f32x4*)(bg + 4), u0 = *(const f32x4*)bu, u1 = *(const f32x4*)(bu + 4);
#pragma unroll
        for (int ai = 0; ai < 2; ++ai)
#pragma unroll
            for (int m = 0; m < 4; ++m) {
                const f32x4 ga = acc[ai][0][m][0] + g0, gb = acc[ai][0][m][1] + g1, ua = acc[ai][1][m][0] + u0, ub = acc[ai][1][m][1] + u1;
                const f32x4 ra = swiglu4(ga, ua), rb = swiglu4(gb, ub);
                const float r[8] = {ra[0], ra[1], ra[2], ra[3], rb[0], rb[1], rb[2], rb[3]};
                u32x4 w; w.x = pk2(r[0], r[1]); w.y = pk2(r[2], r[3]); w.z = pk2(r[4], r[5]); w.w = pk2(r[6], r[7]);
                *(u32x4*)((char*)ACT + (unsigned)((row0 + ai * 128 + m * 16) * 1024 + c0) * 2u) = w;
            }
    }
};
struct EpiMoe2 {
    static constexpr bool PERM = true;
    bf16_t* YS; const float* bd;
    __device__ __forceinline__ void operator()(const f32x4 (&acc)[2][2][4][2], const pg8::Unit& u, int wr, int wc, int fr, int fq) const {
        const int row0 = u.pm * 256 + wr * 64 + fr, col0 = u.pn * 256 + wc * 32 + 8 * fq;
        bf16_t* YS = opaque(this->YS);
        const float* b = opaque(bd) + (size_t)u.e * 1024 + col0;
        f32x4 bv[2][2];
#pragma unroll
        for (int bj = 0; bj < 2; ++bj) { bv[bj][0] = *(const f32x4*)(b + bj * 128); bv[bj][1] = *(const f32x4*)(b + bj * 128 + 4); }
#pragma unroll
        for (int ai = 0; ai < 2; ++ai)
#pragma unroll
            for (int m = 0; m < 4; ++m) { const unsigned ob = (unsigned)((row0 + ai * 128 + m * 16) * 1024 + col0) * 2u;
#pragma unroll
                for (int bj = 0; bj < 2; ++bj) *(u32x4*)((char*)YS + (ob + bj * 256u)) = pack8(acc[ai][bj][m][0] + bv[bj][0], acc[ai][bj][m][1] + bv[bj][1]); }
    }
};

__device__ __forceinline__ void transpose_item(const float* W, int K, int N, bf16_t* WT, int drow0, LAS float* scr, int k0, int n0, int lane) {
    const int n = n0 + (lane & 31); const bool ok = n < N;
#pragma unroll 8
    for (int i = 0; i < 32; ++i) { const int kk = 2 * i + (lane >> 5); scr[kk * 33 + (lane & 31)] = ok ? __builtin_nontemporal_load(W + (size_t)(k0 + kk) * N + n) : 0.f; }
    asm volatile("s_waitcnt lgkmcnt(0)" ::: "memory");
    const int c = lane & 7;
#pragma unroll
    for (int j = 0; j < 4; ++j) { const int nn = (lane >> 3) + 8 * j; const LAS float* s = scr + (8 * c) * 33 + nn;
        u32x4 o; o.x = pk2(s[0 * 33], s[1 * 33]); o.y = pk2(s[2 * 33], s[3 * 33]); o.z = pk2(s[4 * 33], s[5 * 33]); o.w = pk2(s[6 * 33], s[7 * 33]);
        __builtin_nontemporal_store(o, (u32x4*)(WT + (size_t)(drow0 + nn) * K + k0 + 8 * c)); }
    asm volatile("s_waitcnt lgkmcnt(0)" ::: "memory");
}
__device__ __forceinline__ void phase_prologue(Frame& F) {
    {
        LAS float* s = (LAS float*)(F.lds);
        LAS float* part = (LAS float*)(F.lds + 32768);
        bool have_s = false;
        for (int item = F.bid; item < 384; item += F.G) {
            if (!have_s) {
                for (int i = F.tid; i < 5 * 1024; i += 512) { const int b = i >> 10, k = i & 1023; const float c = b < 4 ? INP(1)[b * 1024 + k] : INP(3)[k]; s[i] = siluf_(c); }
                have_s = true;
            }
            __syncthreads();
            const int l = item / 96, n0 = (item % 96) * 64, ci = F.tid & 63, kg = F.tid >> 6;
            const float* w = INP(4) + ((size_t)l * 1024 + kg * 128) * 6144 + n0 + ci;
            float a0 = 0.f, a1 = 0.f, a2 = 0.f, a3 = 0.f, a4 = 0.f;
#pragma unroll 8
            for (int k = 0; k < 128; ++k) { const float wv = w[(size_t)k * 6144]; const int kk = kg * 128 + k;
                a0 += s[kk] * wv; a1 += s[1024 + kk] * wv; a2 += s[2048 + kk] * wv; a3 += s[3072 + kk] * wv; a4 += s[4096 + kk] * wv; }
            part[(kg * 5 + 0) * 64 + ci] = a0; part[(kg * 5 + 1) * 64 + ci] = a1; part[(kg * 5 + 2) * 64 + ci] = a2; part[(kg * 5 + 3) * 64 + ci] = a3; part[(kg * 5 + 4) * 64 + ci] = a4;
            __syncthreads();
            if (F.tid < 320) { const int b = F.tid >> 6, c2 = F.tid & 63; float sum = INP(5)[l * 6144 + n0 + c2];
#pragma unroll
                for (int g = 0; g < 8; ++g) sum += part[(g * 5 + b) * 64 + c2];
                WSP(float, WS_MOD)[(l * 5 + b) * 6144 + n0 + c2] = sum; }
        }
        __syncthreads();
        if (F.bid == (F.G > 1 ? F.G - 1 : 0)) {
            const int c = F.tid; const float* hl = INP(11);
            const float v0 = hl[c], v1 = hl[512 + c], v2 = hl[1024 + c], v3 = hl[1536 + c];
            const float mx = fmaxf(fmaxf(v0, v1), fmaxf(v2, v3));
            const float e0 = expf(v0 - mx), e1 = expf(v1 - mx), e2 = expf(v2 - mx), e3 = expf(v3 - mx); const float inv = 1.0f / (e0 + e1 + e2 + e3);
            float* LB = WSP(float, WS_LB);
            LB[c] = 0.f; LB[512 + c] = fmaxf(e1 * inv, 0.f); LB[1024 + c] = fmaxf((e1 + e2) * inv, 0.f); LB[1536 + c] = fmaxf((e1 + e2 + e3) * inv, 0.f);
        }
        if (F.bid == (F.G > 2 ? F.G - 2 : 0)) {
            for (int i = F.tid; i < 2048; i += 512) { const int pos = i >> 4, q = i & 15; const float inv = powf(10000.0f, -(float)q / 16.0f); const float ang = (float)pos * inv;
                WSP(f32x2, WS_ROPE)[i] = (f32x2){cosf(ang), sinf(ang)}; }
        }
        __syncthreads();
    }
    LAS float* scr = (LAS float*)(F.lds + F.wave * 16384);
    const int gw = F.bid * 8 + F.wave, NGW = F.G * 8;
    constexpr int I_WIN = 16 * 136, I_SQ = 16 * 32, I_QKV = 16 * 96, I_GU = 16 * 64;
    constexpr int N0 = 2 * I_WIN, N1 = N0 + 2 * I_SQ, N2 = N1 + 2 * I_QKV, N3 = N2 + 2 * I_SQ, N4 = N3 + 128 * I_GU, N5 = N4 + 128 * I_SQ;
    for (int it = gw; it < N5; it += NGW) {
        if (it < N0) { const int j = it / I_WIN, r = it % I_WIN, kb = r / 136, nb = r % 136;
            transpose_item(INP(8) + (size_t)j * 1024 * 4112, 1024, 4112, WSP(bf16_t, WS_WIN) + (size_t)j * NREC * 1024, nb * 32, scr, kb * 64, nb * 32, F.lane); }
        else if (it < N1) { const int q = it - N0, j = q / I_SQ, r = q % I_SQ, kb = r / 32, nb = r % 32;
            transpose_item(INP(10) + (size_t)j * 1024 * 1024, 1024, 1024, WSP(bf16_t, WS_WROUT) + (size_t)j * 1024 * 1024, nb * 32, scr, kb * 64, nb * 32, F.lane); }
        else if (it < N2) { const int q = it - N1, j = q / I_QKV, r = q % I_QKV, kb = r / 96, nb = r % 96;
            transpose_item(INP(14) + (size_t)j * 1024 * 3072, 1024, 3072, WSP(bf16_t, WS_WQKV) + (size_t)j * 3072 * 1024, nb * 32, scr, kb * 64, nb * 32, F.lane); }
        else if (it < N3) { const int q = it - N2, j = q / I_SQ, r = q % I_SQ, kb = r / 32, nb = r % 32;
            transpose_item(INP(15) + (size_t)j * 1024 * 1024, 1024, 1024, WSP(bf16_t, WS_WNOUT) + (size_t)j * 1024 * 1024, nb * 32, scr, kb * 64, nb * 32, F.lane); }
        else if (it < N4) { const int q = it - N3, j = q / I_GU, r = q % I_GU, kb = r / 64, nb = r % 64; const int n0 = nb * 32;
            const int nn = n0 & 1023; const int drow = 256 * (nn >> 7) + (n0 >= 1024 ? 128 : 0) + (nn & 127);
            transpose_item(INP(21) + (size_t)j * 1024 * 2048, 1024, 2048, WSP(bf16_t, WS_WGU) + (size_t)j * 2048 * 1024, drow, scr, kb * 64, n0, F.lane); }
        else { const int q = it - N4, j = q / I_SQ, r = q % I_SQ, kb = r / 32, nb = r % 32;
            transpose_item(INP(23) + (size_t)j * 1024 * 1024, 1024, 1024, WSP(bf16_t, WS_WD) + (size_t)j * 1024 * 1024, nb * 32, scr, kb * 64, nb * 32, F.lane); }
    }
    __syncthreads();
}

__device__ __forceinline__ void expert_prefix(const Frame& F, int l, LAS int* base_out, LAS int* cnt_out, int scale, bool total) {
    if (F.tid < 64) {
        const int e = F.tid & 31;
        const int c = (int)F.ctl[CW_CNT + (l * 32 + e) * 64];
        const int t = (F.tid < 32) ? ((c + 255) >> 8) : 0;
        int incl = t;
#pragma unroll
        for (int o = 1; o < 32; o <<= 1) { const int y = __builtin_amdgcn_ds_bpermute(((F.tid - o) & 63) << 2, incl); if (F.tid >= o) incl += y; }
        if (F.tid < 32) { base_out[e] = (incl - t) * scale; if (cnt_out) cnt_out[e] = c; }
        if (total && F.tid == 31) base_out[32] = incl * scale;
    }
}
template <int MODE>
__device__ __forceinline__ void phase_norm1(Frame& F, int l) {
    LAS int* sbase = (LAS int*)(F.lds + MISC_OFF + 1024);
    if (MODE != 0) {
        expert_prefix(F, l - 1, sbase, (LAS int*)0, 256, false);
        __syncthreads();
    }
    const int gw = F.bid * 8 + F.wave, NGW = F.G * 8;
    bf16_t* X = WSP(bf16_t, WS_X); bf16_t* H = WSP(bf16_t, WS_H); const bf16_t* YS = WSP(bf16_t, WS_YS);
    const float* MOD = WSP(float, WS_MOD);
    const int* TE = WSP(int, WS_TOKE); const int* TP = WSP(int, WS_TOKP); const float* TW = WSP(float, WS_TOKW);
    const int nrows = (MODE == 2) ? RL : NR;
    for (int pr = gw; pr < nrows / 2; pr += NGW) {
        const int row0 = 2 * pr; const int bidx = row_bidx(row0);
        f32x4 v[2][4];
#pragma unroll
        for (int rr = 0; rr < 2; ++rr) { const int row = row0 + rr;
            if (MODE == 0) { const float* src = row < RL ? INP(0) + (size_t)row * 1024 : INP(2) + (size_t)(row - RL) * 1024;
#pragma unroll
                for (int j = 0; j < 4; ++j) v[rr][j] = __builtin_nontemporal_load((const f32x4*)(src + 4 * F.lane + 256 * j)); }
            else { const bf16_t* src = X + (size_t)row * 1024;
#pragma unroll
                for (int j = 0; j < 4; ++j) v[rr][j] = h4_to_f4(__builtin_nontemporal_load((const u32x2*)(src + 4 * F.lane + 256 * j))); } }
        if (MODE != 0) {
            u32x2 ys[2][4][4]; float wk[2][4];
#pragma unroll
            for (int rr = 0; rr < 2; ++rr)
#pragma unroll
                for (int k = 0; k < 4; ++k) { const int row = row0 + rr; const int e = TE[row * 4 + k], p = TP[row * 4 + k]; wk[rr][k] = TW[row * 4 + k];
                    const bf16_t* yr = YS + (size_t)(sbase[e] + p) * 1024 + 4 * F.lane;
#pragma unroll
                    for (int j = 0; j < 4; ++j) ys[rr][k][j] = __builtin_nontemporal_load((const u32x2*)(yr + 256 * j)); }
            const float* g2 = MOD + ((l - 1) * 5 + bidx) * 6144 + 5120 + 4 * F.lane;
#pragma unroll
            for (int j = 0; j < 4; ++j) { const f32x4 gg = *(const f32x4*)(g2 + 256 * j);
#pragma unroll
                for (int rr = 0; rr < 2; ++rr) { f32x4 f = (f32x4){0.f, 0.f, 0.f, 0.f};
#pragma unroll
                    for (int k = 0; k < 4; ++k) { const u32x2 q = ys[rr][k][j]; f += wk[rr][k] * (f32x4){bf2f(q.x & 0xffffu), bf2f(q.x >> 16), bf2f(q.y & 0xffffu), bf2f(q.y >> 16)}; }
                    v[rr][j] += gg * f; } }
        }
        if (MODE == 2) {
#pragma unroll
            for (int rr = 0; rr < 2; ++rr)
#pragma unroll
                for (int j = 0; j < 4; ++j) __builtin_nontemporal_store(v[rr][j], (f32x4*)(F.out + (size_t)(row0 + rr) * 1024 + 4 * F.lane + 256 * j));
            continue;
        }
        if (F.lane < 32) WSP(float, WS_SSK)[row0 * 16 + F.lane] = 0.f;
        float rstd[2];
#pragma unroll
        for (int rr = 0; rr < 2; ++rr) { float ss = 0.f;
#pragma unroll
            for (int j = 0; j < 4; ++j) { __builtin_nontemporal_store(f4_to_h4(v[rr][j]), (u32x2*)(X + (size_t)(row0 + rr) * 1024 + 4 * F.lane + 256 * j));
                ss += (v[rr][j][0] * v[rr][j][0] + v[rr][j][1] * v[rr][j][1]) + (v[rr][j][2] * v[rr][j][2] + v[rr][j][3] * v[rr][j][3]); }
            rstd[rr] = rsqrtf(wave_sum(ss, F.lane) * (1.0f / 1024.0f) + EPS); }
        const float* gm = INP(6) + l * 1024; const float* sh = MOD + (l * 5 + bidx) * 6144; const float* sc = sh + 1024;
#pragma unroll
        for (int j = 0; j < 4; ++j) { const int c = 4 * F.lane + 256 * j;
            const f32x4 g = *(const f32x4*)(gm + c), s1 = *(const f32x4*)(sc + c), s0 = *(const f32x4*)(sh + c); const f32x4 gs = g * (1.0f + s1);
#pragma unroll
            for (int rr = 0; rr < 2; ++rr) { const f32x4 h = v[rr][j] * rstd[rr] * gs + s0;
                u32x2 w; w.x = pk2(h[0], h[1]); w.y = pk2(h[2], h[3]);
                *(u32x2*)(H + (size_t)(row0 + rr) * 1024 + c) = w; } }
    }
}

__device__ __forceinline__ void router_finish(Frame& F, float (&lg)[32], int row, int r0, const float* br, LAS int* hist, LAS int* sel, float* TW) {
#pragma unroll
    for (int s5 = 0; s5 < 5; ++s5) { const int half = 16 >> s5; const bool up = (F.lane >> (5 - s5)) & 1;
#pragma unroll
        for (int i = 0; i < half; ++i) { const float a2 = lg[i], b2 = lg[i + half]; const float send = up ? a2 : b2, keep = up ? b2 : a2; lg[i] = keep + shx(send, 32 >> s5, F.lane); } }
    float logit = lg[0] + shx(lg[0], 1, F.lane);
    const int myE = F.lane >> 1;
    logit += br[myE];
    int rank = 0;
#pragma unroll
    for (int e = 0; e < 32; ++e) { const float le = __int_as_float(__builtin_amdgcn_readlane(__float_as_int(logit), 2 * e)); rank += (le > logit || (le == logit && e < myE)) ? 1 : 0; }
    float tv[4]; int ti[4];
#pragma unroll
    for (int k = 0; k < 4; ++k) { const unsigned long long bm = __ballot(rank == k); const int src = __builtin_amdgcn_readfirstlane((int)__builtin_ctzll(bm));
        tv[k] = __int_as_float(__builtin_amdgcn_readlane(__float_as_int(logit), src)); ti[k] = src >> 1; }
    const float e1 = __expf(tv[1] - tv[0]), e2 = __expf(tv[2] - tv[0]), e3 = __expf(tv[3] - tv[0]); const float inv = 1.0f / (1.0f + e1 + e2 + e3);
    if (F.lane < 4) { const int k = F.lane; const int e = k == 0 ? ti[0] : k == 1 ? ti[1] : k == 2 ? ti[2] : ti[3]; const float w = (k == 0 ? 1.0f : k == 1 ? e1 : k == 2 ? e2 : e3) * inv;
        const int lpos = atomicAdd((int*)&hist[e], 1);
        sel[(row - r0) * 4 + k] = e | (lpos << 8);
        TW[row * 4 + k] = w; }
}
__device__ __forceinline__ void phase_router(Frame& F, int l) {
    LAS float* wr = (LAS float*)F.lds;
    LAS int* hist = (LAS int*)(F.lds + MISC_OFF + 1024);
    LAS int* gbase = hist + 32;
    LAS int* sel = gbase + 32;
    const float* wsrc = INP(19) + (size_t)l * 1024 * 32;
    for (int i = F.tid; i < 1024 * 8; i += 512) { const int k = i >> 3, ch = i & 7; const f32x4 w = *(const f32x4*)(wsrc + k * 32 + ch * 4);
        const int p = (k >> 2) + 256 * (k & 3); *(LAS f32x4*)(wr + p * 32 + 4 * ((ch + (p >> 1)) & 7)) = w; }
    if (F.tid < 32) hist[F.tid] = 0;
    __syncthreads();
    const int NRr = (l == 3) ? RL : NR;
    const int RPB = (((NRr + F.G - 1) / F.G) + 1) & ~1;
    const int r0 = min(F.bid * RPB, NRr), r1 = min(r0 + RPB, NRr);
    bf16_t* X = WSP(bf16_t, WS_X); bf16_t* H = WSP(bf16_t, WS_H); const float* MOD = WSP(float, WS_MOD);
    int* TE = WSP(int, WS_TOKE); int* TP = WSP(int, WS_TOKP); float* TW = WSP(float, WS_TOKW); int* LIST = WSP(int, WS_LIST);
    const float* br = INP(20) + l * 32;
    const int rotl = F.lane >> 1;
    const LAS float* wbase = wr + F.lane * 32; int roff[8];
#pragma unroll
    for (int ch = 0; ch < 8; ++ch) roff[ch] = 4 * ((ch + rotl) & 7);
    for (int rowA = r0 + 2 * F.wave; rowA < r1; rowA += 16) {
        const bool hasB = rowA + 1 < r1; const int rowB = hasB ? rowA + 1 : rowA;
        const int bidx = row_bidx(rowA);
        bf16_t* xa = X + (size_t)rowA * 1024 + 4 * F.lane; bf16_t* xb = X + (size_t)rowB * 1024 + 4 * F.lane;
        const bf16_t* ya = WSP(bf16_t, WS_Y) + (size_t)rowA * 1024 + 4 * F.lane; const bf16_t* yb = WSP(bf16_t, WS_Y) + (size_t)rowB * 1024 + 4 * F.lane;
        float ssa = 0.f, ssb = 0.f;
#pragma unroll
        for (int j = 0; j < 4; ++j) { f32x4 va = h4_to_f4(*(const u32x2*)(xa + 256 * j)), vb = h4_to_f4(*(const u32x2*)(xb + 256 * j));
            { const u32x2 q = __builtin_nontemporal_load((const u32x2*)(ya + 256 * j)); va += (f32x4){bf2f(q.x & 0xffffu), bf2f(q.x >> 16), bf2f(q.y & 0xffffu), bf2f(q.y >> 16)}; *(u32x2*)(xa + 256 * j) = f4_to_h4(va); }
            if (hasB) { const u32x2 q = __builtin_nontemporal_load((const u32x2*)(yb + 256 * j)); vb += (f32x4){bf2f(q.x & 0xffffu), bf2f(q.x >> 16), bf2f(q.y & 0xffffu), bf2f(q.y >> 16)}; *(u32x2*)(xb + 256 * j) = f4_to_h4(vb); }
            ssa += (va[0] * va[0] + va[1] * va[1]) + (va[2] * va[2] + va[3] * va[3]); ssb += (vb[0] * vb[0] + vb[1] * vb[1]) + (vb[2] * vb[2] + vb[3] * vb[3]); }
        const float rsa = rsqrtf(wave_sum(ssa, F.lane) * (1.0f / 1024.0f) + EPS), rsb = rsqrtf(wave_sum(ssb, F.lane) * (1.0f / 1024.0f) + EPS);
        const float* gm = INP(7) + l * 1024 + 4 * F.lane; const float* sh = MOD + (l * 5 + bidx) * 6144 + 3072 + 4 * F.lane; const float* sc = sh + 1024;
        float lga[32], lgb[32];
#pragma unroll
        for (int e = 0; e < 32; ++e) { lga[e] = 0.f; lgb[e] = 0.f; }
#pragma unroll 1
        for (int j = 0; j < 4; ++j) { const int c = 256 * j;
            const f32x4 va = h4_to_f4(*(const u32x2*)(xa + c)), vb = h4_to_f4(*(const u32x2*)(xb + c));
            const f32x4 g = *(const f32x4*)(gm + c), s1 = *(const f32x4*)(sc + c), s0 = *(const f32x4*)(sh + c); const f32x4 gs = g * (1.0f + s1);
            const f32x4 ha = va * rsa * gs + s0, hb = vb * rsb * gs + s0;
            { u32x2 w; w.x = pk2(ha[0], ha[1]); w.y = pk2(ha[2], ha[3]); *(u32x2*)(H + (size_t)rowA * 1024 + 4 * F.lane + c) = w; }
            if (hasB) { u32x2 w; w.x = pk2(hb[0], hb[1]); w.y = pk2(hb[2], hb[3]); *(u32x2*)(H + (size_t)rowB * 1024 + 4 * F.lane + c) = w; }
            const LAS float* wj = wbase + (64 * j) * 32;
#pragma unroll
            for (int cc = 0; cc < 4; ++cc) {
                const LAS float* wp = wj + (256 * cc) * 32; const float hva = ha[cc], hvb = hb[cc];
#pragma unroll
                for (int ch = 0; ch < 8; ++ch) { const f32x4 w4 = *(const LAS f32x4*)(wp + roff[ch]);
                    lga[4 * ch + 0] += hva * w4[0]; lga[4 * ch + 1] += hva * w4[1]; lga[4 * ch + 2] += hva * w4[2]; lga[4 * ch + 3] += hva * w4[3];
                    lgb[4 * ch + 0] += hvb * w4[0]; lgb[4 * ch + 1] += hvb * w4[1]; lgb[4 * ch + 2] += hvb * w4[2]; lgb[4 * ch + 3] += hvb * w4[3]; }
            }
        }
        router_finish(F, lga, rowA, r0, br, hist, sel, TW);
        if (hasB) router_finish(F, lgb, rowB, r0, br, hist, sel, TW);
    }
    __syncthreads();
    if (F.tid < 32) gbase[F.tid] = (int)atomicAdd(F.ctl + CW_CNT + (l * 32 + F.tid) * 64, (unsigned)hist[F.tid]);
    __syncthreads();
    for (int i = F.tid; i < (r1 - r0) * 4; i += 512) { const int s = sel[i], e = s & 255, pos = gbase[e] + (s >> 8); const int row = r0 + (i >> 2);
        TE[row * 4 + (i & 3)] = e; TP[row * 4 + (i & 3)] = pos; LIST[(size_t)e * CAP + pos] = row; }
    __syncthreads();
}

__device__ __forceinline__ bf16x8 lds_frag(const LAS unsigned char* p) { return *(const LAS bf16x8*)p; }
#define ATT_SHIFT 8.0f
__device__ __forceinline__ void phase_attn(Frame& F, int jl  , bool last) {
    LAS unsigned char* QS = F.lds;
    LAS float* RPB = (LAS float*)(F.lds + 16384);
    LAS float* RK = (LAS float*)(F.lds + 19456);
    LAS unsigned char* KT = F.lds + 24576;
    LAS unsigned char* VT = F.lds + 24576 + 40960;
    const bf16_t* QKV = WSP(bf16_t, WS_QKV); bf16_t* OUT = WSP(bf16_t, WS_MERGED); const bf16_t* VTG = WSP(bf16_t, WS_VTG); const float* SSK = WSP(float, WS_SSK);
    const float* qg = INP(16) + jl * 64; const float* kg = INP(17) + jl * 64; const float* rpb = INP(18) + (size_t)jl * 16 * 465;
    const int w = F.wave, qt = w & 3, qr = w >> 2;
    const bool xmap = (F.G == 256);
    for (int i_ = 0; ; ++i_) {
        int u, bh;
        if (xmap) { const int li = (F.bid >> 3) + 32 * i_; if (li >= 528) break;
            if (li < 512) { bh = (F.bid & 7) * 8 + (li >> 6); u = li & 63; } else { bh = (F.bid & 7) * 8 + ((li - 512) >> 1); u = 64 + ((li - 512) & 1); } }
        else { const int it = F.bid + i_ * F.G; if (it >= NB * 16 * 66) break; u = it % 66; bh = it / 66; }
        int tid_ = F.tid; asm volatile("" : "+v"(tid_));
        const int lane_ = tid_ & 63, ln = lane_ & 15, g = lane_ >> 4;
        const int lkey = tid_ >> 3, lc = tid_ & 7;
        const int h = bh & 15, b = bh >> 4;
        const bool lat = u < 64;
        if (last && !lat) continue;
        const int r0 = 2 * u, rs0 = min(max(r0 - 4, 0), 120), rs1 = min(max(r0 - 3, 0), 120);
        const int urow = r0 + qr, off = qr ? rs1 - rs0 : 0;
        const int rd_first = lat ? 0 : 2;
        u32x4 pkr[5], pvr[5]; float pss[5];
#define ATT_ISSUE(rd_) do { int lk_ = lkey, lc_ = lc; asm volatile("" : "+v"(lk_), "+v"(lc_));   \
            _Pragma("unroll") for (int s5 = 0; s5 < 5; ++s5) { if (s5 == 4 && (rd_) != 0) break; \
            const int gr_ = min(rs0 + (rd_) * 5 + s5, 127); \
            const int krow0 = (rd_) == 2 ? (RL + b * TC + s5 * 64) : (b * TL + gr_ * 64); const int tt0 = (rd_) == 2 ? (TL + s5 * 64) : gr_ * 64; \
            pkr[s5] = *(const u32x4*)((const unsigned char*)QKV + (size_t)krow0 * 6144 + 2048 + h * 128 + (unsigned)(lk_ * 6144 + lc_ * 16)); \
            pvr[s5] = *(const u32x4*)((const unsigned char*)VTG + ((size_t)((b * 16 + h) * 64) * TT + tt0) * 2 + (unsigned)(lk_ * (TT * 2) + lc_ * 16)); \
            pss[s5] = *(const float*)((const unsigned char*)SSK + (size_t)(krow0 * 16 + h) * 4 + (unsigned)(lk_ * 64)); } } while (0)
        if (lat) ATT_ISSUE(0); else ATT_ISSUE(2);
#pragma unroll
        for (int p = 0; p < 2; ++p) {
            const int ql = p * 64 + lkey;
            const int qrow = lat ? (b * TL + (r0 + p) * 64 + lkey) : (RL + b * TC + (u - 64) * 128 + ql);
            const u32x4 raw = *(const u32x4*)(QKV + (size_t)qrow * 3072 + h * 64 + lc * 8);
            float x[8] = {bf2f(raw.x & 0xffffu), bf2f(raw.x >> 16), bf2f(raw.y & 0xffffu), bf2f(raw.y >> 16), bf2f(raw.z & 0xffffu), bf2f(raw.z >> 16), bf2f(raw.w & 0xffffu), bf2f(raw.w >> 16)};
            float ss = 0.f;
#pragma unroll
            for (int i = 0; i < 8; ++i) ss += x[i] * x[i];
            ss += shx(ss, 1, lane_); ss += shx(ss, 2, lane_); ss += shx(ss, 4, lane_);
            const float r = rsqrtf(ss * (1.0f / 64.0f) + EPS) * (0.125f * 1.4426950408889634f);
            const f32x4 g0 = *(const f32x4*)(qg + lc * 8) * *(const f32x4*)(kg + lc * 8), g1 = *(const f32x4*)(qg + lc * 8 + 4) * *(const f32x4*)(kg + lc * 8 + 4);
            u32x4 o; o.x = pk2(x[0] * r * g0[0], x[1] * r * g0[1]); o.y = pk2(x[2] * r * g0[2], x[3] * r * g0[3]); o.z = pk2(x[4] * r * g1[0], x[5] * r * g1[1]); o.w = pk2(x[6] * r * g1[2], x[7] * r * g1[3]);
            *(LAS u32x4*)(QS + ql * 128 + lc * 16) = o;
        }
        for (int i = tid_; i < 15 * 48; i += 512) { const int rr = i / 48, cc = i % 48 - 8; RPB[i] = (cc >= 0 && cc < 31) ? rpb[h * 465 + rr * 31 + cc] * 1.4426950408889634f - ATT_SHIFT : 0.f; }
        f32x4 O[4]; float l_run = 0.f;
#pragma unroll
        for (int e = 0; e < 4; ++e) O[e] = (f32x4){0.f, 0.f, 0.f, 0.f};
        bf16x8 qf[2];
#pragma unroll 1
        for (int rd = rd_first; rd < 3; ++rd) {
            const int nslot = rd == 0 ? 5 : 4;
#pragma unroll
            for (int s5 = 0; s5 < 5; ++s5) {
                if (s5 < nslot) {
                *(LAS u32x4*)(KT + s5 * 8192 + lkey * 128 + ((lc ^ (lkey & 7)) * 16)) = pkr[s5];
                *(LAS u32x4*)(VT + s5 * 8192 + lkey * 128 + ((lc ^ ((lkey ^ (lkey >> 3)) & 7)) * 16)) = pvr[s5];
                if (lc == 0) RK[s5 * 64 + lkey] = rsqrtf(pss[s5] * (1.0f / 64.0f) + EPS);
                }
            }
            __syncthreads();
            if (rd == 0) ATT_ISSUE(1); else if (rd == 1) ATT_ISSUE(2);
            if (rd == rd_first) {
#pragma unroll
                for (int ks = 0; ks < 2; ++ks) qf[ks] = lds_frag(QS + (w * 16 + ln) * 128 + (ks * 4 + g) * 16);
            }
            {
                int t2_ = tid_; asm volatile("" : "+v"(t2_));
                const int ln = t2_ & 15, g = (t2_ & 63) >> 4;
                if (rd < 2) {
                    const int thr = qt == 0 ? max(ln, 8) : qt == 3 ? min(ln, 8) : ln;
                    const int c0 = max(2 * qt - 1 + (g >> 1), 0), c1 = min(2 * qt + 1 + (g >> 1), 7);
                    const int key0 = min(max(16 * qt - 8 + ln, 0), 63), key1 = min(16 * qt + 8 + ln, 63);
                    const int rkb0 = min(max(16 * qt - 8 + 4 * g, 0), 60), rkb1 = min(16 * qt + 8 + 4 * g, 60);
                    bf16x8 ka[2][4]; float rbv[2][8]; f32x4 rkl[2][2];
#define ATT_LOADL(st, s5_) do { const LAS unsigned char* kt_ = KT + (s5_) * 8192; \
                        ka[st][0] = lds_frag(kt_ + key0 * 128 + (((0 + g) ^ (key0 & 7)) * 16)); ka[st][1] = lds_frag(kt_ + key0 * 128 + (((4 + g) ^ (key0 & 7)) * 16)); \
                        ka[st][2] = lds_frag(kt_ + key1 * 128 + (((0 + g) ^ (key1 & 7)) * 16)); ka[st][3] = lds_frag(kt_ + key1 * 128 + (((4 + g) ^ (key1 & 7)) * 16)); \
                        const int rrow_ = min(max(rs0 + rd * 5 + (s5_) - urow + 7, 0), 14); const LAS float* rb_ = RPB + rrow_ * 48 + 15 - ln + 4 * g; \
                        _Pragma("unroll") for (int j = 0; j < 4; ++j) { rbv[st][j] = rb_[j]; rbv[st][4 + j] = rb_[16 + j]; } \
                        rkl[st][0] = *(const LAS f32x4*)(RK + (s5_) * 64 + rkb0); rkl[st][1] = *(const LAS f32x4*)(RK + (s5_) * 64 + rkb1); \
                        } while (0)
#define ATT_LOADLV(s5_) do { const LAS unsigned char* vt_ = VT + (s5_) * 8192; \
                        _Pragma("unroll") for (int et = 0; et < 4; ++et) { const int e = et * 16 + ln; const int sw = (e ^ (e >> 3)) & 7; \
                            vfa[et] = *(const LAS u32x2*)(vt_ + e * 128 + ((c0 ^ sw) * 16) + (g & 1) * 8); vfb[et] = *(const LAS u32x2*)(vt_ + e * 128 + ((c1 ^ sw) * 16) + (g & 1) * 8); } } while (0)
                    ATT_LOADL(0, 0);
#pragma unroll
                    for (int s5 = 0; s5 < 5; ++s5) {
                        if (s5 == 4 && rd != 0) break;
                        const int st = s5 & 1;
                        u32x2 vfa[4], vfb[4];
                        ATT_LOADLV(s5);
                        if (s5 + 1 < 5 && !(s5 + 1 == 4 && rd != 0)) ATT_LOADL(st ^ 1, s5 + 1);
                        __builtin_amdgcn_sched_barrier(0);
                        const int t = rd * 5 + s5;
                        const bool mine = (t >= off) && (t <= off + 7);
                        f32x4 sc0 = (f32x4){0.f, 0.f, 0.f, 0.f}, sc1 = (f32x4){0.f, 0.f, 0.f, 0.f};
                        sc0 = __builtin_amdgcn_mfma_f32_16x16x32_bf16(ka[st][0], qf[0], sc0, 0, 0, 0);
                        sc1 = __builtin_amdgcn_mfma_f32_16x16x32_bf16(ka[st][2], qf[0], sc1, 0, 0, 0);
                        sc0 = __builtin_amdgcn_mfma_f32_16x16x32_bf16(ka[st][1], qf[1], sc0, 0, 0, 0);
                        sc1 = __builtin_amdgcn_mfma_f32_16x16x32_bf16(ka[st][3], qf[1], sc1, 0, 0, 0);
#pragma unroll
                        for (int j = 0; j < 4; ++j) { const int kk = 4 * g + j;
                            const float p0 = (mine && kk >= thr) ? __builtin_amdgcn_exp2f(sc0[j] * rkl[st][0][j] + rbv[st][j]) : 0.f;
                            const float p1 = (mine && kk < thr) ? __builtin_amdgcn_exp2f(sc1[j] * rkl[st][1][j] + rbv[st][4 + j]) : 0.f;
                            sc0[j] = p0; sc1[j] = p1; l_run += p0 + p1; }
                        u32x4 pw; pw.x = pk2(sc0[0], sc0[1]); pw.y = pk2(sc0[2], sc0[3]); pw.z = pk2(sc1[0], sc1[1]); pw.w = pk2(sc1[2], sc1[3]);
                        const bf16x8 pf = __builtin_bit_cast(bf16x8, pw);
#pragma unroll
                        for (int et = 0; et < 4; ++et) { u32x4 vw; vw.x = vfa[et].x; vw.y = vfa[et].y; vw.z = vfb[et].x; vw.w = vfb[et].y;
                            O[et] = __builtin_amdgcn_mfma_f32_16x16x32_bf16(__builtin_bit_cast(bf16x8, vw), pf, O[et], 0, 0, 0); }
                    }
#undef ATT_LOADL
#undef ATT_LOADLV
                } else {
                    bf16x8 kc[2][4][2]; f32x4 rkv[2][4];
#define ATT_LOADCK(st, s5_) do { const LAS unsigned char* kt_ = KT + (s5_) * 8192; \
                        _Pragma("unroll") for (int kt = 0; kt < 4; ++kt) { const int key = kt * 16 + ln; \
                            kc[st][kt][0] = lds_frag(kt_ + key * 128 + (((0 + g) ^ (key & 7)) * 16)); kc[st][kt][1] = lds_frag(kt_ + key * 128 + (((4 + g) ^ (key & 7)) * 16)); \
                            rkv[st][kt] = *(const LAS f32x4*)(RK + (s5_) * 64 + 16 * kt + 4 * g); } } while (0)
                    ATT_LOADCK(0, 0);
#pragma unroll
                    for (int s5 = 0; s5 < 4; ++s5) {
                        const int st = s5 & 1;
                        const LAS unsigned char* vt_ = VT + s5 * 8192;
                        u32x2 vfa[2][4], vfb[2][4];
#pragma unroll
                        for (int ks2 = 0; ks2 < 2; ++ks2)
#pragma unroll
                            for (int et = 0; et < 4; ++et) { const int e = et * 16 + ln; const int sw = (e ^ (e >> 3)) & 7;
                                vfa[ks2][et] = *(const LAS u32x2*)(vt_ + e * 128 + (((4 * ks2 + (g >> 1)) ^ sw) * 16) + (g & 1) * 8);
                                vfb[ks2][et] = *(const LAS u32x2*)(vt_ + e * 128 + (((4 * ks2 + 2 + (g >> 1)) ^ sw) * 16) + (g & 1) * 8); }
                        if (s5 + 1 < 4) ATT_LOADCK(st ^ 1, s5 + 1);
                        __builtin_amdgcn_sched_barrier(0);
                        f32x4 sc[4];
#pragma unroll
                        for (int kt = 0; kt < 4; ++kt) sc[kt] = __builtin_amdgcn_mfma_f32_16x16x32_bf16(kc[st][kt][0], qf[0], (f32x4){0.f, 0.f, 0.f, 0.f}, 0, 0, 0);
#pragma unroll
                        for (int kt = 0; kt < 4; ++kt) sc[kt] = __builtin_amdgcn_mfma_f32_16x16x32_bf16(kc[st][kt][1], qf[1], sc[kt], 0, 0, 0);
#pragma unroll
                        for (int kt = 0; kt < 4; ++kt)
#pragma unroll
                            for (int j = 0; j < 4; ++j) { const float p = __builtin_amdgcn_exp2f(sc[kt][j] * rkv[st][kt][j] - ATT_SHIFT); sc[kt][j] = p; l_run += p; }
#pragma unroll
                        for (int ks2 = 0; ks2 < 2; ++ks2) {
                            u32x4 pw; pw.x = pk2(sc[2 * ks2][0], sc[2 * ks2][1]); pw.y = pk2(sc[2 * ks2][2], sc[2 * ks2][3]); pw.z = pk2(sc[2 * ks2 + 1][0], sc[2 * ks2 + 1][1]); pw.w = pk2(sc[2 * ks2 + 1][2], sc[2 * ks2 + 1][3]);
                            const bf16x8 pf = __builtin_bit_cast(bf16x8, pw);
#pragma unroll
                            for (int et = 0; et < 4; ++et) { u32x4 vw; vw.x = vfa[ks2][et].x; vw.y = vfa[ks2][et].y; vw.z = vfb[ks2][et].x; vw.w = vfb[ks2][et].y;
                                O[et] = __builtin_amdgcn_mfma_f32_16x16x32_bf16(__builtin_bit_cast(bf16x8, vw), pf, O[et], 0, 0, 0); }
                        }
                    }
#undef ATT_LOADCK
                }
            }
            __syncthreads();
        }
        l_run += shx(l_run, 16, lane_); l_run += shx(l_run, 32, lane_);
        {
            const float inv = 1.0f / l_run;
            const int qrow = lat ? (b * TL + urow * 64 + qt * 16 + ln) : (RL + b * TC + (u - 64) * 128 + w * 16 + ln);
#pragma unroll
            for (int e = 0; e < 4; ++e) { u32x2 wv; wv.x = pk2(O[e][0] * inv, O[e][1] * inv); wv.y = pk2(O[e][2] * inv, O[e][3] * inv);
                *(u32x2*)(OUT + (size_t)qrow * 1024 + h * 64 + e * 16 + 4 * g) = wv; }
        }
    }
#undef ATT_ISSUE
}

constexpr size_t WS_GH = WS_ACT, WS_GM = WS_ACT + 72 * MiB, WS_SH = WS_ACT + 128 * MiB, WS_SM = WS_SH + 72 * MiB;
constexpr size_t WS_DECH = WS_YS, WS_DECM = WS_YS + 1 * MiB;
constexpr size_t WS_OTH = WS_OHF, WS_OTM = WS_OMF;
static_assert(WS_GM + (size_t)1056 * 10240 * 4 <= WS_SH && WS_SM + (size_t)1056 * 10240 * 4 <= WS_YS, "scan dumps");
template <int KIND> struct ScanCfg {
    static constexpr int DK = KIND ? 64 : 128, RBQ = DK * 2, CMQ = DK / 8 - 1, KST = DK / 32, NEXT = KIND ? 144 : 128, OBS = KIND ? 148 : 132;
    static constexpr int OFF_OB = 0;
    static constexpr int OFF_QP = KIND ? 36864 : 0, OFF_KP = OFF_QP + 64 * RBQ, OFF_KPT = OFF_KP + 64 * RBQ, OFF_VT = OFF_KPT + DK * 128, OFF_PP = OFF_VT + 20480, OFF_SST = OFF_PP + 8192;
    static constexpr int OFF_SM = 114688;
    static constexpr int GSTRIDE = KIND ? 10240 : 16384;
};
__device__ __forceinline__ int sc_row(int b, int sct, int t) { return sct == 0 ? (RL + b * TC + t) : (b * TL + (sct - 1) * 256 + t); }
__device__ __forceinline__ float exp_c(float x) { return __expf(fminf(fmaxf(x, -80.f), 80.f)); }
template <int KIND> __device__ __forceinline__ int st_n0(int w) { return KIND ? (w >> 2) * 4 : 0; }
template <int KIND> __device__ __forceinline__ int st_nc(int w) { return KIND ? ((w >> 2) ? 5 : 4) : 8; }
template <int KIND> __device__ __forceinline__ int st_mt(int w) { return KIND ? (w & 3) : w; }
template <int KIND> __device__ __forceinline__ int ot_n0(int w) { return (w >> 2) * 4; }
template <int KIND> __device__ __forceinline__ int ot_nc(int w) { return KIND ? ((w >> 2) ? 5 : 4) : 4; }

template <int KIND, int PASS>
__device__ __forceinline__ void scan_super(Frame& F, int jl, int b, int h, int sct, int dir, f32x4 (&S)[8]) {
    typedef ScanCfg<KIND> C;
    LAS unsigned char* L = F.lds;
    LAS float* TOT = (LAS float*)(L + C::OFF_SM); LAS float* EM = TOT + 512; LAS float* E2 = EM + 128; LAS float* BT = E2 + 128; LAS float* RQ = BT + 128; LAS float* CK = RQ + 64; LAS float* SCAL = CK + 64;
    const int w = F.wave;
    const bf16_t* Qg = KIND ? WSP(bf16_t, WS_MQ) : WSP(bf16_t, WS_Q);
    const bf16_t* Kg = KIND ? WSP(bf16_t, WS_MK) : WSP(bf16_t, dir ? WS_KB : WS_KF);
    const bf16_t* Vg = KIND ? WSP(bf16_t, WS_MV) : WSP(bf16_t, WS_V);
    const int hq = h * C::DK;
    u32x4 rq[2], rk[2], rv[2]; float rl[16]; float rg0 = 0.f, rg1 = 0.f;
    const float* LAg = WSP(float, dir ? WS_LAB : WS_LAF); const float* GTg = WSP(float, WS_GATES);
#define SC_ISSUE(ci_, TID) do { const int cN = dir ? 3 - (ci_) : (ci_); const int tN = cN * 64; \
        if (KIND == 0) { const int d_ = (TID) & 127, part_ = (TID) >> 7; \
            _Pragma("unroll") for (int i = 0; i < 16; ++i) rl[i] = LAg[(size_t)sc_row(b, sct, tN + part_ * 16 + i) * 512 + hq + d_]; \
            _Pragma("unroll") for (int p = 0; p < 2; ++p) { const size_t ro = (size_t)sc_row(b, sct, tN + p * 32 + ((TID) >> 4)) * 512 + hq + 8 * ((TID) & 15); \
                if (PASS == 3) rq[p] = *(const u32x4*)(Qg + ro); rk[p] = *(const u32x4*)(Kg + ro); rv[p] = *(const u32x4*)(Vg + ro); } } \
        else { { const size_t ro = (size_t)sc_row(b, sct, tN + ((TID) >> 3)) * 256 + hq + 8 * ((TID) & 7); if (PASS == 3) rq[0] = *(const u32x4*)(Qg + ro); rk[0] = *(const u32x4*)(Kg + ro); } \
            _Pragma("unroll") for (int p = 0; p < 2; ++p) rv[p] = *(const u32x4*)(Vg + (size_t)sc_row(b, sct, tN + p * 32 + ((TID) >> 4)) * 512 + h * 128 + 8 * ((TID) & 15)); \
            if ((TID) < 64) { const size_t go = (size_t)sc_row(b, sct, tN + (TID)) * 16 + h; rg0 = GTg[go + (dir ? 12 : 4)]; rg1 = GTg[go + (dir ? 8 : 0)]; } } } while (0)
    SC_ISSUE(0, F.tid);
#pragma unroll 1
    for (int ci = 0; ci < 4; ++ci) {
        const int c = dir ? 3 - ci : ci; const int t0 = c * 64;
        int tid_ = F.tid; asm volatile("" : "+v"(tid_));
        const int lane_ = tid_ & 63, ln = lane_ & 15, g = lane_ >> 4;
        LAS unsigned char* VRAW = L + C::OFF_SST;
        if (KIND == 0) {
            const int d = tid_ & 127, part = tid_ >> 7;
            if (!dir) {
#pragma unroll
                for (int i = 1; i < 16; ++i) rl[i] += rl[i - 1];
                TOT[part * 128 + d] = rl[15];
            } else {
#pragma unroll
                for (int i = 14; i >= 0; --i) rl[i] += rl[i + 1];
                TOT[part * 128 + d] = rl[0];
            }
#pragma unroll
            for (int p = 0; p < 2; ++p) { const int t = p * 32 + (tid_ >> 4), cc = tid_ & 15;
                if (PASS == 3) *(LAS u32x4*)(L + C::OFF_QP + t * 256 + ((cc ^ (t & 15)) * 16)) = rq[p];
                *(LAS u32x4*)(L + C::OFF_KP + t * 256 + ((cc ^ (t & 15)) * 16)) = rk[p];
                *(LAS u32x4*)(VRAW + t * 256 + cc * 16) = rv[p]; }
        } else {
            { const int t = tid_ >> 3, cc = tid_ & 7;
                if (PASS == 3) *(LAS u32x4*)(L + C::OFF_QP + t * 128 + ((cc ^ (t & 7)) * 16)) = rq[0];
                *(LAS u32x4*)(L + C::OFF_KP + t * 128 + ((cc ^ (t & 7)) * 16)) = rk[0]; }
#pragma unroll
            for (int p = 0; p < 2; ++p) { const int t = p * 32 + (tid_ >> 4), cc = tid_ & 15; *(LAS u32x4*)(VRAW + t * 256 + cc * 16) = rv[p]; }
            if (tid_ < 64) { const int t = tid_;
                float x = rg0; const float ig = rg1;
#pragma unroll
                for (int o = 1; o < 64; o <<= 1) { const int src = dir ? t + o : t - o; const float y = __int_as_float(__builtin_amdgcn_ds_bpermute((src & 63) << 2, __float_as_int(x))); if (src >= 0 && src < 64) x += y; }
                const float ref = __int_as_float(__builtin_amdgcn_readlane(__float_as_int(x), dir ? 32 : 31));
                const float btot = __int_as_float(__builtin_amdgcn_readlane(__float_as_int(x), dir ? 0 : 63));
                RQ[t] = exp_c(x - ref); CK[t] = exp_c(ref - x + ig);
                if (t == 0) { SCAL[0] = __expf(ref); SCAL[1] = __expf(btot - ref); if (PASS == 1) SCAL[2] = (ci == 0 ? 0.f : SCAL[2]) + btot; } }
            if (tid_ < 128) { const int row = 128 + (tid_ >> 3), ch = tid_ & 7; const unsigned one = (row == 128) ? 0x3f803f80u : 0u;
                *(LAS u32x4*)(L + C::OFF_VT + row * 128 + ((ch ^ (row & 7)) * 16)) = (u32x4){one, one, one, one}; }
        }
        __syncthreads();
        if (KIND == 0) {
            const int d = tid_ & 127, part = tid_ >> 7;
            const float t0v = TOT[d], t1v = TOT[128 + d], t2v = TOT[256 + d], t3v = TOT[384 + d];
            const float btot = (t0v + t1v) + (t2v + t3v);
            const float ref = dir ? (t2v + t3v) : (t0v + t1v);
            float off;
            if (!dir) off = part == 0 ? 0.f : part == 1 ? t0v : part == 2 ? (t0v + t1v) : (t0v + t1v + t2v);
            else off = part == 3 ? 0.f : part == 2 ? t3v : part == 1 ? (t3v + t2v) : (t3v + t2v + t1v);
            if (part == 0) { EM[d] = __expf(ref); E2[d] = __expf(btot - ref); if (PASS == 1) BT[d] = (ci == 0 ? 0.f : BT[d]) + btot; }
            unsigned kt[8];
#pragma unroll
            for (int i = 0; i < 16; ++i) { const int t = part * 16 + i; const int ad = t * 256 + (((d >> 3) ^ (t & 15)) * 16) + (d & 7) * 2;
                const float bb = rl[i] + off - ref;
                const float kv = bf2f(*(const LAS bf16_t*)(L + C::OFF_KP + ad)) * exp_c(-bb); const unsigned kb = pk2(kv, kv) & 0xffffu;
                if (PASS == 3) { const float qv = bf2f(*(const LAS bf16_t*)(L + C::OFF_QP + ad)) * exp_c(bb);
                    *(LAS bf16_t*)(L + C::OFF_QP + ad) = (bf16_t)(pk2(qv, qv) & 0xffffu);
                    *(LAS bf16_t*)(L + C::OFF_KP + ad) = (bf16_t)kb; }
                if (i & 1) kt[i >> 1] |= kb << 16; else kt[i >> 1] = kb; }
            *(LAS u32x4*)(L + C::OFF_KPT + d * 128 + (((part * 2) ^ (d & 7)) * 16)) = (u32x4){kt[0], kt[1], kt[2], kt[3]};
            *(LAS u32x4*)(L + C::OFF_KPT + d * 128 + (((part * 2 + 1) ^ (d & 7)) * 16)) = (u32x4){kt[4], kt[5], kt[6], kt[7]};
        } else {
            const int d = tid_ & 63, part = tid_ >> 6;
            unsigned kt[4];
#pragma unroll
            for (int i = 0; i < 8; ++i) { const int t = part * 8 + i; const int ad = t * 128 + (((d >> 3) ^ (t & 7)) * 16) + (d & 7) * 2;
                const float kv = bf2f(*(const LAS bf16_t*)(L + C::OFF_KP + ad)) * CK[t]; const unsigned kb = pk2(kv, kv) & 0xffffu;
                if (PASS == 3) { const float qv = bf2f(*(const LAS bf16_t*)(L + C::OFF_QP + ad)) * RQ[t];
                    *(LAS bf16_t*)(L + C::OFF_QP + ad) = (bf16_t)(pk2(qv, qv) & 0xffffu);
                    *(LAS bf16_t*)(L + C::OFF_KP + ad) = (bf16_t)kb; }
                if (i & 1) kt[i >> 1] |= kb << 16; else kt[i >> 1] = kb; }
            *(LAS u32x4*)(L + C::OFF_KPT + d * 128 + ((part ^ (d & 7)) * 16)) = (u32x4){kt[0], kt[1], kt[2], kt[3]};
        }
        {
            const int e = tid_ & 127, part = tid_ >> 7; unsigned vt[8];
#pragma unroll
            for (int i = 0; i < 16; ++i) { const unsigned vb = *(const LAS bf16_t*)(VRAW + (part * 16 + i) * 256 + e * 2); if (i & 1) vt[i >> 1] |= vb << 16; else vt[i >> 1] = vb; }
            *(LAS u32x4*)(L + C::OFF_VT + e * 128 + (((part * 2) ^ (e & 7)) * 16)) = (u32x4){vt[0], vt[1], vt[2], vt[3]};
            *(LAS u32x4*)(L + C::OFF_VT + e * 128 + (((part * 2 + 1) ^ (e & 7)) * 16)) = (u32x4){vt[4], vt[5], vt[6], vt[7]};
        }
        if (ci < 3) SC_ISSUE(ci + 1, tid_);
        __syncthreads();
        const int smt = st_mt<KIND>(w), sn0 = st_n0<KIND>(w), snc = st_nc<KIND>(w), onc = KIND ? snc : 4;
#define SC_ET(n) (KIND ? (sn0 + (n)) : (((((n) >> 2) ^ (w >> 2)) << 2) + ((n) & 3)))
        {
            f32x4 em;
            if (KIND == 0) em = *(const LAS f32x4*)(EM + smt * 16 + 4 * g); else { const float s0 = SCAL[0]; em = (f32x4){s0, s0, s0, s0}; }
#pragma unroll
            for (int n = 0; n < 8; ++n) if (n < snc) { S[n] *= em;
                if (PASS == 3) { const int e = SC_ET(n) * 16 + ln; u32x2 wv; wv.x = pk2(S[n][0], S[n][1]); wv.y = pk2(S[n][2], S[n][3]);
                    *(LAS u32x2*)(L + C::OFF_SST + e * C::RBQ + (((2 * smt + (g >> 1)) ^ (e & C::CMQ)) * 16) + (g & 1) * 8) = wv; } }
        }
        constexpr int NVT = KIND ? 5 : 8;
        bf16x8 vt[NVT][2], kf[2];
#pragma unroll
        for (int n = 0; n < NVT; ++n) if (n < snc) { const int e = SC_ET(n) * 16 + ln;
#pragma unroll
            for (int ks = 0; ks < 2; ++ks) vt[n][ks] = lds_frag(L + C::OFF_VT + e * 128 + (((ks * 4 + g) ^ (e & 7)) * 16)); }
        { const int d_row = smt * 16 + ln;
#pragma unroll
            for (int ks = 0; ks < 2; ++ks) kf[ks] = lds_frag(L + C::OFF_KPT + d_row * 128 + (((ks * 4 + g) ^ (d_row & 7)) * 16)); }
        f32x4 e2;
        if (KIND == 0) e2 = *(const LAS f32x4*)(E2 + smt * 16 + 4 * g); else { const float s1 = SCAL[1]; e2 = (f32x4){s1, s1, s1, s1}; }
        f32x4 oacc[5];
        if (PASS == 3) {
            {
                const int st = w & 3, s_row = st * 16 + ln;
                bf16x8 af[C::KST], qfr[2][C::KST];
#pragma unroll
                for (int ks = 0; ks < C::KST; ++ks) af[ks] = lds_frag(L + C::OFF_KP + s_row * C::RBQ + (((ks * 4 + g) ^ (s_row & C::CMQ)) * 16));
#pragma unroll
                for (int tq = 0; tq < 2; ++tq) { const int t_row = ((w >> 2) * 2 + tq) * 16 + ln;
#pragma unroll
                    for (int ks = 0; ks < C::KST; ++ks) qfr[tq][ks] = lds_frag(L + C::OFF_QP + t_row * C::RBQ + (((ks * 4 + g) ^ (t_row & C::CMQ)) * 16)); }
                __builtin_amdgcn_sched_barrier(0);
#pragma unroll
                for (int tq = 0; tq < 2; ++tq) { const int tt = (w >> 2) * 2 + tq, t_row = tt * 16 + ln;
                    f32x4 acc = (f32x4){0.f, 0.f, 0.f, 0.f};
#pragma unroll
                    for (int ks = 0; ks < C::KST; ++ks) acc = __builtin_amdgcn_mfma_f32_16x16x32_bf16(af[ks], qfr[tq][ks], acc, 0, 0, 0);
#pragma unroll
                    for (int j = 0; j < 4; ++j) { const int sidx = st * 16 + 4 * g + j; const bool keep = dir ? (sidx >= t_row) : (sidx <= t_row); acc[j] = keep ? acc[j] : 0.f; }
                    u32x2 wv; wv.x = pk2(acc[0], acc[1]); wv.y = pk2(acc[2], acc[3]);
                    *(LAS u32x2*)(L + C::OFF_PP + t_row * 128 + (((2 * st + (g >> 1)) ^ (t_row & 7)) * 16) + (g & 1) * 8) = wv; }
            }
        } else __builtin_amdgcn_sched_barrier(0);
#pragma unroll
        for (int n = 0; n < NVT; ++n) if (n < snc) {
#pragma unroll
            for (int ks = 0; ks < 2; ++ks) S[n] = __builtin_amdgcn_mfma_f32_16x16x32_bf16(kf[ks], vt[n][ks], S[n], 0, 0, 0);
            S[n] *= e2; }
        if (PASS == 3) {
            __syncthreads();
            {
                const int tt = w & 3, t_row = tt * 16 + ln;
                bf16x8 pf[2], qf2[C::KST], sst[5][C::KST];
#pragma unroll
                for (int ks = 0; ks < 2; ++ks) pf[ks] = lds_frag(L + C::OFF_PP + t_row * 128 + (((ks * 4 + g) ^ (t_row & 7)) * 16));
#pragma unroll
                for (int ks = 0; ks < C::KST; ++ks) qf2[ks] = lds_frag(L + C::OFF_QP + t_row * C::RBQ + (((ks * 4 + g) ^ (t_row & C::CMQ)) * 16));
#pragma unroll
                for (int n = 0; n < 5; ++n) if (n < onc) { const int e = SC_ET(n) * 16 + ln;
#pragma unroll
                    for (int ks = 0; ks < C::KST; ++ks) sst[n][ks] = lds_frag(L + C::OFF_SST + e * C::RBQ + (((ks * 4 + g) ^ (e & C::CMQ)) * 16)); }
                __builtin_amdgcn_sched_barrier(0);
#pragma unroll
                for (int n = 0; n < 5; ++n) if (n < onc) { f32x4 acc = (f32x4){0.f, 0.f, 0.f, 0.f};
#pragma unroll
                    for (int ks = 0; ks < 2; ++ks) acc = __builtin_amdgcn_mfma_f32_16x16x32_bf16(pf[ks], vt[n][ks], acc, 0, 0, 0);
#pragma unroll
                    for (int ks = 0; ks < C::KST; ++ks) acc = __builtin_amdgcn_mfma_f32_16x16x32_bf16(qf2[ks], sst[n][ks], acc, 0, 0, 0);
                    oacc[n] = acc; }
            }
            {
                LAS unsigned char* OBH = (w >> 2) ? (L + MISC_OFF + 4096) : (L + 118912); LAS float* DEN = (LAS float*)(L + MISC_OFF + 4096 + 9216);
                const int tt = w & 3, onc2 = ot_nc<KIND>(w);
#pragma unroll
                for (int n = 0; n < 5; ++n) if (n < onc2) {
                    if (KIND == 1 && n == 4) { if (ln == 0) {
#pragma unroll
                            for (int j = 0; j < 4; ++j) DEN[tt * 16 + 4 * g + j] = oacc[n][j]; } }
                    else { asm volatile("s_nop 11" : "+v"(oacc[n]));
                        const int e = n * 16 + ln; const unsigned p01 = pk2(oacc[n][0], oacc[n][1]), p23 = pk2(oacc[n][2], oacc[n][3]);
                        LAS bf16_t* o_ = (LAS bf16_t*)(OBH + (tt * 16 + 4 * g) * 144) + e;
                        o_[0] = (bf16_t)p01; o_[72] = (bf16_t)(p01 >> 16); o_[144] = (bf16_t)p23; o_[216] = (bf16_t)(p23 >> 16); } }
            }
        }
        __syncthreads();
        if (PASS == 3) {
            {
                const int t = tid_ >> 3, seg = tid_ & 7; const int row = sc_row(b, sct, t0 + t);
                LAS float* DEN = (LAS float*)(L + MISC_OFF + 4096 + 9216);
                const LAS bf16_t* ob = (const LAS bf16_t*)(((seg >> 2) ? (L + MISC_OFF + 4096) : (L + 118912)) + t * 144 + (seg & 3) * 32);
                f32x4 v[4];
                { const u32x4 oa = *(const LAS u32x4*)ob, oc = *(const LAS u32x4*)(ob + 8); const unsigned ow_[8] = {oa.x, oa.y, oa.z, oa.w, oc.x, oc.y, oc.z, oc.w};
#pragma unroll
                    for (int q = 0; q < 4; ++q) v[q] = (f32x4){bf2f(ow_[2 * q] & 0xffffu), bf2f(ow_[2 * q] >> 16), bf2f(ow_[2 * q + 1] & 0xffffu), bf2f(ow_[2 * q + 1] >> 16)}; }
                if (KIND == 1) { const float den = DEN[t]; const float inv = 1.0f / fmaxf(fabsf(den), 1.0f);
#pragma unroll
                    for (int q = 0; q < 4; ++q) v[q] *= inv; }
                float* ot = WSP(float, KIND ? WS_OTM : WS_OTH) + (size_t)row * 512 + h * 128 + seg * 16;
                if (!dir) {
#pragma unroll
                    for (int q = 0; q < 4; ++q) *(f32x4*)(ot + 4 * q) = v[q];
                } else {
                    float ss = 0.f;
#pragma unroll
                    for (int q = 0; q < 4; ++q) { v[q] += *(const f32x4*)(ot + 4 * q); ss += (v[q][0] * v[q][0] + v[q][1] * v[q][1]) + (v[q][2] * v[q][2] + v[q][3] * v[q][3]); }
                    ss += shx(ss, 1, lane_); ss += shx(ss, 2, lane_); ss += shx(ss, 4, lane_);
                    const float r = rsqrtf(ss * (1.0f / 128.0f) + EPS);
                    const float* gn = INP(KIND ? 13 : 12) + jl * 512 + h * 128 + seg * 16;
                    const bf16_t* gate = WSP(bf16_t, KIND ? WS_MO : WS_HG) + (size_t)row * 512 + h * 128 + seg * 16;
                    const u32x4 ga = *(const u32x4*)gate, gb = *(const u32x4*)(gate + 8);
                    const unsigned gw[8] = {ga.x, ga.y, ga.z, ga.w, gb.x, gb.y, gb.z, gb.w};
                    unsigned ow[8];
#pragma unroll
                    for (int q = 0; q < 4; ++q) { const f32x4 gq = *(const f32x4*)(gn + 4 * q);
                        const float y0 = v[q][0] * r * gq[0] * bf2f(gw[2 * q] & 0xffffu), y1 = v[q][1] * r * gq[1] * bf2f(gw[2 * q] >> 16);
                        const float y2 = v[q][2] * r * gq[2] * bf2f(gw[2 * q + 1] & 0xffffu), y3 = v[q][3] * r * gq[3] * bf2f(gw[2 * q + 1] >> 16);
                        ow[2 * q] = pk2(y0, y1); ow[2 * q + 1] = pk2(y2, y3); }
                    bf16_t* mg = WSP(bf16_t, WS_MERGED) + (size_t)row * 1024 + KIND * 512 + h * 128 + seg * 16;
                    *(u32x4*)mg = (u32x4){ow[0], ow[1], ow[2], ow[3]}; *(u32x4*)(mg + 8) = (u32x4){ow[4], ow[5], ow[6], ow[7]};
                }
            }
        }
    }
}
#undef SC_ISSUE
#undef SC_ET
__device__ __forceinline__ void phase_scan1(Frame& F) {
    for (int it = F.bid; it < 2 * 32 * 32; it += F.G) {
        const int cpos = it & 31, ch = (it >> 5) & 31, kind = it >> 10; const int dir = ch & 1, h = (ch >> 1) & 3, b = ch >> 3;
        const int sct = cpos == 0 ? 0 : (dir ? 33 - cpos : cpos);
        f32x4 S[8];
#pragma unroll
        for (int n = 0; n < 8; ++n) S[n] = (f32x4){0.f, 0.f, 0.f, 0.f};
        if (kind == 0) { scan_super<0, 1>(F, 0, b, h, sct, dir, S);
            float* G = WSP(float, WS_GH) + (size_t)(ch * 33 + cpos) * 16384;
#pragma unroll
            for (int n = 0; n < 8; ++n) *(f32x4*)(G + (n * 512 + F.tid) * 4) = S[n];
            if (F.tid < 128) WSP(float, WS_DECH)[(ch * 33 + cpos) * 128 + F.tid] = __expf(((const LAS float*)(F.lds + ScanCfg<0>::OFF_SM))[768 + F.tid]);
        } else { scan_super<1, 1>(F, 0, b, h, sct, dir, S);
            float* G = WSP(float, WS_GM) + (size_t)(ch * 33 + cpos) * 10240;
#pragma unroll
            for (int n = 0; n < 5; ++n) *(f32x4*)(G + (n * 512 + F.tid) * 4) = S[n];
            if (F.tid == 0) WSP(float, WS_DECM)[ch * 33 + cpos] = __expf(((const LAS float*)(F.lds + ScanCfg<1>::OFF_SM))[1024 + 2]);
        }
        __syncthreads();
    }
}
__device__ __forceinline__ void phase_scan23(Frame& F, int jl, int pass) {
    if (pass == 0) {
        const int nb0 = (F.G > 64) ? 32 : 0;
        if (F.bid >= nb0) {
            const int gt = (F.bid - nb0) * 512 + F.tid, NT = (F.G - nb0) * 512;
            for (int i = gt; i < 32 * 4096 + 32 * 2560; i += NT) {
                if (i < 32 * 4096) { const int ch = i >> 12, q = i & 4095, tid = q & 511; const int d0 = 16 * (tid >> 6) + 4 * ((tid & 63) >> 4);
                    const float* G = WSP(float, WS_GH) + (size_t)ch * 33 * 16384 + q * 4; bf16_t* SI = WSP(bf16_t, WS_SH) + (size_t)ch * 33 * 16384 + q * 4; const float* DC = WSP(float, WS_DECH) + ch * 33 * 128 + d0;
                    f32x4 s4 = (f32x4){0.f, 0.f, 0.f, 0.f};
#pragma unroll 4
                    for (int cp = 0; cp < 32; ++cp) { s4 = *(const f32x4*)(DC + cp * 128) * s4 + *(const f32x4*)(G + (size_t)cp * 16384); u32x2 w; w.x = pk2(s4[0], s4[1]); w.y = pk2(s4[2], s4[3]); *(u32x2*)(SI + (size_t)(cp + 1) * 16384) = w; }
                } else { const int k = i - 32 * 4096, ch = k / 2560, q = k % 2560;
                    const float* G = WSP(float, WS_GM) + (size_t)ch * 33 * 10240 + q * 4; bf16_t* SI = WSP(bf16_t, WS_SM) + (size_t)ch * 33 * 10240 + q * 4; const float* DC = WSP(float, WS_DECM) + ch * 33;
                    f32x4 s4 = (f32x4){0.f, 0.f, 0.f, 0.f};
#pragma unroll 4
                    for (int cp = 0; cp < 32; ++cp) { s4 = DC[cp] * s4 + *(const f32x4*)(G + (size_t)cp * 10240); u32x2 w; w.x = pk2(s4[0], s4[1]); w.y = pk2(s4[2], s4[3]); *(u32x2*)(SI + (size_t)(cp + 1) * 10240) = w; }
                }
            }
        }
    }
    const int count = pass == 0 ? 32 : 1024;
    for (int q = F.bid; q < count; q += F.G) {
        const int kind = q & 1, r = q >> 1;
        const int sct = pass == 0 ? 0 : 1 + (r & 31), bh = pass == 0 ? r : (r >> 5), h = bh & 3, b = bh >> 2;
#pragma unroll 1
        for (int dir = 0; dir < 2; ++dir) {
            const int ch = (b * 4 + h) * 2 + dir; const int cpos = sct == 0 ? 0 : (dir ? 33 - sct : sct);
            f32x4 S[8];
            if (kind == 0) { const bf16_t* SI = WSP(bf16_t, WS_SH) + (size_t)(ch * 33 + cpos) * 16384;
#pragma unroll
                for (int n = 0; n < 8; ++n) S[n] = cpos ? ld_bf4(SI + (n * 512 + F.tid) * 4) : (f32x4){0.f, 0.f, 0.f, 0.f};
                scan_super<0, 3>(F, jl, b, h, sct, dir, S);
            } else { const bf16_t* SI = WSP(bf16_t, WS_SM) + (size_t)(ch * 33 + cpos) * 10240;
#pragma unroll
                for (int n = 0; n < 8; ++n) S[n] = (cpos && n < 5) ? ld_bf4(SI + (n * 512 + F.tid) * 4) : (f32x4){0.f, 0.f, 0.f, 0.f};
                scan_super<1, 3>(F, jl, b, h, sct, dir, S);
            }
        }
    }
}

template <int PHMASK_T>
__global__ void __launch_bounds__(512, 2) mk_fwd(Args args) {
    extern __shared__ __attribute__((aligned(16))) unsigned char lds_raw[];
    Frame F;
    F.lds = (LAS unsigned char*)lds_raw;
    F.tid = threadIdx.x; F.lane = F.tid & 63; F.wave = __builtin_amdgcn_readfirstlane(F.tid >> 6);
    F.G = gridDim.x; F.bid = blockIdx.x;
    F.out = args.out; F.ws = args.ws; F.ctl = (unsigned*)(args.ws + WS_CTL);
    volatile LAS unsigned* MISC = (volatile LAS unsigned*)(F.lds + MISC_OFF);
    if (F.tid < 64) MISC[F.tid] = 0u;
    if (F.tid >= 64 && F.tid < 64 + 25) { const unsigned long long p = (unsigned long long)args.in[F.tid - 64]; MISC[64 + 2 * (F.tid - 64)] = (unsigned)p; MISC[65 + 2 * (F.tid - 64)] = (unsigned)(p >> 32); }
    __syncthreads();
    const int lo = args.ph_lo, hi = args.ph_hi;
    if (hi - lo > 1) (void)xcd_barrier_post(F.ctl + CW_BAR, MISC + 8);
#define EN(b) ((PHMASK_T >> (b)) & 1)
#define IN(k) (lo <= (k) && (k) < hi)
#if MK_ONE_LAUNCH
#define SEAM(k) do { if (IN(k) && IN((k) + 1)) { XcdBarrier bar_; bar_.bar = (unsigned*)(args.ws + WS_CTL) + CW_BAR; bar_.x = xb_xcc_id(); bar_.st = (volatile LAS unsigned*)(F.lds + MISC_OFF) + 8; bar_.leader = (F.wave == 0 && lane_id_volatile() == 0) ? 1 : 0; xcd_barrier(bar_); } } while (0)
#else
#define SEAM(k) do { } while (0)
#endif
    LAS int* tb = (LAS int*)(F.lds + MISC_OFF + 2048);
    LAS int* cnts = tb + 40;

    if (EN(0) && IN(0)) { _Pragma("unroll 1") for (int rp = 0; rp < REP_PRO; ++rp) { Frame P = fresh(F); phase_prologue(P); } }
    SEAM(0);
    for (int l0 = 0; l0 < 4; ++l0) {
        const int pb = 1 + 10 * l0; const bool rec = (l0 & 1) == 0;
        if (EN(1) && IN(pb + 0)) { Frame P = fresh(F); const int l = fresh_i(l0); if (l0 == 0) phase_norm1<0>(P, l); else phase_norm1<1>(P, l); }
        SEAM(pb + 0);
        if (rec) {
            if (EN(2) && IN(pb + 1)) _Pragma("unroll 1") for (int rp = 0; rp < REP_GIN; ++rp) {
                Frame P = fresh(F); const int l = fresh_i(l0), j = l >> 1;
                pg8::StaticOrder S; S.init(NR, NREC, P.G, P.bid);
                EpiRec E{P.ws, inp_ptr(P, 9) + (size_t)j * 4112, (float*)(P.ws + WS_LB) + l * 512, l};
                pg8::gemm_phase(P.lds, (const bf16_t*)(P.ws + WS_H), (const bf16_t*)(P.ws + WS_WIN) + (size_t)j * NREC * 1024, 1024, 0, S, E, pg8::RowIdentity{}, P.tid);
            }
            SEAM(pb + 1);
            if (EN(3) && IN(pb + 2)) { _Pragma("unroll 1") for (int rp = 0; rp < REP_SCAN1; ++rp) { Frame P = fresh(F); phase_scan1(P); } }
            SEAM(pb + 2);
#pragma unroll 1
            for (int pass = 0; pass < 2; ++pass) {
                if (EN(4) && IN(pb + 3 + pass)) { Frame P = fresh(F); phase_scan23(P, fresh_i(l0) >> 1, fresh_i(pass)); }
                SEAM(pb + 3 + pass);
            }
        } else {
            if (EN(5) && IN(pb + 1)) _Pragma("unroll 1") for (int rp = 0; rp < REP_GIN; ++rp) {
                Frame P = fresh(F); const int l = fresh_i(l0), j = l >> 1;
                pg8::StaticOrder S; S.init(NR, 3072, P.G, P.bid);
                EpiQKV E{P.ws};
                pg8::gemm_phase(P.lds, (const bf16_t*)(P.ws + WS_H), (const bf16_t*)(P.ws + WS_WQKV) + (size_t)j * 3072 * 1024, 1024, 0, S, E, pg8::RowIdentity{}, P.tid);
            }
            SEAM(pb + 1);
            if (EN(6) && IN(pb + 2)) { _Pragma("unroll 1") for (int rp = 0; rp < REP_ATT; ++rp) { Frame P = fresh(F); phase_attn(P, fresh_i(l0) >> 1, l0 == 3); } }
            SEAM(pb + 2);
        }
        if (EN(7) && IN(pb + 5)) {
            Frame P = fresh(F); const int l = fresh_i(l0), j = l >> 1;
            pg8::StaticOrder S; S.init(l0 == 3 ? RL : NR, 1024, P.G, P.bid);
            EpiResid E{(bf16_t*)(P.ws + WS_Y), (const float*)(P.ws + WS_MOD) + l * 5 * 6144};
            pg8::gemm_phase(P.lds, (const bf16_t*)(P.ws + WS_MERGED), (const bf16_t*)(P.ws + ((l & 1) ? WS_WNOUT : WS_WROUT)) + (size_t)j * 1024 * 1024, 1024, 0, S, E, pg8::RowIdentity{}, P.tid);
        }
        SEAM(pb + 5);
        if (EN(8) && IN(pb + 6)) { Frame P = fresh(F); phase_router(P, fresh_i(l0)); }
        SEAM(pb + 6);
        if ((EN(9) && IN(pb + 7)) || (EN(10) && IN(pb + 8))) {
            Frame P = fresh(F); const int l = fresh_i(l0);
            expert_prefix(P, l, tb, cnts, 1, true);
            __syncthreads();
        }
        if (EN(9) && IN(pb + 7)) _Pragma("unroll 1") for (int rp = 0; rp < REP_MOE; ++rp) {
            Frame P = fresh(F); const int l = fresh_i(l0);
            pg8::MoeOrder S{tb, tb[32], 3, P.G, P.bid};
            EpiMoe1 E{(bf16_t*)(P.ws + WS_ACT), inp_ptr(P, 22) + (size_t)l * 32 * 2048};
            pg8::RowGather AO{(const int*)(P.ws + WS_LIST), cnts};
            pg8::gemm_phase(P.lds, (const bf16_t*)(P.ws + WS_H), (const bf16_t*)(P.ws + WS_WGU) + (size_t)l * 32 * 2048 * 1024, 1024, (size_t)2048 * 1024 * 2, S, E, AO, P.tid);
        }
        SEAM(pb + 7);
        if (EN(10) && IN(pb + 8)) _Pragma("unroll 1") for (int rp = 0; rp < REP_MOE; ++rp) {
            Frame P = fresh(F); const int l = fresh_i(l0);
            pg8::MoeOrder S{tb, tb[32], 2, P.G, P.bid};
            EpiMoe2 E{(bf16_t*)(P.ws + WS_YS), inp_ptr(P, 24) + (size_t)l * 32 * 1024};
            pg8::gemm_phase(P.lds, (const bf16_t*)(P.ws + WS_ACT), (const bf16_t*)(P.ws + WS_WD) + (size_t)l * 32 * 1024 * 1024, 1024, (size_t)1024 * 1024 * 2, S, E, pg8::RowIdentity{}, P.tid);
        }
        SEAM(pb + 8);
    }
    if (EN(11) && IN(41)) { Frame P = fresh(F); phase_norm1<2>(P, fresh_i(4)); }
#undef IN
#undef SEAM
}

typedef void (*kern_t)(Args);
static int phase_bit(int p) {
    if (p == 0) return 0; if (p == 41) return 11;
    const int l = (p - 1) / 10, k = (p - 1) % 10; const bool rec = (l & 1) == 0;
    switch (k) { case 0: return 1; case 1: return rec ? 2 : 5; case 2: return rec ? 3 : 6; case 3: return rec ? 3 : -1; case 4: return rec ? 4 : -1; case 5: return 7; case 6: return 8; case 7: return 9; case 8: return 10; default: return -1; }
}
extern "C" void kernel_launch(void* const* d_in, const int* in_sizes, int n_in, void* d_out, int out_size, void* d_ws, size_t ws_size, hipStream_t stream) {
    static int grid = 0;
#if MK_ONE_LAUNCH
    #ifndef ONE_MASK
#define ONE_MASK 0xfff
#endif
    static const kern_t kerns[1] = { mk_fwd<ONE_MASK> };
    const int nk = 1;
#else
    static const kern_t kerns[12] = { mk_fwd<1>, mk_fwd<2>, mk_fwd<4>, mk_fwd<8>, mk_fwd<16>, mk_fwd<32>, mk_fwd<64>, mk_fwd<128>, mk_fwd<256>, mk_fwd<512>, mk_fwd<1024>, mk_fwd<2048> };
    const int nk = 12;
#endif
    if (grid == 0) {
        if (n_in != 25 || out_size != RL * D || ws_size < WS_END) { fprintf(stderr, "kernel_launch: unexpected shapes (n_in %d out %d ws %zu)\n", n_in, out_size, ws_size); grid = -1; return; }
        int dev = 0, cus = 0;
        if (hipGetDevice(&dev) != hipSuccess || hipDeviceGetAttribute(&cus, hipDeviceAttributeMultiprocessorCount, dev) != hipSuccess) { grid = -1; return; }
        for (int i = 0; i < nk; ++i)
            if (hipFuncSetAttribute((const void*)kerns[i], hipFuncAttributeMaxDynamicSharedMemorySize, LDS_BYTES) != hipSuccess) { fprintf(stderr, "kernel_launch: hipFuncSetAttribute failed\n"); grid = -1; return; }
        (void)hipGetLastError();
        grid = cus;
    }
    if (grid < 0) return;
    (void)hipMemsetAsync((char*)d_ws + WS_CTL, 0, CTL_BYTES, stream);
    Args a{};
    for (int i = 0; i < 25; ++i) a.in[i] = (const float*)d_in[i];
    a.out = (float*)d_out; a.ws = (unsigned char*)d_ws;
#if MK_ONE_LAUNCH
    a.ph_lo = 0; a.ph_hi = NPHASE;
    hipLaunchKernelGGL(kerns[0], dim3(grid), dim3(512), LDS_BYTES, stream, a);
#else
    for (int p = 0; p < NPHASE; ++p) {
        const int bit = phase_bit(p); if (bit < 0) continue;
        a.ph_lo = p; a.ph_hi = p + 1;
        hipLaunchKernelGGL(kerns[bit], dim3(grid), dim3(512), LDS_BYTES, stream, a);
    }
#endif
}
```

```cpp
#include <hip/hip_runtime.h>
#include <stdint.h>
#include <stdio.h>

#ifndef MK_ONE_LAUNCH
#define MK_ONE_LAUNCH 1
#endif
#ifndef REP_PRO
#define REP_PRO 1
#endif
#ifndef REP_SCAN1
#define REP_SCAN1 1
#endif
#ifndef REP_SCAN2
#define REP_SCAN2 1
#endif
#ifndef REP_SCAN3
#define REP_SCAN3 1
#endif
#ifndef REP_ATT
#define REP_ATT 1
#endif
#ifndef REP_MOE
#define REP_MOE 1
#endif
#ifndef REP_GIN
#define REP_GIN 1
#endif
#define LAS __attribute__((address_space(3)))
#define GAS __attribute__((address_space(1)))
typedef unsigned short bf16_t;
typedef short bf16x8 __attribute__((ext_vector_type(8)));
typedef float f32x4 __attribute__((ext_vector_type(4)));
typedef float f32x2 __attribute__((ext_vector_type(2)));
typedef unsigned u32x4 __attribute__((ext_vector_type(4)));
typedef unsigned u32x2 __attribute__((ext_vector_type(2)));

constexpr int D = 1024, NB = 4, TL = 8192, TC = 256;
constexpr int RL = NB * TL;
constexpr int RC = NB * TC;
constexpr int NR = RL + RC;
constexpr int NREC = 4352;
constexpr int NE = 32, DFF = 1024;
constexpr int CAP = NR;
constexpr int SLOT_ROWS = 143360;
constexpr float EPS = 1e-6f;
constexpr int NPHASE = 42;

constexpr size_t MiB = 1u << 20;
constexpr size_t WS_CTL = 0, CTL_BYTES = 1 * MiB;
constexpr size_t WS_MOD = 1 * MiB;
constexpr size_t WS_LB = WS_MOD + 512 * 1024;
constexpr size_t WS_ROPE = WS_LB + 8 * 1024;
constexpr size_t WS_WIN = 2 * MiB;
constexpr size_t WS_WROUT = 19 * MiB;
constexpr size_t WS_WQKV = 23 * MiB;
constexpr size_t WS_WNOUT = 35 * MiB;
constexpr size_t WS_WGU = 40 * MiB;
constexpr size_t WS_WD = 552 * MiB;
constexpr size_t WS_X = 808 * MiB;
constexpr size_t WS_H = 940 * MiB;
constexpr size_t WS_MERGED = 1006 * MiB;
constexpr size_t WS_STREAM = 1072 * MiB;
constexpr size_t SZ_B512 = (size_t)NR * 512 * 2;
constexpr size_t SZ_F512 = (size_t)NR * 512 * 4;
constexpr size_t WS_Q = WS_STREAM, WS_KF = WS_Q + SZ_B512, WS_KB = WS_KF + SZ_B512, WS_V = WS_KB + SZ_B512, WS_HG = WS_V + SZ_B512;
constexpr size_t WS_MV = WS_HG + SZ_B512, WS_MO = WS_MV + SZ_B512, WS_MQ = WS_MO + SZ_B512, WS_MK = WS_MQ + SZ_B512 / 2;
constexpr size_t WS_LAF = WS_MK + SZ_B512 / 2, WS_LAB = WS_LAF + SZ_F512, WS_GATES = WS_LAB + SZ_F512;
constexpr size_t WS_OHF = WS_GATES + 3 * MiB, WS_OHB = WS_OHF + SZ_F512, WS_OMF = WS_OHB + SZ_F512, WS_OMB = WS_OMF + SZ_F512;
constexpr size_t WS_STREAM_END = WS_OMB + SZ_F512;
constexpr size_t WS_Y = WS_STREAM;
constexpr size_t WS_QKV = WS_STREAM;
constexpr int TT = TL + TC;
constexpr size_t WS_VTG = WS_STREAM + 200 * MiB;
constexpr size_t WS_SSK = WS_STREAM + 272 * MiB;
constexpr size_t WS_TOKE = 1744 * MiB, WS_TOKP = WS_TOKE + 1 * MiB, WS_TOKW = WS_TOKP + 1 * MiB, WS_LIST = WS_TOKW + 1 * MiB;
constexpr size_t WS_ACT = 1752 * MiB;
constexpr size_t WS_YS = 2032 * MiB;
constexpr size_t WS_END = 2312 * MiB;
static_assert(WS_STREAM_END <= WS_TOKE && WS_QKV + (size_t)NR * 3072 * 2 <= WS_TOKE, "stream region");
static_assert(WS_LIST + (size_t)NE * CAP * 4 <= WS_ACT && WS_ACT + (size_t)SLOT_ROWS * 1024 * 2 <= WS_YS && WS_YS + (size_t)SLOT_ROWS * 1024 * 2 <= WS_END, "moe region");
static_assert(WS_WIN + (size_t)2 * NREC * 1024 * 2 <= WS_WROUT && WS_WGU + (size_t)128 * 2048 * 1024 * 2 <= WS_WD && WS_WD + (size_t)128 * 1024 * 1024 * 2 <= WS_X, "weights");
constexpr int CW_BAR = 4096;
constexpr int CW_CNT = 16384;

constexpr int RING_BYTES = 131072;
constexpr int MISC_OFF = RING_BYTES;
constexpr int LDS_BYTES = 147456;

__device__ __forceinline__ float bf2f(unsigned b) { return __uint_as_float(b << 16); }
typedef _Float16 f16x4 __attribute__((ext_vector_type(4)));
__device__ __forceinline__ f32x4 h4_to_f4(u32x2 q) { return __builtin_convertvector(__builtin_bit_cast(f16x4, q), f32x4); }
__device__ __forceinline__ u32x2 f4_to_h4(f32x4 v) { f32x4 c; c[0] = __builtin_amdgcn_fmed3f(v[0], -65504.f, 65504.f); c[1] = __builtin_amdgcn_fmed3f(v[1], -65504.f, 65504.f); c[2] = __builtin_amdgcn_fmed3f(v[2], -65504.f, 65504.f); c[3] = __builtin_amdgcn_fmed3f(v[3], -65504.f, 65504.f);
    return __builtin_bit_cast(u32x2, __builtin_convertvector(c, f16x4)); }
__device__ __forceinline__ f32x4 ld_bf4(const bf16_t* p) { const u32x2 q = *(const u32x2*)p; return (f32x4){bf2f(q.x & 0xffffu), bf2f(q.x >> 16), bf2f(q.y & 0xffffu), bf2f(q.y >> 16)}; }
__device__ __forceinline__ unsigned f2bf(float f) { unsigned u = __float_as_uint(f); return (u + 0x7fffu + ((u >> 16) & 1u)) >> 16; }
__device__ __forceinline__ unsigned pk2(float lo, float hi) { unsigned r; asm("v_cvt_pk_bf16_f32 %0, %1, %2" : "=v"(r) : "v"(lo), "v"(hi)); return r; }
__device__ __forceinline__ float shx(float v, int o, int lane) { return __int_as_float(__builtin_amdgcn_ds_bpermute((lane ^ o) << 2, __float_as_int(v))); }
__device__ __forceinline__ int shxi(int v, int o, int lane) { return __builtin_amdgcn_ds_bpermute((lane ^ o) << 2, v); }
__device__ __forceinline__ float wave_sum(float v, int) {
    v += __int_as_float(__builtin_amdgcn_update_dpp(0, __float_as_int(v), 0xB1, 0xF, 0xF, true));
    v += __int_as_float(__builtin_amdgcn_update_dpp(0, __float_as_int(v), 0x4E, 0xF, 0xF, true));
    v += __int_as_float(__builtin_amdgcn_update_dpp(0, __float_as_int(v), 0x141, 0xF, 0xF, true));
    v += __int_as_float(__builtin_amdgcn_update_dpp(0, __float_as_int(v), 0x140, 0xF, 0xF, true));
    const float r0 = __int_as_float(__builtin_amdgcn_readlane(__float_as_int(v), 0)), r1 = __int_as_float(__builtin_amdgcn_readlane(__float_as_int(v), 16));
    const float r2 = __int_as_float(__builtin_amdgcn_readlane(__float_as_int(v), 32)), r3 = __int_as_float(__builtin_amdgcn_readlane(__float_as_int(v), 48));
    return (r0 + r1) + (r2 + r3);
}
__device__ __forceinline__ float wave_max(float v, int lane) {
#pragma unroll
    for (int o = 1; o < 64; o <<= 1) v = fmaxf(v, shx(v, o, lane));
    return v;
}
__device__ __forceinline__ int lane_id_volatile() { int l; asm volatile("v_mbcnt_lo_u32_b32 %0, -1, 0\n\tv_mbcnt_hi_u32_b32 %0, -1, %0" : "=v"(l)); return l; }
__device__ __forceinline__ float sigmoidf_(float x) { return __builtin_amdgcn_rcpf(1.0f + __builtin_amdgcn_exp2f(x * -1.4426950408889634f)); }
__device__ __forceinline__ float siluf_(float x) { return x * sigmoidf_(x); }
__device__ __forceinline__ float logsigmoidf_(float x) { return fminf(x, 0.f) - 0.6931471805599453f * __builtin_amdgcn_logf(1.0f + __builtin_amdgcn_exp2f(fabsf(x) * -1.4426950408889634f)); }
__device__ __forceinline__ int row_bidx(int r) { return r < RL ? (r >> 13) : 4; }

#define XB_TMO      128
#define XB_XCNT(j)  (256  + 64 * (j))
#define XB_XSUB(j)  (1280 + 64 * (j))
#define XB_XGEN(j)  (2304 + 64 * (j))
#define XB_TOP      3328
#define XB_TOPGEN   3392
#define XCD_BAR_WORDS 3456
#define XB_SPIN_CAP (1u << 18)
__device__ __forceinline__ unsigned xb_ld(unsigned* p)              { return __hip_atomic_load((GAS unsigned*)p, __ATOMIC_RELAXED, __HIP_MEMORY_SCOPE_AGENT); }
__device__ __forceinline__ unsigned xb_add(unsigned* p, unsigned v) { return __hip_atomic_fetch_add((GAS unsigned*)p, v, __ATOMIC_RELAXED, __HIP_MEMORY_SCOPE_AGENT); }
__device__ __forceinline__ unsigned xb_xcc_id() { return (unsigned)__builtin_amdgcn_s_getreg((3 << 11) | 20) & 0xFu; }
#define XB_SPIN(cond, bar) do { unsigned _sp = 0; while (cond) { __builtin_amdgcn_s_sleep(1); \
    if ((++_sp & 255u) == 0u) { if (xb_ld(&(bar)[XB_TMO])) break; if (_sp > XB_SPIN_CAP) { (void)xb_add(&(bar)[XB_TMO], 1u); break; } } } } while (0)
struct XcdBarrier { unsigned* bar; unsigned x; volatile LAS unsigned* st; int leader; };
__device__ __forceinline__ XcdBarrier xcd_barrier_post(unsigned* bar, volatile LAS unsigned* st) {
    XcdBarrier b; b.bar = bar; b.x = xb_xcc_id(); b.st = st;
    if (threadIdx.x == 0) (void)xb_add(&bar[XB_XCNT(b.x)], 1u);
    return b;
}
__device__ __forceinline__ void xcd_barrier_complete(unsigned* bar, unsigned x, unsigned& nloc, unsigned& nx) {
    const unsigned G = gridDim.x * gridDim.y * gridDim.z;
    unsigned sum, cnt, mine, sp = 0u;
    for (;;) {
        sum = 0u; cnt = 0u; mine = 0u;
#pragma unroll
        for (unsigned j = 0; j < 16; ++j) { const unsigned c = xb_ld(&bar[XB_XCNT(j)]); sum += c; cnt += (c > 0u) ? 1u : 0u; mine = (j == x) ? c : mine; }
        if (sum == G) break;
        __builtin_amdgcn_s_sleep(1);
        if ((++sp & 255u) == 0u) { if (xb_ld(&bar[XB_TMO])) break; if (sp > XB_SPIN_CAP) { (void)xb_add(&bar[XB_TMO], 1u); break; } }
    }
    nloc = mine > 0u ? mine : 1u; nx = cnt > 0u ? cnt : 1u;
}
__device__ __noinline__ void xcd_barrier(const XcdBarrier b) {
    asm volatile("s_waitcnt vmcnt(0)" ::: "memory");
    __syncthreads();
    if (b.leader) {
        unsigned* bar = b.bar;
        __builtin_amdgcn_s_waitcnt(0);
        unsigned nloc = b.st[0], nx = b.st[1];
        if (nloc == 0u) { xcd_barrier_complete(bar, b.x, nloc, nx); b.st[0] = nloc; b.st[1] = nx; }
        const unsigned old = xb_add(&bar[XB_XSUB(b.x)], 1u);
        const unsigned gen = old / nloc;
        if (old + 1u == (gen + 1u) * nloc) {
            __builtin_amdgcn_fence(__ATOMIC_RELEASE, "agent");
            asm volatile("s_waitcnt vmcnt(0)" ::: "memory");
            const unsigned og = xb_add(&bar[XB_TOP], 1u);
            const unsigned tg = og / nx;
            if (og + 1u == (tg + 1u) * nx) xb_add(&bar[XB_TOPGEN], 1u);
            else XB_SPIN(xb_ld(&bar[XB_TOPGEN]) == tg, bar);
            __builtin_amdgcn_fence(__ATOMIC_ACQUIRE, "agent");
            xb_add(&bar[XB_XGEN(b.x)], 1u);
            asm volatile("s_waitcnt vmcnt(0)" ::: "memory");
        } else {
            XB_SPIN(xb_ld(&bar[XB_XGEN(b.x)]) == gen, bar);
            __builtin_amdgcn_fence(__ATOMIC_ACQUIRE, "agent");
            asm volatile("s_waitcnt vmcnt(0)" ::: "memory");
        }
    }
    __syncthreads();
}

namespace pg8 {
constexpr int BM = 256, BK = 64, HALF = 128, HTB = HALF * BK * 2, STAGE_BYTES = 8 * HTB, NXCD = 8, WGM = 8;
__host__ __device__ __forceinline__ int lds_byte(int r, int c) { const int st = (r >> 4) * 2 + (c >> 5), rr = r & 15, cc = c & 31, ob = rr * 64 + cc * 2; return st * 1024 + (ob ^ (((ob >> 9) & 1) << 5)); }
__host__ __device__ __forceinline__ void stage_rc(int b, int& R, int& C) { const int st = b / 1024, sb = b % 1024, swz = sb ^ (((sb >> 9) & 1) << 5); R = (st >> 1) * 16 + swz / 64; C = (st & 1) * 32 + (swz % 64) / 2; }
__host__ __device__ __forceinline__ int perm32(int rho) { const int n = rho >> 4, i = rho & 15; return 8 * (i >> 2) + 4 * n + (i & 3); }
struct Unit { int pm, pn, e, mt; };
struct StaticOrder {
    int nM, nN, nwg, G, c;
    __device__ void init(int M, int N, int G_, int c_) { nM = M / BM; nN = N / BM; nwg = nM * nN; G = G_; c = c_; }
    __device__ bool next(int i, Unit& u) const {
        const long L = (long)i * G + c; if (L >= nwg) return false;
        int wgid = (int)L; { const int q = nwg / NXCD, r = nwg % NXCD, xcd = wgid % NXCD, off = wgid / NXCD; wgid = (xcd < r ? xcd * (q + 1) : r * (q + 1) + (xcd - r) * q) + off; }
        const int nig = WGM * nN, gid = wgid / nig, fm = gid * WGM, gsz = (nM - fm) < WGM ? (nM - fm) : WGM;
        u.pm = fm + ((wgid % nig) % gsz); u.pn = (wgid % nig) / gsz; u.e = 0; u.mt = 0; return true;
    }
};
struct MoeOrder {
    const LAS int* tb; int T, lg, G, c;
    __device__ bool next(int i, Unit& u) const {
        int tile, pn; const int npn = 1 << lg;
        if (G == 256) { const int x = c & 7, j = c >> 3, tpx = 32 >> lg; tile = (i * 8 + x) * tpx + (j >> lg); pn = j & (npn - 1); }
        else { const long L = (long)i * G + c; tile = (int)(L >> lg); pn = (int)(L & (npn - 1)); }
        if (tile >= T) return false;
        int ln_; asm volatile("v_mbcnt_lo_u32_b32 %0, -1, 0\n\tv_mbcnt_hi_u32_b32 %0, -1, %0" : "=v"(ln_));
        const int e = (int)__builtin_popcountll(__ballot(ln_ < 31 && tb[(ln_ < 31 ? ln_ : 31) + 1] <= tile));
        u.e = e; u.mt = tile - tb[e]; u.pm = tile; u.pn = pn; return true;
    }
};
struct RowIdentity { static constexpr bool GATHER = false; __device__ __forceinline__ int row(const Unit& u, int r) const { return r; } };
struct RowGather { static constexpr bool GATHER = true; const int* list; const LAS int* cnt; __device__ __forceinline__ int row(const Unit& u, int r) const { const int p = u.mt * BM + r; return p < cnt[u.e] ? list[(size_t)u.e * CAP + p] : 0; } };

__device__ __forceinline__ unsigned cvt_pk_bf16(float lo, float hi) { unsigned r; asm volatile("v_cvt_pk_bf16_f32 %0, %1, %2" : "=v"(r) : "v"(lo), "v"(hi)); return r; }

template <class Epi, class Sched, class AOff>
__device__ __forceinline__ void gemm_phase(LAS unsigned char* lds, const bf16_t* A, const bf16_t* Bt, const int K, const size_t estride  , const Sched& S, const Epi& E, const AOff& AO, const int tid) {
    const int wid = __builtin_amdgcn_readfirstlane(tid >> 6), lane = tid & 63, wr = wid >> 2, wc = wid & 3, fr = lane & 15, fq = lane >> 4;
    const int nt = K / BK;
    int Rr[2], Cc[2]; unsigned voffB[2];
#pragma unroll
    for (int i = 0; i < 2; ++i) { int R, C; stage_rc(tid * 16 + i * 8192, R, C); const int Rb = Epi::PERM ? ((R & ~31) + perm32(R & 31)) : R;
        Rr[i] = R; Cc[i] = C; voffB[i] = (unsigned)(Rb * K + C) * 2u; }
    const size_t kstep = (size_t)(BK * 2);
    const size_t hstep = (size_t)HALF * K * 2;
    const size_t tstep = 2 * hstep;
    const unsigned ldsw = (unsigned)wid * 1024u;
    const int aoff = lds_byte(wr * 64 + fr, fq * 8), boff = lds_byte(wc * 32 + fr, fq * 8);
#define PG8_SA(b, h) (((b) * 2 + (h)) * HTB)
#define PG8_SB(b, h) ((4 + (b) * 2 + (h)) * HTB)
#define PG8_STAGE(bufoff, gbase, voff) do { _Pragma("unroll") for (int _i = 0; _i < 2; ++_i) \
        __builtin_amdgcn_global_load_lds((const unsigned*)((const char*)(gbase) + (voff)[_i]), (LAS unsigned*)(lds + (bufoff) + ldsw + _i * 8192), 16, 0, 0); } while (0)
#define PG8_STAGE2(bufoff, gbase, v0, v1) do { \
        __builtin_amdgcn_global_load_lds((const unsigned*)((const char*)(gbase) + (v0)), (LAS unsigned*)(lds + (bufoff) + ldsw), 16, 0, 0); \
        __builtin_amdgcn_global_load_lds((const unsigned*)((const char*)(gbase) + (v1)), (LAS unsigned*)(lds + (bufoff) + ldsw + 8192), 16, 0, 0); } while (0)
#define PG8_LDA(dst, b, h) do { _Pragma("unroll") for (int m = 0; m < 4; ++m) _Pragma("unroll") for (int k = 0; k < 2; ++k) dst[m][k] = *(const LAS bf16x8*)(lds + PG8_SA(b, h) + aoff + m * 2048 + k * 1024); } while (0)
#define PG8_LDB(dst, b, h) do { _Pragma("unroll") for (int n = 0; n < 2; ++n) _Pragma("unroll") for (int k = 0; k < 2; ++k) dst[n][k] = *(const LAS bf16x8*)(lds + PG8_SB(b, h) + boff + n * 2048 + k * 1024); } while (0)
#define PG8_MMA(ai, bj, At, Bt_) do { __builtin_amdgcn_s_setprio(1); _Pragma("unroll") for (int m = 0; m < 4; ++m) _Pragma("unroll") for (int n = 0; n < 2; ++n) _Pragma("unroll") for (int k = 0; k < 2; ++k) \
        acc[ai][bj][m][n] = __builtin_amdgcn_mfma_f32_16x16x32_bf16(Bt_[n][k], At[m][k], acc[ai][bj][m][n], 0, 0, 0); __builtin_amdgcn_s_setprio(0); } while (0)
#define PG8_WAIT_V(n) asm volatile("s_waitcnt vmcnt(" #n ")" ::: "memory")
#define PG8_WAIT_L(n) asm volatile("s_waitcnt lgkmcnt(" #n ")" ::: "memory")
#define PG8_BAR __builtin_amdgcn_s_barrier()
#define PG8_SCHED __builtin_amdgcn_sched_barrier(0)
#define PG8_AOFFS(dst, u) do { _Pragma("unroll") for (int _h = 0; _h < 2; ++_h) _Pragma("unroll") for (int _i = 0; _i < 2; ++_i) \
        dst[_h][_i] = ((unsigned)AO.row(u, _h * HALF + Rr[_i]) * (unsigned)K + (unsigned)Cc[_i]) * 2u; } while (0)
    Unit cur, nxt; int ui = 0;
    if (!S.next(0, cur)) return;
    f32x4 acc[2][2][4][2];
#pragma unroll
    for (int a = 0; a < 2; ++a)
#pragma unroll
        for (int b = 0; b < 2; ++b)
#pragma unroll
            for (int m = 0; m < 4; ++m)
#pragma unroll
                for (int n = 0; n < 2; ++n) acc[a][b][m][n] = (f32x4){0.f, 0.f, 0.f, 0.f};
    bf16x8 At[4][2], B0[2][2], B1[2][2];
    unsigned vc[2][2], vn[2][2];
    PG8_AOFFS(vc, cur);
    const char* Ab = (const char*)A;
    const char* aC = AOff::GATHER ? Ab : Ab + (size_t)cur.pm * tstep;
    const char* cB = (const char*)Bt + (size_t)cur.e * estride + (size_t)cur.pn * tstep;
    PG8_STAGE(PG8_SB(0, 0), cB, voffB); PG8_STAGE2(PG8_SA(0, 0), aC, vc[0][0], vc[0][1]); PG8_STAGE(PG8_SB(0, 1), cB + hstep, voffB); PG8_STAGE2(PG8_SA(0, 1), aC, vc[1][0], vc[1][1]);
    if (wr == 1) PG8_BAR;
    PG8_WAIT_V(4); PG8_BAR;
    PG8_STAGE(PG8_SB(1, 0), cB + kstep, voffB); PG8_STAGE2(PG8_SA(1, 0), aC + kstep, vc[0][0], vc[0][1]); PG8_STAGE(PG8_SB(1, 1), cB + hstep + kstep, voffB);
    PG8_WAIT_V(6); PG8_BAR;
    for (;;) {
        const bool has_next = S.next(ui + 1, nxt);
        if (AOff::GATHER && has_next) { PG8_AOFFS(vn, nxt); }
        else {
#pragma unroll
            for (int _h = 0; _h < 2; ++_h)
#pragma unroll
                for (int _i = 0; _i < 2; ++_i) vn[_h][_i] = vc[_h][_i];
        }
        const char* nB = has_next ? (const char*)Bt + (size_t)nxt.e * estride + (size_t)nxt.pn * tstep : cB;
        const char* aN = (AOff::GATHER || !has_next) ? aC : Ab + (size_t)nxt.pm * tstep;
        for (int t = 0; t < nt; t += 2) {
            const bool last = (t == nt - 2);
            const char* a1 = aC + (size_t)(t + 1) * kstep;
            const char* a2 = last ? aN : aC + (size_t)(t + 2) * kstep; const char* b2 = last ? nB : cB + (size_t)(t + 2) * kstep;
            const char* a3 = a2 + kstep; const char* b3 = b2 + kstep;
            const unsigned x00 = last ? vn[0][0] : vc[0][0], x01 = last ? vn[0][1] : vc[0][1], x10 = last ? vn[1][0] : vc[1][0], x11 = last ? vn[1][1] : vc[1][1];
            PG8_LDB(B0, 0, 0); PG8_SCHED; PG8_LDA(At, 0, 0); PG8_STAGE2(PG8_SA(1, 1), a1, vc[1][0], vc[1][1]);
            PG8_WAIT_L(8); PG8_BAR; PG8_WAIT_L(0); PG8_MMA(0, 0, At, B0); PG8_BAR; PG8_SCHED;
            PG8_LDB(B1, 0, 1); PG8_STAGE(PG8_SB(0, 0), b2, voffB);
            PG8_BAR; PG8_WAIT_L(0); PG8_MMA(0, 1, At, B1); PG8_BAR;
            PG8_LDA(At, 0, 1); PG8_STAGE2(PG8_SA(0, 0), a2, x00, x01);
            PG8_BAR; PG8_WAIT_L(0); PG8_MMA(1, 0, At, B0); PG8_BAR; PG8_SCHED;
            PG8_STAGE(PG8_SB(0, 1), b2 + hstep, voffB);
            PG8_WAIT_V(6); PG8_BAR; PG8_MMA(1, 1, At, B1); PG8_BAR;
            PG8_LDB(B0, 1, 0); PG8_SCHED; PG8_LDA(At, 1, 0); PG8_STAGE2(PG8_SA(0, 1), a2, x10, x11);
            PG8_WAIT_L(8); PG8_BAR; PG8_WAIT_L(0); PG8_MMA(0, 0, At, B0); PG8_BAR; PG8_SCHED;
            PG8_LDB(B1, 1, 1); PG8_STAGE(PG8_SB(1, 0), b3, voffB);
            PG8_BAR; PG8_WAIT_L(0); PG8_MMA(0, 1, At, B1); PG8_BAR;
            PG8_LDA(At, 1, 1); PG8_STAGE2(PG8_SA(1, 0), a3, x00, x01);
            PG8_BAR; PG8_WAIT_L(0); PG8_MMA(1, 0, At, B0); PG8_BAR; PG8_SCHED;
            PG8_STAGE(PG8_SB(1, 1), b3 + hstep, voffB);
            PG8_WAIT_V(6); PG8_BAR; PG8_MMA(1, 1, At, B1); PG8_BAR;
        }
        E(acc, cur, wr, wc, fr, fq);
        if (!has_next) break;
#pragma unroll
        for (int a = 0; a < 2; ++a)
#pragma unroll
            for (int b = 0; b < 2; ++b)
#pragma unroll
                for (int m = 0; m < 4; ++m)
#pragma unroll
                    for (int n = 0; n < 2; ++n) acc[a][b][m][n] = (f32x4){0.f, 0.f, 0.f, 0.f};
        cur = nxt; cB = nB; aC = aN; ++ui;
#pragma unroll
        for (int _h = 0; _h < 2; ++_h)
#pragma unroll
            for (int _i = 0; _i < 2; ++_i) vc[_h][_i] = vn[_h][_i];
    }
    PG8_WAIT_V(0);
    if (wr == 0) PG8_BAR;
    PG8_BAR;
#undef PG8_SA
#undef PG8_SB
#undef PG8_STAGE
#undef PG8_STAGE2
#undef PG8_LDA
#undef PG8_LDB
#undef PG8_MMA
#undef PG8_WAIT_V
#undef PG8_WAIT_L
#undef PG8_BAR
#undef PG8_SCHED
#undef PG8_AOFFS
}
}

struct Args { const float* in[25]; float* out; unsigned char* ws; int ph_lo, ph_hi; };
struct Frame {
    LAS unsigned char* lds; int tid, lane, wave, G, bid;
    float* out; unsigned char* ws; unsigned* ctl;
};
__device__ __forceinline__ const float* inp_ptr(const Frame& F, int k) {
    const LAS unsigned* t = (const LAS unsigned*)(F.lds + MISC_OFF + 256) + 2 * k;
    const unsigned lo = __builtin_amdgcn_readfirstlane(t[0]), hi = __builtin_amdgcn_readfirstlane(t[1]);
    return (const float*)(const GAS float*)(((unsigned long long)hi << 32) | lo);
}
#define INP(k) inp_ptr(F, (k))
__device__ __forceinline__ Frame fresh(const Frame& F) {
    Frame P = F;
    int z = 0;
    asm volatile("" : "+s"(z), "+s"(P.G), "+s"(P.bid), "+s"(P.wave));
    P.lane = lane_id_volatile() & 63; P.tid = (P.wave << 6) | P.lane;
    P.ws = F.ws + z; P.out = F.out + z;
    P.wave &= 7; P.ctl = (unsigned*)(P.ws + WS_CTL);
    return P;
}
__device__ __forceinline__ int fresh_i(int v) { asm volatile("" : "+s"(v)); return v; }
#define WSP(T, off) ((T*)(F.ws + (off)))

template <class T> __device__ __forceinline__ T* opaque(T* p) { int z = 0; asm volatile("" : "+s"(z)); return p + z; }
__device__ __forceinline__ u32x4 pack8(const f32x4 a, const f32x4 b) { u32x4 w; w.x = pk2(a[0], a[1]); w.y = pk2(a[2], a[3]); w.z = pk2(b[0], b[1]); w.w = pk2(b[2], b[3]); return w; }
__device__ __forceinline__ f32x4 sigm4(const f32x4 a) { const f32x4 z = a * -1.4426950408889634f; f32x4 e, r;
#pragma unroll
    for (int j = 0; j < 4; ++j) e[j] = __builtin_amdgcn_exp2f(z[j]);
    const f32x4 d = e + 1.0f;
#pragma unroll
    for (int j = 0; j < 4; ++j) r[j] = __builtin_amdgcn_rcpf(d[j]);
    return r; }
__device__ __forceinline__ f32x4 silu4(const f32x4 a) { return a * sigm4(a); }
__device__ __forceinline__ f32x4 lsig4(const f32x4 a) { return (f32x4){logsigmoidf_(a[0]), logsigmoidf_(a[1]), logsigmoidf_(a[2]), logsigmoidf_(a[3])}; }
__device__ __forceinline__ void fgate4(const f32x4 x, const f32x4 lbv, f32x4& kk, f32x4& la) {
    const f32x4 z = x * -1.4426950408889634f; f32x4 e, sg, lg;
#pragma unroll
    for (int j = 0; j < 4; ++j) e[j] = __builtin_amdgcn_exp2f(fminf(z[j], 125.0f));
    const f32x4 d = e + 1.0f;
#pragma unroll
    for (int j = 0; j < 4; ++j) sg[j] = __builtin_amdgcn_rcpf(d[j]);
    const f32x4 om = 1.0f - lbv;
    const f32x4 f = lbv + om * sg;
    kk = om * (1.0f - sg);
#pragma unroll
    for (int j = 0; j < 4; ++j) lg[j] = __builtin_amdgcn_logf(f[j]);
    la = lg * 0.6931471805599453f;
}
template <int KIND>
__device__ __forceinline__ void rec_group(unsigned char* ws, const float* bias, const float* lb, f32x4 v0, f32x4 v1, int row, int gc, int sc, int ct, int wc, int fq, int fr, bool latent) {
    const bool gate_lane = (KIND != 9) || (ct < 16);
    const int gcs = gate_lane ? gc : 0;
    v0 += *(const f32x4*)((const char*)bias + (unsigned)(gcs * 4)); v1 += *(const f32x4*)((const char*)bias + (unsigned)(gcs * 4 + 16));
    if (KIND == 0) {
        *(u32x4*)(ws + WS_Q + (unsigned)(row * 1024 + sc * 2)) = pack8(silu4(v0) * 0.08838834764831845f, silu4(v1) * 0.08838834764831845f);
    } else if (KIND == 1 || KIND == 2) {
        f32x4 k0, k1, l0, l1;
        fgate4(v0, *(const f32x4*)((const char*)lb + (unsigned)(sc * 4)), k0, l0); fgate4(v1, *(const f32x4*)((const char*)lb + (unsigned)(sc * 4 + 16)), k1, l1);
        *(u32x4*)(ws + (KIND == 1 ? WS_KF : WS_KB) + (unsigned)(row * 1024 + sc * 2)) = pack8(k0, k1);
        float* lp = (float*)(ws + (KIND == 1 ? WS_LAF : WS_LAB) + (unsigned)(row * 2048 + sc * 4));
        *(f32x4*)lp = l0; *(f32x4*)(lp + 4) = l1;
    } else if (KIND == 3 || KIND == 4 || KIND == 7 || KIND == 8) {
        if (KIND == 4) { v0 = silu4(v0); v1 = silu4(v1); }
        if (KIND == 8) { v0 = sigm4(v0); v1 = sigm4(v1); }
        const size_t off = KIND == 3 ? WS_V : KIND == 4 ? WS_HG : KIND == 7 ? WS_MV : WS_MO;
        *(u32x4*)(ws + off + (unsigned)(row * 1024 + sc * 2)) = pack8(v0, v1);
    } else if (KIND == 5 || KIND == 6) {
        if (KIND == 6) { v0 *= 0.125f; v1 *= 0.125f; }
        f32x4 p0, p1;
#pragma unroll
        for (int j = 0; j < 4; ++j) { p0[j] = shx(v0[j], 32, fq * 16 + fr); p1[j] = shx(v1[j], 32, fq * 16 + fr); }
        if (latent) {
            const int t = row & 8191; const int pos = (wc & 1) ? (t & 63) : (t >> 6);
            const f32x4* rp = (const f32x4*)((const f32x2*)(ws + WS_ROPE) + pos * 16 + 8 * (fq & 1));
            const f32x4 c01 = rp[0], c23 = rp[1], c45 = rp[2], c67 = rp[3];
            const f32x4 cs0 = (f32x4){c01[0], c01[2], c23[0], c23[2]}, sn0 = (f32x4){c01[1], c01[3], c23[1], c23[3]};
            const f32x4 cs1 = (f32x4){c45[0], c45[2], c67[0], c67[2]}, sn1 = (f32x4){c45[1], c45[3], c67[1], c67[3]};
            const float sg = (fq >= 2) ? 1.0f : -1.0f;
            v0 = v0 * cs0 + sg * (p0 * sn0); v1 = v1 * cs1 + sg * (p1 * sn1);
        }
        *(u32x4*)(ws + (KIND == 5 ? WS_MQ : WS_MK) + (unsigned)(row * 512 + sc * 2)) = pack8(v0, v1);
    } else {
        if (gate_lane) { float* gp = (float*)(ws + WS_GATES + (unsigned)(row * 64 + ct * 4)); *(f32x4*)gp = v0; *(f32x4*)(gp + 4) = lsig4(v1); }
    }
}
struct EpiRec {
    static constexpr bool PERM = true;
    unsigned char* ws; const float* bias; const float* lb; int layer;
    template <int KIND>
    __device__ __forceinline__ void run(const f32x4 (&acc)[2][2][4][2], const pg8::Unit& u, int wr, int wc, int fr, int fq, int cbase  ) const {
        const int row0 = u.pm * 256 + wr * 64 + fr;
        const bool latent = u.pm < 128;
#define REC_G(ai, m) { const int row = row0 + (ai) * 128 + (m) * 16; \
        { const int ct = wc * 32 + 8 * fq; rec_group<KIND>(ws, bias, lb, acc[ai][0][m][0], acc[ai][0][m][1], row, u.pn * 256 + ct, cbase + ct, ct, wc, fq, fr, latent); } \
        if (KIND != 9) { const int ct = 128 + wc * 32 + 8 * fq; rec_group<KIND>(ws, bias, lb, acc[ai][1][m][0], acc[ai][1][m][1], row, u.pn * 256 + ct, cbase + ct, ct, wc, fq, fr, latent); } if ((m) == 3) asm volatile("" ::: "memory"); }
        REC_G(0, 0) REC_G(0, 1) REC_G(0, 2) REC_G(0, 3) REC_G(1, 0) REC_G(1, 1) REC_G(1, 2) REC_G(1, 3)
#undef REC_G
    }
    __device__ __forceinline__ void operator()(const f32x4 (&acc)[2][2][4][2], const pg8::Unit& u, int wr, int wc, int fr, int fq) const {
        const int pn = u.pn;
        EpiRec o{opaque(ws), opaque(bias), opaque(lb), layer};
        asm volatile("" : "+v"(fr), "+v"(fq));
        o.dispatch(acc, u, wr, wc, fr, fq, pn);
    }
    __device__ __forceinline__ void dispatch(const f32x4 (&acc)[2][2][4][2], const pg8::Unit& u, int wr, int wc, int fr, int fq, int pn) const {
        if (pn < 2) run<0>(acc, u, wr, wc, fr, fq, pn * 256);
        else if (pn < 4) run<1>(acc, u, wr, wc, fr, fq, (pn - 2) * 256);
        else if (pn < 6) run<2>(acc, u, wr, wc, fr, fq, (pn - 4) * 256);
        else if (pn < 8) run<3>(acc, u, wr, wc, fr, fq, (pn - 6) * 256);
        else if (pn < 10) run<4>(acc, u, wr, wc, fr, fq, (pn - 8) * 256);
        else if (pn == 10) run<5>(acc, u, wr, wc, fr, fq, 0);
        else if (pn == 11) run<6>(acc, u, wr, wc, fr, fq, 0);
        else if (pn < 14) run<7>(acc, u, wr, wc, fr, fq, (pn - 12) * 256);
        else if (pn < 16) run<8>(acc, u, wr, wc, fr, fq, (pn - 14) * 256);
        else run<9>(acc, u, wr, wc, fr, fq, 0);
    }
};
struct EpiQKV {
    static constexpr bool PERM = true;
    unsigned char* ws;
    __device__ __forceinline__ void operator()(const f32x4 (&acc)[2][2][4][2], const pg8::Unit& u, int wr, int wc, int fr, int fq) const {
        const int row0 = u.pm * 256 + wr * 64 + fr;
        unsigned char* w_ = opaque(ws);
        asm volatile("" : "+v"(fr), "+v"(fq));
        if (u.pn < 8) {
            const int col0 = u.pn * 256 + wc * 32 + 8 * fq;
#pragma unroll
            for (int ai = 0; ai < 2; ++ai)
#pragma unroll
                for (int m = 0; m < 4; ++m) { const int row = row0 + ai * 128 + m * 16; const unsigned ob = (unsigned)(row * 3072 + col0) * 2u;
#pragma unroll
                    for (int bj = 0; bj < 2; ++bj) { const f32x4 v0 = acc[ai][bj][m][0], v1 = acc[ai][bj][m][1];
                        *(u32x4*)(w_ + WS_QKV + (ob + bj * 256u)) = pack8(v0, v1);
                        if (u.pn >= 4) {
                            float ss = (v0[0] * v0[0] + v0[1] * v0[1]) + (v0[2] * v0[2] + v0[3] * v0[3]) + (v1[0] * v1[0] + v1[1] * v1[1]) + (v1[2] * v1[2] + v1[3] * v1[3]);
                            const int lane = fq * 16 + fr; ss += shx(ss, 16, lane); ss += shx(ss, 32, lane);
                            if (fq == 0) atomicAdd((float*)(w_ + WS_SSK) + row * 16 + (((u.pn - 4) * 256 + bj * 128 + wc * 32) >> 6), ss); } } }
        } else {
            const int b = u.pm < 128 ? (u.pm >> 5) : (u.pm - 128); const int tt0 = u.pm < 128 ? ((u.pm & 31) * 256) : TL;
#pragma unroll
            for (int ai = 0; ai < 2; ++ai)
#pragma unroll
                for (int m = 0; m < 4; ++m) { const int tt = tt0 + wr * 64 + fr + ai * 128 + m * 16;
#pragma unroll
                    for (int bj = 0; bj < 2; ++bj) { const int c = (u.pn - 8) * 256 + bj * 128 + wc * 32 + 8 * fq;
                        const unsigned base = (unsigned)(((b * 16 + (c >> 6)) * 64 + (c & 63)) * TT + tt) * 2u;
                        const u32x4 pk = pack8(acc[ai][bj][m][0], acc[ai][bj][m][1]); const unsigned pw[4] = {pk.x, pk.y, pk.z, pk.w};
#pragma unroll
                        for (int q = 0; q < 8; ++q) *(bf16_t*)(w_ + WS_VTG + (base + (unsigned)q * (TT * 2u))) = (bf16_t)((q & 1) ? (pw[q >> 1] >> 16) : (pw[q >> 1] & 0xffffu)); } }
        }
    }
};
struct EpiResid {
    static constexpr bool PERM = true;
    bf16_t* Y; const float* modl;
    __device__ __forceinline__ void operator()(const f32x4 (&acc)[2][2][4][2], const pg8::Unit& u, int wr, int wc, int fr, int fq) const {
        const int row0 = u.pm * 256 + wr * 64 + fr, col0 = u.pn * 256 + wc * 32 + 8 * fq;
        const int bidx = u.pm < 128 ? (u.pm >> 5) : 4;
        bf16_t* Y = opaque(this->Y);
        const float* g = opaque(modl) + bidx * 6144 + 2048 + col0;
        f32x4 gv[2][2];
#pragma unroll
        for (int bj = 0; bj < 2; ++bj) { gv[bj][0] = *(const f32x4*)(g + bj * 128); gv[bj][1] = *(const f32x4*)(g + bj * 128 + 4); }
#pragma unroll
        for (int ai = 0; ai < 2; ++ai)
#pragma unroll
            for (int m = 0; m < 4; ++m) { const unsigned ob = (unsigned)((row0 + ai * 128 + m * 16) * 1024 + col0) * 2u;
#pragma unroll
                for (int bj = 0; bj < 2; ++bj) *(u32x4*)((char*)Y + (ob + bj * 256u)) = pack8(acc[ai][bj][m][0] * gv[bj][0], acc[ai][bj][m][1] * gv[bj][1]); }
    }
};
__device__ __forceinline__ f32x4 swiglu4(const f32x4 g, const f32x4 u) {
    f32x4 gt, up, e, r;
#pragma unroll
    for (int j = 0; j < 4; ++j) { gt[j] = fminf(g[j], 7.0f); up[j] = __builtin_amdgcn_fmed3f(u[j], -7.0f, 7.0f); }
    const f32x4 z = gt * -2.4554669595930157f;
#pragma unroll
    for (int j = 0; j < 4; ++j) e[j] = __builtin_amdgcn_exp2f(z[j]);
    const f32x4 d = e + 1.0f;
#pragma unroll
    for (int j = 0; j < 4; ++j) r[j] = __builtin_amdgcn_rcpf(d[j]);
    return (gt * r) * (up + 1.0f);
}
struct EpiMoe1 {
    static constexpr bool PERM = true;
    bf16_t* ACT; const float* bgu;
    __device__ __forceinline__ void operator()(const f32x4 (&acc)[2][2][4][2], const pg8::Unit& u, int wr, int wc, int fr, int fq) const {
        const int row0 = u.pm * 256 + wr * 64 + fr, c0 = u.pn * 128 + wc * 32 + 8 * fq;
        bf16_t* ACT = opaque(this->ACT);
        const float* bg = opaque(bgu) + (size_t)u.e * 2048 + c0; const float* bu = bg + 1024;
        const f32x4 g0 = *(const f32x4*)bg, g1 = *(const f32x4*)(bg + 4), u0 = *(const f32x4*)bu, u1 = *(const f32x4*)(bu + 4);
#pragma unroll
        for (int ai = 0; ai < 2; ++ai)
#pragma unroll
            for (int m = 0; m < 4; ++m) {
                const f32x4 ga = acc[ai][0][m][0] + g0, gb = acc[ai][0][m][1] + g1, ua = acc[ai][1][m][0] + u0, ub = acc[ai][1][m][1] + u1;
                const f32x4 ra = swiglu4(ga, ua), rb = swiglu4(gb, ub);
                const float r[8] = {ra[0], ra[1], ra[2], ra[3], rb[0], rb[1], rb[2], rb[3]};
                u32x4 w; w.x = pk2(r[0], r[1]); w.y = pk2(r[2], r[3]); w.z = pk2(r[4], r[5]); w.w = pk2(r[6], r[7]);
                *(u32x4*)((char*)ACT + (unsigned)((row0 + ai * 128 + m * 16) * 1024 + c0) * 2u) = w;
            }
    }
};
struct EpiMoe2 {
    static constexpr bool PERM = true;
    bf16_t* YS; const float* bd;
    __device__ __forceinline__ void operator()(const f32x4 (&acc)[2][2][4][2], const pg8::Unit& u, int wr, int wc, int fr, int fq) const {
        const int row0 = u.pm * 256 + wr * 64 + fr, col0 = u.pn * 256 + wc * 32 + 8 * fq;
        bf16_t* YS = opaque(this->YS);
        const float* b = opaque(bd) + (size_t)u.e * 1024 + col0;
        f32x4 bv[2][2];
#pragma unroll
        for (int bj = 0; bj < 2; ++bj) { bv[bj][0] = *(const f32x4*)(b + bj * 128); bv[bj][1] = *(const f32x4*)(b + bj * 128 + 4); }
#pragma unroll
        for (int ai = 0; ai < 2; ++ai)
#pragma unroll
            for (int m = 0; m < 4; ++m) { const unsigned ob = (unsigned)((row0 + ai * 128 + m * 16) * 1024 + col0) * 2u;
#pragma unroll
                for (int bj = 0; bj < 2; ++bj) *(u32x4*)((char*)YS + (ob + bj * 256u)) = pack8(acc[ai][bj][m][0] + bv[bj][0], acc[ai][bj][m][1] + bv[bj][1]); }
    }
};

__device__ __forceinline__ void transpose_item(const float* W, int K, int N, bf16_t* WT, int drow0, LAS float* scr, int k0, int n0, int lane) {
    const int n = n0 + (lane & 31); const bool ok = n < N;
#pragma unroll 8
    for (int i = 0; i < 32; ++i) { const int kk = 2 * i + (lane >> 5); scr[kk * 33 + (lane & 31)] = ok ? __builtin_nontemporal_load(W + (size_t)(k0 + kk) * N + n) : 0.f; }
    asm volatile("s_waitcnt lgkmcnt(0)" ::: "memory");
    const int c = lane & 7;
#pragma unroll
    for (int j = 0; j < 4; ++j) { const int nn = (lane >> 3) + 8 * j; const LAS float* s = scr + (8 * c) * 33 + nn;
        u32x4 o; o.x = pk2(s[0 * 33], s[1 * 33]); o.y = pk2(s[2 * 33], s[3 * 33]); o.z = pk2(s[4 * 33], s[5 * 33]); o.w = pk2(s[6 * 33], s[7 * 33]);
        __builtin_nontemporal_store(o, (u32x4*)(WT + (size_t)(drow0 + nn) * K + k0 + 8 * c)); }
    asm volatile("s_waitcnt lgkmcnt(0)" ::: "memory");
}
__device__ __forceinline__ void phase_prologue(Frame& F) {
    {
        LAS float* s = (LAS float*)(F.lds);
        LAS float* part = (LAS float*)(F.lds + 32768);
        bool have_s = false;
        for (int item = F.bid; item < 384; item += F.G) {
            if (!have_s) {
                for (int i = F.tid; i < 5 * 1024; i += 512) { const int b = i >> 10, k = i & 1023; const float c = b < 4 ? INP(1)[b * 1024 + k] : INP(3)[k]; s[i] = siluf_(c); }
                have_s = true;
            }
            __syncthreads();
            const int l = item / 96, n0 = (item % 96) * 64, ci = F.tid & 63, kg = F.tid >> 6;
            const float* w = INP(4) + ((size_t)l * 1024 + kg * 128) * 6144 + n0 + ci;
            float a0 = 0.f, a1 = 0.f, a2 = 0.f, a3 = 0.f, a4 = 0.f;
#pragma unroll 8
            for (int k = 0; k < 128; ++k) { const float wv = w[(size_t)k * 6144]; const int kk = kg * 128 + k;
                a0 += s[kk] * wv; a1 += s[1024 + kk] * wv; a2 += s[2048 + kk] * wv; a3 += s[3072 + kk] * wv; a4 += s[4096 + kk] * wv; }
            part[(kg * 5 + 0) * 64 + ci] = a0; part[(kg * 5 + 1) * 64 + ci] = a1; part[(kg * 5 + 2) * 64 + ci] = a2; part[(kg * 5 + 3) * 64 + ci] = a3; part[(kg * 5 + 4) * 64 + ci] = a4;
            __syncthreads();
            if (F.tid < 320) { const int b = F.tid >> 6, c2 = F.tid & 63; float sum = INP(5)[l * 6144 + n0 + c2];
#pragma unroll
                for (int g = 0; g < 8; ++g) sum += part[(g * 5 + b) * 64 + c2];
                WSP(float, WS_MOD)[(l * 5 + b) * 6144 + n0 + c2] = sum; }
        }
        __syncthreads();
        if (F.bid == (F.G > 1 ? F.G - 1 : 0)) {
            const int c = F.tid; const float* hl = INP(11);
            const float v0 = hl[c], v1 = hl[512 + c], v2 = hl[1024 + c], v3 = hl[1536 + c];
            const float mx = fmaxf(fmaxf(v0, v1), fmaxf(v2, v3));
            const float e0 = expf(v0 - mx), e1 = expf(v1 - mx), e2 = expf(v2 - mx), e3 = expf(v3 - mx); const float inv = 1.0f / (e0 + e1 + e2 + e3);
            float* LB = WSP(float, WS_LB);
            LB[c] = 0.f; LB[512 + c] = fmaxf(e1 * inv, 0.f); LB[1024 + c] = fmaxf((e1 + e2) * inv, 0.f); LB[1536 + c] = fmaxf((e1 + e2 + e3) * inv, 0.f);
        }
        if (F.bid == (F.G > 2 ? F.G - 2 : 0)) {
            for (int i = F.tid; i < 2048; i += 512) { const int pos = i >> 4, q = i & 15; const float inv = powf(10000.0f, -(float)q / 16.0f); const float ang = (float)pos * inv;
                WSP(f32x2, WS_ROPE)[i] = (f32x2){cosf(ang), sinf(ang)}; }
        }
        __syncthreads();
    }
    LAS float* scr = (LAS float*)(F.lds + F.wave * 16384);
    const int gw = F.bid * 8 + F.wave, NGW = F.G * 8;
    constexpr int I_WIN = 16 * 136, I_SQ = 16 * 32, I_QKV = 16 * 96, I_GU = 16 * 64;
    constexpr int N0 = 2 * I_WIN, N1 = N0 + 2 * I_SQ, N2 = N1 + 2 * I_QKV, N3 = N2 + 2 * I_SQ, N4 = N3 + 128 * I_GU, N5 = N4 + 128 * I_SQ;
    for (int it = gw; it < N5; it += NGW) {
        if (it < N0) { const int j = it / I_WIN, r = it % I_WIN, kb = r / 136, nb = r % 136;
            transpose_item(INP(8) + (size_t)j * 1024 * 4112, 1024, 4112, WSP(bf16_t, WS_WIN) + (size_t)j * NREC * 1024, nb * 32, scr, kb * 64, nb * 32, F.lane); }
        else if (it < N1) { const int q = it - N0, j = q / I_SQ, r = q % I_SQ, kb = r / 32, nb = r % 32;
            transpose_item(INP(10) + (size_t)j * 1024 * 1024, 1024, 1024, WSP(bf16_t, WS_WROUT) + (size_t)j * 1024 * 1024, nb * 32, scr, kb * 64, nb * 32, F.lane); }
        else if (it < N2) { const int q = it - N1, j = q / I_QKV, r = q % I_QKV, kb = r / 96, nb = r % 96;
            transpose_item(INP(14) + (size_t)j * 1024 * 3072, 1024, 3072, WSP(bf16_t, WS_WQKV) + (size_t)j * 3072 * 1024, nb * 32, scr, kb * 64, nb * 32, F.lane); }
        else if (it < N3) { const int q = it - N2, j = q / I_SQ, r = q % I_SQ, kb = r / 32, nb = r % 32;
            transpose_item(INP(15) + (size_t)j * 1024 * 1024, 1024, 1024, WSP(bf16_t, WS_WNOUT) + (size_t)j * 1024 * 1024, nb * 32, scr, kb * 64, nb * 32, F.lane); }
        else if (it < N4) { const int q = it - N3, j = q / I_GU, r = q % I_GU, kb = r / 64, nb = r % 64; const int n0 = nb * 32;
            const int nn = n0 & 1023; const int drow = 256 * (nn >> 7) + (n0 >= 1024 ? 128 : 0) + (nn & 127);
            transpose_item(INP(21) + (size_t)j * 1024 * 2048, 1024, 2048, WSP(bf16_t, WS_WGU) + (size_t)j * 2048 * 1024, drow, scr, kb * 64, n0, F.lane); }
        else { const int q = it - N4, j = q / I_SQ, r = q % I_SQ, kb = r / 32, nb = r % 32;
            transpose_item(INP(23) + (size_t)j * 1024 * 1024, 1024, 1024, WSP(bf16_t, WS_WD) + (size_t)j * 1024 * 1024, nb * 32, scr, kb * 64, nb * 32, F.lane); }
    }
    __syncthreads();
}

__device__ __forceinline__ void expert_prefix(const Frame& F, int l, LAS int* base_out, LAS int* cnt_out, int scale, bool total) {
    if (F.tid < 64) {
        const int e = F.tid & 31;
        const int c = (int)F.ctl[CW_CNT + (l * 32 + e) * 64];
        const int t = (F.tid < 32) ? ((c + 255) >> 8) : 0;
        int incl = t;
#pragma unroll
        for (int o = 1; o < 32; o <<= 1) { const int y = __builtin_amdgcn_ds_bpermute(((F.tid - o) & 63) << 2, incl); if (F.tid >= o) incl += y; }
        if (F.tid < 32) { base_out[e] = (incl - t) * scale; if (cnt_out) cnt_out[e] = c; }
        if (total && F.tid == 31) base_out[32] = incl * scale;
    }
}
template <int MODE>
__device__ __forceinline__ void phase_norm1(Frame& F, int l) {
    LAS int* sbase = (LAS int*)(F.lds + MISC_OFF + 1024);
    if (MODE != 0) {
        expert_prefix(F, l - 1, sbase, (LAS int*)0, 256, false);
        __syncthreads();
    }
    const int gw = F.bid * 8 + F.wave, NGW = F.G * 8;
    bf16_t* X = WSP(bf16_t, WS_X); bf16_t* H = WSP(bf16_t, WS_H); const bf16_t* YS = WSP(bf16_t, WS_YS);
    const float* MOD = WSP(float, WS_MOD);
    const int* TE = WSP(int, WS_TOKE); const int* TP = WSP(int, WS_TOKP); const float* TW = WSP(float, WS_TOKW);
    const int nrows = (MODE == 2) ? RL : NR;
    for (int pr = gw; pr < nrows / 2; pr += NGW) {
        const int row0 = 2 * pr; const int bidx = row_bidx(row0);
        f32x4 v[2][4];
#pragma unroll
        for (int rr = 0; rr < 2; ++rr) { const int row = row0 + rr;
            if (MODE == 0) { const float* src = row < RL ? INP(0) + (size_t)row * 1024 : INP(2) + (size_t)(row - RL) * 1024;
#pragma unroll
                for (int j = 0; j < 4; ++j) v[rr][j] = __builtin_nontemporal_load((const f32x4*)(src + 4 * F.lane + 256 * j)); }
            else { const bf16_t* src = X + (size_t)row * 1024;
#pragma unroll
                for (int j = 0; j < 4; ++j) v[rr][j] = h4_to_f4(__builtin_nontemporal_load((const u32x2*)(src + 4 * F.lane + 256 * j))); } }
        if (MODE != 0) {
            u32x2 ys[2][4][4]; float wk[2][4];
#pragma unroll
            for (int rr = 0; rr < 2; ++rr)
#pragma unroll
                for (int k = 0; k < 4; ++k) { const int row = row0 + rr; const int e = TE[row * 4 + k], p = TP[row * 4 + k]; wk[rr][k] = TW[row * 4 + k];
                    const bf16_t* yr = YS + (size_t)(sbase[e] + p) * 1024 + 4 * F.lane;
#pragma unroll
                    for (int j = 0; j < 4; ++j) ys[rr][k][j] = __builtin_nontemporal_load((const u32x2*)(yr + 256 * j)); }
            const float* g2 = MOD + ((l - 1) * 5 + bidx) * 6144 + 5120 + 4 * F.lane;
#pragma unroll
            for (int j = 0; j < 4; ++j) { const f32x4 gg = *(const f32x4*)(g2 + 256 * j);
#pragma unroll
                for (int rr = 0; rr < 2; ++rr) { f32x4 f = (f32x4){0.f, 0.f, 0.f, 0.f};
#pragma unroll
                    for (int k = 0; k < 4; ++k) { const u32x2 q = ys[rr][k][j]; f += wk[rr][k] * (f32x4){bf2f(q.x & 0xffffu), bf2f(q.x >> 16), bf2f(q.y & 0xffffu), bf2f(q.y >> 16)}; }
                    v[rr][j] += gg * f; } }
        }
        if (MODE == 2) {
#pragma unroll
            for (int rr = 0; rr < 2; ++rr)
#pragma unroll
                for (int j = 0; j < 4; ++j) __builtin_nontemporal_store(v[rr][j], (f32x4*)(F.out + (size_t)(row0 + rr) * 1024 + 4 * F.lane + 256 * j));
            continue;
        }
        if (F.lane < 32) WSP(float, WS_SSK)[row0 * 16 + F.lane] = 0.f;
        float rstd[2];
#pragma unroll
        for (int rr = 0; rr < 2; ++rr) { float ss = 0.f;
#pragma unroll
            for (int j = 0; j < 4; ++j) { __builtin_nontemporal_store(f4_to_h4(v[rr][j]), (u32x2*)(X + (size_t)(row0 + rr) * 1024 + 4 * F.lane + 256 * j));
                ss += (v[rr][j][0] * v[rr][j][0] + v[rr][j][1] * v[rr][j][1]) + (v[rr][j][2] * v[rr][j][2] + v[rr][j][3] * v[rr][j][3]); }
            rstd[rr] = rsqrtf(wave_sum(ss, F.lane) * (1.0f / 1024.0f) + EPS); }
        const float* gm = INP(6) + l * 1024; const float* sh = MOD + (l * 5 + bidx) * 6144; const float* sc = sh + 1024;
#pragma unroll
        for (int j = 0; j < 4; ++j) { const int c = 4 * F.lane + 256 * j;
            const f32x4 g = *(const f32x4*)(gm + c), s1 = *(const f32x4*)(sc + c), s0 = *(const f32x4*)(sh + c); const f32x4 gs = g * (1.0f + s1);
#pragma unroll
            for (int rr = 0; rr < 2; ++rr) { const f32x4 h = v[rr][j] * rstd[rr] * gs + s0;
                u32x2 w; w.x = pk2(h[0], h[1]); w.y = pk2(h[2], h[3]);
                *(u32x2*)(H + (size_t)(row0 + rr) * 1024 + c) = w; } }
    }
}

__device__ __forceinline__ void router_finish(Frame& F, float (&lg)[32], int row, int r0, const float* br, LAS int* hist, LAS int* sel, float* TW) {
#pragma unroll
    for (int s5 = 0; s5 < 5; ++s5) { const int half = 16 >> s5; const bool up = (F.lane >> (5 - s5)) & 1;
#pragma unroll
        for (int i = 0; i < half; ++i) { const float a2 = lg[i], b2 = lg[i + half]; const float send = up ? a2 : b2, keep = up ? b2 : a2; lg[i] = keep + shx(send, 32 >> s5, F.lane); } }
    float logit = lg[0] + shx(lg[0], 1, F.lane);
    const int myE = F.lane >> 1;
    logit += br[myE];
    int rank = 0;
#pragma unroll
    for (int e = 0; e < 32; ++e) { const float le = __int_as_float(__builtin_amdgcn_readlane(__float_as_int(logit), 2 * e)); rank += (le > logit || (le == logit && e < myE)) ? 1 : 0; }
    float tv[4]; int ti[4];
#pragma unroll
    for (int k = 0; k < 4; ++k) { const unsigned long long bm = __ballot(rank == k); const int src = __builtin_amdgcn_readfirstlane((int)__builtin_ctzll(bm));
        tv[k] = __int_as_float(__builtin_amdgcn_readlane(__float_as_int(logit), src)); ti[k] = src >> 1; }
    const float e1 = __expf(tv[1] - tv[0]), e2 = __expf(tv[2] - tv[0]), e3 = __expf(tv[3] - tv[0]); const float inv = 1.0f / (1.0f + e1 + e2 + e3);
    if (F.lane < 4) { const int k = F.lane; const int e = k == 0 ? ti[0] : k == 1 ? ti[1] : k == 2 ? ti[2] : ti[3]; const float w = (k == 0 ? 1.0f : k == 1 ? e1 : k == 2 ? e2 : e3) * inv;
        const int lpos = atomicAdd((int*)&hist[e], 1);
        sel[(row - r0) * 4 + k] = e | (lpos << 8);
        TW[row * 4 + k] = w; }
}
__device__ __forceinline__ void phase_router(Frame& F, int l) {
    LAS float* wr = (LAS float*)F.lds;
    LAS int* hist = (LAS int*)(F.lds + MISC_OFF + 1024);
    LAS int* gbase = hist + 32;
    LAS int* sel = gbase + 32;
    const float* wsrc = INP(19) + (size_t)l * 1024 * 32;
    for (int i = F.tid; i < 1024 * 8; i += 512) { const int k = i >> 3, ch = i & 7; const f32x4 w = *(const f32x4*)(wsrc + k * 32 + ch * 4);
        const int p = (k >> 2) + 256 * (k & 3); *(LAS f32x4*)(wr + p * 32 + 4 * ((ch + (p >> 1)) & 7)) = w; }
    if (F.tid < 32) hist[F.tid] = 0;
    __syncthreads();
    const int NRr = (l == 3) ? RL : NR;
    const int RPB = (((NRr + F.G - 1) / F.G) + 1) & ~1;
    const int r0 = min(F.bid * RPB, NRr), r1 = min(r0 + RPB, NRr);
    bf16_t* X = WSP(bf16_t, WS_X); bf16_t* H = WSP(bf16_t, WS_H); const float* MOD = WSP(float, WS_MOD);
    int* TE = WSP(int, WS_TOKE); int* TP = WSP(int, WS_TOKP); float* TW = WSP(float, WS_TOKW); int* LIST = WSP(int, WS_LIST);
    const float* br = INP(20) + l * 32;
    const int rotl = F.lane >> 1;
    const LAS float* wbase = wr + F.lane * 32; int roff[8];
#pragma unroll
    for (int ch = 0; ch < 8; ++ch) roff[ch] = 4 * ((ch + rotl) & 7);
    for (int rowA = r0 + 2 * F.wave; rowA < r1; rowA += 16) {
        const bool hasB = rowA + 1 < r1; const int rowB = hasB ? rowA + 1 : rowA;
        const int bidx = row_bidx(rowA);
        bf16_t* xa = X + (size_t)rowA * 1024 + 4 * F.lane; bf16_t* xb = X + (size_t)rowB * 1024 + 4 * F.lane;
        const bf16_t* ya = WSP(bf16_t, WS_Y) + (size_t)rowA * 1024 + 4 * F.lane; const bf16_t* yb = WSP(bf16_t, WS_Y) + (size_t)rowB * 1024 + 4 * F.lane;
        float ssa = 0.f, ssb = 0.f;
#pragma unroll
        for (int j = 0; j < 4; ++j) { f32x4 va = h4_to_f4(*(const u32x2*)(xa + 256 * j)), vb = h4_to_f4(*(const u32x2*)(xb + 256 * j));
            { const u32x2 q = __builtin_nontemporal_load((const u32x2*)(ya + 256 * j)); va += (f32x4){bf2f(q.x & 0xffffu), bf2f(q.x >> 16), bf2f(q.y & 0xffffu), bf2f(q.y >> 16)}; *(u32x2*)(xa + 256 * j) = f4_to_h4(va); }
            if (hasB) { const u32x2 q = __builtin_nontemporal_load((const u32x2*)(yb + 256 * j)); vb += (f32x4){bf2f(q.x & 0xffffu), bf2f(q.x >> 16), bf2f(q.y & 0xffffu), bf2f(q.y >> 16)}; *(u32x2*)(xb + 256 * j) = f4_to_h4(vb); }
            ssa += (va[0] * va[0] + va[1] * va[1]) + (va[2] * va[2] + va[3] * va[3]); ssb += (vb[0] * vb[0] + vb[1] * vb[1]) + (vb[2] * vb[2] + vb[3] * vb[3]); }
        const float rsa = rsqrtf(wave_sum(ssa, F.lane) * (1.0f / 1024.0f) + EPS), rsb = rsqrtf(wave_sum(ssb, F.lane) * (1.0f / 1024.0f) + EPS);
        const float* gm = INP(7) + l * 1024 + 4 * F.lane; const float* sh = MOD + (l * 5 + bidx) * 6144 + 3072 + 4 * F.lane; const float* sc = sh + 1024;
        float lga[32], lgb[32];
#pragma unroll
        for (int e = 0; e < 32; ++e) { lga[e] = 0.f; lgb[e] = 0.f; }
#pragma unroll 1
        for (int j = 0; j < 4; ++j) { const int c = 256 * j;
            const f32x4 va = h4_to_f4(*(const u32x2*)(xa + c)), vb = h4_to_f4(*(const u32x2*)(xb + c));
            const f32x4 g = *(const f32x4*)(gm + c), s1 = *(const f32x4*)(sc + c), s0 = *(const f32x4*)(sh + c); const f32x4 gs = g * (1.0f + s1);
            const f32x4 ha = va * rsa * gs + s0, hb = vb * rsb * gs + s0;
            { u32x2 w; w.x = pk2(ha[0], ha[1]); w.y = pk2(ha[2], ha[3]); *(u32x2*)(H + (size_t)rowA * 1024 + 4 * F.lane + c) = w; }
            if (hasB) { u32x2 w; w.x = pk2(hb[0], hb[1]); w.y = pk2(hb[2], hb[3]); *(u32x2*)(H + (size_t)rowB * 1024 + 4 * F.lane + c) = w; }
            const LAS float* wj = wbase + (64 * j) * 32;
#pragma unroll
            for (int cc = 0; cc < 4; ++cc) {
                const LAS float* wp = wj + (256 * cc) * 32; const float hva = ha[cc], hvb = hb[cc];
#pragma unroll
                for (int ch = 0; ch < 8; ++ch) { const f32x4 w4 = *(const LAS f32x4*)(wp + roff[ch]);
                    lga[4 * ch + 0] += hva * w4[0]; lga[4 * ch + 1] += hva * w4[1]; lga[4 * ch + 2] += hva * w4[2]; lga[4 * ch + 3] += hva * w4[3];
                    lgb[4 * ch + 0] += hvb * w4[0]; lgb[4 * ch + 1] += hvb * w4[1]; lgb[4 * ch + 2] += hvb * w4[2]; lgb[4 * ch + 3] += hvb * w4[3]; }
            }
        }
        router_finish(F, lga, rowA, r0, br, hist, sel, TW);
        if (hasB) router_finish(F, lgb, rowB, r0, br, hist, sel, TW);
    }
    __syncthreads();
    if (F.tid < 32) gbase[F.tid] = (int)atomicAdd(F.ctl + CW_CNT + (l * 32 + F.tid) * 64, (unsigned)hist[F.tid]);
    __syncthreads();
    for (int i = F.tid; i < (r1 - r0) * 4; i += 512) { const int s = sel[i], e = s & 255, pos = gbase[e] + (s >> 8); const int row = r0 + (i >> 2);
        TE[row * 4 + (i & 3)] = e; TP[row * 4 + (i & 3)] = pos; LIST[(size_t)e * CAP + pos] = row; }
    __syncthreads();
}

__device__ __forceinline__ bf16x8 lds_frag(const LAS unsigned char* p) { return *(const LAS bf16x8*)p; }
#define ATT_SHIFT 8.0f
__device__ __forceinline__ void phase_attn(Frame& F, int jl  , bool last) {
    LAS unsigned char* QS = F.lds;
    LAS float* RPB = (LAS float*)(F.lds + 16384);
    LAS float* RK = (LAS float*)(F.lds + 19456);
    LAS unsigned char* KT = F.lds + 24576;
    LAS unsigned char* VT = F.lds + 24576 + 40960;
    const bf16_t* QKV = WSP(bf16_t, WS_QKV); bf16_t* OUT = WSP(bf16_t, WS_MERGED); const bf16_t* VTG = WSP(bf16_t, WS_VTG); const float* SSK = WSP(float, WS_SSK);
    const float* qg = INP(16) + jl * 64; const float* kg = INP(17) + jl * 64; const float* rpb = INP(18) + (size_t)jl * 16 * 465;
    const int w = F.wave, qt = w & 3, qr = w >> 2;
    const bool xmap = (F.G == 256);
    for (int i_ = 0; ; ++i_) {
        int u, bh;
        if (xmap) { const int li = (F.bid >> 3) + 32 * i_; if (li >= 528) break;
            if (li < 512) { bh = (F.bid & 7) * 8 + (li >> 6); u = li & 63; } else { bh = (F.bid & 7) * 8 + ((li - 512) >> 1); u = 64 + ((li - 512) & 1); } }
        else { const int it = F.bid + i_ * F.G; if (it >= NB * 16 * 66) break; u = it % 66; bh = it / 66; }
        int tid_ = (F.wave << 6) | (lane_id_volatile() & 63);
        const int lane_ = tid_ & 63, ln = lane_ & 15, g = lane_ >> 4;
        const int lkey = tid_ >> 3, lc = tid_ & 7;
        const int h = bh & 15, b = bh >> 4;
        const bool lat = u < 64;
        if (last && !lat) continue;
        const int r0 = 2 * u, rs0 = min(max(r0 - 4, 0), 120), rs1 = min(max(r0 - 3, 0), 120);
        const int urow = r0 + qr, off = qr ? rs1 - rs0 : 0;
        const int rd_first = lat ? 0 : 2;
        u32x4 pkr[5], pvr[5]; float pss[5];
#define ATT_ISSUE(rd_) do { int lk_ = lkey, lc_ = lc; asm volatile("" : "+v"(lk_), "+v"(lc_));   \
            _Pragma("unroll") for (int s5 = 0; s5 < 5; ++s5) { if (s5 == 4 && (rd_) != 0) break; \
            const int gr_ = min(rs0 + (rd_) * 5 + s5, 127); \
            const int krow0 = (rd_) == 2 ? (RL + b * TC + s5 * 64) : (b * TL + gr_ * 64); const int tt0 = (rd_) == 2 ? (TL + s5 * 64) : gr_ * 64; \
            pkr[s5] = *(const u32x4*)((const unsigned char*)QKV + (size_t)krow0 * 6144 + 2048 + h * 128 + (unsigned)(lk_ * 6144 + lc_ * 16)); \
            pvr[s5] = *(const u32x4*)((const unsigned char*)VTG + ((size_t)((b * 16 + h) * 64) * TT + tt0) * 2 + (unsigned)(lk_ * (TT * 2) + lc_ * 16)); \
            pss[s5] = *(const float*)((const unsigned char*)SSK + (size_t)(krow0 * 16 + h) * 4 + (unsigned)(lk_ * 64)); } } while (0)
        if (lat) ATT_ISSUE(0); else ATT_ISSUE(2);
#pragma unroll
        for (int p = 0; p < 2; ++p) {
            const int ql = p * 64 + lkey;
            const int qrow = lat ? (b * TL + (r0 + p) * 64 + lkey) : (RL + b * TC + (u - 64) * 128 + ql);
            const u32x4 raw = *(const u32x4*)(QKV + (size_t)qrow * 3072 + h * 64 + lc * 8);
            float x[8] = {bf2f(raw.x & 0xffffu), bf2f(raw.x >> 16), bf2f(raw.y & 0xffffu), bf2f(raw.y >> 16), bf2f(raw.z & 0xffffu), bf2f(raw.z >> 16), bf2f(raw.w & 0xffffu), bf2f(raw.w >> 16)};
            float ss = 0.f;
#pragma unroll
            for (int i = 0; i < 8; ++i) ss += x[i] * x[i];
            ss += shx(ss, 1, lane_); ss += shx(ss, 2, lane_); ss += shx(ss, 4, lane_);
            const float r = rsqrtf(ss * (1.0f / 64.0f) + EPS) * (0.125f * 1.4426950408889634f);
            const f32x4 g0 = *(const f32x4*)(qg + lc * 8) * *(const f32x4*)(kg + lc * 8), g1 = *(const f32x4*)(qg + lc * 8 + 4) * *(const f32x4*)(kg + lc * 8 + 4);
            u32x4 o; o.x = pk2(x[0] * r * g0[0], x[1] * r * g0[1]); o.y = pk2(x[2] * r * g0[2], x[3] * r * g0[3]); o.z = pk2(x[4] * r * g1[0], x[5] * r * g1[1]); o.w = pk2(x[6] * r * g1[2], x[7] * r * g1[3]);
            *(LAS u32x4*)(QS + ql * 128 + lc * 16) = o;
        }
        for (int i = tid_; i < 15 * 48; i += 512) { const int rr = i / 48, cc = i % 48 - 8; RPB[i] = (cc >= 0 && cc < 31) ? rpb[h * 465 + rr * 31 + cc] * 1.4426950408889634f - ATT_SHIFT : 0.f; }
        f32x4 O[4]; f32x4 Lsum = (f32x4){0.f, 0.f, 0.f, 0.f};
        const bf16x8 ones8 = __builtin_bit_cast(bf16x8, (u32x4){0x3f803f80u, 0x3f803f80u, 0x3f803f80u, 0x3f803f80u});
#pragma unroll
        for (int e = 0; e < 4; ++e) O[e] = (f32x4){0.f, 0.f, 0.f, 0.f};
        bf16x8 qf[2];
#pragma unroll 1
        for (int rd = rd_first; rd < 3; ++rd) {
            const int nslot = rd == 0 ? 5 : 4;
#pragma unroll
            for (int s5 = 0; s5 < 5; ++s5) {
                if (s5 < nslot) {
                *(LAS u32x4*)(KT + s5 * 8192 + lkey * 128 + ((lc ^ (lkey & 7)) * 16)) = pkr[s5];
                *(LAS u32x4*)(VT + s5 * 8192 + lkey * 128 + ((lc ^ ((lkey ^ (lkey >> 3)) & 7)) * 16)) = pvr[s5];
                if (lc == 0) RK[s5 * 64 + lkey] = rsqrtf(pss[s5] * (1.0f / 64.0f) + EPS);
                }
            }
            __syncthreads();
            if (rd == 0) ATT_ISSUE(1); else if (rd == 1) ATT_ISSUE(2);
            if (rd == rd_first) {
#pragma unroll
                for (int ks = 0; ks < 2; ++ks) qf[ks] = lds_frag(QS + (w * 16 + ln) * 128 + (ks * 4 + g) * 16);
            }
            {
                int t2_ = tid_; asm volatile("" : "+v"(t2_));
                const int ln = t2_ & 15, g = (t2_ & 63) >> 4;
                if (rd < 2) {
                    const int thr = qt == 0 ? max(ln, 8) : qt == 3 ? min(ln, 8) : ln;
                    const int c0 = max(2 * qt - 1 + (g >> 1), 0), c1 = min(2 * qt + 1 + (g >> 1), 7);
                    const int key0 = min(max(16 * qt - 8 + ln, 0), 63), key1 = min(16 * qt + 8 + ln, 63);
                    const int rkb0 = min(max(16 * qt - 8 + 4 * g, 0), 60), rkb1 = min(16 * qt + 8 + 4 * g, 60);
                    bf16x8 ka[2][4]; float rbv[2][8]; f32x4 rkl[2][2];
#define ATT_LOADL(st, s5_) do { const LAS unsigned char* kt_ = KT + (s5_) * 8192; \
                        ka[st][0] = lds_frag(kt_ + key0 * 128 + (((0 + g) ^ (key0 & 7)) * 16)); ka[st][1] = lds_frag(kt_ + key0 * 128 + (((4 + g) ^ (key0 & 7)) * 16)); \
                        ka[st][2] = lds_frag(kt_ + key1 * 128 + (((0 + g) ^ (key1 & 7)) * 16)); ka[st][3] = lds_frag(kt_ + key1 * 128 + (((4 + g) ^ (key1 & 7)) * 16)); \
                        const int rrow_ = min(max(rs0 + rd * 5 + (s5_) - urow + 7, 0), 14); const LAS float* rb_ = RPB + rrow_ * 48 + 15 - ln + 4 * g; \
                        _Pragma("unroll") for (int j = 0; j < 4; ++j) { rbv[st][j] = rb_[j]; rbv[st][4 + j] = rb_[16 + j]; } \
                        rkl[st][0] = *(const LAS f32x4*)(RK + (s5_) * 64 + rkb0); rkl[st][1] = *(const LAS f32x4*)(RK + (s5_) * 64 + rkb1); \
                        } while (0)
#define ATT_LOADLV(s5_) do { const LAS unsigned char* vt_ = VT + (s5_) * 8192; \
                        _Pragma("unroll") for (int et = 0; et < 4; ++et) { const int e = et * 16 + ln; const int sw = (e ^ (e >> 3)) & 7; \
                            vfa[et] = *(const LAS u32x2*)(vt_ + e * 128 + ((c0 ^ sw) * 16) + (g & 1) * 8); vfb[et] = *(const LAS u32x2*)(vt_ + e * 128 + ((c1 ^ sw) * 16) + (g & 1) * 8); } } while (0)
                    ATT_LOADL(0, 0);
#pragma unroll
                    for (int s5 = 0; s5 < 5; ++s5) {
                        if (s5 == 4 && rd != 0) break;
                        const int st = s5 & 1;
                        u32x2 vfa[4], vfb[4];
                        ATT_LOADLV(s5);
                        if (s5 + 1 < 5 && !(s5 + 1 == 4 && rd != 0)) ATT_LOADL(st ^ 1, s5 + 1);
                        __builtin_amdgcn_sched_barrier(0);
                        const int t = rd * 5 + s5;
                        const bool mine = (t >= off) && (t <= off + 7);
                        f32x4 sc0 = (f32x4){0.f, 0.f, 0.f, 0.f}, sc1 = (f32x4){0.f, 0.f, 0.f, 0.f};
                        sc0 = __builtin_amdgcn_mfma_f32_16x16x32_bf16(ka[st][0], qf[0], sc0, 0, 0, 0);
                        sc1 = __builtin_amdgcn_mfma_f32_16x16x32_bf16(ka[st][2], qf[0], sc1, 0, 0, 0);
                        sc0 = __builtin_amdgcn_mfma_f32_16x16x32_bf16(ka[st][1], qf[1], sc0, 0, 0, 0);
                        sc1 = __builtin_amdgcn_mfma_f32_16x16x32_bf16(ka[st][3], qf[1], sc1, 0, 0, 0);
#pragma unroll
                        for (int j = 0; j < 4; ++j) { const int kk = 4 * g + j;
                            const float p0 = (mine && kk >= thr) ? __builtin_amdgcn_exp2f(sc0[j] * rkl[st][0][j] + rbv[st][j]) : 0.f;
                            const float p1 = (mine && kk < thr) ? __builtin_amdgcn_exp2f(sc1[j] * rkl[st][1][j] + rbv[st][4 + j]) : 0.f;
                            sc0[j] = p0; sc1[j] = p1; }
                        u32x4 pw; pw.x = pk2(sc0[0], sc0[1]); pw.y = pk2(sc0[2], sc0[3]); pw.z = pk2(sc1[0], sc1[1]); pw.w = pk2(sc1[2], sc1[3]);
                        const bf16x8 pf = __builtin_bit_cast(bf16x8, pw);
                        Lsum = __builtin_amdgcn_mfma_f32_16x16x32_bf16(ones8, pf, Lsum, 0, 0, 0);
#pragma unroll
                        for (int et = 0; et < 4; ++et) { u32x4 vw; vw.x = vfa[et].x; vw.y = vfa[et].y; vw.z = vfb[et].x; vw.w = vfb[et].y;
                            O[et] = __builtin_amdgcn_mfma_f32_16x16x32_bf16(__builtin_bit_cast(bf16x8, vw), pf, O[et], 0, 0, 0); }
                    }
#undef ATT_LOADL
#undef ATT_LOADLV
                } else {
                    bf16x8 kc[1][4][2]; f32x4 rkv[1][4];
#define ATT_LOADCK(st, s5_) do { const LAS unsigned char* kt_ = KT + (s5_) * 8192; \
                        _Pragma("unroll") for (int kt = 0; kt < 4; ++kt) { const int key = kt * 16 + ln; \
                            kc[st][kt][0] = lds_frag(kt_ + key * 128 + (((0 + g) ^ (key & 7)) * 16)); kc[st][kt][1] = lds_frag(kt_ + key * 128 + (((4 + g) ^ (key & 7)) * 16)); \
                            rkv[st][kt] = *(const LAS f32x4*)(RK + (s5_) * 64 + 16 * kt + 4 * g); } } while (0)
#pragma unroll
                    for (int s5 = 0; s5 < 4; ++s5) {
                        const int st = 0;
                        const LAS unsigned char* vt_ = VT + s5 * 8192;
                        u32x2 vfa[2][4], vfb[2][4];
#pragma unroll
                        for (int ks2 = 0; ks2 < 2; ++ks2)
#pragma unroll
                            for (int et = 0; et < 4; ++et) { const int e = et * 16 + ln; const int sw = (e ^ (e >> 3)) & 7;
                                vfa[ks2][et] = *(const LAS u32x2*)(vt_ + e * 128 + (((4 * ks2 + (g >> 1)) ^ sw) * 16) + (g & 1) * 8);
                                vfb[ks2][et] = *(const LAS u32x2*)(vt_ + e * 128 + (((4 * ks2 + 2 + (g >> 1)) ^ sw) * 16) + (g & 1) * 8); }
                        ATT_LOADCK(0, s5);
                        __builtin_amdgcn_sched_barrier(0);
                        f32x4 sc[4];
#pragma unroll
                        for (int kt = 0; kt < 4; ++kt) sc[kt] = __builtin_amdgcn_mfma_f32_16x16x32_bf16(kc[st][kt][0], qf[0], (f32x4){0.f, 0.f, 0.f, 0.f}, 0, 0, 0);
#pragma unroll
                        for (int kt = 0; kt < 4; ++kt) sc[kt] = __builtin_amdgcn_mfma_f32_16x16x32_bf16(kc[st][kt][1], qf[1], sc[kt], 0, 0, 0);
#pragma unroll
                        for (int kt = 0; kt < 4; ++kt)
#pragma unroll
                            for (int j = 0; j < 4; ++j) { const float p = __builtin_amdgcn_exp2f(sc[kt][j] * rkv[st][kt][j] - ATT_SHIFT); sc[kt][j] = p; }
#pragma unroll
                        for (int ks2 = 0; ks2 < 2; ++ks2) {
                            u32x4 pw; pw.x = pk2(sc[2 * ks2][0], sc[2 * ks2][1]); pw.y = pk2(sc[2 * ks2][2], sc[2 * ks2][3]); pw.z = pk2(sc[2 * ks2 + 1][0], sc[2 * ks2 + 1][1]); pw.w = pk2(sc[2 * ks2 + 1][2], sc[2 * ks2 + 1][3]);
                            const bf16x8 pf = __builtin_bit_cast(bf16x8, pw);
                            Lsum = __builtin_amdgcn_mfma_f32_16x16x32_bf16(ones8, pf, Lsum, 0, 0, 0);
#pragma unroll
                            for (int et = 0; et < 4; ++et) { u32x4 vw; vw.x = vfa[ks2][et].x; vw.y = vfa[ks2][et].y; vw.z = vfb[ks2][et].x; vw.w = vfb[ks2][et].y;
                                O[et] = __builtin_amdgcn_mfma_f32_16x16x32_bf16(__builtin_bit_cast(bf16x8, vw), pf, O[et], 0, 0, 0); }
                        }
                    }
#undef ATT_LOADCK
                }
            }
            __syncthreads();
        }
        {
            const float inv = 1.0f / Lsum[0];
            const int qrow = lat ? (b * TL + urow * 64 + qt * 16 + ln) : (RL + b * TC + (u - 64) * 128 + w * 16 + ln);
#pragma unroll
            for (int e = 0; e < 4; ++e) { u32x2 wv; wv.x = pk2(O[e][0] * inv, O[e][1] * inv); wv.y = pk2(O[e][2] * inv, O[e][3] * inv);
                *(u32x2*)(OUT + (size_t)qrow * 1024 + h * 64 + e * 16 + 4 * g) = wv; }
        }
    }
#undef ATT_ISSUE
}

constexpr size_t WS_GH = WS_ACT, WS_GM = WS_ACT + 72 * MiB, WS_SH = WS_ACT + 128 * MiB, WS_SM = WS_SH + 72 * MiB;
constexpr size_t WS_DECH = WS_YS, WS_DECM = WS_YS + 1 * MiB;
constexpr size_t WS_OTH = WS_OHF, WS_OTM = WS_OMF;
static_assert(WS_GM + (size_t)1056 * 10240 * 4 <= WS_SH && WS_SM + (size_t)1056 * 10240 * 4 <= WS_YS, "scan dumps");
template <int KIND> struct ScanCfg {
    static constexpr int DK = KIND ? 64 : 128, RBQ = DK * 2, CMQ = DK / 8 - 1, KST = DK / 32, NEXT = KIND ? 144 : 128, OBS = KIND ? 148 : 132;
    static constexpr int OFF_OB = 0;
    static constexpr int OFF_QP = KIND ? 36864 : 0, OFF_KP = OFF_QP + 64 * RBQ, OFF_KPT = OFF_KP + 64 * RBQ, OFF_VT = OFF_KPT + DK * 128, OFF_PP = OFF_VT + 20480, OFF_SST = OFF_PP + 8192;
    static constexpr int OFF_SM = 114688;
    static constexpr int GSTRIDE = KIND ? 10240 : 16384;
};
__device__ __forceinline__ int sc_row(int b, int sct, int t) { return sct == 0 ? (RL + b * TC + t) : (b * TL + (sct - 1) * 256 + t); }
__device__ __forceinline__ float exp_c(float x) { return __expf(fminf(fmaxf(x, -80.f), 80.f)); }
template <int KIND> __device__ __forceinline__ int st_n0(int w) { return KIND ? (w >> 2) * 4 : 0; }
template <int KIND> __device__ __forceinline__ int st_nc(int w) { return KIND ? ((w >> 2) ? 5 : 4) : 8; }
template <int KIND> __device__ __forceinline__ int st_mt(int w) { return KIND ? (w & 3) : w; }
template <int KIND> __device__ __forceinline__ int ot_n0(int w) { return (w >> 2) * 4; }
template <int KIND> __device__ __forceinline__ int ot_nc(int w) { return KIND ? ((w >> 2) ? 5 : 4) : 4; }

template <int KIND, int PASS>
__device__ __forceinline__ void scan_super(Frame& F, int jl, int b, int h, int sct, int dir, f32x4 (&S)[8]) {
    typedef ScanCfg<KIND> C;
    LAS unsigned char* L = F.lds;
    LAS float* TOT = (LAS float*)(L + C::OFF_SM); LAS float* EM = TOT + 512; LAS float* E2 = EM + 128; LAS float* BT = E2 + 128; LAS float* RQ = BT + 128; LAS float* CK = RQ + 64; LAS float* SCAL = CK + 64;
    const int w = F.wave;
    const bf16_t* Qg = KIND ? WSP(bf16_t, WS_MQ) : WSP(bf16_t, WS_Q);
    const bf16_t* Kg = KIND ? WSP(bf16_t, WS_MK) : WSP(bf16_t, dir ? WS_KB : WS_KF);
    const bf16_t* Vg = KIND ? WSP(bf16_t, WS_MV) : WSP(bf16_t, WS_V);
    const int hq = h * C::DK;
    u32x4 rq[2], rk[2], rv[2]; float rl[16]; float rg0 = 0.f, rg1 = 0.f;
    const float* LAg = WSP(float, dir ? WS_LAB : WS_LAF); const float* GTg = WSP(float, WS_GATES);
#define SC_ISSUE(ci_, TID) do { const int cN = dir ? 3 - (ci_) : (ci_); const int tN = cN * 64; \
        if (KIND == 0) { const int d_ = (TID) & 127, part_ = (TID) >> 7; \
            _Pragma("unroll") for (int i = 0; i < 16; ++i) rl[i] = LAg[(size_t)sc_row(b, sct, tN + part_ * 16 + i) * 512 + hq + d_]; \
            _Pragma("unroll") for (int p = 0; p < 2; ++p) { const size_t ro = (size_t)sc_row(b, sct, tN + p * 32 + ((TID) >> 4)) * 512 + hq + 8 * ((TID) & 15); \
                if (PASS == 3) rq[p] = *(const u32x4*)(Qg + ro); rk[p] = *(const u32x4*)(Kg + ro); rv[p] = *(const u32x4*)(Vg + ro); } } \
        else { { const size_t ro = (size_t)sc_row(b, sct, tN + ((TID) >> 3)) * 256 + hq + 8 * ((TID) & 7); if (PASS == 3) rq[0] = *(const u32x4*)(Qg + ro); rk[0] = *(const u32x4*)(Kg + ro); } \
            _Pragma("unroll") for (int p = 0; p < 2; ++p) rv[p] = *(const u32x4*)(Vg + (size_t)sc_row(b, sct, tN + p * 32 + ((TID) >> 4)) * 512 + h * 128 + 8 * ((TID) & 15)); \
            if ((TID) < 64) { const size_t go = (size_t)sc_row(b, sct, tN + (TID)) * 16 + h; rg0 = GTg[go + (dir ? 12 : 4)]; rg1 = GTg[go + (dir ? 8 : 0)]; } } } while (0)
    SC_ISSUE(0, F.tid);
#pragma unroll 1
    for (int ci = 0; ci < 4; ++ci) {
        const int c = dir ? 3 - ci : ci; const int t0 = c * 64;
        int tid_ = F.tid; asm volatile("" : "+v"(tid_));
        const int lane_ = tid_ & 63, ln = lane_ & 15, g = lane_ >> 4;
        LAS unsigned char* VRAW = L + C::OFF_SST;
        if (KIND == 0) {
            const int d = tid_ & 127, part = tid_ >> 7;
            if (!dir) {
#pragma unroll
                for (int i = 1; i < 16; ++i) rl[i] += rl[i - 1];
                TOT[part * 128 + d] = rl[15];
            } else {
#pragma unroll
                for (int i = 14; i >= 0; --i) rl[i] += rl[i + 1];
                TOT[part * 128 + d] = rl[0];
            }
#pragma unroll
            for (int p = 0; p < 2; ++p) { const int t = p * 32 + (tid_ >> 4), cc = tid_ & 15;
                if (PASS == 3) *(LAS u32x4*)(L + C::OFF_QP + t * 256 + ((cc ^ (t & 15)) * 16)) = rq[p];
                *(LAS u32x4*)(L + C::OFF_KP + t * 256 + ((cc ^ (t & 15)) * 16)) = rk[p];
                *(LAS u32x4*)(VRAW + t * 256 + cc * 16) = rv[p]; }
        } else {
            { const int t = tid_ >> 3, cc = tid_ & 7;
                if (PASS == 3) *(LAS u32x4*)(L + C::OFF_QP + t * 128 + ((cc ^ (t & 7)) * 16)) = rq[0];
                *(LAS u32x4*)(L + C::OFF_KP + t * 128 + ((cc ^ (t & 7)) * 16)) = rk[0]; }
#pragma unroll
            for (int p = 0; p < 2; ++p) { const int t = p * 32 + (tid_ >> 4), cc = tid_ & 15; *(LAS u32x4*)(VRAW + t * 256 + cc * 16) = rv[p]; }
            if (tid_ < 64) { const int t = tid_;
                float x = rg0; const float ig = rg1;
#pragma unroll
                for (int o = 1; o < 64; o <<= 1) { const int src = dir ? t + o : t - o; const float y = __int_as_float(__builtin_amdgcn_ds_bpermute((src & 63) << 2, __float_as_int(x))); if (src >= 0 && src < 64) x += y; }
                const float ref = __int_as_float(__builtin_amdgcn_readlane(__float_as_int(x), dir ? 32 : 31));
                const float btot = __int_as_float(__builtin_amdgcn_readlane(__float_as_int(x), dir ? 0 : 63));
                RQ[t] = exp_c(x - ref); CK[t] = exp_c(ref - x + ig);
                if (t == 0) { SCAL[0] = __expf(ref); SCAL[1] = __expf(btot - ref); if (PASS == 1) SCAL[2] = (ci == 0 ? 0.f : SCAL[2]) + btot; } }
            if (tid_ < 128) { const int row = 128 + (tid_ >> 3), ch = tid_ & 7; const unsigned one = (row == 128) ? 0x3f803f80u : 0u;
                *(LAS u32x4*)(L + C::OFF_VT + row * 128 + ((ch ^ (row & 7)) * 16)) = (u32x4){one, one, one, one}; }
        }
        __syncthreads();
        if (KIND == 0) {
            const int d = tid_ & 127, part = tid_ >> 7;
            const float t0v = TOT[d], t1v = TOT[128 + d], t2v = TOT[256 + d], t3v = TOT[384 + d];
            const float btot = (t0v + t1v) + (t2v + t3v);
            const float ref = dir ? (t2v + t3v) : (t0v + t1v);
            float off;
            if (!dir) off = part == 0 ? 0.f : part == 1 ? t0v : part == 2 ? (t0v + t1v) : (t0v + t1v + t2v);
            else off = part == 3 ? 0.f : part == 2 ? t3v : part == 1 ? (t3v + t2v) : (t3v + t2v + t1v);
            if (part == 0) { EM[d] = __expf(ref); E2[d] = __expf(btot - ref); if (PASS == 1) BT[d] = (ci == 0 ? 0.f : BT[d]) + btot; }
            unsigned kt[8];
#pragma unroll
            for (int i = 0; i < 16; ++i) { const int t = part * 16 + i; const int ad = t * 256 + (((d >> 3) ^ (t & 15)) * 16) + (d & 7) * 2;
                const float bb = rl[i] + off - ref;
                const float kv = bf2f(*(const LAS bf16_t*)(L + C::OFF_KP + ad)) * exp_c(-bb); const unsigned kb = pk2(kv, kv) & 0xffffu;
                if (PASS == 3) { const float qv = bf2f(*(const LAS bf16_t*)(L + C::OFF_QP + ad)) * exp_c(bb);
                    *(LAS bf16_t*)(L + C::OFF_QP + ad) = (bf16_t)(pk2(qv, qv) & 0xffffu);
                    *(LAS bf16_t*)(L + C::OFF_KP + ad) = (bf16_t)kb; }
                if (i & 1) kt[i >> 1] |= kb << 16; else kt[i >> 1] = kb; }
            *(LAS u32x4*)(L + C::OFF_KPT + d * 128 + (((part * 2) ^ (d & 7)) * 16)) = (u32x4){kt[0], kt[1], kt[2], kt[3]};
            *(LAS u32x4*)(L + C::OFF_KPT + d * 128 + (((part * 2 + 1) ^ (d & 7)) * 16)) = (u32x4){kt[4], kt[5], kt[6], kt[7]};
        } else {
            const int d = tid_ & 63, part = tid_ >> 6;
            unsigned kt[4];
#pragma unroll
            for (int i = 0; i < 8; ++i) { const int t = part * 8 + i; const int ad = t * 128 + (((d >> 3) ^ (t & 7)) * 16) + (d & 7) * 2;
                const float kv = bf2f(*(const LAS bf16_t*)(L + C::OFF_KP + ad)) * CK[t]; const unsigned kb = pk2(kv, kv) & 0xffffu;
                if (PASS == 3) { const float qv = bf2f(*(const LAS bf16_t*)(L + C::OFF_QP + ad)) * RQ[t];
                    *(LAS bf16_t*)(L + C::OFF_QP + ad) = (bf16_t)(pk2(qv, qv) & 0xffffu);
                    *(LAS bf16_t*)(L + C::OFF_KP + ad) = (bf16_t)kb; }
                if (i & 1) kt[i >> 1] |= kb << 16; else kt[i >> 1] = kb; }
            *(LAS u32x4*)(L + C::OFF_KPT + d * 128 + ((part ^ (d & 7)) * 16)) = (u32x4){kt[0], kt[1], kt[2], kt[3]};
        }
        {
            const int e = tid_ & 127, part = tid_ >> 7; unsigned vt[8];
#pragma unroll
            for (int i = 0; i < 16; ++i) { const unsigned vb = *(const LAS bf16_t*)(VRAW + (part * 16 + i) * 256 + e * 2); if (i & 1) vt[i >> 1] |= vb << 16; else vt[i >> 1] = vb; }
            *(LAS u32x4*)(L + C::OFF_VT + e * 128 + (((part * 2) ^ (e & 7)) * 16)) = (u32x4){vt[0], vt[1], vt[2], vt[3]};
            *(LAS u32x4*)(L + C::OFF_VT + e * 128 + (((part * 2 + 1) ^ (e & 7)) * 16)) = (u32x4){vt[4], vt[5], vt[6], vt[7]};
        }
        if (ci < 3) SC_ISSUE(ci + 1, tid_);
        __syncthreads();
        const int smt = st_mt<KIND>(w), sn0 = st_n0<KIND>(w), snc = st_nc<KIND>(w), onc = KIND ? snc : 4;
#define SC_ET(n) (KIND ? (sn0 + (n)) : (((((n) >> 2) ^ (w >> 2)) << 2) + ((n) & 3)))
        {
            f32x4 em;
            if (KIND == 0) em = *(const LAS f32x4*)(EM + smt * 16 + 4 * g); else { const float s0 = SCAL[0]; em = (f32x4){s0, s0, s0, s0}; }
#pragma unroll
            for (int n = 0; n < 8; ++n) if (n < snc) { S[n] *= em;
                if (PASS == 3) { const int e = SC_ET(n) * 16 + ln; u32x2 wv; wv.x = pk2(S[n][0], S[n][1]); wv.y = pk2(S[n][2], S[n][3]);
                    *(LAS u32x2*)(L + C::OFF_SST + e * C::RBQ + (((2 * smt + (g >> 1)) ^ (e & C::CMQ)) * 16) + (g & 1) * 8) = wv; } }
        }
        constexpr int NVT = KIND ? 5 : 8;
        bf16x8 vt[NVT][2], kf[2];
#pragma unroll
        for (int n = 0; n < NVT; ++n) if (n < snc) { const int e = SC_ET(n) * 16 + ln;
#pragma unroll
            for (int ks = 0; ks < 2; ++ks) vt[n][ks] = lds_frag(L + C::OFF_VT + e * 128 + (((ks * 4 + g) ^ (e & 7)) * 16)); }
        { const int d_row = smt * 16 + ln;
#pragma unroll
            for (int ks = 0; ks < 2; ++ks) kf[ks] = lds_frag(L + C::OFF_KPT + d_row * 128 + (((ks * 4 + g) ^ (d_row & 7)) * 16)); }
        f32x4 e2;
        if (KIND == 0) e2 = *(const LAS f32x4*)(E2 + smt * 16 + 4 * g); else { const float s1 = SCAL[1]; e2 = (f32x4){s1, s1, s1, s1}; }
        f32x4 oacc[5];
        if (PASS == 3) {
            {
                const int st = w & 3, s_row = st * 16 + ln;
                bf16x8 af[C::KST], qfr[2][C::KST];
#pragma unroll
                for (int ks = 0; ks < C::KST; ++ks) af[ks] = lds_frag(L + C::OFF_KP + s_row * C::RBQ + (((ks * 4 + g) ^ (s_row & C::CMQ)) * 16));
#pragma unroll
                for (int tq = 0; tq < 2; ++tq) { const int t_row = ((w >> 2) * 2 + tq) * 16 + ln;
#pragma unroll
                    for (int ks = 0; ks < C::KST; ++ks) qfr[tq][ks] = lds_frag(L + C::OFF_QP + t_row * C::RBQ + (((ks * 4 + g) ^ (t_row & C::CMQ)) * 16)); }
                __builtin_amdgcn_sched_barrier(0);
#pragma unroll
                for (int tq = 0; tq < 2; ++tq) { const int tt = (w >> 2) * 2 + tq, t_row = tt * 16 + ln;
                    f32x4 acc = (f32x4){0.f, 0.f, 0.f, 0.f};
#pragma unroll
                    for (int ks = 0; ks < C::KST; ++ks) acc = __builtin_amdgcn_mfma_f32_16x16x32_bf16(af[ks], qfr[tq][ks], acc, 0, 0, 0);
#pragma unroll
                    for (int j = 0; j < 4; ++j) { const int sidx = st * 16 + 4 * g + j; const bool keep = dir ? (sidx >= t_row) : (sidx <= t_row); acc[j] = keep ? acc[j] : 0.f; }
                    u32x2 wv; wv.x = pk2(acc[0], acc[1]); wv.y = pk2(acc[2], acc[3]);
                    *(LAS u32x2*)(L + C::OFF_PP + t_row * 128 + (((2 * st + (g >> 1)) ^ (t_row & 7)) * 16) + (g & 1) * 8) = wv; }
            }
        } else __builtin_amdgcn_sched_barrier(0);
#pragma unroll
        for (int n = 0; n < NVT; ++n) if (n < snc) {
#pragma unroll
            for (int ks = 0; ks < 2; ++ks) S[n] = __builtin_amdgcn_mfma_f32_16x16x32_bf16(kf[ks], vt[n][ks], S[n], 0, 0, 0);
            S[n] *= e2; }
        if (PASS == 3) {
            __syncthreads();
            {
                const int tt = w & 3, t_row = tt * 16 + ln;
                bf16x8 pf[2], qf2[C::KST], sst[5][C::KST];
#pragma unroll
                for (int ks = 0; ks < 2; ++ks) pf[ks] = lds_frag(L + C::OFF_PP + t_row * 128 + (((ks * 4 + g) ^ (t_row & 7)) * 16));
#pragma unroll
                for (int ks = 0; ks < C::KST; ++ks) qf2[ks] = lds_frag(L + C::OFF_QP + t_row * C::RBQ + (((ks * 4 + g) ^ (t_row & C::CMQ)) * 16));
#pragma unroll
                for (int n = 0; n < 5; ++n) if (n < onc) { const int e = SC_ET(n) * 16 + ln;
#pragma unroll
                    for (int ks = 0; ks < C::KST; ++ks) sst[n][ks] = lds_frag(L + C::OFF_SST + e * C::RBQ + (((ks * 4 + g) ^ (e & C::CMQ)) * 16)); }
                __builtin_amdgcn_sched_barrier(0);
#pragma unroll
                for (int n = 0; n < 5; ++n) if (n < onc) { f32x4 acc = (f32x4){0.f, 0.f, 0.f, 0.f};
#pragma unroll
                    for (int ks = 0; ks < 2; ++ks) acc = __builtin_amdgcn_mfma_f32_16x16x32_bf16(pf[ks], vt[n][ks], acc, 0, 0, 0);
#pragma unroll
                    for (int ks = 0; ks < C::KST; ++ks) acc = __builtin_amdgcn_mfma_f32_16x16x32_bf16(qf2[ks], sst[n][ks], acc, 0, 0, 0);
                    oacc[n] = acc; }
            }
            {
                LAS unsigned char* OBH = (w >> 2) ? (L + MISC_OFF + 4096) : (L + 118912); LAS float* DEN = (LAS float*)(L + MISC_OFF + 4096 + 9216);
                const int tt = w & 3, onc2 = ot_nc<KIND>(w);
#pragma unroll
                for (int n = 0; n < 5; ++n) if (n < onc2) {
                    if (KIND == 1 && n == 4) { if (ln == 0) {
#pragma unroll
                            for (int j = 0; j < 4; ++j) DEN[tt * 16 + 4 * g + j] = oacc[n][j]; } }
                    else { asm volatile("s_nop 11" : "+v"(oacc[n]));
                        const int e = n * 16 + ln; const unsigned p01 = pk2(oacc[n][0], oacc[n][1]), p23 = pk2(oacc[n][2], oacc[n][3]);
                        LAS bf16_t* o_ = (LAS bf16_t*)(OBH + (tt * 16 + 4 * g) * 144) + e;
                        o_[0] = (bf16_t)p01; o_[72] = (bf16_t)(p01 >> 16); o_[144] = (bf16_t)p23; o_[216] = (bf16_t)(p23 >> 16); } }
            }
        }
        __syncthreads();
        if (PASS == 3) {
            {
                const int t = tid_ >> 3, seg = tid_ & 7; const int row = sc_row(b, sct, t0 + t);
                LAS float* DEN = (LAS float*)(L + MISC_OFF + 4096 + 9216);
                const LAS bf16_t* ob = (const LAS bf16_t*)(((seg >> 2) ? (L + MISC_OFF + 4096) : (L + 118912)) + t * 144 + (seg & 3) * 32);
                f32x4 v[4];
                { const u32x4 oa = *(const LAS u32x4*)ob, oc = *(const LAS u32x4*)(ob + 8); const unsigned ow_[8] = {oa.x, oa.y, oa.z, oa.w, oc.x, oc.y, oc.z, oc.w};
#pragma unroll
                    for (int q = 0; q < 4; ++q) v[q] = (f32x4){bf2f(ow_[2 * q] & 0xffffu), bf2f(ow_[2 * q] >> 16), bf2f(ow_[2 * q + 1] & 0xffffu), bf2f(ow_[2 * q + 1] >> 16)}; }
                if (KIND == 1) { const float den = DEN[t]; const float inv = 1.0f / fmaxf(fabsf(den), 1.0f);
#pragma unroll
                    for (int q = 0; q < 4; ++q) v[q] *= inv; }
                float* ot = WSP(float, KIND ? WS_OTM : WS_OTH) + (size_t)row * 512 + h * 128 + seg * 16;
                if (!dir) {
#pragma unroll
                    for (int q = 0; q < 4; ++q) *(f32x4*)(ot + 4 * q) = v[q];
                } else {
                    float ss = 0.f;
#pragma unroll
                    for (int q = 0; q < 4; ++q) { v[q] += *(const f32x4*)(ot + 4 * q); ss += (v[q][0] * v[q][0] + v[q][1] * v[q][1]) + (v[q][2] * v[q][2] + v[q][3] * v[q][3]); }
                    ss += shx(ss, 1, lane_); ss += shx(ss, 2, lane_); ss += shx(ss, 4, lane_);
                    const float r = rsqrtf(ss * (1.0f / 128.0f) + EPS);
                    const float* gn = INP(KIND ? 13 : 12) + jl * 512 + h * 128 + seg * 16;
                    const bf16_t* gate = WSP(bf16_t, KIND ? WS_MO : WS_HG) + (size_t)row * 512 + h * 128 + seg * 16;
                    const u32x4 ga = *(const u32x4*)gate, gb = *(const u32x4*)(gate + 8);
                    const unsigned gw[8] = {ga.x, ga.y, ga.z, ga.w, gb.x, gb.y, gb.z, gb.w};
                    unsigned ow[8];
#pragma unroll
                    for (int q = 0; q < 4; ++q) { const f32x4 gq = *(const f32x4*)(gn + 4 * q);
                        const float y0 = v[q][0] * r * gq[0] * bf2f(gw[2 * q] & 0xffffu), y1 = v[q][1] * r * gq[1] * bf2f(gw[2 * q] >> 16);
                        const float y2 = v[q][2] * r * gq[2] * bf2f(gw[2 * q + 1] & 0xffffu), y3 = v[q][3] * r * gq[3] * bf2f(gw[2 * q + 1] >> 16);
                        ow[2 * q] = pk2(y0, y1); ow[2 * q + 1] = pk2(y2, y3); }
                    bf16_t* mg = WSP(bf16_t, WS_MERGED) + (size_t)row * 1024 + KIND * 512 + h * 128 + seg * 16;
                    *(u32x4*)mg = (u32x4){ow[0], ow[1], ow[2], ow[3]}; *(u32x4*)(mg + 8) = (u32x4){ow[4], ow[5], ow[6], ow[7]};
                }
            }
        }
    }
}
#undef SC_ISSUE
#undef SC_ET
__device__ __forceinline__ void phase_scan1(Frame& F) {
    for (int it = F.bid; it < 2 * 32 * 32; it += F.G) {
        const int cpos = it & 31, ch = (it >> 5) & 31, kind = it >> 10; const int dir = ch & 1, h = (ch >> 1) & 3, b = ch >> 3;
        const int sct = cpos == 0 ? 0 : (dir ? 33 - cpos : cpos);
        f32x4 S[8];
#pragma unroll
        for (int n = 0; n < 8; ++n) S[n] = (f32x4){0.f, 0.f, 0.f, 0.f};
        if (kind == 0) { scan_super<0, 1>(F, 0, b, h, sct, dir, S);
            float* G = WSP(float, WS_GH) + (size_t)(ch * 33 + cpos) * 16384;
#pragma unroll
            for (int n = 0; n < 8; ++n) *(f32x4*)(G + (n * 512 + F.tid) * 4) = S[n];
            if (F.tid < 128) WSP(float, WS_DECH)[(ch * 33 + cpos) * 128 + F.tid] = __expf(((const LAS float*)(F.lds + ScanCfg<0>::OFF_SM))[768 + F.tid]);
        } else { scan_super<1, 1>(F, 0, b, h, sct, dir, S);
            float* G = WSP(float, WS_GM) + (size_t)(ch * 33 + cpos) * 10240;
#pragma unroll
            for (int n = 0; n < 5; ++n) *(f32x4*)(G + (n * 512 + F.tid) * 4) = S[n];
            if (F.tid == 0) WSP(float, WS_DECM)[ch * 33 + cpos] = __expf(((const LAS float*)(F.lds + ScanCfg<1>::OFF_SM))[1024 + 2]);
        }
        __syncthreads();
    }
}
__device__ __forceinline__ void phase_scan23(Frame& F, int jl, int pass) {
    if (pass == 0) {
        const int nb0 = (F.G > 64) ? 32 : 0;
        if (F.bid >= nb0) {
            const int gt = (F.bid - nb0) * 512 + F.tid, NT = (F.G - nb0) * 512;
            for (int i = gt; i < 32 * 4096 + 32 * 2560; i += NT) {
                if (i < 32 * 4096) { const int ch = i >> 12, q = i & 4095, tid = q & 511; const int d0 = 16 * (tid >> 6) + 4 * ((tid & 63) >> 4);
                    const float* G = WSP(float, WS_GH) + (size_t)ch * 33 * 16384 + q * 4; bf16_t* SI = WSP(bf16_t, WS_SH) + (size_t)ch * 33 * 16384 + q * 4; const float* DC = WSP(float, WS_DECH) + ch * 33 * 128 + d0;
                    f32x4 s4 = (f32x4){0.f, 0.f, 0.f, 0.f};
#pragma unroll 4
                    for (int cp = 0; cp < 32; ++cp) { s4 = *(const f32x4*)(DC + cp * 128) * s4 + *(const f32x4*)(G + (size_t)cp * 16384); u32x2 w; w.x = pk2(s4[0], s4[1]); w.y = pk2(s4[2], s4[3]); *(u32x2*)(SI + (size_t)(cp + 1) * 16384) = w; }
                } else { const int k = i - 32 * 4096, ch = k / 2560, q = k % 2560;
                    const float* G = WSP(float, WS_GM) + (size_t)ch * 33 * 10240 + q * 4; bf16_t* SI = WSP(bf16_t, WS_SM) + (size_t)ch * 33 * 10240 + q * 4; const float* DC = WSP(float, WS_DECM) + ch * 33;
                    f32x4 s4 = (f32x4){0.f, 0.f, 0.f, 0.f};
#pragma unroll 4
                    for (int cp = 0; cp < 32; ++cp) { s4 = DC[cp] * s4 + *(const f32x4*)(G + (size_t)cp * 10240); u32x2 w; w.x = pk2(s4[0], s4[1]); w.y = pk2(s4[2], s4[3]); *(u32x2*)(SI + (size_t)(cp + 1) * 10240) = w; }
                }
            }
        }
    }
    const int count = pass == 0 ? 32 : 1024;
    for (int q = F.bid; q < count; q += F.G) {
        const int kind = q & 1, r = q >> 1;
        const int sct = pass == 0 ? 0 : 1 + (r & 31), bh = pass == 0 ? r : (r >> 5), h = bh & 3, b = bh >> 2;
#pragma unroll 1
        for (int dir = 0; dir < 2; ++dir) {
            const int ch = (b * 4 + h) * 2 + dir; const int cpos = sct == 0 ? 0 : (dir ? 33 - sct : sct);
            f32x4 S[8];
            if (kind == 0) { const bf16_t* SI = WSP(bf16_t, WS_SH) + (size_t)(ch * 33 + cpos) * 16384;
#pragma unroll
                for (int n = 0; n < 8; ++n) S[n] = cpos ? ld_bf4(SI + (n * 512 + F.tid) * 4) : (f32x4){0.f, 0.f, 0.f, 0.f};
                scan_super<0, 3>(F, jl, b, h, sct, dir, S);
            } else { const bf16_t* SI = WSP(bf16_t, WS_SM) + (size_t)(ch * 33 + cpos) * 10240;
#pragma unroll
                for (int n = 0; n < 8; ++n) S[n] = (cpos && n < 5) ? ld_bf4(SI + (n * 512 + F.tid) * 4) : (f32x4){0.f, 0.f, 0.f, 0.f};
                scan_super<1, 3>(F, jl, b, h, sct, dir, S);
            }
        }
    }
}

template <int PHMASK_T>
__global__ void __launch_bounds__(512, 2) mk_fwd(Args args) {
    extern __shared__ __attribute__((aligned(16))) unsigned char lds_raw[];
    Frame F;
    F.lds = (LAS unsigned char*)lds_raw;
    F.tid = threadIdx.x; F.lane = F.tid & 63; F.wave = __builtin_amdgcn_readfirstlane(F.tid >> 6);
    F.G = gridDim.x; F.bid = blockIdx.x;
    F.out = args.out; F.ws = args.ws; F.ctl = (unsigned*)(args.ws + WS_CTL);
    volatile LAS unsigned* MISC = (volatile LAS unsigned*)(F.lds + MISC_OFF);
    if (F.tid < 64) MISC[F.tid] = 0u;
    if (F.tid >= 64 && F.tid < 64 + 25) { const unsigned long long p = (unsigned long long)args.in[F.tid - 64]; MISC[64 + 2 * (F.tid - 64)] = (unsigned)p; MISC[65 + 2 * (F.tid - 64)] = (unsigned)(p >> 32); }
    __syncthreads();
    const int lo = args.ph_lo, hi = args.ph_hi;
    if (hi - lo > 1) (void)xcd_barrier_post(F.ctl + CW_BAR, MISC + 8);
#define EN(b) ((PHMASK_T >> (b)) & 1)
#define IN(k) (lo <= (k) && (k) < hi)
#if MK_ONE_LAUNCH
#define SEAM(k) do { if (IN(k) && IN((k) + 1)) { XcdBarrier bar_; bar_.bar = (unsigned*)(args.ws + WS_CTL) + CW_BAR; bar_.x = xb_xcc_id(); bar_.st = (volatile LAS unsigned*)(F.lds + MISC_OFF) + 8; bar_.leader = (F.wave == 0 && lane_id_volatile() == 0) ? 1 : 0; xcd_barrier(bar_); } } while (0)
#else
#define SEAM(k) do { } while (0)
#endif
    LAS int* tb = (LAS int*)(F.lds + MISC_OFF + 2048);
    LAS int* cnts = tb + 40;

    if (EN(0) && IN(0)) { _Pragma("unroll 1") for (int rp = 0; rp < REP_PRO; ++rp) { Frame P = fresh(F); phase_prologue(P); } }
    SEAM(0);
    for (int l0 = 0; l0 < 4; ++l0) {
        const int pb = 1 + 10 * l0; const bool rec = (l0 & 1) == 0;
        if (EN(1) && IN(pb + 0)) { Frame P = fresh(F); const int l = fresh_i(l0); if (l0 == 0) phase_norm1<0>(P, l); else phase_norm1<1>(P, l); }
        SEAM(pb + 0);
        if (rec) {
            if (EN(2) && IN(pb + 1)) _Pragma("unroll 1") for (int rp = 0; rp < REP_GIN; ++rp) {
                Frame P = fresh(F); const int l = fresh_i(l0), j = l >> 1;
                pg8::StaticOrder S; S.init(NR, NREC, P.G, P.bid);
                EpiRec E{P.ws, inp_ptr(P, 9) + (size_t)j * 4112, (float*)(P.ws + WS_LB) + l * 512, l};
                pg8::gemm_phase(P.lds, (const bf16_t*)(P.ws + WS_H), (const bf16_t*)(P.ws + WS_WIN) + (size_t)j * NREC * 1024, 1024, 0, S, E, pg8::RowIdentity{}, P.tid);
            }
            SEAM(pb + 1);
            if (EN(3) && IN(pb + 2)) { _Pragma("unroll 1") for (int rp = 0; rp < REP_SCAN1; ++rp) { Frame P = fresh(F); phase_scan1(P); } }
            SEAM(pb + 2);
#pragma unroll 1
            for (int pass = 0; pass < 2; ++pass) {
                if (EN(4) && IN(pb + 3 + pass)) { Frame P = fresh(F); phase_scan23(P, fresh_i(l0) >> 1, fresh_i(pass)); }
                SEAM(pb + 3 + pass);
            }
        } else {
            if (EN(5) && IN(pb + 1)) _Pragma("unroll 1") for (int rp = 0; rp < REP_GIN; ++rp) {
                Frame P = fresh(F); const int l = fresh_i(l0), j = l >> 1;
                pg8::StaticOrder S; S.init(NR, 3072, P.G, P.bid);
                EpiQKV E{P.ws};
                pg8::gemm_phase(P.lds, (const bf16_t*)(P.ws + WS_H), (const bf16_t*)(P.ws + WS_WQKV) + (size_t)j * 3072 * 1024, 1024, 0, S, E, pg8::RowIdentity{}, P.tid);
            }
            SEAM(pb + 1);
            if (EN(6) && IN(pb + 2)) { _Pragma("unroll 1") for (int rp = 0; rp < REP_ATT; ++rp) { Frame P = fresh(F); phase_attn(P, fresh_i(l0) >> 1, l0 == 3); } }
            SEAM(pb + 2);
        }
        if (EN(7) && IN(pb + 5)) {
            Frame P = fresh(F); const int l = fresh_i(l0), j = l >> 1;
            pg8::StaticOrder S; S.init(l0 == 3 ? RL : NR, 1024, P.G, P.bid);
            EpiResid E{(bf16_t*)(P.ws + WS_Y), (const float*)(P.ws + WS_MOD) + l * 5 * 6144};
            pg8::gemm_phase(P.lds, (const bf16_t*)(P.ws + WS_MERGED), (const bf16_t*)(P.ws + ((l & 1) ? WS_WNOUT : WS_WROUT)) + (size_t)j * 1024 * 1024, 1024, 0, S, E, pg8::RowIdentity{}, P.tid);
        }
        SEAM(pb + 5);
        if (EN(8) && IN(pb + 6)) { Frame P = fresh(F); phase_router(P, fresh_i(l0)); }
        SEAM(pb + 6);
        if ((EN(9) && IN(pb + 7)) || (EN(10) && IN(pb + 8))) {
            Frame P = fresh(F); const int l = fresh_i(l0);
            expert_prefix(P, l, tb, cnts, 1, true);
            __syncthreads();
        }
        if (EN(9) && IN(pb + 7)) _Pragma("unroll 1") for (int rp = 0; rp < REP_MOE; ++rp) {
            Frame P = fresh(F); const int l = fresh_i(l0);
            pg8::MoeOrder S{tb, tb[32], 3, P.G, P.bid};
            EpiMoe1 E{(bf16_t*)(P.ws + WS_ACT), inp_ptr(P, 22) + (size_t)l * 32 * 2048};
            pg8::RowGather AO{(const int*)(P.ws + WS_LIST), cnts};
            pg8::gemm_phase(P.lds, (const bf16_t*)(P.ws + WS_H), (const bf16_t*)(P.ws + WS_WGU) + (size_t)l * 32 * 2048 * 1024, 1024, (size_t)2048 * 1024 * 2, S, E, AO, P.tid);
        }
        SEAM(pb + 7);
        if (EN(10) && IN(pb + 8)) _Pragma("unroll 1") for (int rp = 0; rp < REP_MOE; ++rp) {
            Frame P = fresh(F); const int l = fresh_i(l0);
            pg8::MoeOrder S{tb, tb[32], 2, P.G, P.bid};
            EpiMoe2 E{(bf16_t*)(P.ws + WS_YS), inp_ptr(P, 24) + (size_t)l * 32 * 1024};
            pg8::gemm_phase(P.lds, (const bf16_t*)(P.ws + WS_ACT), (const bf16_t*)(P.ws + WS_WD) + (size_t)l * 32 * 1024 * 1024, 1024, (size_t)1024 * 1024 * 2, S, E, pg8::RowIdentity{}, P.tid);
        }
        SEAM(pb + 8);
    }
    if (EN(11) && IN(41)) { Frame P = fresh(F); phase_norm1<2>(P, fresh_i(4)); }
#undef IN
#undef SEAM
}

typedef void (*kern_t)(Args);
static int phase_bit(int p) {
    if (p == 0) return 0; if (p == 41) return 11;
    const int l = (p - 1) / 10, k = (p - 1) % 10; const bool rec = (l & 1) == 0;
    switch (k) { case 0: return 1; case 1: return rec ? 2 : 5; case 2: return rec ? 3 : 6; case 3: return rec ? 3 : -1; case 4: return rec ? 4 : -1; case 5: return 7; case 6: return 8; case 7: return 9; case 8: return 10; default: return -1; }
}
extern "C" void kernel_launch(void* const* d_in, const int* in_sizes, int n_in, void* d_out, int out_size, void* d_ws, size_t ws_size, hipStream_t stream) {
    static int grid = 0;
#if MK_ONE_LAUNCH
    #ifndef ONE_MASK
#define ONE_MASK 0xfff
#endif
    static const kern_t kerns[1] = { mk_fwd<ONE_MASK> };
    const int nk = 1;
#else
    static const kern_t kerns[12] = { mk_fwd<1>, mk_fwd<2>, mk_fwd<4>, mk_fwd<8>, mk_fwd<16>, mk_fwd<32>, mk_fwd<64>, mk_fwd<128>, mk_fwd<256>, mk_fwd<512>, mk_fwd<1024>, mk_fwd<2048> };
    const int nk = 12;
#endif
    if (grid == 0) {
        if (n_in != 25 || out_size != RL * D || ws_size < WS_END) { fprintf(stderr, "kernel_launch: unexpected shapes (n_in %d out %d ws %zu)\n", n_in, out_size, ws_size); grid = -1; return; }
        int dev = 0, cus = 0;
        if (hipGetDevice(&dev) != hipSuccess || hipDeviceGetAttribute(&cus, hipDeviceAttributeMultiprocessorCount, dev) != hipSuccess) { grid = -1; return; }
        for (int i = 0; i < nk; ++i)
            if (hipFuncSetAttribute((const void*)kerns[i], hipFuncAttributeMaxDynamicSharedMemorySize, LDS_BYTES) != hipSuccess) { fprintf(stderr, "kernel_launch: hipFuncSetAttribute failed\n"); grid = -1; return; }
        (void)hipGetLastError();
        grid = cus;
    }
    if (grid < 0) return;
    (void)hipMemsetAsync((char*)d_ws + WS_CTL, 0, CTL_BYTES, stream);
    Args a{};
    for (int i = 0; i < 25; ++i) a.in[i] = (const float*)d_in[i];
    a.out = (float*)d_out; a.ws = (unsigned char*)d_ws;
#if MK_ONE_LAUNCH
    a.ph_lo = 0; a.ph_hi = NPHASE;
    hipLaunchKernelGGL(kerns[0], dim3(grid), dim3(512), LDS_BYTES, stream, a);
#else
    for (int p = 0; p < NPHASE; ++p) {
        const int bit = phase_bit(p); if (bit < 0) continue;
        a.ph_lo = p; a.ph_hi = p + 1;
        hipLaunchKernelGGL(kerns[bit], dim3(grid), dim3(512), LDS_BYTES, stream, a);
    }
#endif
}
```

```cpp
#include <hip/hip_runtime.h>
#include <stdint.h>
#include <stdio.h>

#ifndef MK_ONE_LAUNCH
#define MK_ONE_LAUNCH 1
#endif
#ifndef REP_PRO
#define REP_PRO 1
#endif
#ifndef REP_SCAN1
#define REP_SCAN1 1
#endif
#ifndef REP_SCAN2
#define REP_SCAN2 1
#endif
#ifndef REP_SCAN3
#define REP_SCAN3 1
#endif
#ifndef REP_ATT
#define REP_ATT 1
#endif
#ifndef REP_MOE
#define REP_MOE 1
#endif
#ifndef REP_GIN
#define REP_GIN 1
#endif
#define LAS __attribute__((address_space(3)))
#define GAS __attribute__((address_space(1)))
typedef unsigned short bf16_t;
typedef short bf16x8 __attribute__((ext_vector_type(8)));
typedef float f32x4 __attribute__((ext_vector_type(4)));
typedef float f32x2 __attribute__((ext_vector_type(2)));
typedef unsigned u32x4 __attribute__((ext_vector_type(4)));
typedef unsigned u32x2 __attribute__((ext_vector_type(2)));

constexpr int D = 1024, NB = 4, TL = 8192, TC = 256;
constexpr int RL = NB * TL;
constexpr int RC = NB * TC;
constexpr int NR = RL + RC;
constexpr int NREC = 4352;
constexpr int NE = 32, DFF = 1024;
constexpr int CAP = NR;
constexpr int SLOT_ROWS = 143360;
constexpr float EPS = 1e-6f;
constexpr int NPHASE = 42;

constexpr size_t MiB = 1u << 20;
constexpr size_t WS_CTL = 0, CTL_BYTES = 1 * MiB;
constexpr size_t WS_MOD = 1 * MiB;
constexpr size_t WS_LB = WS_MOD + 512 * 1024;
constexpr size_t WS_ROPE = WS_LB + 8 * 1024;
constexpr size_t WS_WIN = 2 * MiB;
constexpr size_t WS_WROUT = 19 * MiB;
constexpr size_t WS_WQKV = 23 * MiB;
constexpr size_t WS_WNOUT = 35 * MiB;
constexpr size_t WS_WGU = 40 * MiB;
constexpr size_t WS_WD = 552 * MiB;
constexpr size_t WS_X = 808 * MiB;
constexpr size_t WS_H = 940 * MiB;
constexpr size_t WS_MERGED = 1006 * MiB;
constexpr size_t WS_STREAM = 1072 * MiB;
constexpr size_t SZ_B512 = (size_t)NR * 512 * 2;
constexpr size_t SZ_F512 = (size_t)NR * 512 * 4;
constexpr size_t WS_Q = WS_STREAM, WS_KF = WS_Q + SZ_B512, WS_KB = WS_KF + SZ_B512, WS_V = WS_KB + SZ_B512, WS_HG = WS_V + SZ_B512;
constexpr size_t WS_MV = WS_HG + SZ_B512, WS_MO = WS_MV + SZ_B512, WS_MQ = WS_MO + SZ_B512, WS_MK = WS_MQ + SZ_B512 / 2;
constexpr size_t WS_LAF = WS_MK + SZ_B512 / 2, WS_LAB = WS_LAF + SZ_F512, WS_GATES = WS_LAB + SZ_F512;
constexpr size_t WS_OHF = WS_GATES + 3 * MiB, WS_OHB = WS_OHF + SZ_F512, WS_OMF = WS_OHB + SZ_F512, WS_OMB = WS_OMF + SZ_F512;
constexpr size_t WS_STREAM_END = WS_OMB + SZ_F512;
constexpr size_t WS_Y = WS_STREAM;
constexpr size_t WS_QKV = WS_STREAM;
constexpr int TT = TL + TC;
constexpr size_t WS_VTG = WS_STREAM + 200 * MiB;
constexpr size_t WS_SSK = WS_STREAM + 272 * MiB;
constexpr size_t WS_TOKE = 1744 * MiB, WS_TOKP = WS_TOKE + 1 * MiB, WS_TOKW = WS_TOKP + 1 * MiB, WS_LIST = WS_TOKW + 1 * MiB;
constexpr size_t WS_ACT = 1752 * MiB;
constexpr size_t WS_YS = 2032 * MiB;
constexpr size_t WS_END = 2312 * MiB;
static_assert(WS_STREAM_END <= WS_TOKE && WS_QKV + (size_t)NR * 3072 * 2 <= WS_TOKE, "stream region");
static_assert(WS_LIST + (size_t)NE * CAP * 4 <= WS_ACT && WS_ACT + (size_t)SLOT_ROWS * 1024 * 2 <= WS_YS && WS_YS + (size_t)SLOT_ROWS * 1024 * 2 <= WS_END, "moe region");
static_assert(WS_WIN + (size_t)2 * NREC * 1024 * 2 <= WS_WROUT && WS_WGU + (size_t)128 * 2048 * 1024 * 2 <= WS_WD && WS_WD + (size_t)128 * 1024 * 1024 * 2 <= WS_X, "weights");
constexpr int CW_BAR = 4096;
constexpr int CW_CNT = 16384;

constexpr int RING_BYTES = 131072;
constexpr int MISC_OFF = RING_BYTES;
constexpr int LDS_BYTES = 147456;

__device__ __forceinline__ float bf2f(unsigned b) { return __uint_as_float(b << 16); }
typedef _Float16 f16x4 __attribute__((ext_vector_type(4)));
__device__ __forceinline__ f32x4 h4_to_f4(u32x2 q) { return __builtin_convertvector(__builtin_bit_cast(f16x4, q), f32x4); }
__device__ __forceinline__ u32x2 f4_to_h4(f32x4 v) { f32x4 c; c[0] = __builtin_amdgcn_fmed3f(v[0], -65504.f, 65504.f); c[1] = __builtin_amdgcn_fmed3f(v[1], -65504.f, 65504.f); c[2] = __builtin_amdgcn_fmed3f(v[2], -65504.f, 65504.f); c[3] = __builtin_amdgcn_fmed3f(v[3], -65504.f, 65504.f);
    return __builtin_bit_cast(u32x2, __builtin_convertvector(c, f16x4)); }
__device__ __forceinline__ f32x4 ld_bf4(const bf16_t* p) { const u32x2 q = *(const u32x2*)p; return (f32x4){bf2f(q.x & 0xffffu), bf2f(q.x >> 16), bf2f(q.y & 0xffffu), bf2f(q.y >> 16)}; }
__device__ __forceinline__ unsigned f2bf(float f) { unsigned u = __float_as_uint(f); return (u + 0x7fffu + ((u >> 16) & 1u)) >> 16; }
__device__ __forceinline__ unsigned pk2(float lo, float hi) { unsigned r; asm("v_cvt_pk_bf16_f32 %0, %1, %2" : "=v"(r) : "v"(lo), "v"(hi)); return r; }
__device__ __forceinline__ float shx(float v, int o, int lane) { return __int_as_float(__builtin_amdgcn_ds_bpermute((lane ^ o) << 2, __float_as_int(v))); }
__device__ __forceinline__ int shxi(int v, int o, int lane) { return __builtin_amdgcn_ds_bpermute((lane ^ o) << 2, v); }
__device__ __forceinline__ float wave_sum(float v, int) {
    v += __int_as_float(__builtin_amdgcn_update_dpp(0, __float_as_int(v), 0xB1, 0xF, 0xF, true));
    v += __int_as_float(__builtin_amdgcn_update_dpp(0, __float_as_int(v), 0x4E, 0xF, 0xF, true));
    v += __int_as_float(__builtin_amdgcn_update_dpp(0, __float_as_int(v), 0x141, 0xF, 0xF, true));
    v += __int_as_float(__builtin_amdgcn_update_dpp(0, __float_as_int(v), 0x140, 0xF, 0xF, true));
    const float r0 = __int_as_float(__builtin_amdgcn_readlane(__float_as_int(v), 0)), r1 = __int_as_float(__builtin_amdgcn_readlane(__float_as_int(v), 16));
    const float r2 = __int_as_float(__builtin_amdgcn_readlane(__float_as_int(v), 32)), r3 = __int_as_float(__builtin_amdgcn_readlane(__float_as_int(v), 48));
    return (r0 + r1) + (r2 + r3);
}
__device__ __forceinline__ float wave_max(float v, int lane) {
#pragma unroll
    for (int o = 1; o < 64; o <<= 1) v = fmaxf(v, shx(v, o, lane));
    return v;
}
__device__ __forceinline__ int lane_id_volatile() { int l; asm volatile("v_mbcnt_lo_u32_b32 %0, -1, 0\n\tv_mbcnt_hi_u32_b32 %0, -1, %0" : "=v"(l)); return l; }
__device__ __forceinline__ float sigmoidf_(float x) { return __builtin_amdgcn_rcpf(1.0f + __builtin_amdgcn_exp2f(x * -1.4426950408889634f)); }
__device__ __forceinline__ float siluf_(float x) { return x * sigmoidf_(x); }
__device__ __forceinline__ float logsigmoidf_(float x) { return fminf(x, 0.f) - 0.6931471805599453f * __builtin_amdgcn_logf(1.0f + __builtin_amdgcn_exp2f(fabsf(x) * -1.4426950408889634f)); }
__device__ __forceinline__ int row_bidx(int r) { return r < RL ? (r >> 13) : 4; }

#define XB_TMO      128
#define XB_XCNT(j)  (256  + 64 * (j))
#define XB_XSUB(j)  (1280 + 64 * (j))
#define XB_XGEN(j)  (2304 + 64 * (j))
#define XB_TOP      3328
#define XB_TOPGEN   3392
#define XCD_BAR_WORDS 3456
#define XB_SPIN_CAP (1u << 18)
__device__ __forceinline__ unsigned xb_ld(unsigned* p)              { return __hip_atomic_load((GAS unsigned*)p, __ATOMIC_RELAXED, __HIP_MEMORY_SCOPE_AGENT); }
__device__ __forceinline__ unsigned xb_add(unsigned* p, unsigned v) { return __hip_atomic_fetch_add((GAS unsigned*)p, v, __ATOMIC_RELAXED, __HIP_MEMORY_SCOPE_AGENT); }
__device__ __forceinline__ unsigned xb_xcc_id() { return (unsigned)__builtin_amdgcn_s_getreg((3 << 11) | 20) & 0xFu; }
#define XB_SPIN(cond, bar) do { unsigned _sp = 0; while (cond) { __builtin_amdgcn_s_sleep(1); \
    if ((++_sp & 255u) == 0u) { if (xb_ld(&(bar)[XB_TMO])) break; if (_sp > XB_SPIN_CAP) { (void)xb_add(&(bar)[XB_TMO], 1u); break; } } } } while (0)
struct XcdBarrier { unsigned* bar; unsigned x; volatile LAS unsigned* st; int leader; };
__device__ __forceinline__ XcdBarrier xcd_barrier_post(unsigned* bar, volatile LAS unsigned* st) {
    XcdBarrier b; b.bar = bar; b.x = xb_xcc_id(); b.st = st;
    if (threadIdx.x == 0) (void)xb_add(&bar[XB_XCNT(b.x)], 1u);
    return b;
}
__device__ __forceinline__ void xcd_barrier_complete(unsigned* bar, unsigned x, unsigned& nloc, unsigned& nx) {
    const unsigned G = gridDim.x * gridDim.y * gridDim.z;
    unsigned sum, cnt, mine, sp = 0u;
    for (;;) {
        sum = 0u; cnt = 0u; mine = 0u;
#pragma unroll
        for (unsigned j = 0; j < 16; ++j) { const unsigned c = xb_ld(&bar[XB_XCNT(j)]); sum += c; cnt += (c > 0u) ? 1u : 0u; mine = (j == x) ? c : mine; }
        if (sum == G) break;
        __builtin_amdgcn_s_sleep(1);
        if ((++sp & 255u) == 0u) { if (xb_ld(&bar[XB_TMO])) break; if (sp > XB_SPIN_CAP) { (void)xb_add(&bar[XB_TMO], 1u); break; } }
    }
    nloc = mine > 0u ? mine : 1u; nx = cnt > 0u ? cnt : 1u;
}
__device__ __noinline__ void xcd_barrier(const XcdBarrier b) {
    asm volatile("s_waitcnt vmcnt(0)" ::: "memory");
    __syncthreads();
    if (b.leader) {
        unsigned* bar = b.bar;
        __builtin_amdgcn_s_waitcnt(0);
        unsigned nloc = b.st[0], nx = b.st[1];
        if (nloc == 0u) { xcd_barrier_complete(bar, b.x, nloc, nx); b.st[0] = nloc; b.st[1] = nx; }
        const unsigned old = xb_add(&bar[XB_XSUB(b.x)], 1u);
        const unsigned gen = old / nloc;
        if (old + 1u == (gen + 1u) * nloc) {
            __builtin_amdgcn_fence(__ATOMIC_RELEASE, "agent");
            asm volatile("s_waitcnt vmcnt(0)" ::: "memory");
            const unsigned og = xb_add(&bar[XB_TOP], 1u);
            const unsigned tg = og / nx;
            if (og + 1u == (tg + 1u) * nx) xb_add(&bar[XB_TOPGEN], 1u);
            else XB_SPIN(xb_ld(&bar[XB_TOPGEN]) == tg, bar);
            __builtin_amdgcn_fence(__ATOMIC_ACQUIRE, "agent");
            xb_add(&bar[XB_XGEN(b.x)], 1u);
            asm volatile("s_waitcnt vmcnt(0)" ::: "memory");
        } else {
            XB_SPIN(xb_ld(&bar[XB_XGEN(b.x)]) == gen, bar);
            __builtin_amdgcn_fence(__ATOMIC_ACQUIRE, "agent");
            asm volatile("s_waitcnt vmcnt(0)" ::: "memory");
        }
    }
    __syncthreads();
}

namespace pg8 {
constexpr int BM = 256, BK = 64, HALF = 128, HTB = HALF * BK * 2, STAGE_BYTES = 8 * HTB, NXCD = 8, WGM = 8;
__host__ __device__ __forceinline__ int lds_byte(int r, int c) { const int st = (r >> 4) * 2 + (c >> 5), rr = r & 15, cc = c & 31, ob = rr * 64 + cc * 2; return st * 1024 + (ob ^ (((ob >> 9) & 1) << 5)); }
__host__ __device__ __forceinline__ void stage_rc(int b, int& R, int& C) { const int st = b / 1024, sb = b % 1024, swz = sb ^ (((sb >> 9) & 1) << 5); R = (st >> 1) * 16 + swz / 64; C = (st & 1) * 32 + (swz % 64) / 2; }
__host__ __device__ __forceinline__ int perm32(int rho) { const int n = rho >> 4, i = rho & 15; return 8 * (i >> 2) + 4 * n + (i & 3); }
struct Unit { int pm, pn, e, mt; };
struct StaticOrder {
    int nM, nN, nwg, G, c;
    __device__ void init(int M, int N, int G_, int c_) { nM = M / BM; nN = N / BM; nwg = nM * nN; G = G_; c = c_; }
    __device__ bool next(int i, Unit& u) const {
        const long L = (long)i * G + c; if (L >= nwg) return false;
        int wgid = (int)L; { const int q = nwg / NXCD, r = nwg % NXCD, xcd = wgid % NXCD, off = wgid / NXCD; wgid = (xcd < r ? xcd * (q + 1) : r * (q + 1) + (xcd - r) * q) + off; }
        const int nig = WGM * nN, gid = wgid / nig, fm = gid * WGM, gsz = (nM - fm) < WGM ? (nM - fm) : WGM;
        u.pm = fm + ((wgid % nig) % gsz); u.pn = (wgid % nig) / gsz; u.e = 0; u.mt = 0; return true;
    }
};
struct MoeOrder {
    const LAS int* tb; int T, lg, G, c;
    __device__ bool next(int i, Unit& u) const {
        int tile, pn; const int npn = 1 << lg;
        if (G == 256) { const int x = c & 7, j = c >> 3, tpx = 32 >> lg; tile = (i * 8 + x) * tpx + (j >> lg); pn = j & (npn - 1); }
        else { const long L = (long)i * G + c; tile = (int)(L >> lg); pn = (int)(L & (npn - 1)); }
        if (tile >= T) return false;
        int ln_; asm volatile("v_mbcnt_lo_u32_b32 %0, -1, 0\n\tv_mbcnt_hi_u32_b32 %0, -1, %0" : "=v"(ln_));
        const int e = (int)__builtin_popcountll(__ballot(ln_ < 31 && tb[(ln_ < 31 ? ln_ : 31) + 1] <= tile));
        u.e = e; u.mt = tile - tb[e]; u.pm = tile; u.pn = pn; return true;
    }
};
struct RowIdentity { static constexpr bool GATHER = false; __device__ __forceinline__ int row(const Unit& u, int r) const { return r; } };
struct RowGather { static constexpr bool GATHER = true; const int* list; const LAS int* cnt; __device__ __forceinline__ int row(const Unit& u, int r) const { const int p = u.mt * BM + r; return p < cnt[u.e] ? list[(size_t)u.e * CAP + p] : 0; } };

__device__ __forceinline__ unsigned cvt_pk_bf16(float lo, float hi) { unsigned r; asm volatile("v_cvt_pk_bf16_f32 %0, %1, %2" : "=v"(r) : "v"(lo), "v"(hi)); return r; }

template <class Epi, class Sched, class AOff>
__device__ __forceinline__ void gemm_phase(LAS unsigned char* lds, const bf16_t* A, const bf16_t* Bt, const int K, const size_t estride  , const Sched& S, const Epi& E, const AOff& AO, const int tid) {
    const int wid = __builtin_amdgcn_readfirstlane(tid >> 6), lane = tid & 63, wr = wid >> 2, wc = wid & 3, fr = lane & 15, fq = lane >> 4;
    const int nt = K / BK;
    int Rr[2], Cc[2]; unsigned voffB[2];
#pragma unroll
    for (int i = 0; i < 2; ++i) { int R, C; stage_rc(tid * 16 + i * 8192, R, C); const int Rb = Epi::PERM ? ((R & ~31) + perm32(R & 31)) : R;
        Rr[i] = R; Cc[i] = C; voffB[i] = (unsigned)(Rb * K + C) * 2u; }
    const size_t kstep = (size_t)(BK * 2);
    const size_t hstep = (size_t)HALF * K * 2;
    const size_t tstep = 2 * hstep;
    const unsigned ldsw = (unsigned)wid * 1024u;
    const int aoff = lds_byte(wr * 64 + fr, fq * 8), boff = lds_byte(wc * 32 + fr, fq * 8);
#define PG8_SA(b, h) (((b) * 2 + (h)) * HTB)
#define PG8_SB(b, h) ((4 + (b) * 2 + (h)) * HTB)
#define PG8_STAGE(bufoff, gbase, voff) do { _Pragma("unroll") for (int _i = 0; _i < 2; ++_i) \
        __builtin_amdgcn_global_load_lds((const unsigned*)((const char*)(gbase) + (voff)[_i]), (LAS unsigned*)(lds + (bufoff) + ldsw + _i * 8192), 16, 0, 0); } while (0)
#define PG8_STAGE2(bufoff, gbase, v0, v1) do { \
        __builtin_amdgcn_global_load_lds((const unsigned*)((const char*)(gbase) + (v0)), (LAS unsigned*)(lds + (bufoff) + ldsw), 16, 0, 0); \
        __builtin_amdgcn_global_load_lds((const unsigned*)((const char*)(gbase) + (v1)), (LAS unsigned*)(lds + (bufoff) + ldsw + 8192), 16, 0, 0); } while (0)
#define PG8_LDA(dst, b, h) do { _Pragma("unroll") for (int m = 0; m < 4; ++m) _Pragma("unroll") for (int k = 0; k < 2; ++k) dst[m][k] = *(const LAS bf16x8*)(lds + PG8_SA(b, h) + aoff + m * 2048 + k * 1024); } while (0)
#define PG8_LDB(dst, b, h) do { _Pragma("unroll") for (int n = 0; n < 2; ++n) _Pragma("unroll") for (int k = 0; k < 2; ++k) dst[n][k] = *(const LAS bf16x8*)(lds + PG8_SB(b, h) + boff + n * 2048 + k * 1024); } while (0)
#define PG8_MMA(ai, bj, At, Bt_) do { __builtin_amdgcn_s_setprio(1); _Pragma("unroll") for (int m = 0; m < 4; ++m) _Pragma("unroll") for (int n = 0; n < 2; ++n) _Pragma("unroll") for (int k = 0; k < 2; ++k) \
        acc[ai][bj][m][n] = __builtin_amdgcn_mfma_f32_16x16x32_bf16(Bt_[n][k], At[m][k], acc[ai][bj][m][n], 0, 0, 0); __builtin_amdgcn_s_setprio(0); } while (0)
#define PG8_WAIT_V(n) asm volatile("s_waitcnt vmcnt(" #n ")" ::: "memory")
#define PG8_WAIT_L(n) asm volatile("s_waitcnt lgkmcnt(" #n ")" ::: "memory")
#define PG8_BAR __builtin_amdgcn_s_barrier()
#define PG8_SCHED __builtin_amdgcn_sched_barrier(0)
#define PG8_AOFFS(dst, u) do { _Pragma("unroll") for (int _h = 0; _h < 2; ++_h) _Pragma("unroll") for (int _i = 0; _i < 2; ++_i) \
        dst[_h][_i] = ((unsigned)AO.row(u, _h * HALF + Rr[_i]) * (unsigned)K + (unsigned)Cc[_i]) * 2u; } while (0)
    Unit cur, nxt; int ui = 0;
    if (!S.next(0, cur)) return;
    f32x4 acc[2][2][4][2];
#pragma unroll
    for (int a = 0; a < 2; ++a)
#pragma unroll
        for (int b = 0; b < 2; ++b)
#pragma unroll
            for (int m = 0; m < 4; ++m)
#pragma unroll
                for (int n = 0; n < 2; ++n) acc[a][b][m][n] = (f32x4){0.f, 0.f, 0.f, 0.f};
    bf16x8 At[4][2], B0[2][2], B1[2][2];
    unsigned vc[2][2], vn[2][2];
    PG8_AOFFS(vc, cur);
    const char* Ab = (const char*)A;
    const char* aC = AOff::GATHER ? Ab : Ab + (size_t)cur.pm * tstep;
    const char* cB = (const char*)Bt + (size_t)cur.e * estride + (size_t)cur.pn * tstep;
    PG8_STAGE(PG8_SB(0, 0), cB, voffB); PG8_STAGE2(PG8_SA(0, 0), aC, vc[0][0], vc[0][1]); PG8_STAGE(PG8_SB(0, 1), cB + hstep, voffB); PG8_STAGE2(PG8_SA(0, 1), aC, vc[1][0], vc[1][1]);
    if (wr == 1) PG8_BAR;
    PG8_WAIT_V(4); PG8_BAR;
    PG8_STAGE(PG8_SB(1, 0), cB + kstep, voffB); PG8_STAGE2(PG8_SA(1, 0), aC + kstep, vc[0][0], vc[0][1]); PG8_STAGE(PG8_SB(1, 1), cB + hstep + kstep, voffB);
    PG8_WAIT_V(6); PG8_BAR;
    for (;;) {
        const bool has_next = S.next(ui + 1, nxt);
        if (AOff::GATHER && has_next) { PG8_AOFFS(vn, nxt); }
        else {
#pragma unroll
            for (int _h = 0; _h < 2; ++_h)
#pragma unroll
                for (int _i = 0; _i < 2; ++_i) vn[_h][_i] = vc[_h][_i];
        }
        const char* nB = has_next ? (const char*)Bt + (size_t)nxt.e * estride + (size_t)nxt.pn * tstep : cB;
        const char* aN = (AOff::GATHER || !has_next) ? aC : Ab + (size_t)nxt.pm * tstep;
        for (int t = 0; t < nt; t += 2) {
            const bool last = (t == nt - 2);
            const char* a1 = aC + (size_t)(t + 1) * kstep;
            const char* a2 = last ? aN : aC + (size_t)(t + 2) * kstep; const char* b2 = last ? nB : cB + (size_t)(t + 2) * kstep;
            const char* a3 = a2 + kstep; const char* b3 = b2 + kstep;
            const unsigned x00 = last ? vn[0][0] : vc[0][0], x01 = last ? vn[0][1] : vc[0][1], x10 = last ? vn[1][0] : vc[1][0], x11 = last ? vn[1][1] : vc[1][1];
            PG8_LDB(B0, 0, 0); PG8_SCHED; PG8_LDA(At, 0, 0); PG8_STAGE2(PG8_SA(1, 1), a1, vc[1][0], vc[1][1]);
            PG8_WAIT_L(8); PG8_BAR; PG8_WAIT_L(0); PG8_MMA(0, 0, At, B0); PG8_BAR; PG8_SCHED;
            PG8_LDB(B1, 0, 1); PG8_STAGE(PG8_SB(0, 0), b2, voffB);
            PG8_BAR; PG8_WAIT_L(0); PG8_MMA(0, 1, At, B1); PG8_BAR;
            PG8_LDA(At, 0, 1); PG8_STAGE2(PG8_SA(0, 0), a2, x00, x01);
            PG8_BAR; PG8_WAIT_L(0); PG8_MMA(1, 0, At, B0); PG8_BAR; PG8_SCHED;
            PG8_STAGE(PG8_SB(0, 1), b2 + hstep, voffB);
            PG8_WAIT_V(6); PG8_BAR; PG8_MMA(1, 1, At, B1); PG8_BAR;
            PG8_LDB(B0, 1, 0); PG8_SCHED; PG8_LDA(At, 1, 0); PG8_STAGE2(PG8_SA(0, 1), a2, x10, x11);
            PG8_WAIT_L(8); PG8_BAR; PG8_WAIT_L(0); PG8_MMA(0, 0, At, B0); PG8_BAR; PG8_SCHED;
            PG8_LDB(B1, 1, 1); PG8_STAGE(PG8_SB(1, 0), b3, voffB);
            PG8_BAR; PG8_WAIT_L(0); PG8_MMA(0, 1, At, B1); PG8_BAR;
            PG8_LDA(At, 1, 1); PG8_STAGE2(PG8_SA(1, 0), a3, x00, x01);
            PG8_BAR; PG8_WAIT_L(0); PG8_MMA(1, 0, At, B0); PG8_BAR; PG8_SCHED;
            PG8_STAGE(PG8_SB(1, 1), b3 + hstep, voffB);
            PG8_WAIT_V(6); PG8_BAR; PG8_MMA(1, 1, At, B1); PG8_BAR;
        }
        E(acc, cur, wr, wc, fr, fq);
        if (!has_next) break;
#pragma unroll
        for (int a = 0; a < 2; ++a)
#pragma unroll
            for (int b = 0; b < 2; ++b)
#pragma unroll
                for (int m = 0; m < 4; ++m)
#pragma unroll
                    for (int n = 0; n < 2; ++n) acc[a][b][m][n] = (f32x4){0.f, 0.f, 0.f, 0.f};
        cur = nxt; cB = nB; aC = aN; ++ui;
#pragma unroll
        for (int _h = 0; _h < 2; ++_h)
#pragma unroll
            for (int _i = 0; _i < 2; ++_i) vc[_h][_i] = vn[_h][_i];
    }
    PG8_WAIT_V(0);
    if (wr == 0) PG8_BAR;
    PG8_BAR;
#undef PG8_SA
#undef PG8_SB
#undef PG8_STAGE
#undef PG8_STAGE2
#undef PG8_LDA
#undef PG8_LDB
#undef PG8_MMA
#undef PG8_WAIT_V
#undef PG8_WAIT_L
#undef PG8_BAR
#undef PG8_SCHED
#undef PG8_AOFFS
}
}

struct Args { const float* in[25]; float* out; unsigned char* ws; int ph_lo, ph_hi; };
struct Frame {
    LAS unsigned char* lds; int tid, lane, wave, G, bid;
    float* out; unsigned char* ws; unsigned* ctl;
};
__device__ __forceinline__ const float* inp_ptr(const Frame& F, int k) {
    const LAS unsigned* t = (const LAS unsigned*)(F.lds + MISC_OFF + 256) + 2 * k;
    const unsigned lo = __builtin_amdgcn_readfirstlane(t[0]), hi = __builtin_amdgcn_readfirstlane(t[1]);
    return (const float*)(const GAS float*)(((unsigned long long)hi << 32) | lo);
}
#define INP(k) inp_ptr(F, (k))
__device__ __forceinline__ Frame fresh(const Frame& F) {
    Frame P = F;
    int z = 0;
    asm volatile("" : "+s"(z), "+s"(P.G), "+s"(P.bid), "+s"(P.wave));
    P.lane = lane_id_volatile() & 63; P.tid = (P.wave << 6) | P.lane;
    P.ws = F.ws + z; P.out = F.out + z;
    P.wave &= 7; P.ctl = (unsigned*)(P.ws + WS_CTL);
    return P;
}
__device__ __forceinline__ int fresh_i(int v) { asm volatile("" : "+s"(v)); return v; }
#define WSP(T, off) ((T*)(F.ws + (off)))

template <class T> __device__ __forceinline__ T* opaque(T* p) { int z = 0; asm volatile("" : "+s"(z)); return p + z; }
__device__ __forceinline__ u32x4 pack8(const f32x4 a, const f32x4 b) { u32x4 w; w.x = pk2(a[0], a[1]); w.y = pk2(a[2], a[3]); w.z = pk2(b[0], b[1]); w.w = pk2(b[2], b[3]); return w; }
__device__ __forceinline__ f32x4 sigm4(const f32x4 a) { const f32x4 z = a * -1.4426950408889634f; f32x4 e, r;
#pragma unroll
    for (int j = 0; j < 4; ++j) e[j] = __builtin_amdgcn_exp2f(z[j]);
    const f32x4 d = e + 1.0f;
#pragma unroll
    for (int j = 0; j < 4; ++j) r[j] = __builtin_amdgcn_rcpf(d[j]);
    return r; }
__device__ __forceinline__ f32x4 silu4(const f32x4 a) { return a * sigm4(a); }
__device__ __forceinline__ f32x4 lsig4(const f32x4 a) { return (f32x4){logsigmoidf_(a[0]), logsigmoidf_(a[1]), logsigmoidf_(a[2]), logsigmoidf_(a[3])}; }
__device__ __forceinline__ void fgate4(const f32x4 x, const f32x4 lbv, f32x4& kk, f32x4& la) {
    const f32x4 z = x * -1.4426950408889634f; f32x4 e, sg, lg;
#pragma unroll
    for (int j = 0; j < 4; ++j) e[j] = __builtin_amdgcn_exp2f(fminf(z[j], 125.0f));
    const f32x4 d = e + 1.0f;
#pragma unroll
    for (int j = 0; j < 4; ++j) sg[j] = __builtin_amdgcn_rcpf(d[j]);
    const f32x4 om = 1.0f - lbv;
    const f32x4 f = lbv + om * sg;
    kk = om * (1.0f - sg);
#pragma unroll
    for (int j = 0; j < 4; ++j) lg[j] = __builtin_amdgcn_logf(f[j]);
    la = lg * 0.6931471805599453f;
}
template <int KIND>
__device__ __forceinline__ void rec_group(unsigned char* ws, const float* bias, const float* lb, f32x4 v0, f32x4 v1, int row, int gc, int sc, int ct, int wc, int fq, int fr, bool latent) {
    const bool gate_lane = (KIND != 9) || (ct < 16);
    const int gcs = gate_lane ? gc : 0;
    v0 += *(const f32x4*)((const char*)bias + (unsigned)(gcs * 4)); v1 += *(const f32x4*)((const char*)bias + (unsigned)(gcs * 4 + 16));
    if (KIND == 0) {
        *(u32x4*)(ws + WS_Q + (unsigned)(row * 1024 + sc * 2)) = pack8(silu4(v0) * 0.08838834764831845f, silu4(v1) * 0.08838834764831845f);
    } else if (KIND == 1 || KIND == 2) {
        f32x4 k0, k1, l0, l1;
        fgate4(v0, *(const f32x4*)((const char*)lb + (unsigned)(sc * 4)), k0, l0); fgate4(v1, *(const f32x4*)((const char*)lb + (unsigned)(sc * 4 + 16)), k1, l1);
        *(u32x4*)(ws + (KIND == 1 ? WS_KF : WS_KB) + (unsigned)(row * 1024 + sc * 2)) = pack8(k0, k1);
        float* lp = (float*)(ws + (KIND == 1 ? WS_LAF : WS_LAB) + (unsigned)(row * 2048 + sc * 4));
        *(f32x4*)lp = l0; *(f32x4*)(lp + 4) = l1;
    } else if (KIND == 3 || KIND == 4 || KIND == 7 || KIND == 8) {
        if (KIND == 4) { v0 = silu4(v0); v1 = silu4(v1); }
        if (KIND == 8) { v0 = sigm4(v0); v1 = sigm4(v1); }
        const size_t off = KIND == 3 ? WS_V : KIND == 4 ? WS_HG : KIND == 7 ? WS_MV : WS_MO;
        *(u32x4*)(ws + off + (unsigned)(row * 1024 + sc * 2)) = pack8(v0, v1);
    } else if (KIND == 5 || KIND == 6) {
        if (KIND == 6) { v0 *= 0.125f; v1 *= 0.125f; }
        f32x4 p0, p1;
#pragma unroll
        for (int j = 0; j < 4; ++j) { p0[j] = shx(v0[j], 32, fq * 16 + fr); p1[j] = shx(v1[j], 32, fq * 16 + fr); }
        if (latent) {
            const int t = row & 8191; const int pos = (wc & 1) ? (t & 63) : (t >> 6);
            const f32x4* rp = (const f32x4*)((const f32x2*)(ws + WS_ROPE) + pos * 16 + 8 * (fq & 1));
            const f32x4 c01 = rp[0], c23 = rp[1], c45 = rp[2], c67 = rp[3];
            const f32x4 cs0 = (f32x4){c01[0], c01[2], c23[0], c23[2]}, sn0 = (f32x4){c01[1], c01[3], c23[1], c23[3]};
            const f32x4 cs1 = (f32x4){c45[0], c45[2], c67[0], c67[2]}, sn1 = (f32x4){c45[1], c45[3], c67[1], c67[3]};
            const float sg = (fq >= 2) ? 1.0f : -1.0f;
            v0 = v0 * cs0 + sg * (p0 * sn0); v1 = v1 * cs1 + sg * (p1 * sn1);
        }
        *(u32x4*)(ws + (KIND == 5 ? WS_MQ : WS_MK) + (unsigned)(row * 512 + sc * 2)) = pack8(v0, v1);
    } else {
        if (gate_lane) { float* gp = (float*)(ws + WS_GATES + (unsigned)(row * 64 + ct * 4)); *(f32x4*)gp = v0; *(f32x4*)(gp + 4) = lsig4(v1); }
    }
}
struct EpiRec {
    static constexpr bool PERM = true;
    unsigned char* ws; const float* bias; const float* lb; int layer;
    template <int KIND>
    __device__ __forceinline__ void run(const f32x4 (&acc)[2][2][4][2], const pg8::Unit& u, int wr, int wc, int fr, int fq, int cbase  ) const {
        const int row0 = u.pm * 256 + wr * 64 + fr;
        const bool latent = u.pm < 128;
#define REC_G(ai, m) { const int row = row0 + (ai) * 128 + (m) * 16; \
        { const int ct = wc * 32 + 8 * fq; rec_group<KIND>(ws, bias, lb, acc[ai][0][m][0], acc[ai][0][m][1], row, u.pn * 256 + ct, cbase + ct, ct, wc, fq, fr, latent); } \
        if (KIND != 9) { const int ct = 128 + wc * 32 + 8 * fq; rec_group<KIND>(ws, bias, lb, acc[ai][1][m][0], acc[ai][1][m][1], row, u.pn * 256 + ct, cbase + ct, ct, wc, fq, fr, latent); } if ((m) == 3) asm volatile("" ::: "memory"); }
        REC_G(0, 0) REC_G(0, 1) REC_G(0, 2) REC_G(0, 3) REC_G(1, 0) REC_G(1, 1) REC_G(1, 2) REC_G(1, 3)
#undef REC_G
    }
    __device__ __forceinline__ void operator()(const f32x4 (&acc)[2][2][4][2], const pg8::Unit& u, int wr, int wc, int fr, int fq) const {
        const int pn = u.pn;
        EpiRec o{opaque(ws), opaque(bias), opaque(lb), layer};
        asm volatile("" : "+v"(fr), "+v"(fq));
        o.dispatch(acc, u, wr, wc, fr, fq, pn);
    }
    __device__ __forceinline__ void dispatch(const f32x4 (&acc)[2][2][4][2], const pg8::Unit& u, int wr, int wc, int fr, int fq, int pn) const {
        if (pn < 2) run<0>(acc, u, wr, wc, fr, fq, pn * 256);
        else if (pn < 4) run<1>(acc, u, wr, wc, fr, fq, (pn - 2) * 256);
        else if (pn < 6) run<2>(acc, u, wr, wc, fr, fq, (pn - 4) * 256);
        else if (pn < 8) run<3>(acc, u, wr, wc, fr, fq, (pn - 6) * 256);
        else if (pn < 10) run<4>(acc, u, wr, wc, fr, fq, (pn - 8) * 256);
        else if (pn == 10) run<5>(acc, u, wr, wc, fr, fq, 0);
        else if (pn == 11) run<6>(acc, u, wr, wc, fr, fq, 0);
        else if (pn < 14) run<7>(acc, u, wr, wc, fr, fq, (pn - 12) * 256);
        else if (pn < 16) run<8>(acc, u, wr, wc, fr, fq, (pn - 14) * 256);
        else run<9>(acc, u, wr, wc, fr, fq, 0);
    }
};
struct EpiQKV {
    static constexpr bool PERM = true;
    unsigned char* ws;
    __device__ __forceinline__ void operator()(const f32x4 (&acc)[2][2][4][2], const pg8::Unit& u, int wr, int wc, int fr, int fq) const {
        const int row0 = u.pm * 256 + wr * 64 + fr;
        unsigned char* w_ = opaque(ws);
        asm volatile("" : "+v"(fr), "+v"(fq));
        if (u.pn < 8) {
            const int col0 = u.pn * 256 + wc * 32 + 8 * fq;
#pragma unroll
            for (int ai = 0; ai < 2; ++ai)
#pragma unroll
                for (int m = 0; m < 4; ++m) { const int row = row0 + ai * 128 + m * 16; const unsigned ob = (unsigned)(row * 3072 + col0) * 2u;
#pragma unroll
                    for (int bj = 0; bj < 2; ++bj) { const f32x4 v0 = acc[ai][bj][m][0], v1 = acc[ai][bj][m][1];
                        *(u32x4*)(w_ + WS_QKV + (ob + bj * 256u)) = pack8(v0, v1);
                        if (u.pn >= 4) {
                            float ss = (v0[0] * v0[0] + v0[1] * v0[1]) + (v0[2] * v0[2] + v0[3] * v0[3]) + (v1[0] * v1[0] + v1[1] * v1[1]) + (v1[2] * v1[2] + v1[3] * v1[3]);
                            const int lane = fq * 16 + fr; ss += shx(ss, 16, lane); ss += shx(ss, 32, lane);
                            if (fq == 0) atomicAdd((float*)(w_ + WS_SSK) + row * 16 + (((u.pn - 4) * 256 + bj * 128 + wc * 32) >> 6), ss); } } }
        } else {
            const int b = u.pm < 128 ? (u.pm >> 5) : (u.pm - 128); const int tt0 = u.pm < 128 ? ((u.pm & 31) * 256) : TL;
#pragma unroll
            for (int ai = 0; ai < 2; ++ai)
#pragma unroll
                for (int m = 0; m < 4; ++m) { const int tt = tt0 + wr * 64 + fr + ai * 128 + m * 16;
#pragma unroll
                    for (int bj = 0; bj < 2; ++bj) { const int c = (u.pn - 8) * 256 + bj * 128 + wc * 32 + 8 * fq;
                        const unsigned base = (unsigned)(((b * 16 + (c >> 6)) * 64 + (c & 63)) * TT + tt) * 2u;
                        const u32x4 pk = pack8(acc[ai][bj][m][0], acc[ai][bj][m][1]); const unsigned pw[4] = {pk.x, pk.y, pk.z, pk.w};
#pragma unroll
                        for (int q = 0; q < 8; ++q) *(bf16_t*)(w_ + WS_VTG + (base + (unsigned)q * (TT * 2u))) = (bf16_t)((q & 1) ? (pw[q >> 1] >> 16) : (pw[q >> 1] & 0xffffu)); } }
        }
    }
};
struct EpiResid {
    static constexpr bool PERM = true;
    bf16_t* Y; const float* modl;
    __device__ __forceinline__ void operator()(const f32x4 (&acc)[2][2][4][2], const pg8::Unit& u, int wr, int wc, int fr, int fq) const {
        const int row0 = u.pm * 256 + wr * 64 + fr, col0 = u.pn * 256 + wc * 32 + 8 * fq;
        const int bidx = u.pm < 128 ? (u.pm >> 5) : 4;
        bf16_t* Y = opaque(this->Y);
        const float* g = opaque(modl) + bidx * 6144 + 2048 + col0;
        f32x4 gv[2][2];
#pragma unroll
        for (int bj = 0; bj < 2; ++bj) { gv[bj][0] = *(const f32x4*)(g + bj * 128); gv[bj][1] = *(const f32x4*)(g + bj * 128 + 4); }
#pragma unroll
        for (int ai = 0; ai < 2; ++ai)
#pragma unroll
            for (int m = 0; m < 4; ++m) { const unsigned ob = (unsigned)((row0 + ai * 128 + m * 16) * 1024 + col0) * 2u;
#pragma unroll
                for (int bj = 0; bj < 2; ++bj) *(u32x4*)((char*)Y + (ob + bj * 256u)) = pack8(acc[ai][bj][m][0] * gv[bj][0], acc[ai][bj][m][1] * gv[bj][1]); }
    }
};
__device__ __forceinline__ f32x4 swiglu4(const f32x4 g, const f32x4 u) {
    f32x4 gt, up, e, r;
#pragma unroll
    for (int j = 0; j < 4; ++j) { gt[j] = fminf(g[j], 7.0f); up[j] = __builtin_amdgcn_fmed3f(u[j], -7.0f, 7.0f); }
    const f32x4 z = gt * -2.4554669595930157f;
#pragma unroll
    for (int j = 0; j < 4; ++j) e[j] = __builtin_amdgcn_exp2f(z[j]);
    const f32x4 d = e + 1.0f;
#pragma unroll
    for (int j = 0; j < 4; ++j) r[j] = __builtin_amdgcn_rcpf(d[j]);
    return (gt * r) * (up + 1.0f);
}
struct EpiMoe1 {
    static constexpr bool PERM = true;
    bf16_t* ACT; const float* bgu;
    __device__ __forceinline__ void operator()(const f32x4 (&acc)[2][2][4][2], const pg8::Unit& u, int wr, int wc, int fr, int fq) const {
        const int row0 = u.pm * 256 + wr * 64 + fr, c0 = u.pn * 128 + wc * 32 + 8 * fq;
        bf16_t* ACT = opaque(this->ACT);
        const float* bg = opaque(bgu) + (size_t)u.e * 2048 + c0; const float* bu = bg + 1024;
        const f32x4 g0 = *(const f32x4*)bg, g1 = *(const f32x4*)(bg + 4), u0 = *(const f32x4*)bu, u1 = *(const f32x4*)(bu + 4);
#pragma unroll
        for (int ai = 0; ai < 2; ++ai)
#pragma unroll
            for (int m = 0; m < 4; ++m) {
                const f32x4 ga = acc[ai][0][m][0] + g0, gb = acc[ai][0][m][1] + g1, ua = acc[ai][1][m][0] + u0, ub = acc[ai][1][m][1] + u1;
                const f32x4 ra = swiglu4(ga, ua), rb = swiglu4(gb, ub);
                const float r[8] = {ra[0], ra[1], ra[2], ra[3], rb[0], rb[1], rb[2], rb[3]};
                u32x4 w; w.x = pk2(r[0], r[1]); w.y = pk2(r[2], r[3]); w.z = pk2(r[4], r[5]); w.w = pk2(r[6], r[7]);
                *(u32x4*)((char*)ACT + (unsigned)((row0 + ai * 128 + m * 16) * 1024 + c0) * 2u) = w;
            }
    }
};
struct EpiMoe2 {
    static constexpr bool PERM = true;
    bf16_t* YS; const float* bd;
    __device__ __forceinline__ void operator()(const f32x4 (&acc)[2][2][4][2], const pg8::Unit& u, int wr, int wc, int fr, int fq) const {
        const int row0 = u.pm * 256 + wr * 64 + fr, col0 = u.pn * 256 + wc * 32 + 8 * fq;
        bf16_t* YS = opaque(this->YS);
        const float* b = opaque(bd) + (size_t)u.e * 1024 + col0;
        f32x4 bv[2][2];
#pragma unroll
        for (int bj = 0; bj < 2; ++bj) { bv[bj][0] = *(const f32x4*)(b + bj * 128); bv[bj][1] = *(const f32x4*)(b + bj * 128 + 4); }
#pragma unroll
        for (int ai = 0; ai < 2; ++ai)
#pragma unroll
            for (int m = 0; m < 4; ++m) { const unsigned ob = (unsigned)((row0 + ai * 128 + m * 16) * 1024 + col0) * 2u;
#pragma unroll
                for (int bj = 0; bj < 2; ++bj) *(u32x4*)((char*)YS + (ob + bj * 256u)) = pack8(acc[ai][bj][m][0] + bv[bj][0], acc[ai][bj][m][1] + bv[bj][1]); }
    }
};

__device__ __forceinline__ void transpose_item(const float* W, int K, int N, bf16_t* WT, int drow0, LAS float* scr, int k0, int n0, int lane) {
    const int n = n0 + (lane & 31); const bool ok = n < N;
#pragma unroll 8
    for (int i = 0; i < 32; ++i) { const int kk = 2 * i + (lane >> 5); scr[kk * 33 + (lane & 31)] = ok ? __builtin_nontemporal_load(W + (size_t)(k0 + kk) * N + n) : 0.f; }
    asm volatile("s_waitcnt lgkmcnt(0)" ::: "memory");
    const int c = lane & 7;
#pragma unroll
    for (int j = 0; j < 4; ++j) { const int nn = (lane >> 3) + 8 * j; const LAS float* s = scr + (8 * c) * 33 + nn;
        u32x4 o; o.x = pk2(s[0 * 33], s[1 * 33]); o.y = pk2(s[2 * 33], s[3 * 33]); o.z = pk2(s[4 * 33], s[5 * 33]); o.w = pk2(s[6 * 33], s[7 * 33]);
        __builtin_nontemporal_store(o, (u32x4*)(WT + (size_t)(drow0 + nn) * K + k0 + 8 * c)); }
    asm volatile("s_waitcnt lgkmcnt(0)" ::: "memory");
}
__device__ __forceinline__ void phase_prologue(Frame& F) {
    {
        LAS float* s = (LAS float*)(F.lds);
        LAS float* part = (LAS float*)(F.lds + 32768);
        bool have_s = false;
        for (int item = F.bid; item < 384; item += F.G) {
            if (!have_s) {
                for (int i = F.tid; i < 5 * 1024; i += 512) { const int b = i >> 10, k = i & 1023; const float c = b < 4 ? INP(1)[b * 1024 + k] : INP(3)[k]; s[i] = siluf_(c); }
                have_s = true;
            }
            __syncthreads();
            const int l = item / 96, n0 = (item % 96) * 64, ci = F.tid & 63, kg = F.tid >> 6;
            const float* w = INP(4) + ((size_t)l * 1024 + kg * 128) * 6144 + n0 + ci;
            float a0 = 0.f, a1 = 0.f, a2 = 0.f, a3 = 0.f, a4 = 0.f;
#pragma unroll 8
            for (int k = 0; k < 128; ++k) { const float wv = w[(size_t)k * 6144]; const int kk = kg * 128 + k;
                a0 += s[kk] * wv; a1 += s[1024 + kk] * wv; a2 += s[2048 + kk] * wv; a3 += s[3072 + kk] * wv; a4 += s[4096 + kk] * wv; }
            part[(kg * 5 + 0) * 64 + ci] = a0; part[(kg * 5 + 1) * 64 + ci] = a1; part[(kg * 5 + 2) * 64 + ci] = a2; part[(kg * 5 + 3) * 64 + ci] = a3; part[(kg * 5 + 4) * 64 + ci] = a4;
            __syncthreads();
            if (F.tid < 320) { const int b = F.tid >> 6, c2 = F.tid & 63; float sum = INP(5)[l * 6144 + n0 + c2];
#pragma unroll
                for (int g = 0; g < 8; ++g) sum += part[(g * 5 + b) * 64 + c2];
                WSP(float, WS_MOD)[(l * 5 + b) * 6144 + n0 + c2] = sum; }
        }
        __syncthreads();
        if (F.bid == (F.G > 1 ? F.G - 1 : 0)) {
            const int c = F.tid; const float* hl = INP(11);
            const float v0 = hl[c], v1 = hl[512 + c], v2 = hl[1024 + c], v3 = hl[1536 + c];
            const float mx = fmaxf(fmaxf(v0, v1), fmaxf(v2, v3));
            const float e0 = expf(v0 - mx), e1 = expf(v1 - mx), e2 = expf(v2 - mx), e3 = expf(v3 - mx); const float inv = 1.0f / (e0 + e1 + e2 + e3);
            float* LB = WSP(float, WS_LB);
            LB[c] = 0.f; LB[512 + c] = fmaxf(e1 * inv, 0.f); LB[1024 + c] = fmaxf((e1 + e2) * inv, 0.f); LB[1536 + c] = fmaxf((e1 + e2 + e3) * inv, 0.f);
        }
        if (F.bid == (F.G > 2 ? F.G - 2 : 0)) {
            for (int i = F.tid; i < 2048; i += 512) { const int pos = i >> 4, q = i & 15; const float inv = powf(10000.0f, -(float)q / 16.0f); const float ang = (float)pos * inv;
                WSP(f32x2, WS_ROPE)[i] = (f32x2){cosf(ang), sinf(ang)}; }
        }
        __syncthreads();
    }
    LAS float* scr = (LAS float*)(F.lds + F.wave * 16384);
    const int gw = F.bid * 8 + F.wave, NGW = F.G * 8;
    constexpr int I_WIN = 16 * 136, I_SQ = 16 * 32, I_QKV = 16 * 96, I_GU = 16 * 64;
    constexpr int N0 = 2 * I_WIN, N1 = N0 + 2 * I_SQ, N2 = N1 + 2 * I_QKV, N3 = N2 + 2 * I_SQ, N4 = N3 + 128 * I_GU, N5 = N4 + 128 * I_SQ;
    for (int it = gw; it < N5; it += NGW) {
        if (it < N0) { const int j = it / I_WIN, r = it % I_WIN, kb = r / 136, nb = r % 136;
            transpose_item(INP(8) + (size_t)j * 1024 * 4112, 1024, 4112, WSP(bf16_t, WS_WIN) + (size_t)j * NREC * 1024, nb * 32, scr, kb * 64, nb * 32, F.lane); }
        else if (it < N1) { const int q = it - N0, j = q / I_SQ, r = q % I_SQ, kb = r / 32, nb = r % 32;
            transpose_item(INP(10) + (size_t)j * 1024 * 1024, 1024, 1024, WSP(bf16_t, WS_WROUT) + (size_t)j * 1024 * 1024, nb * 32, scr, kb * 64, nb * 32, F.lane); }
        else if (it < N2) { const int q = it - N1, j = q / I_QKV, r = q % I_QKV, kb = r / 96, nb = r % 96;
            transpose_item(INP(14) + (size_t)j * 1024 * 3072, 1024, 3072, WSP(bf16_t, WS_WQKV) + (size_t)j * 3072 * 1024, nb * 32, scr, kb * 64, nb * 32, F.lane); }
        else if (it < N3) { const int q = it - N2, j = q / I_SQ, r = q % I_SQ, kb = r / 32, nb = r % 32;
            transpose_item(INP(15) + (size_t)j * 1024 * 1024, 1024, 1024, WSP(bf16_t, WS_WNOUT) + (size_t)j * 1024 * 1024, nb * 32, scr, kb * 64, nb * 32, F.lane); }
        else if (it < N4) { const int q = it - N3, j = q / I_GU, r = q % I_GU, kb = r / 64, nb = r % 64; const int n0 = nb * 32;
            const int nn = n0 & 1023; const int drow = 256 * (nn >> 7) + (n0 >= 1024 ? 128 : 0) + (nn & 127);
            transpose_item(INP(21) + (size_t)j * 1024 * 2048, 1024, 2048, WSP(bf16_t, WS_WGU) + (size_t)j * 2048 * 1024, drow, scr, kb * 64, n0, F.lane); }
        else { const int q = it - N4, j = q / I_SQ, r = q % I_SQ, kb = r / 32, nb = r % 32;
            transpose_item(INP(23) + (size_t)j * 1024 * 1024, 1024, 1024, WSP(bf16_t, WS_WD) + (size_t)j * 1024 * 1024, nb * 32, scr, kb * 64, nb * 32, F.lane); }
    }
    __syncthreads();
}

__device__ __forceinline__ void expert_prefix(const Frame& F, int l, LAS int* base_out, LAS int* cnt_out, int scale, bool total) {
    if (F.tid < 64) {
        const int e = F.tid & 31;
        const int c = (int)F.ctl[CW_CNT + (l * 32 + e) * 64];
        const int t = (F.tid < 32) ? ((c + 255) >> 8) : 0;
        int incl = t;
#pragma unroll
        for (int o = 1; o < 32; o <<= 1) { const int y = __builtin_amdgcn_ds_bpermute(((F.tid - o) & 63) << 2, incl); if (F.tid >= o) incl += y; }
        if (F.tid < 32) { base_out[e] = (incl - t) * scale; if (cnt_out) cnt_out[e] = c; }
        if (total && F.tid == 31) base_out[32] = incl * scale;
    }
}
template <int MODE>
__device__ __forceinline__ void phase_norm1(Frame& F, int l) {
    LAS int* sbase = (LAS int*)(F.lds + MISC_OFF + 1024);
    if (MODE != 0) {
        expert_prefix(F, l - 1, sbase, (LAS int*)0, 256, false);
        __syncthreads();
    }
    const int gw = F.bid * 8 + F.wave, NGW = F.G * 8;
    bf16_t* X = WSP(bf16_t, WS_X); bf16_t* H = WSP(bf16_t, WS_H); const bf16_t* YS = WSP(bf16_t, WS_YS);
    const float* MOD = WSP(float, WS_MOD);
    const int* TE = WSP(int, WS_TOKE); const int* TP = WSP(int, WS_TOKP); const float* TW = WSP(float, WS_TOKW);
    const int nrows = (MODE == 2) ? RL : NR;
    for (int pr = gw; pr < nrows / 2; pr += NGW) {
        const int row0 = 2 * pr; const int bidx = row_bidx(row0);
        f32x4 v[2][4];
#pragma unroll
        for (int rr = 0; rr < 2; ++rr) { const int row = row0 + rr;
            if (MODE == 0) { const float* src = row < RL ? INP(0) + (size_t)row * 1024 : INP(2) + (size_t)(row - RL) * 1024;
#pragma unroll
                for (int j = 0; j < 4; ++j) v[rr][j] = __builtin_nontemporal_load((const f32x4*)(src + 4 * F.lane + 256 * j)); }
            else { const bf16_t* src = X + (size_t)row * 1024;
#pragma unroll
                for (int j = 0; j < 4; ++j) v[rr][j] = h4_to_f4(__builtin_nontemporal_load((const u32x2*)(src + 4 * F.lane + 256 * j))); } }
        if (MODE != 0) {
            u32x2 ys[2][4][4]; float wk[2][4];
#pragma unroll
            for (int rr = 0; rr < 2; ++rr)
#pragma unroll
                for (int k = 0; k < 4; ++k) { const int row = row0 + rr; const int e = TE[row * 4 + k], p = TP[row * 4 + k]; wk[rr][k] = TW[row * 4 + k];
                    const bf16_t* yr = YS + (size_t)(sbase[e] + p) * 1024 + 4 * F.lane;
#pragma unroll
                    for (int j = 0; j < 4; ++j) ys[rr][k][j] = __builtin_nontemporal_load((const u32x2*)(yr + 256 * j)); }
            const float* g2 = MOD + ((l - 1) * 5 + bidx) * 6144 + 5120 + 4 * F.lane;
#pragma unroll
            for (int j = 0; j < 4; ++j) { const f32x4 gg = *(const f32x4*)(g2 + 256 * j);
#pragma unroll
                for (int rr = 0; rr < 2; ++rr) { f32x4 f = (f32x4){0.f, 0.f, 0.f, 0.f};
#pragma unroll
                    for (int k = 0; k < 4; ++k) { const u32x2 q = ys[rr][k][j]; f += wk[rr][k] * (f32x4){bf2f(q.x & 0xffffu), bf2f(q.x >> 16), bf2f(q.y & 0xffffu), bf2f(q.y >> 16)}; }
                    v[rr][j] += gg * f; } }
        }
        if (MODE == 2) {
#pragma unroll
            for (int rr = 0; rr < 2; ++rr)
#pragma unroll
                for (int j = 0; j < 4; ++j) __builtin_nontemporal_store(v[rr][j], (f32x4*)(F.out + (size_t)(row0 + rr) * 1024 + 4 * F.lane + 256 * j));
            continue;
        }
        if (F.lane < 32) WSP(float, WS_SSK)[row0 * 16 + F.lane] = 0.f;
        float rstd[2];
#pragma unroll
        for (int rr = 0; rr < 2; ++rr) { float ss = 0.f;
#pragma unroll
            for (int j = 0; j < 4; ++j) { __builtin_nontemporal_store(f4_to_h4(v[rr][j]), (u32x2*)(X + (size_t)(row0 + rr) * 1024 + 4 * F.lane + 256 * j));
                ss += (v[rr][j][0] * v[rr][j][0] + v[rr][j][1] * v[rr][j][1]) + (v[rr][j][2] * v[rr][j][2] + v[rr][j][3] * v[rr][j][3]); }
            rstd[rr] = rsqrtf(wave_sum(ss, F.lane) * (1.0f / 1024.0f) + EPS); }
        const float* gm = INP(6) + l * 1024; const float* sh = MOD + (l * 5 + bidx) * 6144; const float* sc = sh + 1024;
#pragma unroll
        for (int j = 0; j < 4; ++j) { const int c = 4 * F.lane + 256 * j;
            const f32x4 g = *(const f32x4*)(gm + c), s1 = *(const f32x4*)(sc + c), s0 = *(const f32x4*)(sh + c); const f32x4 gs = g * (1.0f + s1);
#pragma unroll
            for (int rr = 0; rr < 2; ++rr) { const f32x4 h = v[rr][j] * rstd[rr] * gs + s0;
                u32x2 w; w.x = pk2(h[0], h[1]); w.y = pk2(h[2], h[3]);
                *(u32x2*)(H + (size_t)(row0 + rr) * 1024 + c) = w; } }
    }
}

__device__ __forceinline__ void router_finish(Frame& F, float (&lg)[32], int row, int r0, const float* br, LAS int* hist, LAS int* sel, float* TW) {
#pragma unroll
    for (int s5 = 0; s5 < 5; ++s5) { const int half = 16 >> s5; const bool up = (F.lane >> (5 - s5)) & 1;
#pragma unroll
        for (int i = 0; i < half; ++i) { const float a2 = lg[i], b2 = lg[i + half]; const float send = up ? a2 : b2, keep = up ? b2 : a2; lg[i] = keep + shx(send, 32 >> s5, F.lane); } }
    float logit = lg[0] + shx(lg[0], 1, F.lane);
    const int myE = F.lane >> 1;
    logit += br[myE];
    int rank = 0;
#pragma unroll
    for (int e = 0; e < 32; ++e) { const float le = __int_as_float(__builtin_amdgcn_readlane(__float_as_int(logit), 2 * e)); rank += (le > logit || (le == logit && e < myE)) ? 1 : 0; }
    float tv[4]; int ti[4];
#pragma unroll
    for (int k = 0; k < 4; ++k) { const unsigned long long bm = __ballot(rank == k); const int src = __builtin_amdgcn_readfirstlane((int)__builtin_ctzll(bm));
        tv[k] = __int_as_float(__builtin_amdgcn_readlane(__float_as_int(logit), src)); ti[k] = src >> 1; }
    const float e1 = __expf(tv[1] - tv[0]), e2 = __expf(tv[2] - tv[0]), e3 = __expf(tv[3] - tv[0]); const float inv = 1.0f / (1.0f + e1 + e2 + e3);
    if (F.lane < 4) { const int k = F.lane; const int e = k == 0 ? ti[0] : k == 1 ? ti[1] : k == 2 ? ti[2] : ti[3]; const float w = (k == 0 ? 1.0f : k == 1 ? e1 : k == 2 ? e2 : e3) * inv;
        const int lpos = atomicAdd((int*)&hist[e], 1);
        sel[(row - r0) * 4 + k] = e | (lpos << 8);
        TW[row * 4 + k] = w; }
}
__device__ __forceinline__ void phase_router(Frame& F, int l) {
    LAS float* wr = (LAS float*)F.lds;
    LAS int* hist = (LAS int*)(F.lds + MISC_OFF + 1024);
    LAS int* gbase = hist + 32;
    LAS int* sel = gbase + 32;
    const float* wsrc = INP(19) + (size_t)l * 1024 * 32;
    for (int i = F.tid; i < 1024 * 8; i += 512) { const int k = i >> 3, ch = i & 7; const f32x4 w = *(const f32x4*)(wsrc + k * 32 + ch * 4);
        const int p = (k >> 2) + 256 * (k & 3); *(LAS f32x4*)(wr + p * 32 + 4 * ((ch + (p >> 1)) & 7)) = w; }
    if (F.tid < 32) hist[F.tid] = 0;
    __syncthreads();
    const int NRr = (l == 3) ? RL : NR;
    const int RPB = (((NRr + F.G - 1) / F.G) + 1) & ~1;
    const int r0 = min(F.bid * RPB, NRr), r1 = min(r0 + RPB, NRr);
    bf16_t* X = WSP(bf16_t, WS_X); bf16_t* H = WSP(bf16_t, WS_H); const float* MOD = WSP(float, WS_MOD);
    int* TE = WSP(int, WS_TOKE); int* TP = WSP(int, WS_TOKP); float* TW = WSP(float, WS_TOKW); int* LIST = WSP(int, WS_LIST);
    const float* br = INP(20) + l * 32;
    const int rotl = F.lane >> 1;
    const LAS float* wbase = wr + F.lane * 32; int roff[8];
#pragma unroll
    for (int ch = 0; ch < 8; ++ch) roff[ch] = 4 * ((ch + rotl) & 7);
    for (int rowA = r0 + 2 * F.wave; rowA < r1; rowA += 16) {
        const bool hasB = rowA + 1 < r1; const int rowB = hasB ? rowA + 1 : rowA;
        const int bidx = row_bidx(rowA);
        bf16_t* xa = X + (size_t)rowA * 1024 + 4 * F.lane; bf16_t* xb = X + (size_t)rowB * 1024 + 4 * F.lane;
        const bf16_t* ya = WSP(bf16_t, WS_Y) + (size_t)rowA * 1024 + 4 * F.lane; const bf16_t* yb = WSP(bf16_t, WS_Y) + (size_t)rowB * 1024 + 4 * F.lane;
        float ssa = 0.f, ssb = 0.f;
#pragma unroll
        for (int j = 0; j < 4; ++j) { f32x4 va = h4_to_f4(*(const u32x2*)(xa + 256 * j)), vb = h4_to_f4(*(const u32x2*)(xb + 256 * j));
            { const u32x2 q = __builtin_nontemporal_load((const u32x2*)(ya + 256 * j)); va += (f32x4){bf2f(q.x & 0xffffu), bf2f(q.x >> 16), bf2f(q.y & 0xffffu), bf2f(q.y >> 16)}; *(u32x2*)(xa + 256 * j) = f4_to_h4(va); }
            if (hasB) { const u32x2 q = __builtin_nontemporal_load((const u32x2*)(yb + 256 * j)); vb += (f32x4){bf2f(q.x & 0xffffu), bf2f(q.x >> 16), bf2f(q.y & 0xffffu), bf2f(q.y >> 16)}; *(u32x2*)(xb + 256 * j) = f4_to_h4(vb); }
            ssa += (va[0] * va[0] + va[1] * va[1]) + (va[2] * va[2] + va[3] * va[3]); ssb += (vb[0] * vb[0] + vb[1] * vb[1]) + (vb[2] * vb[2] + vb[3] * vb[3]); }
        const float rsa = rsqrtf(wave_sum(ssa, F.lane) * (1.0f / 1024.0f) + EPS), rsb = rsqrtf(wave_sum(ssb, F.lane) * (1.0f / 1024.0f) + EPS);
        const float* gm = INP(7) + l * 1024 + 4 * F.lane; const float* sh = MOD + (l * 5 + bidx) * 6144 + 3072 + 4 * F.lane; const float* sc = sh + 1024;
        float lga[32], lgb[32];
#pragma unroll
        for (int e = 0; e < 32; ++e) { lga[e] = 0.f; lgb[e] = 0.f; }
#pragma unroll 1
        for (int j = 0; j < 4; ++j) { const int c = 256 * j;
            const f32x4 va = h4_to_f4(*(const u32x2*)(xa + c)), vb = h4_to_f4(*(const u32x2*)(xb + c));
            const f32x4 g = *(const f32x4*)(gm + c), s1 = *(const f32x4*)(sc + c), s0 = *(const f32x4*)(sh + c); const f32x4 gs = g * (1.0f + s1);
            const f32x4 ha = va * rsa * gs + s0, hb = vb * rsb * gs + s0;
            { u32x2 w; w.x = pk2(ha[0], ha[1]); w.y = pk2(ha[2], ha[3]); *(u32x2*)(H + (size_t)rowA * 1024 + 4 * F.lane + c) = w; }
            if (hasB) { u32x2 w; w.x = pk2(hb[0], hb[1]); w.y = pk2(hb[2], hb[3]); *(u32x2*)(H + (size_t)rowB * 1024 + 4 * F.lane + c) = w; }
            const LAS float* wj = wbase + (64 * j) * 32;
#pragma unroll
            for (int cc = 0; cc < 4; ++cc) {
                const LAS float* wp = wj + (256 * cc) * 32; const float hva = ha[cc], hvb = hb[cc];
#pragma unroll
                for (int ch = 0; ch < 8; ++ch) { const f32x4 w4 = *(const LAS f32x4*)(wp + roff[ch]);
                    lga[4 * ch + 0] += hva * w4[0]; lga[4 * ch + 1] += hva * w4[1]; lga[4 * ch + 2] += hva * w4[2]; lga[4 * ch + 3] += hva * w4[3];
                    lgb[4 * ch + 0] += hvb * w4[0]; lgb[4 * ch + 1] += hvb * w4[1]; lgb[4 * ch + 2] += hvb * w4[2]; lgb[4 * ch + 3] += hvb * w4[3]; }
            }
        }
        router_finish(F, lga, rowA, r0, br, hist, sel, TW);
        if (hasB) router_finish(F, lgb, rowB, r0, br, hist, sel, TW);
    }
    __syncthreads();
    if (F.tid < 32) gbase[F.tid] = (int)atomicAdd(F.ctl + CW_CNT + (l * 32 + F.tid) * 64, (unsigned)hist[F.tid]);
    __syncthreads();
    for (int i = F.tid; i < (r1 - r0) * 4; i += 512) { const int s = sel[i], e = s & 255, pos = gbase[e] + (s >> 8); const int row = r0 + (i >> 2);
        TE[row * 4 + (i & 3)] = e; TP[row * 4 + (i & 3)] = pos; LIST[(size_t)e * CAP + pos] = row; }
    __syncthreads();
}

__device__ __forceinline__ bf16x8 lds_frag(const LAS unsigned char* p) { return *(const LAS bf16x8*)p; }
#define ATT_SHIFT 8.0f
__device__ __forceinline__ void phase_attn(Frame& F, int jl  , bool last) {
    LAS unsigned char* QS = F.lds;
    LAS float* RPB = (LAS float*)(F.lds + 16384);
    LAS float* RK = (LAS float*)(F.lds + 19456);
    LAS unsigned char* KT = F.lds + 24576;
    LAS unsigned char* VT = F.lds + 24576 + 40960;
    const bf16_t* QKV = WSP(bf16_t, WS_QKV); bf16_t* OUT = WSP(bf16_t, WS_MERGED); const bf16_t* VTG = WSP(bf16_t, WS_VTG); const float* SSK = WSP(float, WS_SSK);
    const float* qg = INP(16) + jl * 64; const float* kg = INP(17) + jl * 64; const float* rpb = INP(18) + (size_t)jl * 16 * 465;
    const int w = F.wave, qt = w & 3, qr = w >> 2;
    const bool xmap = (F.G == 256);
    const int nli = last ? 512 : 528, nu = last ? 64 : 66;
#define ATT_ITEM(i, U, BH, OK) do { if (xmap) { const int li = (F.bid >> 3) + 32 * (i); OK = li < nli; \
            if (li < 512) { BH = (F.bid & 7) * 8 + (li >> 6); U = li & 63; } else { BH = (F.bid & 7) * 8 + ((li - 512) >> 1); U = 64 + ((li - 512) & 1); } } \
        else { const int it = F.bid + (i) * F.G; OK = it < NB * 16 * nu; U = it % nu; BH = it / nu; } } while (0)
#define ATT_ISSUE_X(rd_, RS0, B_, H_) do { int lk_ = lkey, lc_ = lc; asm volatile("" : "+v"(lk_), "+v"(lc_));   \
            _Pragma("unroll") for (int s5 = 0; s5 < 5; ++s5) { if (s5 == 4 && (rd_) != 0) break; \
            const int gr_ = min((RS0) + (rd_) * 5 + s5, 127); \
            const int krow0 = (rd_) == 2 ? (RL + (B_) * TC + s5 * 64) : ((B_) * TL + gr_ * 64); const int tt0 = (rd_) == 2 ? (TL + s5 * 64) : gr_ * 64; \
            pkr[s5] = *(const u32x4*)((const unsigned char*)QKV + (size_t)krow0 * 6144 + 2048 + (H_) * 128 + (unsigned)(lk_ * 6144 + lc_ * 16)); \
            pvr[s5] = *(const u32x4*)((const unsigned char*)VTG + ((size_t)(((B_) * 16 + (H_)) * 64) * TT + tt0) * 2 + (unsigned)(lk_ * (TT * 2) + lc_ * 16)); \
            pss[s5] = *(const float*)((const unsigned char*)SSK + (size_t)(krow0 * 16 + (H_)) * 4 + (unsigned)(lk_ * 64)); } } while (0)
#define ATT_ISSUE(rd_) ATT_ISSUE_X(rd_, rs0, b, h)
#define ATT_FIRST(U, BH) do { const int h_ = (BH) & 15, b_ = (BH) >> 4; const bool lat_ = (U) < 64; const int r0_ = 2 * (U), rs0_ = min(max(r0_ - 4, 0), 120); \
            if (lat_) ATT_ISSUE_X(0, rs0_, b_, h_); else ATT_ISSUE_X(2, rs0_, b_, h_); \
            _Pragma("unroll") for (int p = 0; p < 2; ++p) { const int qrow_ = lat_ ? (b_ * TL + (r0_ + p) * 64 + lkey) : (RL + b_ * TC + ((U) - 64) * 128 + p * 64 + lkey); \
                qraw[p] = *(const u32x4*)(QKV + (size_t)qrow_ * 3072 + h_ * 64 + lc * 8); } } while (0)
    u32x4 pkr[5], pvr[5]; float pss[5]; u32x4 qraw[2];
    int u, bh; bool valid;
    ATT_ITEM(0, u, bh, valid);
    if (valid) { const int t0_ = (F.wave << 6) | (lane_id_volatile() & 63); const int lkey = t0_ >> 3, lc = t0_ & 7; ATT_FIRST(u, bh); }
    for (int i_ = 0; valid; ++i_) {
        int tid_ = (F.wave << 6) | (lane_id_volatile() & 63);
        const int lane_ = tid_ & 63, ln = lane_ & 15, g = lane_ >> 4;
        const int lkey = tid_ >> 3, lc = tid_ & 7;
        const int h = bh & 15, b = bh >> 4;
        const bool lat = u < 64;
        const int r0 = 2 * u, rs0 = min(max(r0 - 4, 0), 120), rs1 = min(max(r0 - 3, 0), 120);
        const int urow = r0 + qr, off = qr ? rs1 - rs0 : 0;
        const int rd_first = lat ? 0 : 2;
        int un = 0, bhn = 0; bool validn = false;
#pragma unroll
        for (int p = 0; p < 2; ++p) {
            const int ql = p * 64 + lkey;
            const u32x4 raw = qraw[p];
            float x[8] = {bf2f(raw.x & 0xffffu), bf2f(raw.x >> 16), bf2f(raw.y & 0xffffu), bf2f(raw.y >> 16), bf2f(raw.z & 0xffffu), bf2f(raw.z >> 16), bf2f(raw.w & 0xffffu), bf2f(raw.w >> 16)};
            float ss = 0.f;
#pragma unroll
            for (int i = 0; i < 8; ++i) ss += x[i] * x[i];
            ss += shx(ss, 1, lane_); ss += shx(ss, 2, lane_); ss += shx(ss, 4, lane_);
            const float r = rsqrtf(ss * (1.0f / 64.0f) + EPS) * (0.125f * 1.4426950408889634f);
            const f32x4 g0 = *(const f32x4*)(qg + lc * 8) * *(const f32x4*)(kg + lc * 8), g1 = *(const f32x4*)(qg + lc * 8 + 4) * *(const f32x4*)(kg + lc * 8 + 4);
            u32x4 o; o.x = pk2(x[0] * r * g0[0], x[1] * r * g0[1]); o.y = pk2(x[2] * r * g0[2], x[3] * r * g0[3]); o.z = pk2(x[4] * r * g1[0], x[5] * r * g1[1]); o.w = pk2(x[6] * r * g1[2], x[7] * r * g1[3]);
            *(LAS u32x4*)(QS + ql * 128 + lc * 16) = o;
        }
        for (int i = tid_; i < 15 * 48; i += 512) { const int rr = i / 48, cc = i % 48 - 8; RPB[i] = (cc >= 0 && cc < 31) ? rpb[h * 465 + rr * 31 + cc] * 1.4426950408889634f - ATT_SHIFT : 0.f; }
        f32x4 O[4]; f32x4 Lsum = (f32x4){0.f, 0.f, 0.f, 0.f};
        const bf16x8 ones8 = __builtin_bit_cast(bf16x8, (u32x4){0x3f803f80u, 0x3f803f80u, 0x3f803f80u, 0x3f803f80u});
#pragma unroll
        for (int e = 0; e < 4; ++e) O[e] = (f32x4){0.f, 0.f, 0.f, 0.f};
        bf16x8 qf[2];
#pragma unroll 1
        for (int rd = rd_first; rd < 3; ++rd) {
            const int nslot = rd == 0 ? 5 : 4;
#pragma unroll
            for (int s5 = 0; s5 < 5; ++s5) {
                if (s5 < nslot) {
                *(LAS u32x4*)(KT + s5 * 8192 + lkey * 128 + ((lc ^ (lkey & 7)) * 16)) = pkr[s5];
                *(LAS u32x4*)(VT + s5 * 8192 + lkey * 128 + ((lc ^ ((lkey ^ (lkey >> 3)) & 7)) * 16)) = pvr[s5];
                if (lc == 0) RK[s5 * 64 + lkey] = rsqrtf(pss[s5] * (1.0f / 64.0f) + EPS);
                }
            }
            __syncthreads();
            if (rd == 0) ATT_ISSUE(1); else if (rd == 1) ATT_ISSUE(2);
            else { ATT_ITEM(i_ + 1, un, bhn, validn); if (validn) ATT_FIRST(un, bhn); }
            if (rd == rd_first) {
#pragma unroll
                for (int ks = 0; ks < 2; ++ks) qf[ks] = lds_frag(QS + (w * 16 + ln) * 128 + (ks * 4 + g) * 16);
            }
            {
                int t2_ = tid_; asm volatile("" : "+v"(t2_));
                const int ln = t2_ & 15, g = (t2_ & 63) >> 4;
                if (rd < 2) {
                    const int thr = qt == 0 ? max(ln, 8) : qt == 3 ? min(ln, 8) : ln;
                    const int c0 = max(2 * qt - 1 + (g >> 1), 0), c1 = min(2 * qt + 1 + (g >> 1), 7);
                    const int key0 = min(max(16 * qt - 8 + ln, 0), 63), key1 = min(16 * qt + 8 + ln, 63);
                    const int rkb0 = min(max(16 * qt - 8 + 4 * g, 0), 60), rkb1 = min(16 * qt + 8 + 4 * g, 60);
                    bf16x8 ka[2][4]; float rbv[2][8]; f32x4 rkl[2][2];
#define ATT_LOADL(st, s5_) do { const LAS unsigned char* kt_ = KT + (s5_) * 8192; \
                        ka[st][0] = lds_frag(kt_ + key0 * 128 + (((0 + g) ^ (key0 & 7)) * 16)); ka[st][1] = lds_frag(kt_ + key0 * 128 + (((4 + g) ^ (key0 & 7)) * 16)); \
                        ka[st][2] = lds_frag(kt_ + key1 * 128 + (((0 + g) ^ (key1 & 7)) * 16)); ka[st][3] = lds_frag(kt_ + key1 * 128 + (((4 + g) ^ (key1 & 7)) * 16)); \
                        const int rrow_ = min(max(rs0 + rd * 5 + (s5_) - urow + 7, 0), 14); const LAS float* rb_ = RPB + rrow_ * 48 + 15 - ln + 4 * g; \
                        _Pragma("unroll") for (int j = 0; j < 4; ++j) { rbv[st][j] = rb_[j]; rbv[st][4 + j] = rb_[16 + j]; } \
                        rkl[st][0] = *(const LAS f32x4*)(RK + (s5_) * 64 + rkb0); rkl[st][1] = *(const LAS f32x4*)(RK + (s5_) * 64 + rkb1); \
                        } while (0)
#define ATT_LOADLV(s5_) do { const LAS unsigned char* vt_ = VT + (s5_) * 8192; \
                        _Pragma("unroll") for (int et = 0; et < 4; ++et) { const int e = et * 16 + ln; const int sw = (e ^ (e >> 3)) & 7; \
                            vfa[et] = *(const LAS u32x2*)(vt_ + e * 128 + ((c0 ^ sw) * 16) + (g & 1) * 8); vfb[et] = *(const LAS u32x2*)(vt_ + e * 128 + ((c1 ^ sw) * 16) + (g & 1) * 8); } } while (0)
                    ATT_LOADL(0, 0);
#pragma unroll
                    for (int s5 = 0; s5 < 5; ++s5) {
                        if (s5 == 4 && rd != 0) break;
                        const int st = s5 & 1;
                        u32x2 vfa[4], vfb[4];
                        ATT_LOADLV(s5);
                        if (s5 + 1 < 5 && !(s5 + 1 == 4 && rd != 0)) ATT_LOADL(st ^ 1, s5 + 1);
                        __builtin_amdgcn_sched_barrier(0);
                        const int t = rd * 5 + s5;
                        const bool mine = (t >= off) && (t <= off + 7);
                        f32x4 sc0 = (f32x4){0.f, 0.f, 0.f, 0.f}, sc1 = (f32x4){0.f, 0.f, 0.f, 0.f};
                        sc0 = __builtin_amdgcn_mfma_f32_16x16x32_bf16(ka[st][0], qf[0], sc0, 0, 0, 0);
                        sc1 = __builtin_amdgcn_mfma_f32_16x16x32_bf16(ka[st][2], qf[0], sc1, 0, 0, 0);
                        sc0 = __builtin_amdgcn_mfma_f32_16x16x32_bf16(ka[st][1], qf[1], sc0, 0, 0, 0);
                        sc1 = __builtin_amdgcn_mfma_f32_16x16x32_bf16(ka[st][3], qf[1], sc1, 0, 0, 0);
#pragma unroll
                        for (int j = 0; j < 4; ++j) { const int kk = 4 * g + j;
                            const float p0 = (mine && kk >= thr) ? __builtin_amdgcn_exp2f(sc0[j] * rkl[st][0][j] + rbv[st][j]) : 0.f;
                            const float p1 = (mine && kk < thr) ? __builtin_amdgcn_exp2f(sc1[j] * rkl[st][1][j] + rbv[st][4 + j]) : 0.f;
                            sc0[j] = p0; sc1[j] = p1; }
                        u32x4 pw; pw.x = pk2(sc0[0], sc0[1]); pw.y = pk2(sc0[2], sc0[3]); pw.z = pk2(sc1[0], sc1[1]); pw.w = pk2(sc1[2], sc1[3]);
                        const bf16x8 pf = __builtin_bit_cast(bf16x8, pw);
                        Lsum = __builtin_amdgcn_mfma_f32_16x16x32_bf16(ones8, pf, Lsum, 0, 0, 0);
#pragma unroll
                        for (int et = 0; et < 4; ++et) { u32x4 vw; vw.x = vfa[et].x; vw.y = vfa[et].y; vw.z = vfb[et].x; vw.w = vfb[et].y;
                            O[et] = __builtin_amdgcn_mfma_f32_16x16x32_bf16(__builtin_bit_cast(bf16x8, vw), pf, O[et], 0, 0, 0); }
                    }
#undef ATT_LOADL
#undef ATT_LOADLV
                } else {
                    bf16x8 kc[1][4][2]; f32x4 rkv[1][4];
#define ATT_LOADCK(st, s5_) do { const LAS unsigned char* kt_ = KT + (s5_) * 8192; \
                        _Pragma("unroll") for (int kt = 0; kt < 4; ++kt) { const int key = kt * 16 + ln; \
                            kc[st][kt][0] = lds_frag(kt_ + key * 128 + (((0 + g) ^ (key & 7)) * 16)); kc[st][kt][1] = lds_frag(kt_ + key * 128 + (((4 + g) ^ (key & 7)) * 16)); \
                            rkv[st][kt] = *(const LAS f32x4*)(RK + (s5_) * 64 + 16 * kt + 4 * g); } } while (0)
#pragma unroll
                    for (int s5 = 0; s5 < 4; ++s5) {
                        const int st = 0;
                        const LAS unsigned char* vt_ = VT + s5 * 8192;
                        u32x2 vfa[2][4], vfb[2][4];
#pragma unroll
                        for (int ks2 = 0; ks2 < 2; ++ks2)
#pragma unroll
                            for (int et = 0; et < 4; ++et) { const int e = et * 16 + ln; const int sw = (e ^ (e >> 3)) & 7;
                                vfa[ks2][et] = *(const LAS u32x2*)(vt_ + e * 128 + (((4 * ks2 + (g >> 1)) ^ sw) * 16) + (g & 1) * 8);
                                vfb[ks2][et] = *(const LAS u32x2*)(vt_ + e * 128 + (((4 * ks2 + 2 + (g >> 1)) ^ sw) * 16) + (g & 1) * 8); }
                        ATT_LOADCK(0, s5);
                        __builtin_amdgcn_sched_barrier(0);
                        f32x4 sc[4];
#pragma unroll
                        for (int kt = 0; kt < 4; ++kt) sc[kt] = __builtin_amdgcn_mfma_f32_16x16x32_bf16(kc[st][kt][0], qf[0], (f32x4){0.f, 0.f, 0.f, 0.f}, 0, 0, 0);
#pragma unroll
                        for (int kt = 0; kt < 4; ++kt) sc[kt] = __builtin_amdgcn_mfma_f32_16x16x32_bf16(kc[st][kt][1], qf[1], sc[kt], 0, 0, 0);
#pragma unroll
                        for (int kt = 0; kt < 4; ++kt)
#pragma unroll
                            for (int j = 0; j < 4; ++j) { const float p = __builtin_amdgcn_exp2f(sc[kt][j] * rkv[st][kt][j] - ATT_SHIFT); sc[kt][j] = p; }
#pragma unroll
                        for (int ks2 = 0; ks2 < 2; ++ks2) {
                            u32x4 pw; pw.x = pk2(sc[2 * ks2][0], sc[2 * ks2][1]); pw.y = pk2(sc[2 * ks2][2], sc[2 * ks2][3]); pw.z = pk2(sc[2 * ks2 + 1][0], sc[2 * ks2 + 1][1]); pw.w = pk2(sc[2 * ks2 + 1][2], sc[2 * ks2 + 1][3]);
                            const bf16x8 pf = __builtin_bit_cast(bf16x8, pw);
                            Lsum = __builtin_amdgcn_mfma_f32_16x16x32_bf16(ones8, pf, Lsum, 0, 0, 0);
#pragma unroll
                            for (int et = 0; et < 4; ++et) { u32x4 vw; vw.x = vfa[ks2][et].x; vw.y = vfa[ks2][et].y; vw.z = vfb[ks2][et].x; vw.w = vfb[ks2][et].y;
                                O[et] = __builtin_amdgcn_mfma_f32_16x16x32_bf16(__builtin_bit_cast(bf16x8, vw), pf, O[et], 0, 0, 0); }
                        }
                    }
#undef ATT_LOADCK
                }
            }
            __syncthreads();
        }
        {
            const float inv = 1.0f / Lsum[0];
            const int qrow = lat ? (b * TL + urow * 64 + qt * 16 + ln) : (RL + b * TC + (u - 64) * 128 + w * 16 + ln);
#pragma unroll
            for (int e = 0; e < 4; ++e) { u32x2 wv; wv.x = pk2(O[e][0] * inv, O[e][1] * inv); wv.y = pk2(O[e][2] * inv, O[e][3] * inv);
                *(u32x2*)(OUT + (size_t)qrow * 1024 + h * 64 + e * 16 + 4 * g) = wv; }
        }
        u = un; bh = bhn; valid = validn;
    }
#undef ATT_ISSUE
#undef ATT_ISSUE_X
#undef ATT_FIRST
#undef ATT_ITEM
}

constexpr size_t WS_GH = WS_ACT, WS_GM = WS_ACT + 72 * MiB, WS_SH = WS_ACT + 128 * MiB, WS_SM = WS_SH + 72 * MiB;
constexpr size_t WS_DECH = WS_YS, WS_DECM = WS_YS + 1 * MiB;
constexpr size_t WS_OTH = WS_OHF, WS_OTM = WS_OMF;
static_assert(WS_GM + (size_t)1056 * 10240 * 4 <= WS_SH && WS_SM + (size_t)1056 * 10240 * 4 <= WS_YS, "scan dumps");
template <int KIND> struct ScanCfg {
    static constexpr int DK = KIND ? 64 : 128, RBQ = DK * 2, CMQ = DK / 8 - 1, KST = DK / 32, NEXT = KIND ? 144 : 128, OBS = KIND ? 148 : 132;
    static constexpr int OFF_OB = 0;
    static constexpr int OFF_QP = KIND ? 36864 : 0, OFF_KP = OFF_QP + 64 * RBQ, OFF_KPT = OFF_KP + 64 * RBQ, OFF_VT = OFF_KPT + DK * 128, OFF_PP = OFF_VT + 20480, OFF_SST = OFF_PP + 8192;
    static constexpr int OFF_SM = 114688;
    static constexpr int GSTRIDE = KIND ? 10240 : 16384;
};
__device__ __forceinline__ int sc_row(int b, int sct, int t) { return sct == 0 ? (RL + b * TC + t) : (b * TL + (sct - 1) * 256 + t); }
__device__ __forceinline__ float exp_c(float x) { return __expf(fminf(fmaxf(x, -80.f), 80.f)); }
template <int KIND> __device__ __forceinline__ int st_n0(int w) { return KIND ? (w >> 2) * 4 : 0; }
template <int KIND> __device__ __forceinline__ int st_nc(int w) { return KIND ? ((w >> 2) ? 5 : 4) : 8; }
template <int KIND> __device__ __forceinline__ int st_mt(int w) { return KIND ? (w & 3) : w; }
template <int KIND> __device__ __forceinline__ int ot_n0(int w) { return (w >> 2) * 4; }
template <int KIND> __device__ __forceinline__ int ot_nc(int w) { return KIND ? ((w >> 2) ? 5 : 4) : 4; }

template <int KIND, int PASS>
__device__ __forceinline__ void scan_super(Frame& F, int jl, int b, int h, int sct, int dir, f32x4 (&S)[8]) {
    typedef ScanCfg<KIND> C;
    LAS unsigned char* L = F.lds;
    LAS float* TOT = (LAS float*)(L + C::OFF_SM); LAS float* EM = TOT + 512; LAS float* E2 = EM + 128; LAS float* BT = E2 + 128; LAS float* RQ = BT + 128; LAS float* CK = RQ + 64; LAS float* SCAL = CK + 64;
    const int w = F.wave;
    const bf16_t* Qg = KIND ? WSP(bf16_t, WS_MQ) : WSP(bf16_t, WS_Q);
    const bf16_t* Kg = KIND ? WSP(bf16_t, WS_MK) : WSP(bf16_t, dir ? WS_KB : WS_KF);
    const bf16_t* Vg = KIND ? WSP(bf16_t, WS_MV) : WSP(bf16_t, WS_V);
    const int hq = h * C::DK;
    u32x4 rq[2], rk[2], rv[2]; float rl[16]; float rg0 = 0.f, rg1 = 0.f;
    const float* LAg = WSP(float, dir ? WS_LAB : WS_LAF); const float* GTg = WSP(float, WS_GATES);
#define SC_ISSUE(ci_, TID) do { const int cN = dir ? 3 - (ci_) : (ci_); const int tN = cN * 64; \
        if (KIND == 0) { const int d_ = (TID) & 127, part_ = (TID) >> 7; \
            _Pragma("unroll") for (int i = 0; i < 16; ++i) rl[i] = LAg[(size_t)sc_row(b, sct, tN + part_ * 16 + i) * 512 + hq + d_]; \
            _Pragma("unroll") for (int p = 0; p < 2; ++p) { const size_t ro = (size_t)sc_row(b, sct, tN + p * 32 + ((TID) >> 4)) * 512 + hq + 8 * ((TID) & 15); \
                if (PASS == 3) rq[p] = *(const u32x4*)(Qg + ro); rk[p] = *(const u32x4*)(Kg + ro); rv[p] = *(const u32x4*)(Vg + ro); } } \
        else { { const size_t ro = (size_t)sc_row(b, sct, tN + ((TID) >> 3)) * 256 + hq + 8 * ((TID) & 7); if (PASS == 3) rq[0] = *(const u32x4*)(Qg + ro); rk[0] = *(const u32x4*)(Kg + ro); } \
            _Pragma("unroll") for (int p = 0; p < 2; ++p) rv[p] = *(const u32x4*)(Vg + (size_t)sc_row(b, sct, tN + p * 32 + ((TID) >> 4)) * 512 + h * 128 + 8 * ((TID) & 15)); \
            if ((TID) < 64) { const size_t go = (size_t)sc_row(b, sct, tN + (TID)) * 16 + h; rg0 = GTg[go + (dir ? 12 : 4)]; rg1 = GTg[go + (dir ? 8 : 0)]; } } } while (0)
    SC_ISSUE(0, F.tid);
#pragma unroll 1
    for (int ci = 0; ci < 4; ++ci) {
        const int c = dir ? 3 - ci : ci; const int t0 = c * 64;
        int tid_ = F.tid; asm volatile("" : "+v"(tid_));
        const int lane_ = tid_ & 63, ln = lane_ & 15, g = lane_ >> 4;
        LAS unsigned char* VRAW = L + C::OFF_SST;
        if (KIND == 0) {
            const int d = tid_ & 127, part = tid_ >> 7;
            if (!dir) {
#pragma unroll
                for (int i = 1; i < 16; ++i) rl[i] += rl[i - 1];
                TOT[part * 128 + d] = rl[15];
            } else {
#pragma unroll
                for (int i = 14; i >= 0; --i) rl[i] += rl[i + 1];
                TOT[part * 128 + d] = rl[0];
            }
#pragma unroll
            for (int p = 0; p < 2; ++p) { const int t = p * 32 + (tid_ >> 4), cc = tid_ & 15;
                if (PASS == 3) *(LAS u32x4*)(L + C::OFF_QP + t * 256 + ((cc ^ (t & 15)) * 16)) = rq[p];
                *(LAS u32x4*)(L + C::OFF_KP + t * 256 + ((cc ^ (t & 15)) * 16)) = rk[p];
                *(LAS u32x4*)(VRAW + t * 256 + cc * 16) = rv[p]; }
        } else {
            { const int t = tid_ >> 3, cc = tid_ & 7;
                if (PASS == 3) *(LAS u32x4*)(L + C::OFF_QP + t * 128 + ((cc ^ (t & 7)) * 16)) = rq[0];
                *(LAS u32x4*)(L + C::OFF_KP + t * 128 + ((cc ^ (t & 7)) * 16)) = rk[0]; }
#pragma unroll
            for (int p = 0; p < 2; ++p) { const int t = p * 32 + (tid_ >> 4), cc = tid_ & 15; *(LAS u32x4*)(VRAW + t * 256 + cc * 16) = rv[p]; }
            if (tid_ < 64) { const int t = tid_;
                float x = rg0; const float ig = rg1;
#pragma unroll
                for (int o = 1; o < 64; o <<= 1) { const int src = dir ? t + o : t - o; const float y = __int_as_float(__builtin_amdgcn_ds_bpermute((src & 63) << 2, __float_as_int(x))); if (src >= 0 && src < 64) x += y; }
                const float ref = __int_as_float(__builtin_amdgcn_readlane(__float_as_int(x), dir ? 32 : 31));
                const float btot = __int_as_float(__builtin_amdgcn_readlane(__float_as_int(x), dir ? 0 : 63));
                RQ[t] = exp_c(x - ref); CK[t] = exp_c(ref - x + ig);
                if (t == 0) { SCAL[0] = __expf(ref); SCAL[1] = __expf(btot - ref); if (PASS == 1) SCAL[2] = (ci == 0 ? 0.f : SCAL[2]) + btot; } }
            if (tid_ < 128) { const int row = 128 + (tid_ >> 3), ch = tid_ & 7; const unsigned one = (row == 128) ? 0x3f803f80u : 0u;
                *(LAS u32x4*)(L + C::OFF_VT + row * 128 + ((ch ^ (row & 7)) * 16)) = (u32x4){one, one, one, one}; }
        }
        __syncthreads();
        if (KIND == 0) {
            const int d = tid_ & 127, part = tid_ >> 7;
            const float t0v = TOT[d], t1v = TOT[128 + d], t2v = TOT[256 + d], t3v = TOT[384 + d];
            const float btot = (t0v + t1v) + (t2v + t3v);
            const float ref = dir ? (t2v + t3v) : (t0v + t1v);
            float off;
            if (!dir) off = part == 0 ? 0.f : part == 1 ? t0v : part == 2 ? (t0v + t1v) : (t0v + t1v + t2v);
            else off = part == 3 ? 0.f : part == 2 ? t3v : part == 1 ? (t3v + t2v) : (t3v + t2v + t1v);
            if (part == 0) { EM[d] = __expf(ref); E2[d] = __expf(btot - ref); if (PASS == 1) BT[d] = (ci == 0 ? 0.f : BT[d]) + btot; }
            unsigned kt[8];
#pragma unroll
            for (int i = 0; i < 16; ++i) { const int t = part * 16 + i; const int ad = t * 256 + (((d >> 3) ^ (t & 15)) * 16) + (d & 7) * 2;
                const float bb = rl[i] + off - ref;
                const float kv = bf2f(*(const LAS bf16_t*)(L + C::OFF_KP + ad)) * exp_c(-bb); const unsigned kb = pk2(kv, kv) & 0xffffu;
                if (PASS == 3) { const float qv = bf2f(*(const LAS bf16_t*)(L + C::OFF_QP + ad)) * exp_c(bb);
                    *(LAS bf16_t*)(L + C::OFF_QP + ad) = (bf16_t)(pk2(qv, qv) & 0xffffu);
                    *(LAS bf16_t*)(L + C::OFF_KP + ad) = (bf16_t)kb; }
                if (i & 1) kt[i >> 1] |= kb << 16; else kt[i >> 1] = kb; }
            *(LAS u32x4*)(L + C::OFF_KPT + d * 128 + (((part * 2) ^ (d & 7)) * 16)) = (u32x4){kt[0], kt[1], kt[2], kt[3]};
            *(LAS u32x4*)(L + C::OFF_KPT + d * 128 + (((part * 2 + 1) ^ (d & 7)) * 16)) = (u32x4){kt[4], kt[5], kt[6], kt[7]};
        } else {
            const int d = tid_ & 63, part = tid_ >> 6;
            unsigned kt[4];
#pragma unroll
            for (int i = 0; i < 8; ++i) { const int t = part * 8 + i; const int ad = t * 128 + (((d >> 3) ^ (t & 7)) * 16) + (d & 7) * 2;
                const float kv = bf2f(*(const LAS bf16_t*)(L + C::OFF_KP + ad)) * CK[t]; const unsigned kb = pk2(kv, kv) & 0xffffu;
                if (PASS == 3) { const float qv = bf2f(*(const LAS bf16_t*)(L + C::OFF_QP + ad)) * RQ[t];
                    *(LAS bf16_t*)(L + C::OFF_QP + ad) = (bf16_t)(pk2(qv, qv) & 0xffffu);
                    *(LAS bf16_t*)(L + C::OFF_KP + ad) = (bf16_t)kb; }
                if (i & 1) kt[i >> 1] |= kb << 16; else kt[i >> 1] = kb; }
            *(LAS u32x4*)(L + C::OFF_KPT + d * 128 + ((part ^ (d & 7)) * 16)) = (u32x4){kt[0], kt[1], kt[2], kt[3]};
        }
        {
            const int e = tid_ & 127, part = tid_ >> 7; unsigned vt[8];
#pragma unroll
            for (int i = 0; i < 16; ++i) { const unsigned vb = *(const LAS bf16_t*)(VRAW + (part * 16 + i) * 256 + e * 2); if (i & 1) vt[i >> 1] |= vb << 16; else vt[i >> 1] = vb; }
            *(LAS u32x4*)(L + C::OFF_VT + e * 128 + (((part * 2) ^ (e & 7)) * 16)) = (u32x4){vt[0], vt[1], vt[2], vt[3]};
            *(LAS u32x4*)(L + C::OFF_VT + e * 128 + (((part * 2 + 1) ^ (e & 7)) * 16)) = (u32x4){vt[4], vt[5], vt[6], vt[7]};
        }
        if (ci < 3) SC_ISSUE(ci + 1, tid_);
        __syncthreads();
        const int smt = st_mt<KIND>(w), sn0 = st_n0<KIND>(w), snc = st_nc<KIND>(w), onc = KIND ? snc : 4;
#define SC_ET(n) (KIND ? (sn0 + (n)) : (((((n) >> 2) ^ (w >> 2)) << 2) + ((n) & 3)))
        {
            f32x4 em;
            if (KIND == 0) em = *(const LAS f32x4*)(EM + smt * 16 + 4 * g); else { const float s0 = SCAL[0]; em = (f32x4){s0, s0, s0, s0}; }
#pragma unroll
            for (int n = 0; n < 8; ++n) if (n < snc) { S[n] *= em;
                if (PASS == 3) { const int e = SC_ET(n) * 16 + ln; u32x2 wv; wv.x = pk2(S[n][0], S[n][1]); wv.y = pk2(S[n][2], S[n][3]);
                    *(LAS u32x2*)(L + C::OFF_SST + e * C::RBQ + (((2 * smt + (g >> 1)) ^ (e & C::CMQ)) * 16) + (g & 1) * 8) = wv; } }
        }
        constexpr int NVT = KIND ? 5 : 8;
        bf16x8 vt[NVT][2], kf[2];
#pragma unroll
        for (int n = 0; n < NVT; ++n) if (n < snc) { const int e = SC_ET(n) * 16 + ln;
#pragma unroll
            for (int ks = 0; ks < 2; ++ks) vt[n][ks] = lds_frag(L + C::OFF_VT + e * 128 + (((ks * 4 + g) ^ (e & 7)) * 16)); }
        { const int d_row = smt * 16 + ln;
#pragma unroll
            for (int ks = 0; ks < 2; ++ks) kf[ks] = lds_frag(L + C::OFF_KPT + d_row * 128 + (((ks * 4 + g) ^ (d_row & 7)) * 16)); }
        f32x4 e2;
        if (KIND == 0) e2 = *(const LAS f32x4*)(E2 + smt * 16 + 4 * g); else { const float s1 = SCAL[1]; e2 = (f32x4){s1, s1, s1, s1}; }
        f32x4 oacc[5];
        if (PASS == 3) {
            {
                const int st = w & 3, s_row = st * 16 + ln;
                bf16x8 af[C::KST], qfr[2][C::KST];
#pragma unroll
                for (int ks = 0; ks < C::KST; ++ks) af[ks] = lds_frag(L + C::OFF_KP + s_row * C::RBQ + (((ks * 4 + g) ^ (s_row & C::CMQ)) * 16));
#pragma unroll
                for (int tq = 0; tq < 2; ++tq) { const int t_row = ((w >> 2) * 2 + tq) * 16 + ln;
#pragma unroll
                    for (int ks = 0; ks < C::KST; ++ks) qfr[tq][ks] = lds_frag(L + C::OFF_QP + t_row * C::RBQ + (((ks * 4 + g) ^ (t_row & C::CMQ)) * 16)); }
                __builtin_amdgcn_sched_barrier(0);
#pragma unroll
                for (int tq = 0; tq < 2; ++tq) { const int tt = (w >> 2) * 2 + tq, t_row = tt * 16 + ln;
                    f32x4 acc = (f32x4){0.f, 0.f, 0.f, 0.f};
#pragma unroll
                    for (int ks = 0; ks < C::KST; ++ks) acc = __builtin_amdgcn_mfma_f32_16x16x32_bf16(af[ks], qfr[tq][ks], acc, 0, 0, 0);
#pragma unroll
                    for (int j = 0; j < 4; ++j) { const int sidx = st * 16 + 4 * g + j; const bool keep = dir ? (sidx >= t_row) : (sidx <= t_row); acc[j] = keep ? acc[j] : 0.f; }
                    u32x2 wv; wv.x = pk2(acc[0], acc[1]); wv.y = pk2(acc[2], acc[3]);
                    *(LAS u32x2*)(L + C::OFF_PP + t_row * 128 + (((2 * st + (g >> 1)) ^ (t_row & 7)) * 16) + (g & 1) * 8) = wv; }
            }
        } else __builtin_amdgcn_sched_barrier(0);
#pragma unroll
        for (int n = 0; n < NVT; ++n) if (n < snc) {
#pragma unroll
            for (int ks = 0; ks < 2; ++ks) S[n] = __builtin_amdgcn_mfma_f32_16x16x32_bf16(kf[ks], vt[n][ks], S[n], 0, 0, 0);
            S[n] *= e2; }
        if (PASS == 3) {
            __syncthreads();
            {
                const int tt = w & 3, t_row = tt * 16 + ln;
                bf16x8 pf[2], qf2[C::KST], sst[5][C::KST];
#pragma unroll
                for (int ks = 0; ks < 2; ++ks) pf[ks] = lds_frag(L + C::OFF_PP + t_row * 128 + (((ks * 4 + g) ^ (t_row & 7)) * 16));
#pragma unroll
                for (int ks = 0; ks < C::KST; ++ks) qf2[ks] = lds_frag(L + C::OFF_QP + t_row * C::RBQ + (((ks * 4 + g) ^ (t_row & C::CMQ)) * 16));
#pragma unroll
                for (int n = 0; n < 5; ++n) if (n < onc) { const int e = SC_ET(n) * 16 + ln;
#pragma unroll
                    for (int ks = 0; ks < C::KST; ++ks) sst[n][ks] = lds_frag(L + C::OFF_SST + e * C::RBQ + (((ks * 4 + g) ^ (e & C::CMQ)) * 16)); }
                __builtin_amdgcn_sched_barrier(0);
#pragma unroll
                for (int n = 0; n < 5; ++n) if (n < onc) { f32x4 acc = (f32x4){0.f, 0.f, 0.f, 0.f};
#pragma unroll
                    for (int ks = 0; ks < 2; ++ks) acc = __builtin_amdgcn_mfma_f32_16x16x32_bf16(pf[ks], vt[n][ks], acc, 0, 0, 0);
#pragma unroll
                    for (int ks = 0; ks < C::KST; ++ks) acc = __builtin_amdgcn_mfma_f32_16x16x32_bf16(qf2[ks], sst[n][ks], acc, 0, 0, 0);
                    oacc[n] = acc; }
            }
            {
                LAS unsigned char* OBH = (w >> 2) ? (L + MISC_OFF + 4096) : (L + 118912); LAS float* DEN = (LAS float*)(L + MISC_OFF + 4096 + 9216);
                const int tt = w & 3, onc2 = ot_nc<KIND>(w);
#pragma unroll
                for (int n = 0; n < 5; ++n) if (n < onc2) {
                    if (KIND == 1 && n == 4) { if (ln == 0) {
#pragma unroll
                            for (int j = 0; j < 4; ++j) DEN[tt * 16 + 4 * g + j] = oacc[n][j]; } }
                    else { asm volatile("s_nop 11" : "+v"(oacc[n]));
                        const int e = n * 16 + ln; const unsigned p01 = pk2(oacc[n][0], oacc[n][1]), p23 = pk2(oacc[n][2], oacc[n][3]);
                        LAS bf16_t* o_ = (LAS bf16_t*)(OBH + (tt * 16 + 4 * g) * 144) + e;
                        o_[0] = (bf16_t)p01; o_[72] = (bf16_t)(p01 >> 16); o_[144] = (bf16_t)p23; o_[216] = (bf16_t)(p23 >> 16); } }
            }
        }
        __syncthreads();
        if (PASS == 3) {
            {
                const int t = tid_ >> 3, seg = tid_ & 7; const int row = sc_row(b, sct, t0 + t);
                LAS float* DEN = (LAS float*)(L + MISC_OFF + 4096 + 9216);
                const LAS bf16_t* ob = (const LAS bf16_t*)(((seg >> 2) ? (L + MISC_OFF + 4096) : (L + 118912)) + t * 144 + (seg & 3) * 32);
                f32x4 v[4];
                { const u32x4 oa = *(const LAS u32x4*)ob, oc = *(const LAS u32x4*)(ob + 8); const unsigned ow_[8] = {oa.x, oa.y, oa.z, oa.w, oc.x, oc.y, oc.z, oc.w};
#pragma unroll
                    for (int q = 0; q < 4; ++q) v[q] = (f32x4){bf2f(ow_[2 * q] & 0xffffu), bf2f(ow_[2 * q] >> 16), bf2f(ow_[2 * q + 1] & 0xffffu), bf2f(ow_[2 * q + 1] >> 16)}; }
                if (KIND == 1) { const float den = DEN[t]; const float inv = 1.0f / fmaxf(fabsf(den), 1.0f);
#pragma unroll
                    for (int q = 0; q < 4; ++q) v[q] *= inv; }
                float* ot = WSP(float, KIND ? WS_OTM : WS_OTH) + (size_t)row * 512 + h * 128 + seg * 16;
                if (!dir) {
#pragma unroll
                    for (int q = 0; q < 4; ++q) *(f32x4*)(ot + 4 * q) = v[q];
                } else {
                    float ss = 0.f;
#pragma unroll
                    for (int q = 0; q < 4; ++q) { v[q] += *(const f32x4*)(ot + 4 * q); ss += (v[q][0] * v[q][0] + v[q][1] * v[q][1]) + (v[q][2] * v[q][2] + v[q][3] * v[q][3]); }
                    ss += shx(ss, 1, lane_); ss += shx(ss, 2, lane_); ss += shx(ss, 4, lane_);
                    const float r = rsqrtf(ss * (1.0f / 128.0f) + EPS);
                    const float* gn = INP(KIND ? 13 : 12) + jl * 512 + h * 128 + seg * 16;
                    const bf16_t* gate = WSP(bf16_t, KIND ? WS_MO : WS_HG) + (size_t)row * 512 + h * 128 + seg * 16;
                    const u32x4 ga = *(const u32x4*)gate, gb = *(const u32x4*)(gate + 8);
                    const unsigned gw[8] = {ga.x, ga.y, ga.z, ga.w, gb.x, gb.y, gb.z, gb.w};
                    unsigned ow[8];
#pragma unroll
                    for (int q = 0; q < 4; ++q) { const f32x4 gq = *(const f32x4*)(gn + 4 * q);
                        const float y0 = v[q][0] * r * gq[0] * bf2f(gw[2 * q] & 0xffffu), y1 = v[q][1] * r * gq[1] * bf2f(gw[2 * q] >> 16);
                        const float y2 = v[q][2] * r * gq[2] * bf2f(gw[2 * q + 1] & 0xffffu), y3 = v[q][3] * r * gq[3] * bf2f(gw[2 * q + 1] >> 16);
                        ow[2 * q] = pk2(y0, y1); ow[2 * q + 1] = pk2(y2, y3); }
                    bf16_t* mg = WSP(bf16_t, WS_MERGED) + (size_t)row * 1024 + KIND * 512 + h * 128 + seg * 16;
                    *(u32x4*)mg = (u32x4){ow[0], ow[1], ow[2], ow[3]}; *(u32x4*)(mg + 8) = (u32x4){ow[4], ow[5], ow[6], ow[7]};
                }
            }
        }
    }
}
#undef SC_ISSUE
#undef SC_ET
__device__ __forceinline__ void phase_scan1(Frame& F) {
    for (int it = F.bid; it < 2 * 32 * 32; it += F.G) {
        const int cpos = it & 31, ch = (it >> 5) & 31, kind = it >> 10; const int dir = ch & 1, h = (ch >> 1) & 3, b = ch >> 3;
        const int sct = cpos == 0 ? 0 : (dir ? 33 - cpos : cpos);
        f32x4 S[8];
#pragma unroll
        for (int n = 0; n < 8; ++n) S[n] = (f32x4){0.f, 0.f, 0.f, 0.f};
        if (kind == 0) { scan_super<0, 1>(F, 0, b, h, sct, dir, S);
            float* G = WSP(float, WS_GH) + (size_t)(ch * 33 + cpos) * 16384;
#pragma unroll
            for (int n = 0; n < 8; ++n) *(f32x4*)(G + (n * 512 + F.tid) * 4) = S[n];
            if (F.tid < 128) WSP(float, WS_DECH)[(ch * 33 + cpos) * 128 + F.tid] = __expf(((const LAS float*)(F.lds + ScanCfg<0>::OFF_SM))[768 + F.tid]);
        } else { scan_super<1, 1>(F, 0, b, h, sct, dir, S);
            float* G = WSP(float, WS_GM) + (size_t)(ch * 33 + cpos) * 10240;
#pragma unroll
            for (int n = 0; n < 5; ++n) *(f32x4*)(G + (n * 512 + F.tid) * 4) = S[n];
            if (F.tid == 0) WSP(float, WS_DECM)[ch * 33 + cpos] = __expf(((const LAS float*)(F.lds + ScanCfg<1>::OFF_SM))[1024 + 2]);
        }
        __syncthreads();
    }
}
__device__ __forceinline__ void phase_scan23(Frame& F, int jl, int pass) {
    if (pass == 0) {
        const int nb0 = (F.G > 64) ? 32 : 0;
        if (F.bid >= nb0) {
            const int gt = (F.bid - nb0) * 512 + F.tid, NT = (F.G - nb0) * 512;
            for (int i = gt; i < 32 * 4096 + 32 * 2560; i += NT) {
                if (i < 32 * 4096) { const int ch = i >> 12, q = i & 4095, tid = q & 511; const int d0 = 16 * (tid >> 6) + 4 * ((tid & 63) >> 4);
                    const float* G = WSP(float, WS_GH) + (size_t)ch * 33 * 16384 + q * 4; bf16_t* SI = WSP(bf16_t, WS_SH) + (size_t)ch * 33 * 16384 + q * 4; const float* DC = WSP(float, WS_DECH) + ch * 33 * 128 + d0;
                    f32x4 s4 = (f32x4){0.f, 0.f, 0.f, 0.f};
#pragma unroll 4
                    for (int cp = 0; cp < 32; ++cp) { s4 = *(const f32x4*)(DC + cp * 128) * s4 + *(const f32x4*)(G + (size_t)cp * 16384); u32x2 w; w.x = pk2(s4[0], s4[1]); w.y = pk2(s4[2], s4[3]); *(u32x2*)(SI + (size_t)(cp + 1) * 16384) = w; }
                } else { const int k = i - 32 * 4096, ch = k / 2560, q = k % 2560;
                    const float* G = WSP(float, WS_GM) + (size_t)ch * 33 * 10240 + q * 4; bf16_t* SI = WSP(bf16_t, WS_SM) + (size_t)ch * 33 * 10240 + q * 4; const float* DC = WSP(float, WS_DECM) + ch * 33;
                    f32x4 s4 = (f32x4){0.f, 0.f, 0.f, 0.f};
#pragma unroll 4
                    for (int cp = 0; cp < 32; ++cp) { s4 = DC[cp] * s4 + *(const f32x4*)(G + (size_t)cp * 10240); u32x2 w; w.x = pk2(s4[0], s4[1]); w.y = pk2(s4[2], s4[3]); *(u32x2*)(SI + (size_t)(cp + 1) * 10240) = w; }
                }
            }
        }
    }
    const int count = pass == 0 ? 32 : 1024;
    for (int q = F.bid; q < count; q += F.G) {
        const int kind = q & 1, r = q >> 1;
        const int sct = pass == 0 ? 0 : 1 + (r & 31), bh = pass == 0 ? r : (r >> 5), h = bh & 3, b = bh >> 2;
#pragma unroll 1
        for (int dir = 0; dir < 2; ++dir) {
            const int ch = (b * 4 + h) * 2 + dir; const int cpos = sct == 0 ? 0 : (dir ? 33 - sct : sct);
            f32x4 S[8];
            if (kind == 0) { const bf16_t* SI = WSP(bf16_t, WS_SH) + (size_t)(ch * 33 + cpos) * 16384;
#pragma unroll
                for (int n = 0; n < 8; ++n) S[n] = cpos ? ld_bf4(SI + (n * 512 + F.tid) * 4) : (f32x4){0.f, 0.f, 0.f, 0.f};
                scan_super<0, 3>(F, jl, b, h, sct, dir, S);
            } else { const bf16_t* SI = WSP(bf16_t, WS_SM) + (size_t)(ch * 33 + cpos) * 10240;
#pragma unroll
                for (int n = 0; n < 8; ++n) S[n] = (cpos && n < 5) ? ld_bf4(SI + (n * 512 + F.tid) * 4) : (f32x4){0.f, 0.f, 0.f, 0.f};
                scan_super<1, 3>(F, jl, b, h, sct, dir, S);
            }
        }
    }
}

template <int PHMASK_T>
__global__ void __launch_bounds__(512, 2) mk_fwd(Args args) {
    extern __shared__ __attribute__((aligned(16))) unsigned char lds_raw[];
    Frame F;
    F.lds = (LAS unsigned char*)lds_raw;
    F.tid = threadIdx.x; F.lane = F.tid & 63; F.wave = __builtin_amdgcn_readfirstlane(F.tid >> 6);
    F.G = gridDim.x; F.bid = blockIdx.x;
    F.out = args.out; F.ws = args.ws; F.ctl = (unsigned*)(args.ws + WS_CTL);
    volatile LAS unsigned* MISC = (volatile LAS unsigned*)(F.lds + MISC_OFF);
    if (F.tid < 64) MISC[F.tid] = 0u;
    if (F.tid >= 64 && F.tid < 64 + 25) { const unsigned long long p = (unsigned long long)args.in[F.tid - 64]; MISC[64 + 2 * (F.tid - 64)] = (unsigned)p; MISC[65 + 2 * (F.tid - 64)] = (unsigned)(p >> 32); }
    __syncthreads();
    const int lo = args.ph_lo, hi = args.ph_hi;
    if (hi - lo > 1) (void)xcd_barrier_post(F.ctl + CW_BAR, MISC + 8);
#define EN(b) ((PHMASK_T >> (b)) & 1)
#define IN(k) (lo <= (k) && (k) < hi)
#if MK_ONE_LAUNCH
#define SEAM(k) do { if (IN(k) && IN((k) + 1)) { XcdBarrier bar_; bar_.bar = (unsigned*)(args.ws + WS_CTL) + CW_BAR; bar_.x = xb_xcc_id(); bar_.st = (volatile LAS unsigned*)(F.lds + MISC_OFF) + 8; bar_.leader = (F.wave == 0 && lane_id_volatile() == 0) ? 1 : 0; xcd_barrier(bar_); } } while (0)
#else
#define SEAM(k) do { } while (0)
#endif
    LAS int* tb = (LAS int*)(F.lds + MISC_OFF + 2048);
    LAS int* cnts = tb + 40;

    if (EN(0) && IN(0)) { _Pragma("unroll 1") for (int rp = 0; rp < REP_PRO; ++rp) { Frame P = fresh(F); phase_prologue(P); } }
    SEAM(0);
    for (int l0 = 0; l0 < 4; ++l0) {
        const int pb = 1 + 10 * l0; const bool rec = (l0 & 1) == 0;
        if (EN(1) && IN(pb + 0)) { Frame P = fresh(F); const int l = fresh_i(l0); if (l0 == 0) phase_norm1<0>(P, l); else phase_norm1<1>(P, l); }
        SEAM(pb + 0);
        if (rec) {
            if (EN(2) && IN(pb + 1)) _Pragma("unroll 1") for (int rp = 0; rp < REP_GIN; ++rp) {
                Frame P = fresh(F); const int l = fresh_i(l0), j = l >> 1;
                pg8::StaticOrder S; S.init(NR, NREC, P.G, P.bid);
                EpiRec E{P.ws, inp_ptr(P, 9) + (size_t)j * 4112, (float*)(P.ws + WS_LB) + l * 512, l};
                pg8::gemm_phase(P.lds, (const bf16_t*)(P.ws + WS_H), (const bf16_t*)(P.ws + WS_WIN) + (size_t)j * NREC * 1024, 1024, 0, S, E, pg8::RowIdentity{}, P.tid);
            }
            SEAM(pb + 1);
            if (EN(3) && IN(pb + 2)) { _Pragma("unroll 1") for (int rp = 0; rp < REP_SCAN1; ++rp) { Frame P = fresh(F); phase_scan1(P); } }
            SEAM(pb + 2);
#pragma unroll 1
            for (int pass = 0; pass < 2; ++pass) {
                if (EN(4) && IN(pb + 3 + pass)) { Frame P = fresh(F); phase_scan23(P, fresh_i(l0) >> 1, fresh_i(pass)); }
                SEAM(pb + 3 + pass);
            }
        } else {
            if (EN(5) && IN(pb + 1)) _Pragma("unroll 1") for (int rp = 0; rp < REP_GIN; ++rp) {
                Frame P = fresh(F); const int l = fresh_i(l0), j = l >> 1;
                pg8::StaticOrder S; S.init(NR, 3072, P.G, P.bid);
                EpiQKV E{P.ws};
                pg8::gemm_phase(P.lds, (const bf16_t*)(P.ws + WS_H), (const bf16_t*)(P.ws + WS_WQKV) + (size_t)j * 3072 * 1024, 1024, 0, S, E, pg8::RowIdentity{}, P.tid);
            }
            SEAM(pb + 1);
            if (EN(6) && IN(pb + 2)) { _Pragma("unroll 1") for (int rp = 0; rp < REP_ATT; ++rp) { Frame P = fresh(F); phase_attn(P, fresh_i(l0) >> 1, l0 == 3); } }
            SEAM(pb + 2);
        }
        if (EN(7) && IN(pb + 5)) {
            Frame P = fresh(F); const int l = fresh_i(l0), j = l >> 1;
            pg8::StaticOrder S; S.init(l0 == 3 ? RL : NR, 1024, P.G, P.bid);
            EpiResid E{(bf16_t*)(P.ws + WS_Y), (const float*)(P.ws + WS_MOD) + l * 5 * 6144};
            pg8::gemm_phase(P.lds, (const bf16_t*)(P.ws + WS_MERGED), (const bf16_t*)(P.ws + ((l & 1) ? WS_WNOUT : WS_WROUT)) + (size_t)j * 1024 * 1024, 1024, 0, S, E, pg8::RowIdentity{}, P.tid);
        }
        SEAM(pb + 5);
        if (EN(8) && IN(pb + 6)) { Frame P = fresh(F); phase_router(P, fresh_i(l0)); }
        SEAM(pb + 6);
        if ((EN(9) && IN(pb + 7)) || (EN(10) && IN(pb + 8))) {
            Frame P = fresh(F); const int l = fresh_i(l0);
            expert_prefix(P, l, tb, cnts, 1, true);
            __syncthreads();
        }
        if (EN(9) && IN(pb + 7)) _Pragma("unroll 1") for (int rp = 0; rp < REP_MOE; ++rp) {
            Frame P = fresh(F); const int l = fresh_i(l0);
            pg8::MoeOrder S{tb, tb[32], 3, P.G, P.bid};
            EpiMoe1 E{(bf16_t*)(P.ws + WS_ACT), inp_ptr(P, 22) + (size_t)l * 32 * 2048};
            pg8::RowGather AO{(const int*)(P.ws + WS_LIST), cnts};
            pg8::gemm_phase(P.lds, (const bf16_t*)(P.ws + WS_H), (const bf16_t*)(P.ws + WS_WGU) + (size_t)l * 32 * 2048 * 1024, 1024, (size_t)2048 * 1024 * 2, S, E, AO, P.tid);
        }
        SEAM(pb + 7);
        if (EN(10) && IN(pb + 8)) _Pragma("unroll 1") for (int rp = 0; rp < REP_MOE; ++rp) {
            Frame P = fresh(F); const int l = fresh_i(l0);
            pg8::MoeOrder S{tb, tb[32], 2, P.G, P.bid};
            EpiMoe2 E{(bf16_t*)(P.ws + WS_YS), inp_ptr(P, 24) + (size_t)l * 32 * 1024};
            pg8::gemm_phase(P.lds, (const bf16_t*)(P.ws + WS_ACT), (const bf16_t*)(P.ws + WS_WD) + (size_t)l * 32 * 1024 * 1024, 1024, (size_t)1024 * 1024 * 2, S, E, pg8::RowIdentity{}, P.tid);
        }
        SEAM(pb + 8);
    }
    if (EN(11) && IN(41)) { Frame P = fresh(F); phase_norm1<2>(P, fresh_i(4)); }
#undef IN
#undef SEAM
}

typedef void (*kern_t)(Args);
static int phase_bit(int p) {
    if (p == 0) return 0; if (p == 41) return 11;
    const int l = (p - 1) / 10, k = (p - 1) % 10; const bool rec = (l & 1) == 0;
    switch (k) { case 0: return 1; case 1: return rec ? 2 : 5; case 2: return rec ? 3 : 6; case 3: return rec ? 3 : -1; case 4: return rec ? 4 : -1; case 5: return 7; case 6: return 8; case 7: return 9; case 8: return 10; default: return -1; }
}
extern "C" void kernel_launch(void* const* d_in, const int* in_sizes, int n_in, void* d_out, int out_size, void* d_ws, size_t ws_size, hipStream_t stream) {
    static int grid = 0;
#if MK_ONE_LAUNCH
    #ifndef ONE_MASK
#define ONE_MASK 0xfff
#endif
    static const kern_t kerns[1] = { mk_fwd<ONE_MASK> };
    const int nk = 1;
#else
    static const kern_t kerns[12] = { mk_fwd<1>, mk_fwd<2>, mk_fwd<4>, mk_fwd<8>, mk_fwd<16>, mk_fwd<32>, mk_fwd<64>, mk_fwd<128>, mk_fwd<256>, mk_fwd<512>, mk_fwd<1024>, mk_fwd<2048> };
    const int nk = 12;
#endif
    if (grid == 0) {
        if (n_in != 25 || out_size != RL * D || ws_size < WS_END) { fprintf(stderr, "kernel_launch: unexpected shapes (n_in %d out %d ws %zu)\n", n_in, out_size, ws_size); grid = -1; return; }
        int dev = 0, cus = 0;
        if (hipGetDevice(&dev) != hipSuccess || hipDeviceGetAttribute(&cus, hipDeviceAttributeMultiprocessorCount, dev) != hipSuccess) { grid = -1; return; }
        for (int i = 0; i < nk; ++i)
            if (hipFuncSetAttribute((const void*)kerns[i], hipFuncAttributeMaxDynamicSharedMemorySize, LDS_BYTES) != hipSuccess) { fprintf(stderr, "kernel_launch: hipFuncSetAttribute failed\n"); grid = -1; return; }
        (void)hipGetLastError();
        grid = cus;
    }
    if (grid < 0) return;
    (void)hipMemsetAsync((char*)d_ws + WS_CTL, 0, CTL_BYTES, stream);
    Args a{};
    for (int i = 0; i < 25; ++i) a.in[i] = (const float*)d_in[i];
    a.out = (float*)d_out; a.ws = (unsigned char*)d_ws;
#if MK_ONE_LAUNCH
    a.ph_lo = 0; a.ph_hi = NPHASE;
    hipLaunchKernelGGL(kerns[0], dim3(grid), dim3(512), LDS_BYTES, stream, a);
#else
    for (int p = 0; p < NPHASE; ++p) {
        const int bit = phase_bit(p); if (bit < 0) continue;
        a.ph_lo = p; a.ph_hi = p + 1;
        hipLaunchKernelGGL(kerns[bit], dim3(grid), dim3(512), LDS_BYTES, stream, a);
    }
#endif
}
```
